# Optimizing an MI355X kernel written in HIP

```python
import math
import jax
import jax.numpy as jnp
from jax import lax
import numpy as np

D_MODEL = 1024
BATCH = 8
SEQ = 4096
DEPTH = 4

N_MIXERS = 2
N_EVEN_LAYERS = (DEPTH + 1) // 2
N_ODD_LAYERS = DEPTH // 2

MLSTM_HEADS = 4
MLSTM_DV = D_MODEL // MLSTM_HEADS
MLSTM_DQK = MLSTM_DV // 2
MLSTM_QK_WIDTH = 2 * MLSTM_HEADS * MLSTM_DQK
MLSTM_V_WIDTH = MLSTM_HEADS * MLSTM_DV
MLSTM_PROJ = MLSTM_QK_WIDTH + 2 * MLSTM_V_WIDTH + 2 * MLSTM_HEADS
MLSTM_CHUNK = 64
CONV_WIDTH = 4
FGATE_BIAS_LO = 3.0
FGATE_BIAS_HI = 6.0

DIFF_HEADS = 8
DIFF_HEAD_DIM = D_MODEL // (2 * DIFF_HEADS)
DIFF_V_DIM = 2 * DIFF_HEAD_DIM
DIFF_QK_WIDTH = 2 * DIFF_HEADS * DIFF_HEAD_DIM
DIFF_PROJ = 2 * DIFF_QK_WIDTH + DIFF_HEADS * DIFF_V_DIM
Q_BLOCK = 128

NUM_BUCKETS = 32
REL_MAX_DISTANCE = 128

D_FF = 3584
N_EXPERTS = 8
TOP_K = 2
MOE_BLOCK = 256

NORM_EPS = 1e-6
SUBLN_EPS = 1e-5

kernel_name = 'mlstm_diffattn_moe_hybrid'


def rms_norm(x, w, eps=NORM_EPS):
    xf = x.astype(jnp.float32)
    y = xf * lax.rsqrt(jnp.mean(xf * xf, axis=-1, keepdims=True) + eps)
    return (y * w.astype(jnp.float32)).astype(x.dtype)


def swiglu(h, w_gate, w_up, w_down):
    return (jax.nn.silu(h @ w_gate) * (h @ w_up)) @ w_down


def causal_depthwise_conv(x, w, b):
    c = x.shape[-1]
    y = lax.conv_general_dilated(
        x, w.reshape(CONV_WIDTH, 1, c).astype(x.dtype), window_strides=(1,),
        padding=[(CONV_WIDTH - 1, 0)], dimension_numbers=('NWC', 'WIO', 'NWC'),
        feature_group_count=c)
    return y + b.astype(x.dtype)


def _mlstm_chunk_step(carry, inp):
    c_mem, n_mem, m_prev = carry
    q, k, v, log_i, log_f = inp
    L = q.shape[2]
    b = jnp.cumsum(log_f, axis=-1)
    causal = jnp.tril(jnp.ones((L, L), dtype=bool))
    log_d = jnp.where(causal, b[..., :, None] - b[..., None, :] + log_i[..., None, :], -jnp.inf)
    log_inter = b + m_prev[..., None]
    m_t = jnp.maximum(log_inter, jnp.max(log_d, axis=-1))
    s = jnp.einsum('bhtd,bhsd->bhts', q, k) * jnp.exp(log_d - m_t[..., None])
    inter = jnp.exp(log_inter - m_t)
    num = jnp.einsum('bhts,bhsv->bhtv', s, v) + inter[..., None] * jnp.einsum('bhtd,bhdv->bhtv', q, c_mem)
    den = jnp.sum(s, axis=-1) + inter * jnp.einsum('bhtd,bhd->bht', q, n_mem)
    h = num / jnp.maximum(jnp.abs(den), jnp.exp(-m_t))[..., None]
    g = b[..., -1]
    log_w = g[..., None] - b + log_i
    m_new = jnp.maximum(g + m_prev, jnp.max(log_w, axis=-1))
    kw = k * jnp.exp(log_w - m_new[..., None])[..., None]
    decay = jnp.exp(g + m_prev - m_new)
    c_new = decay[..., None, None] * c_mem + jnp.einsum('bhsd,bhsv->bhdv', kw, v)
    n_new = decay[..., None] * n_mem + jnp.sum(kw, axis=2)
    return (c_new, n_new, m_new), h


def mlstm_chunkwise(q, k, v, log_i, log_f):
    B, S, H, DK = q.shape
    DV = v.shape[-1]
    L = MLSTM_CHUNK
    nc = S // L

    def to_chunks(t):
        return t.reshape(B, nc, L, H, t.shape[-1]).transpose(1, 0, 3, 2, 4)

    def gate_chunks(t):
        return t.reshape(B, nc, L, H).transpose(1, 0, 3, 2)

    init = (jnp.zeros((B, H, DK, DV), jnp.float32), jnp.zeros((B, H, DK), jnp.float32),
            jnp.zeros((B, H), jnp.float32))
    _, hs = lax.scan(_mlstm_chunk_step, init,
                     (to_chunks(q), to_chunks(k), to_chunks(v), gate_chunks(log_i), gate_chunks(log_f)))
    return hs.transpose(1, 0, 3, 2, 4).reshape(B, S, H, DV)


def mlstm_mixer(h, w_in, conv_w, conv_b, b_igate, b_fgate, head_norm, w_out):
    B, S, _ = h.shape
    proj = h @ w_in
    o1 = MLSTM_QK_WIDTH
    o2 = o1 + MLSTM_V_WIDTH
    o3 = o2 + MLSTM_V_WIDTH
    o4 = o3 + MLSTM_HEADS
    qk = jax.nn.silu(causal_depthwise_conv(proj[..., :o1], conv_w, conv_b))
    q = qk[..., :o1 // 2].reshape(B, S, MLSTM_HEADS, MLSTM_DQK).astype(jnp.float32)
    k = qk[..., o1 // 2:].reshape(B, S, MLSTM_HEADS, MLSTM_DQK).astype(jnp.float32) * (MLSTM_DQK ** -0.5)
    v = proj[..., o1:o2].reshape(B, S, MLSTM_HEADS, MLSTM_DV).astype(jnp.float32)
    o_gate = jax.nn.sigmoid(proj[..., o2:o3])
    log_i = (proj[..., o3:o4] + b_igate).astype(jnp.float32)
    log_f = jax.nn.log_sigmoid((proj[..., o4:] + b_fgate).astype(jnp.float32))
    hh = mlstm_chunkwise(q, k, v, log_i, log_f)
    hh = rms_norm(hh, head_norm.reshape(MLSTM_HEADS, MLSTM_DV)).astype(h.dtype)
    return (o_gate * hh.reshape(B, S, MLSTM_V_WIDTH)) @ w_out


def t5_causal_bucket(rel):
    n = jnp.maximum(rel, 0)
    max_exact = NUM_BUCKETS // 2
    nf = jnp.maximum(n, 1).astype(jnp.float32)
    large = max_exact + (jnp.log(nf / max_exact) / math.log(REL_MAX_DISTANCE / max_exact)
                         * (NUM_BUCKETS - max_exact)).astype(jnp.int32)
    large = jnp.minimum(large, NUM_BUCKETS - 1)
    return jnp.where(n < max_exact, n, large)


def diff_attention(h, w_in, lam_q1, lam_k1, lam_q2, lam_k2, subln, w_out, rel_table, layer_idx):
    B, S, _ = h.shape
    proj = h @ w_in
    q = proj[..., :DIFF_QK_WIDTH].reshape(B, S, 2 * DIFF_HEADS, DIFF_HEAD_DIM).transpose(0, 2, 1, 3)
    k = proj[..., DIFF_QK_WIDTH:2 * DIFF_QK_WIDTH].reshape(B, S, 2 * DIFF_HEADS, DIFF_HEAD_DIM).transpose(0, 2, 1, 3)
    v = proj[..., 2 * DIFF_QK_WIDTH:].reshape(B, S, DIFF_HEADS, DIFF_V_DIM).transpose(0, 2, 1, 3)
    lam_init = 0.8 - 0.6 * math.exp(-0.3 * layer_idx)
    lam = (jnp.exp(jnp.sum(lam_q1.astype(jnp.float32) * lam_k1.astype(jnp.float32)))
           - jnp.exp(jnp.sum(lam_q2.astype(jnp.float32) * lam_k2.astype(jnp.float32))) + lam_init)
    scale = DIFF_HEAD_DIM ** -0.5
    outs = []
    for j in range(S // Q_BLOCK):
        q0 = j * Q_BLOCK
        kv_len = q0 + Q_BLOCK
        qpos = q0 + jnp.arange(Q_BLOCK, dtype=jnp.int32)
        kpos = jnp.arange(kv_len, dtype=jnp.int32)
        rel = qpos[:, None] - kpos[None, :]
        bias = rel_table[t5_causal_bucket(rel)].astype(jnp.float32).transpose(2, 0, 1)
        logits = jnp.einsum('bmqd,bmkd->bmqk', q[:, :, q0:kv_len], k[:, :, :kv_len]).astype(jnp.float32) * scale + bias
        logits = jnp.where(rel[None, None] >= 0, logits, -jnp.inf)
        p = jax.nn.softmax(logits, axis=-1).reshape(B, DIFF_HEADS, 2, Q_BLOCK, kv_len)
        a = p[:, :, 0] - lam * p[:, :, 1]
        outs.append(jnp.einsum('bhqk,bhkv->bhqv', a.astype(v.dtype), v[:, :, :kv_len]))
    o = jnp.concatenate(outs, axis=2)
    o = rms_norm(o, subln, SUBLN_EPS) * (1.0 - lam_init)
    return o.transpose(0, 2, 1, 3).reshape(B, S, DIFF_HEADS * DIFF_V_DIM) @ w_out


def moe_swiglu(h, w_router, b_router, w_gate, w_up, w_down):
    B, S, D = h.shape
    xt = h.reshape(B * S, D)
    n_assign = B * S * TOP_K
    logits = (xt @ w_router).astype(jnp.float32) + b_router.astype(jnp.float32)
    top_logit, top_expert = lax.top_k(logits, TOP_K)
    gates = jax.nn.softmax(top_logit, axis=-1)
    expert_flat = top_expert.reshape(-1).astype(jnp.int32)
    gate_flat = gates.reshape(-1)
    order = jnp.argsort(expert_flat * n_assign + jnp.arange(n_assign, dtype=jnp.int32))
    expert_sorted = expert_flat[order]
    token_sorted = (order // TOP_K).astype(jnp.int32)
    counts = jnp.bincount(expert_flat, length=N_EXPERTS)
    padded = (counts + MOE_BLOCK - 1) // MOE_BLOCK * MOE_BLOCK
    pad_end = jnp.cumsum(padded)
    pad_start = pad_end - padded
    raw_start = jnp.cumsum(counts) - counts
    slot = pad_start[expert_sorted] + jnp.arange(n_assign, dtype=jnp.int32) - raw_start[expert_sorted]
    n_blocks = -(-n_assign // MOE_BLOCK) + N_EXPERTS
    n_slots = n_blocks * MOE_BLOCK
    slot_token = jnp.zeros((n_slots,), jnp.int32).at[slot].set(token_sorted)
    slot_gate = jnp.zeros((n_slots,), jnp.float32).at[slot].set(gate_flat[order])
    block_expert = jnp.minimum(
        jnp.searchsorted(pad_end, jnp.arange(n_blocks, dtype=pad_end.dtype) * MOE_BLOCK, side='right'),
        N_EXPERTS - 1)
    xs = xt[slot_token].reshape(n_blocks, MOE_BLOCK, D)

    def expert_block(args):
        xb, e = args
        return swiglu(xb, w_gate[e], w_up[e], w_down[e])

    ys = lax.map(expert_block, (xs, block_expert)).reshape(n_slots, D)
    out = jnp.zeros_like(xt).at[slot_token].add(ys * slot_gate[:, None].astype(ys.dtype))
    return out.reshape(B, S, D)


def setup_inputs(seed: int = 0) -> dict:
    key = jax.random.key(seed)
    ks = iter(jax.random.split(key, 48))

    def nrm(shape, scale):
        return jax.random.normal(next(ks), shape, jnp.float32) * scale

    na, nb, d = N_EVEN_LAYERS, N_ODD_LAYERS, D_MODEL
    return {
        'x': nrm((BATCH, SEQ, d), 1.0),
        'rel_bias_table': nrm((NUM_BUCKETS, 2 * DIFF_HEADS), 0.5),
        'mlstm_norm': 1.0 + nrm((na, d), 0.05),
        'mlstm_w_in': nrm((na, d, MLSTM_PROJ), d ** -0.5),
        'mlstm_conv_w': nrm((na, CONV_WIDTH, MLSTM_QK_WIDTH), CONV_WIDTH ** -0.5),
        'mlstm_conv_b': nrm((na, MLSTM_QK_WIDTH), 0.02),
        'mlstm_b_igate': nrm((na, MLSTM_HEADS), 0.1),
        'mlstm_b_fgate': jnp.linspace(FGATE_BIAS_LO, FGATE_BIAS_HI, MLSTM_HEADS)[None, :] + nrm((na, MLSTM_HEADS), 0.1),
        'mlstm_head_norm': 1.0 + nrm((na, MLSTM_V_WIDTH), 0.05),
        'mlstm_w_out': nrm((na, MLSTM_V_WIDTH, d), MLSTM_V_WIDTH ** -0.5),
        'diff_norm': 1.0 + nrm((nb, d), 0.05),
        'diff_w_in': nrm((nb, d, DIFF_PROJ), d ** -0.5),
        'diff_lambda_q1': nrm((nb, DIFF_HEAD_DIM), 0.1),
        'diff_lambda_k1': nrm((nb, DIFF_HEAD_DIM), 0.1),
        'diff_lambda_q2': nrm((nb, DIFF_HEAD_DIM), 0.1),
        'diff_lambda_k2': nrm((nb, DIFF_HEAD_DIM), 0.1),
        'diff_subln': 1.0 + nrm((nb, DIFF_V_DIM), 0.05),
        'diff_w_out': nrm((nb, DIFF_HEADS * DIFF_V_DIM, d), (DIFF_HEADS * DIFF_V_DIM) ** -0.5),
        'ffn_norm': 1.0 + nrm((na, d), 0.05),
        'ffn_w_gate': nrm((na, d, D_FF), d ** -0.5),
        'ffn_w_up': nrm((na, d, D_FF), d ** -0.5),
        'ffn_w_down': nrm((na, D_FF, d), D_FF ** -0.5),
        'moe_norm': 1.0 + nrm((nb, d), 0.05),
        'moe_w_router': nrm((nb, d, N_EXPERTS), d ** -0.5),
        'moe_b_router': nrm((nb, N_EXPERTS), 0.01),
        'moe_w_gate': nrm((nb, N_EXPERTS, d, D_FF), d ** -0.5),
        'moe_w_up': nrm((nb, N_EXPERTS, d, D_FF), d ** -0.5),
        'moe_w_down': nrm((nb, N_EXPERTS, D_FF, d), D_FF ** -0.5),
        'final_norm': 1.0 + nrm((d,), 0.05),
    }


def reference(x, rel_bias_table,
              mlstm_norm, mlstm_w_in, mlstm_conv_w, mlstm_conv_b, mlstm_b_igate, mlstm_b_fgate,
              mlstm_head_norm, mlstm_w_out,
              diff_norm, diff_w_in, diff_lambda_q1, diff_lambda_k1, diff_lambda_q2, diff_lambda_k2,
              diff_subln, diff_w_out,
              ffn_norm, ffn_w_gate, ffn_w_up, ffn_w_down,
              moe_norm, moe_w_router, moe_b_router, moe_w_gate, moe_w_up, moe_w_down,
              final_norm):
    for i in range(DEPTH):
        s = i // 2
        if i % N_MIXERS == 0:
            x = x + mlstm_mixer(rms_norm(x, mlstm_norm[s]), mlstm_w_in[s], mlstm_conv_w[s], mlstm_conv_b[s],
                                mlstm_b_igate[s], mlstm_b_fgate[s], mlstm_head_norm[s], mlstm_w_out[s])
            x = x + swiglu(rms_norm(x, ffn_norm[s]), ffn_w_gate[s], ffn_w_up[s], ffn_w_down[s])
        else:
            x = x + diff_attention(rms_norm(x, diff_norm[s]), diff_w_in[s], diff_lambda_q1[s], diff_lambda_k1[s],
                                   diff_lambda_q2[s], diff_lambda_k2[s], diff_subln[s], diff_w_out[s],
                                   rel_bias_table, i)
            x = x + moe_swiglu(rms_norm(x, moe_norm[s]), moe_w_router[s], moe_b_router[s],
                               moe_w_gate[s], moe_w_up[s], moe_w_down[s])
    return rms_norm(x, final_norm)
```

```cpp
#include <hip/hip_runtime.h>
#include <cstdio>
#include <cstdint>
#include <cmath>
namespace nv {
constexpr int B = 8, S = 4096, D = 1024, M = B * S;
constexpr int MPROJ = 3080, APROJ = 3072, FF = 3584, NE = 8;
constexpr int NBLK = 264, NSLOT = NBLK * 256;
typedef float f32x16 __attribute__((ext_vector_type(16)));

__device__ __forceinline__ float wsum(float v) {
#pragma unroll
    for (int o = 32; o >= 1; o >>= 1) v += __shfl_xor(v, o);
    return v;
}
__device__ __forceinline__ float wmax(float v) {
#pragma unroll
    for (int o = 32; o >= 1; o >>= 1) v = fmaxf(v, __shfl_xor(v, o));
    return v;
}

__global__ void __launch_bounds__(256) k_rmsnorm(const float* x, const float* __restrict__ w, float* out, int rows, float eps) {
    const int wave = threadIdx.x >> 6, lane = threadIdx.x & 63;
    const int row = blockIdx.x * 4 + wave;
    if (row >= rows) return;
    const float4* xr = (const float4*)(x + (size_t)row * D);
    float4 v[4]; float ss = 0.f;
#pragma unroll
    for (int j = 0; j < 4; ++j) { v[j] = xr[lane + 64 * j]; ss += v[j].x * v[j].x + v[j].y * v[j].y + v[j].z * v[j].z + v[j].w * v[j].w; }
    ss = wsum(ss);
    const float r = rsqrtf(ss * (1.f / D) + eps);
    float4* o = (float4*)(out + (size_t)row * D);
#pragma unroll
    for (int j = 0; j < 4; ++j) { const float4 ww = ((const float4*)w)[lane + 64 * j]; float4 t; t.x = v[j].x * r * ww.x; t.y = v[j].y * r * ww.y; t.z = v[j].z * r * ww.z; t.w = v[j].w * r * ww.w; o[lane + 64 * j] = t; }
}

struct NG {
    const float* A; const int* rowidx; const float* W; const float* W2; float* C;
    const int* blk_expert; const int* n_used; long long wstride;
    int lda, ldw, ldc, M, N, K, mode, blk0;
};
template <int DUAL>
__global__ void __launch_bounds__(256) k_gemm(NG g) {
    __shared__ float As[16][132];
    __shared__ float Bs[16][132];
    __shared__ float Bs2[DUAL ? 16 : 1][132];
    const int t = threadIdx.x, lane = t & 63, w = t >> 6, wm = w >> 1, wn = w & 1;
    const int m0 = blockIdx.y * 128, n0 = blockIdx.x * 128;
    const float* W = g.W; const float* W2 = g.W2;
    if (g.blk_expert) {
        const int blk = g.blk0 + m0 / 256;
        if (blk >= *g.n_used) return;
        const int e = g.blk_expert[blk];
        W += (size_t)e * g.wstride; if (DUAL) W2 += (size_t)e * g.wstride;
    }
    f32x16 acc[2][2], acc2[2][2];
#pragma unroll
    for (int i = 0; i < 2; ++i)
#pragma unroll
        for (int j = 0; j < 2; ++j) { acc[i][j] = f32x16{}; acc2[i][j] = f32x16{}; }
    const int ar = t >> 1, akq = (t & 1) * 8;
    long long asrc = g.rowidx ? (long long)g.rowidx[m0 + ar] : (long long)(m0 + ar);
    const float* ap = (asrc >= 0) ? g.A + (size_t)asrc * g.lda + akq : nullptr;
    for (int k0 = 0; k0 < g.K; k0 += 16) {
        float4 a0 = make_float4(0.f, 0.f, 0.f, 0.f), a1 = a0;
        if (ap) { a0 = *(const float4*)(ap + k0); a1 = *(const float4*)(ap + k0 + 4); }
        As[akq + 0][ar] = a0.x; As[akq + 1][ar] = a0.y; As[akq + 2][ar] = a0.z; As[akq + 3][ar] = a0.w;
        As[akq + 4][ar] = a1.x; As[akq + 5][ar] = a1.y; As[akq + 6][ar] = a1.z; As[akq + 7][ar] = a1.w;
#pragma unroll
        for (int i = 0; i < 2; ++i) {
            const int k = (t >> 5) + 8 * i, c = (t & 31) * 4, col = n0 + c;
            float4 b = make_float4(0.f, 0.f, 0.f, 0.f);
            if (col < g.N) b = *(const float4*)(W + (size_t)(k0 + k) * g.ldw + col);
            Bs[k][c] = b.x; Bs[k][c + 1] = b.y; Bs[k][c + 2] = b.z; Bs[k][c + 3] = b.w;
            if (DUAL) {
                float4 b2 = make_float4(0.f, 0.f, 0.f, 0.f);
                if (col < g.N) b2 = *(const float4*)(W2 + (size_t)(k0 + k) * g.ldw + col);
                Bs2[k][c] = b2.x; Bs2[k][c + 1] = b2.y; Bs2[k][c + 2] = b2.z; Bs2[k][c + 3] = b2.w;
            }
        }
        __syncthreads();
#pragma unroll
        for (int kk = 0; kk < 8; ++kk) {
            const int kl = 2 * kk + (lane >> 5);
            float a[2], b[2], b2[2];
#pragma unroll
            for (int i = 0; i < 2; ++i) { a[i] = As[kl][wm * 64 + i * 32 + (lane & 31)]; b[i] = Bs[kl][wn * 64 + i * 32 + (lane & 31)]; if (DUAL) b2[i] = Bs2[kl][wn * 64 + i * 32 + (lane & 31)]; }
#pragma unroll
            for (int i = 0; i < 2; ++i)
#pragma unroll
                for (int j = 0; j < 2; ++j) {
                    acc[i][j] = __builtin_amdgcn_mfma_f32_32x32x2f32(a[i], b[j], acc[i][j], 0, 0, 0);
                    if (DUAL) acc2[i][j] = __builtin_amdgcn_mfma_f32_32x32x2f32(a[i], b2[j], acc2[i][j], 0, 0, 0);
                }
        }
        __syncthreads();
    }
#pragma unroll
    for (int i = 0; i < 2; ++i)
#pragma unroll
        for (int j = 0; j < 2; ++j) {
            const int col = n0 + wn * 64 + j * 32 + (lane & 31);
            if (col >= g.N) continue;
#pragma unroll
            for (int r = 0; r < 16; ++r) {
                const int row = m0 + wm * 64 + i * 32 + (r & 3) + 8 * (r >> 2) + 4 * (lane >> 5);
                float* cp = g.C + (size_t)row * g.ldc + col;
                const float v = acc[i][j][r];
                if (g.mode == 0) *cp = v;
                else if (g.mode == 1) *cp += v;
                else { const float u = DUAL ? acc2[i][j][r] : 0.f; *cp = v / (1.f + __expf(-v)) * u; }
            }
        }
}

__global__ void __launch_bounds__(256) k_router(const float* __restrict__ xn, const float* __restrict__ wr, const float* __restrict__ br, int* __restrict__ top_e, float* __restrict__ top_g) {
    const int wave = threadIdx.x >> 6, lane = threadIdx.x & 63;
    const int row = blockIdx.x * 4 + wave;
    const float4* xr = (const float4*)(xn + (size_t)row * D);
    float acc[8];
#pragma unroll
    for (int e = 0; e < 8; ++e) acc[e] = 0.f;
#pragma unroll
    for (int j = 0; j < 4; ++j) {
        const float4 v = xr[lane + 64 * j]; const float xv[4] = {v.x, v.y, v.z, v.w};
#pragma unroll
        for (int i = 0; i < 4; ++i) {
            const int k = (lane + 64 * j) * 4 + i;
            const float4 w0 = *(const float4*)(wr + (size_t)k * 8), w1 = *(const float4*)(wr + (size_t)k * 8 + 4);
            acc[0] += xv[i] * w0.x; acc[1] += xv[i] * w0.y; acc[2] += xv[i] * w0.z; acc[3] += xv[i] * w0.w;
            acc[4] += xv[i] * w1.x; acc[5] += xv[i] * w1.y; acc[6] += xv[i] * w1.z; acc[7] += xv[i] * w1.w;
        }
    }
#pragma unroll
    for (int e = 0; e < 8; ++e) acc[e] = wsum(acc[e]) + br[e];
    if (lane == 0) {
        int e0 = 0; float l0 = acc[0];
#pragma unroll
        for (int e = 1; e < 8; ++e) if (acc[e] > l0) { l0 = acc[e]; e0 = e; }
        int e1 = -1; float l1 = -INFINITY;
#pragma unroll
        for (int e = 0; e < 8; ++e) if (e != e0 && acc[e] > l1) { l1 = acc[e]; e1 = e; }
        const float ex = __expf(l1 - l0), g0 = 1.f / (1.f + ex), g1 = ex / (1.f + ex);
        top_e[row * 2] = e0; top_e[row * 2 + 1] = e1; top_g[row * 2] = g0; top_g[row * 2 + 1] = g1;
    }
}
__global__ void __launch_bounds__(1024) k_assign(const int* __restrict__ top_e, const float* __restrict__ top_g, int* __restrict__ slot_token, float* __restrict__ slot_gate,
                                                 int* __restrict__ tok_slot, int* __restrict__ blk_expert, int* __restrict__ n_used) {
    __shared__ int sc[8][1024];
    __shared__ int tot[8], pstart[8];
    const int t = threadIdx.x, lane = t & 63, w = t >> 6;
    for (int i = t; i < NSLOT; i += 1024) { slot_token[i] = -1; slot_gate[i] = 0.f; }
    int c[8];
#pragma unroll
    for (int e = 0; e < 8; ++e) c[e] = 0;
    for (int i = 0; i < 64; ++i) { const int e = top_e[t * 64 + i];
#pragma unroll
        for (int q = 0; q < 8; ++q) c[q] += (e == q) ? 1 : 0; }
#pragma unroll
    for (int e = 0; e < 8; ++e) sc[e][t] = c[e];
    __syncthreads();
    if (w < 8) {
        int loc[16], s = 0;
#pragma unroll
        for (int i = 0; i < 16; ++i) { loc[i] = sc[w][lane * 16 + i]; s += loc[i]; }
        int inc = s;
#pragma unroll
        for (int o = 1; o < 64; o <<= 1) { const int v = __shfl_up(inc, o); if (lane >= o) inc += v; }
        int run = inc - s;
#pragma unroll
        for (int i = 0; i < 16; ++i) { sc[w][lane * 16 + i] = run; run += loc[i]; }
        if (lane == 63) tot[w] = inc;
    }
    __syncthreads();
    if (t == 0) {
        int acc = 0;
        for (int e = 0; e < 8; ++e) { pstart[e] = acc; acc += (tot[e] + 255) / 256 * 256; }
        const int nb = acc / 256; *n_used = nb;
        int e = 0;
        for (int b = 0; b < NBLK; ++b) {
            while (e < 7 && b * 256 >= pstart[e] + (tot[e] + 255) / 256 * 256) ++e;
            blk_expert[b] = e;
        }
    }
    __syncthreads();
    int run[8];
#pragma unroll
    for (int e = 0; e < 8; ++e) run[e] = pstart[e] + sc[e][t];
    for (int i = 0; i < 64; ++i) {
        const int a = t * 64 + i, e = top_e[a];
        int slot = 0;
#pragma unroll
        for (int q = 0; q < 8; ++q) if (e == q) { slot = run[q]; run[q]++; }
        slot_token[slot] = a >> 1; slot_gate[slot] = top_g[a]; tok_slot[a] = slot;
    }
}
__global__ void __launch_bounds__(256) k_combine(float* __restrict__ x, const float* __restrict__ Y, const int* __restrict__ tok_slot, const float* __restrict__ top_g) {
    const int row = blockIdx.x, t = threadIdx.x;
    const int s0 = tok_slot[row * 2], s1 = tok_slot[row * 2 + 1]; const float g0 = top_g[row * 2], g1 = top_g[row * 2 + 1];
    float4* xp = (float4*)(x + (size_t)row * D) + t; const float4 a = ((const float4*)(Y + (size_t)s0 * D))[t], b = ((const float4*)(Y + (size_t)s1 * D))[t];
    float4 v = *xp; v.x += g0 * a.x + g1 * b.x; v.y += g0 * a.y + g1 * b.y; v.z += g0 * a.z + g1 * b.z; v.w += g0 * a.w + g1 * b.w; *xp = v;
}

__global__ void __launch_bounds__(256) k_mlstm_prep(const float* __restrict__ P, const float* __restrict__ cw, const float* __restrict__ cb, const float* __restrict__ bi, const float* __restrict__ bf,
                                                    float* __restrict__ QK, float* __restrict__ LI, float* __restrict__ LF) {
    const int row = blockIdx.x, t = threadIdx.x, tt = row % S;
#pragma unroll
    for (int i = 0; i < 4; ++i) {
        const int c = t + 256 * i;
        float y = cb[c];
#pragma unroll
        for (int j = 0; j < 4; ++j) { const int ts = tt - 3 + j; if (ts >= 0) y += cw[j * 1024 + c] * P[(size_t)(row - 3 + j) * MPROJ + c]; }
        float s = y / (1.f + __expf(-y));
        if (c >= 512) s *= 0.08838834764831845f;
        QK[(size_t)row * 1024 + c] = s;
    }
    if (t < 4) LI[row * 4 + t] = P[(size_t)row * MPROJ + 3072 + t] + bi[t];
    else if (t < 8) { const int h = t - 4; const float z = P[(size_t)row * MPROJ + 3076 + h] + bf[h]; LF[row * 4 + h] = fminf(z, 0.f) - log1pf(__expf(-fabsf(z))); }
}
__global__ void __launch_bounds__(256) k_mlstm_rec(const float* __restrict__ QK, const float* __restrict__ P, const float* __restrict__ LI, const float* __restrict__ LF, float* __restrict__ HH) {
    __shared__ float qs[128], ks[128], part[8][32], red[2];
    const int tid = threadIdx.x, dv = tid & 31, kg = tid >> 5, lane = tid & 63;
    const int bh = blockIdx.x >> 3, sl = blockIdx.x & 7, b = bh >> 2, h = bh & 3, dv0 = sl * 32;
    float C[16];
#pragma unroll
    for (int j = 0; j < 16; ++j) C[j] = 0.f;
    float n = 0.f, m = 0.f;
    for (int t = 0; t < S; ++t) {
        const size_t row = (size_t)b * S + t;
        if (tid < 128) { qs[tid] = QK[row * 1024 + h * 128 + tid]; ks[tid] = QK[row * 1024 + 512 + h * 128 + tid]; }
        const float v = P[row * MPROJ + 1024 + h * 256 + dv0 + dv];
        const float li = LI[row * 4 + h], lf = LF[row * 4 + h];
        const float mn = fmaxf(lf + m, li), fp = __expf(lf + m - mn), ip = __expf(li - mn); m = mn;
        __syncthreads();
        float pn = 0.f;
#pragma unroll
        for (int j = 0; j < 16; ++j) { C[j] = fp * C[j] + ip * ks[kg * 16 + j] * v; pn += C[j] * qs[kg * 16 + j]; }
        part[kg][dv] = pn;
        if (tid < 128) { n = fp * n + ip * ks[tid]; const float d = wsum(n * qs[tid]); if (lane == 0) red[tid >> 6] = d; }
        __syncthreads();
        if (tid < 32) {
            float num = 0.f;
#pragma unroll
            for (int g = 0; g < 8; ++g) num += part[g][tid];
            const float den = red[0] + red[1];
            HH[row * 1024 + h * 256 + dv0 + tid] = num / fmaxf(fabsf(den), __expf(-m));
        }
        __syncthreads();
    }
}
__global__ void __launch_bounds__(256) k_mlstm_post(const float* __restrict__ HH, const float* __restrict__ P, const float* __restrict__ hn, float* __restrict__ G) {
    const int wave = threadIdx.x >> 6, lane = threadIdx.x & 63;
    const int row = blockIdx.x, h = wave;
    const float4 v = ((const float4*)(HH + (size_t)row * 1024 + h * 256))[lane];
    const float ss = wsum(v.x * v.x + v.y * v.y + v.z * v.z + v.w * v.w);
    const float r = rsqrtf(ss * (1.f / 256.f) + 1e-6f);
    const float4 w = ((const float4*)(hn + h * 256))[lane], o = ((const float4*)(P + (size_t)row * MPROJ + 2048 + h * 256))[lane];
    float4 g;
    g.x = v.x * r * w.x / (1.f + __expf(-o.x)); g.y = v.y * r * w.y / (1.f + __expf(-o.y)); g.z = v.z * r * w.z / (1.f + __expf(-o.z)); g.w = v.w * r * w.w / (1.f + __expf(-o.w));
    ((float4*)(G + (size_t)row * 1024 + h * 256))[lane] = g;
}

__device__ const int BUCKET[128] = {0, 1, 2, 3, 4, 5, 6, 7, 8, 9, 10, 11, 12, 13, 14, 15, 16, 16, 16, 17, 17, 18, 18, 18, 19, 19, 19, 20, 20, 20, 20, 21, 21, 21, 21, 22, 22, 22, 22, 22, 23, 23, 23, 23, 23, 23, 24, 24, 24, 24, 24, 24, 25, 25, 25, 25, 25, 25, 25, 26, 26, 26, 26, 26, 26, 26, 26, 27, 27, 27, 27, 27, 27, 27, 27, 27, 27, 28, 28, 28, 28, 28, 28, 28, 28, 28, 28, 29, 29, 29, 29, 29, 29, 29, 29, 29, 29, 29, 29, 30, 30, 30, 30, 30, 30, 30, 30, 30, 30, 30, 30, 30, 30, 31, 31, 31, 31, 31, 31, 31, 31, 31, 31, 31, 31, 31, 31, 31};
__global__ void __launch_bounds__(128) k_attn(const float* __restrict__ P, const float* __restrict__ rel, const float* __restrict__ lq1, const float* __restrict__ lk1, const float* __restrict__ lq2,
                                              const float* __restrict__ lk2, const float* __restrict__ subln, float lam_init, float* __restrict__ O) {
    extern __shared__ float Lbuf[];
    const int wave = threadIdx.x >> 6, lane = threadIdx.x & 63;
    float* L1 = Lbuf + wave * 8192; float* L2 = L1 + 4096;
    const int wg = blockIdx.x * 2 + wave, head = wg & 7, row = wg >> 3, b = row / S, qpos = row % S;
    const float lam = __expf(wsum(lq1[lane] * lk1[lane])) - __expf(wsum(lq2[lane] * lk2[lane])) + lam_init;
    float sums[2];
#pragma unroll
    for (int mm = 0; mm < 2; ++mm) {
        const int mi = 2 * head + mm; float* L = mm ? L2 : L1;
        float4 qv[16];
#pragma unroll
        for (int i = 0; i < 16; ++i) qv[i] = ((const float4*)(P + (size_t)row * APROJ + mi * 64))[i];
        float lmax = -INFINITY;
        for (int k = lane; k <= qpos; k += 64) {
            const float4* kp = (const float4*)(P + (size_t)(b * S + k) * APROJ + 1024 + mi * 64);
            float d = 0.f;
#pragma unroll
            for (int i = 0; i < 16; ++i) { const float4 kv = kp[i]; d += qv[i].x * kv.x + qv[i].y * kv.y + qv[i].z * kv.z + qv[i].w * kv.w; }
            const int rd = qpos - k; const int bk = rd < 128 ? BUCKET[rd] : 31;
            const float lg = d * 0.125f + rel[bk * 16 + mi];
            L[k] = lg; lmax = fmaxf(lmax, lg);
        }
        lmax = wmax(lmax);
        float s = 0.f;
        for (int k = lane; k <= qpos; k += 64) { const float e = __expf(L[k] - lmax); L[k] = e; s += e; }
        sums[mm] = wsum(s);
    }
    const float i1 = 1.f / sums[0], i2 = lam / sums[1];
    for (int k = lane; k <= qpos; k += 64) L1[k] = L1[k] * i1 - L2[k] * i2;
    __builtin_amdgcn_s_waitcnt(0);
    float o0 = 0.f, o1 = 0.f;
    const float* vp = P + (size_t)(b * S) * APROJ + 2048 + head * 128;
    for (int k = 0; k <= qpos; ++k) { const float a = L1[k]; o0 += a * vp[(size_t)k * APROJ + lane]; o1 += a * vp[(size_t)k * APROJ + 64 + lane]; }
    const float ss = wsum(o0 * o0 + o1 * o1);
    const float r = rsqrtf(ss * (1.f / 128.f) + 1e-5f) * (1.f - lam_init);
    O[(size_t)row * 1024 + head * 128 + lane] = o0 * r * subln[lane];
    O[(size_t)row * 1024 + head * 128 + 64 + lane] = o1 * r * subln[64 + lane];
}
}
namespace nvh {
using namespace nv;
constexpr size_t MiB = 1u << 20;
constexpr size_t N_CTL = 0;
constexpr size_t N_XN = 4 * MiB;
constexpr size_t N_P = 132 * MiB;
constexpr size_t N_QK = 517 * MiB;
constexpr size_t N_HH = 645 * MiB;
constexpr size_t N_G = 773 * MiB;
constexpr size_t N_Y = 363 * MiB;
constexpr size_t C_TOPE = 64 * 1024, C_TOPG = C_TOPE + 65536 * 4, C_SLOTTOK = C_TOPG + 65536 * 4, C_SLOTG = C_SLOTTOK + (size_t)NSLOT * 4, C_TOKSLOT = C_SLOTG + (size_t)NSLOT * 4,
                 C_BLKE = C_TOKSLOT + 65536 * 4, C_NUSED = C_BLKE + 2048, C_LI = 2 * MiB, C_LF = C_LI + (size_t)M * 4 * 4;
static_assert(C_NUSED + 64 <= 2 * MiB && C_LF + (size_t)M * 16 <= 4 * MiB, "ctl map");

struct In { const float* p[29]; };

static inline void gemm(hipStream_t st, const float* A, int lda, const float* W, int ldw, float* C, int ldc, int Mr, int N, int K, int mode, const float* W2 = nullptr, const int* rowidx = nullptr,
                        const int* blk_expert = nullptr, const int* n_used = nullptr, long long wstride = 0, int blk0 = 0) {
    NG g{}; g.A = A; g.rowidx = rowidx; g.W = W; g.W2 = W2; g.C = C; g.blk_expert = blk_expert; g.n_used = n_used; g.wstride = wstride;
    g.lda = lda; g.ldw = ldw; g.ldc = ldc; g.M = Mr; g.N = N; g.K = K; g.mode = mode; g.blk0 = blk0;
    dim3 grid((N + 127) / 128, Mr / 128);
    if (W2) hipLaunchKernelGGL(k_gemm<1>, grid, dim3(256), 0, st, g); else hipLaunchKernelGGL(k_gemm<0>, grid, dim3(256), 0, st, g);
}
static inline void rmsnorm(hipStream_t st, const float* x, const float* w, float* out, float eps) { hipLaunchKernelGGL(k_rmsnorm, dim3(M / 4), dim3(256), 0, st, x, w, out, M, eps); }

static void naive_mlstm(hipStream_t st, const In& in, int s, float* x, unsigned char* ws) {
    float* XN = (float*)(ws + N_XN); float* P = (float*)(ws + N_P); float* QK = (float*)(ws + N_QK); float* HH = (float*)(ws + N_HH); float* G = (float*)(ws + N_G);
    float* LI = (float*)(ws + C_LI); float* LF = (float*)(ws + C_LF);
    rmsnorm(st, x, in.p[2] + s * 1024, XN, 1e-6f);
    gemm(st, XN, 1024, in.p[3] + (size_t)s * 1024 * MPROJ, MPROJ, P, MPROJ, M, MPROJ, 1024, 0);
    hipLaunchKernelGGL(k_mlstm_prep, dim3(M), dim3(256), 0, st, (const float*)P, in.p[4] + s * 4096, in.p[5] + s * 1024, in.p[6] + s * 4, in.p[7] + s * 4, QK, LI, LF);
    hipLaunchKernelGGL(k_mlstm_rec, dim3(256), dim3(256), 0, st, (const float*)QK, (const float*)P, (const float*)LI, (const float*)LF, HH);
    hipLaunchKernelGGL(k_mlstm_post, dim3(M), dim3(256), 0, st, (const float*)HH, (const float*)P, in.p[8] + s * 1024, G);
    gemm(st, G, 1024, in.p[9] + (size_t)s * 1024 * 1024, 1024, x, 1024, M, 1024, 1024, 1);
}
static void naive_ffn(hipStream_t st, const In& in, int s, float* x, unsigned char* ws) {
    float* XN = (float*)(ws + N_XN); float* H = (float*)(ws + N_P);
    rmsnorm(st, x, in.p[18] + s * 1024, XN, 1e-6f);
    gemm(st, XN, 1024, in.p[19] + (size_t)s * 1024 * FF, FF, H, FF, M, FF, 1024, 2, in.p[20] + (size_t)s * 1024 * FF);
    gemm(st, H, FF, in.p[21] + (size_t)s * FF * 1024, 1024, x, 1024, M, 1024, FF, 1);
}
static void naive_attn(hipStream_t st, const In& in, int s, int layer, float* x, unsigned char* ws) {
    float* XN = (float*)(ws + N_XN); float* P = (float*)(ws + N_P); float* O = (float*)(ws + N_HH);
    rmsnorm(st, x, in.p[10] + s * 1024, XN, 1e-6f);
    gemm(st, XN, 1024, in.p[11] + (size_t)s * 1024 * APROJ, APROJ, P, APROJ, M, APROJ, 1024, 0);
    const float lam_init = (float)(0.8 - 0.6 * exp(-0.3 * (double)layer));
    static bool attr = false; if (!attr) { (void)hipFuncSetAttribute((const void*)k_attn, hipFuncAttributeMaxDynamicSharedMemorySize, 65536); attr = true; }
    hipLaunchKernelGGL(k_attn, dim3(M * 8 / 2), dim3(128), 65536, st, (const float*)P, in.p[1], in.p[12] + s * 64, in.p[13] + s * 64, in.p[14] + s * 64, in.p[15] + s * 64, in.p[16] + s * 128, lam_init, O);
    gemm(st, O, 1024, in.p[17] + (size_t)s * 1024 * 1024, 1024, x, 1024, M, 1024, 1024, 1);
}
static void naive_moe(hipStream_t st, const In& in, int s, float* x, unsigned char* ws) {
    float* XN = (float*)(ws + N_XN); float* Hc = (float*)(ws + N_P); float* Y = (float*)(ws + N_Y);
    int* top_e = (int*)(ws + C_TOPE); float* top_g = (float*)(ws + C_TOPG); int* slot_tok = (int*)(ws + C_SLOTTOK); float* slot_g = (float*)(ws + C_SLOTG);
    int* tok_slot = (int*)(ws + C_TOKSLOT); int* blk_e = (int*)(ws + C_BLKE); int* n_used = (int*)(ws + C_NUSED);
    rmsnorm(st, x, in.p[22] + s * 1024, XN, 1e-6f);
    hipLaunchKernelGGL(k_router, dim3(M / 4), dim3(256), 0, st, (const float*)XN, in.p[23] + s * 8192, in.p[24] + s * 8, top_e, top_g);
    hipLaunchKernelGGL(k_assign, dim3(1), dim3(1024), 0, st, (const int*)top_e, (const float*)top_g, slot_tok, slot_g, tok_slot, blk_e, n_used);
    constexpr int CH = 66, CR = CH * 256;
    for (int c = 0; c < 4; ++c) {
        gemm(st, XN, 1024, in.p[25] + (size_t)s * NE * 1024 * FF, FF, Hc, FF, CR, FF, 1024, 2, in.p[26] + (size_t)s * NE * 1024 * FF, slot_tok + c * CR, blk_e, n_used, (long long)1024 * FF, c * CH);
        gemm(st, Hc, FF, in.p[27] + (size_t)s * NE * FF * 1024, 1024, Y + (size_t)c * CR * 1024, 1024, CR, 1024, FF, 0, nullptr, nullptr, blk_e, n_used, (long long)FF * 1024, c * CH);
    }
    hipLaunchKernelGGL(k_combine, dim3(M), dim3(256), 0, st, x, (const float*)Y, (const int*)tok_slot, (const float*)top_g);
}
}
#ifndef SKIP_MASK
#define SKIP_MASK 0
#endif
extern "C" void kernel_launch(void* const* d_in, const int* in_sizes, int n_in, void* d_out, int out_size, void* d_ws, size_t ws_size, hipStream_t stream) {
    using namespace nvh;
    In in; for (int i = 0; i < 29; ++i) in.p[i] = (const float*)d_in[i];
    float* x = (float*)d_out; unsigned char* ws = (unsigned char*)d_ws;
    (void)hipMemcpyAsync(x, in.p[0], (size_t)M * D * 4, hipMemcpyDeviceToDevice, stream);
    for (int i = 0; i < 4; ++i) {
        const int s = i / 2;
        if (i % 2 == 0) { if (!(SKIP_MASK & 1)) naive_mlstm(stream, in, s, x, ws); if (!(SKIP_MASK & 2)) naive_ffn(stream, in, s, x, ws); }
        else { if (!(SKIP_MASK & 4)) naive_attn(stream, in, s, i, x, ws); if (!(SKIP_MASK & 8)) naive_moe(stream, in, s, x, ws); }
    }
    rmsnorm(stream, x, in.p[28], x, 1e-6f);
}
```

```cpp
#include <hip/hip_runtime.h>
#include <cstdio>
#include <cstdint>
#include <cmath>
namespace nv {
constexpr int B = 8, S = 4096, D = 1024, M = B * S;
constexpr int MPROJ = 3080, APROJ = 3072, FF = 3584, NE = 8;
constexpr int NBLK = 264, NSLOT = NBLK * 256;
typedef float f32x16 __attribute__((ext_vector_type(16)));

__device__ __forceinline__ float wsum(float v) {
#pragma unroll
    for (int o = 32; o >= 1; o >>= 1) v += __shfl_xor(v, o);
    return v;
}
__device__ __forceinline__ float wmax(float v) {
#pragma unroll
    for (int o = 32; o >= 1; o >>= 1) v = fmaxf(v, __shfl_xor(v, o));
    return v;
}

__global__ void __launch_bounds__(256) k_rmsnorm(const float* x, const float* __restrict__ w, float* out, int rows, float eps) {
    const int wave = threadIdx.x >> 6, lane = threadIdx.x & 63;
    const int row = blockIdx.x * 4 + wave;
    if (row >= rows) return;
    const float4* xr = (const float4*)(x + (size_t)row * D);
    float4 v[4]; float ss = 0.f;
#pragma unroll
    for (int j = 0; j < 4; ++j) { v[j] = xr[lane + 64 * j]; ss += v[j].x * v[j].x + v[j].y * v[j].y + v[j].z * v[j].z + v[j].w * v[j].w; }
    ss = wsum(ss);
    const float r = rsqrtf(ss * (1.f / D) + eps);
    float4* o = (float4*)(out + (size_t)row * D);
#pragma unroll
    for (int j = 0; j < 4; ++j) { const float4 ww = ((const float4*)w)[lane + 64 * j]; float4 t; t.x = v[j].x * r * ww.x; t.y = v[j].y * r * ww.y; t.z = v[j].z * r * ww.z; t.w = v[j].w * r * ww.w; o[lane + 64 * j] = t; }
}

struct NG {
    const float* A; const int* rowidx; const float* W; const float* W2; float* C;
    const int* blk_expert; const int* n_used; long long wstride;
    int lda, ldw, ldc, M, N, K, mode, blk0;
};
template <int DUAL>
__global__ void __launch_bounds__(256) k_gemm(NG g) {
    __shared__ float As[16][132];
    __shared__ float Bs[16][132];
    __shared__ float Bs2[DUAL ? 16 : 1][132];
    const int t = threadIdx.x, lane = t & 63, w = t >> 6, wm = w >> 1, wn = w & 1;
    const int m0 = blockIdx.y * 128, n0 = blockIdx.x * 128;
    const float* W = g.W; const float* W2 = g.W2;
    if (g.blk_expert) {
        const int blk = g.blk0 + m0 / 256;
        if (blk >= *g.n_used) return;
        const int e = g.blk_expert[blk];
        W += (size_t)e * g.wstride; if (DUAL) W2 += (size_t)e * g.wstride;
    }
    f32x16 acc[2][2], acc2[2][2];
#pragma unroll
    for (int i = 0; i < 2; ++i)
#pragma unroll
        for (int j = 0; j < 2; ++j) { acc[i][j] = f32x16{}; acc2[i][j] = f32x16{}; }
    const int ar = t >> 1, akq = (t & 1) * 8;
    long long asrc = g.rowidx ? (long long)g.rowidx[m0 + ar] : (long long)(m0 + ar);
    const float* ap = (asrc >= 0) ? g.A + (size_t)asrc * g.lda + akq : nullptr;
    for (int k0 = 0; k0 < g.K; k0 += 16) {
        float4 a0 = make_float4(0.f, 0.f, 0.f, 0.f), a1 = a0;
        if (ap) { a0 = *(const float4*)(ap + k0); a1 = *(const float4*)(ap + k0 + 4); }
        As[akq + 0][ar] = a0.x; As[akq + 1][ar] = a0.y; As[akq + 2][ar] = a0.z; As[akq + 3][ar] = a0.w;
        As[akq + 4][ar] = a1.x; As[akq + 5][ar] = a1.y; As[akq + 6][ar] = a1.z; As[akq + 7][ar] = a1.w;
#pragma unroll
        for (int i = 0; i < 2; ++i) {
            const int k = (t >> 5) + 8 * i, c = (t & 31) * 4, col = n0 + c;
            float4 b = make_float4(0.f, 0.f, 0.f, 0.f);
            if (col < g.N) b = *(const float4*)(W + (size_t)(k0 + k) * g.ldw + col);
            Bs[k][c] = b.x; Bs[k][c + 1] = b.y; Bs[k][c + 2] = b.z; Bs[k][c + 3] = b.w;
            if (DUAL) {
                float4 b2 = make_float4(0.f, 0.f, 0.f, 0.f);
                if (col < g.N) b2 = *(const float4*)(W2 + (size_t)(k0 + k) * g.ldw + col);
                Bs2[k][c] = b2.x; Bs2[k][c + 1] = b2.y; Bs2[k][c + 2] = b2.z; Bs2[k][c + 3] = b2.w;
            }
        }
        __syncthreads();
#pragma unroll
        for (int kk = 0; kk < 8; ++kk) {
            const int kl = 2 * kk + (lane >> 5);
            float a[2], b[2], b2[2];
#pragma unroll
            for (int i = 0; i < 2; ++i) { a[i] = As[kl][wm * 64 + i * 32 + (lane & 31)]; b[i] = Bs[kl][wn * 64 + i * 32 + (lane & 31)]; if (DUAL) b2[i] = Bs2[kl][wn * 64 + i * 32 + (lane & 31)]; }
#pragma unroll
            for (int i = 0; i < 2; ++i)
#pragma unroll
                for (int j = 0; j < 2; ++j) {
                    acc[i][j] = __builtin_amdgcn_mfma_f32_32x32x2f32(a[i], b[j], acc[i][j], 0, 0, 0);
                    if (DUAL) acc2[i][j] = __builtin_amdgcn_mfma_f32_32x32x2f32(a[i], b2[j], acc2[i][j], 0, 0, 0);
                }
        }
        __syncthreads();
    }
#pragma unroll
    for (int i = 0; i < 2; ++i)
#pragma unroll
        for (int j = 0; j < 2; ++j) {
            const int col = n0 + wn * 64 + j * 32 + (lane & 31);
            if (col >= g.N) continue;
#pragma unroll
            for (int r = 0; r < 16; ++r) {
                const int row = m0 + wm * 64 + i * 32 + (r & 3) + 8 * (r >> 2) + 4 * (lane >> 5);
                float* cp = g.C + (size_t)row * g.ldc + col;
                const float v = acc[i][j][r];
                if (g.mode == 0) *cp = v;
                else if (g.mode == 1) *cp += v;
                else { const float u = DUAL ? acc2[i][j][r] : 0.f; *cp = v / (1.f + __expf(-v)) * u; }
            }
        }
}

__global__ void __launch_bounds__(256) k_router(const float* __restrict__ xn, const float* __restrict__ wr, const float* __restrict__ br, int* __restrict__ top_e, float* __restrict__ top_g) {
    const int wave = threadIdx.x >> 6, lane = threadIdx.x & 63;
    const int row = blockIdx.x * 4 + wave;
    const float4* xr = (const float4*)(xn + (size_t)row * D);
    float acc[8];
#pragma unroll
    for (int e = 0; e < 8; ++e) acc[e] = 0.f;
#pragma unroll
    for (int j = 0; j < 4; ++j) {
        const float4 v = xr[lane + 64 * j]; const float xv[4] = {v.x, v.y, v.z, v.w};
#pragma unroll
        for (int i = 0; i < 4; ++i) {
            const int k = (lane + 64 * j) * 4 + i;
            const float4 w0 = *(const float4*)(wr + (size_t)k * 8), w1 = *(const float4*)(wr + (size_t)k * 8 + 4);
            acc[0] += xv[i] * w0.x; acc[1] += xv[i] * w0.y; acc[2] += xv[i] * w0.z; acc[3] += xv[i] * w0.w;
            acc[4] += xv[i] * w1.x; acc[5] += xv[i] * w1.y; acc[6] += xv[i] * w1.z; acc[7] += xv[i] * w1.w;
        }
    }
#pragma unroll
    for (int e = 0; e < 8; ++e) acc[e] = wsum(acc[e]) + br[e];
    if (lane == 0) {
        int e0 = 0; float l0 = acc[0];
#pragma unroll
        for (int e = 1; e < 8; ++e) if (acc[e] > l0) { l0 = acc[e]; e0 = e; }
        int e1 = -1; float l1 = -INFINITY;
#pragma unroll
        for (int e = 0; e < 8; ++e) if (e != e0 && acc[e] > l1) { l1 = acc[e]; e1 = e; }
        const float ex = __expf(l1 - l0), g0 = 1.f / (1.f + ex), g1 = ex / (1.f + ex);
        top_e[row * 2] = e0; top_e[row * 2 + 1] = e1; top_g[row * 2] = g0; top_g[row * 2 + 1] = g1;
    }
}
__global__ void __launch_bounds__(1024) k_assign(const int* __restrict__ top_e, const float* __restrict__ top_g, int* __restrict__ slot_token, float* __restrict__ slot_gate,
                                                 int* __restrict__ tok_slot, int* __restrict__ blk_expert, int* __restrict__ n_used) {
    __shared__ int sc[8][1024];
    __shared__ int tot[8], pstart[8];
    const int t = threadIdx.x, lane = t & 63, w = t >> 6;
    for (int i = t; i < NSLOT; i += 1024) { slot_token[i] = -1; slot_gate[i] = 0.f; }
    int c[8];
#pragma unroll
    for (int e = 0; e < 8; ++e) c[e] = 0;
    for (int i = 0; i < 64; ++i) { const int e = top_e[t * 64 + i];
#pragma unroll
        for (int q = 0; q < 8; ++q) c[q] += (e == q) ? 1 : 0; }
#pragma unroll
    for (int e = 0; e < 8; ++e) sc[e][t] = c[e];
    __syncthreads();
    if (w < 8) {
        int loc[16], s = 0;
#pragma unroll
        for (int i = 0; i < 16; ++i) { loc[i] = sc[w][lane * 16 + i]; s += loc[i]; }
        int inc = s;
#pragma unroll
        for (int o = 1; o < 64; o <<= 1) { const int v = __shfl_up(inc, o); if (lane >= o) inc += v; }
        int run = inc - s;
#pragma unroll
        for (int i = 0; i < 16; ++i) { sc[w][lane * 16 + i] = run; run += loc[i]; }
        if (lane == 63) tot[w] = inc;
    }
    __syncthreads();
    if (t == 0) {
        int acc = 0;
        for (int e = 0; e < 8; ++e) { pstart[e] = acc; acc += (tot[e] + 255) / 256 * 256; }
        const int nb = acc / 256; *n_used = nb;
        int e = 0;
        for (int b = 0; b < NBLK; ++b) {
            while (e < 7 && b * 256 >= pstart[e] + (tot[e] + 255) / 256 * 256) ++e;
            blk_expert[b] = e;
        }
    }
    __syncthreads();
    int run[8];
#pragma unroll
    for (int e = 0; e < 8; ++e) run[e] = pstart[e] + sc[e][t];
    for (int i = 0; i < 64; ++i) {
        const int a = t * 64 + i, e = top_e[a];
        int slot = 0;
#pragma unroll
        for (int q = 0; q < 8; ++q) if (e == q) { slot = run[q]; run[q]++; }
        slot_token[slot] = a >> 1; slot_gate[slot] = top_g[a]; tok_slot[a] = slot;
    }
}
__global__ void __launch_bounds__(256) k_combine(float* __restrict__ x, const float* __restrict__ Y, const int* __restrict__ tok_slot, const float* __restrict__ top_g) {
    const int row = blockIdx.x, t = threadIdx.x;
    const int s0 = tok_slot[row * 2], s1 = tok_slot[row * 2 + 1]; const float g0 = top_g[row * 2], g1 = top_g[row * 2 + 1];
    float4* xp = (float4*)(x + (size_t)row * D) + t; const float4 a = ((const float4*)(Y + (size_t)s0 * D))[t], b = ((const float4*)(Y + (size_t)s1 * D))[t];
    float4 v = *xp; v.x += g0 * a.x + g1 * b.x; v.y += g0 * a.y + g1 * b.y; v.z += g0 * a.z + g1 * b.z; v.w += g0 * a.w + g1 * b.w; *xp = v;
}

__global__ void __launch_bounds__(256) k_mlstm_prep(const float* __restrict__ P, const float* __restrict__ cw, const float* __restrict__ cb, const float* __restrict__ bi, const float* __restrict__ bf,
                                                    float* __restrict__ QK, float* __restrict__ LI, float* __restrict__ LF) {
    const int row = blockIdx.x, t = threadIdx.x, tt = row % S;
#pragma unroll
    for (int i = 0; i < 4; ++i) {
        const int c = t + 256 * i;
        float y = cb[c];
#pragma unroll
        for (int j = 0; j < 4; ++j) { const int ts = tt - 3 + j; if (ts >= 0) y += cw[j * 1024 + c] * P[(size_t)(row - 3 + j) * MPROJ + c]; }
        float s = y / (1.f + __expf(-y));
        if (c >= 512) s *= 0.08838834764831845f;
        QK[(size_t)row * 1024 + c] = s;
    }
    if (t < 4) LI[row * 4 + t] = P[(size_t)row * MPROJ + 3072 + t] + bi[t];
    else if (t < 8) { const int h = t - 4; const float z = P[(size_t)row * MPROJ + 3076 + h] + bf[h]; LF[row * 4 + h] = fminf(z, 0.f) - log1pf(__expf(-fabsf(z))); }
}
__global__ void __launch_bounds__(256) k_mlstm_rec(const float* __restrict__ QK, const float* __restrict__ P, const float* __restrict__ LI, const float* __restrict__ LF, float* __restrict__ HH) {
    __shared__ float qs[128], ks[128], part[8][32], red[2];
    const int tid = threadIdx.x, dv = tid & 31, kg = tid >> 5, lane = tid & 63;
    const int bh = blockIdx.x >> 3, sl = blockIdx.x & 7, b = bh >> 2, h = bh & 3, dv0 = sl * 32;
    float C[16];
#pragma unroll
    for (int j = 0; j < 16; ++j) C[j] = 0.f;
    float n = 0.f, m = 0.f;
    for (int t = 0; t < S; ++t) {
        const size_t row = (size_t)b * S + t;
        if (tid < 128) { qs[tid] = QK[row * 1024 + h * 128 + tid]; ks[tid] = QK[row * 1024 + 512 + h * 128 + tid]; }
        const float v = P[row * MPROJ + 1024 + h * 256 + dv0 + dv];
        const float li = LI[row * 4 + h], lf = LF[row * 4 + h];
        const float mn = fmaxf(lf + m, li), fp = __expf(lf + m - mn), ip = __expf(li - mn); m = mn;
        __syncthreads();
        float pn = 0.f;
#pragma unroll
        for (int j = 0; j < 16; ++j) { C[j] = fp * C[j] + ip * ks[kg * 16 + j] * v; pn += C[j] * qs[kg * 16 + j]; }
        part[kg][dv] = pn;
        if (tid < 128) { n = fp * n + ip * ks[tid]; const float d = wsum(n * qs[tid]); if (lane == 0) red[tid >> 6] = d; }
        __syncthreads();
        if (tid < 32) {
            float num = 0.f;
#pragma unroll
            for (int g = 0; g < 8; ++g) num += part[g][tid];
            const float den = red[0] + red[1];
            HH[row * 1024 + h * 256 + dv0 + tid] = num / fmaxf(fabsf(den), __expf(-m));
        }
        __syncthreads();
    }
}
__global__ void __launch_bounds__(256) k_mlstm_post(const float* __restrict__ HH, const float* __restrict__ P, const float* __restrict__ hn, float* __restrict__ G) {
    const int wave = threadIdx.x >> 6, lane = threadIdx.x & 63;
    const int row = blockIdx.x, h = wave;
    const float4 v = ((const float4*)(HH + (size_t)row * 1024 + h * 256))[lane];
    const float ss = wsum(v.x * v.x + v.y * v.y + v.z * v.z + v.w * v.w);
    const float r = rsqrtf(ss * (1.f / 256.f) + 1e-6f);
    const float4 w = ((const float4*)(hn + h * 256))[lane], o = ((const float4*)(P + (size_t)row * MPROJ + 2048 + h * 256))[lane];
    float4 g;
    g.x = v.x * r * w.x / (1.f + __expf(-o.x)); g.y = v.y * r * w.y / (1.f + __expf(-o.y)); g.z = v.z * r * w.z / (1.f + __expf(-o.z)); g.w = v.w * r * w.w / (1.f + __expf(-o.w));
    ((float4*)(G + (size_t)row * 1024 + h * 256))[lane] = g;
}

__device__ const int BUCKET[128] = {0, 1, 2, 3, 4, 5, 6, 7, 8, 9, 10, 11, 12, 13, 14, 15, 16, 16, 16, 17, 17, 18, 18, 18, 19, 19, 19, 20, 20, 20, 20, 21, 21, 21, 21, 22, 22, 22, 22, 22, 23, 23, 23, 23, 23, 23, 24, 24, 24, 24, 24, 24, 25, 25, 25, 25, 25, 25, 25, 26, 26, 26, 26, 26, 26, 26, 26, 27, 27, 27, 27, 27, 27, 27, 27, 27, 27, 28, 28, 28, 28, 28, 28, 28, 28, 28, 28, 29, 29, 29, 29, 29, 29, 29, 29, 29, 29, 29, 29, 30, 30, 30, 30, 30, 30, 30, 30, 30, 30, 30, 30, 30, 30, 31, 31, 31, 31, 31, 31, 31, 31, 31, 31, 31, 31, 31, 31, 31};
__global__ void __launch_bounds__(128) k_attn(const float* __restrict__ P, const float* __restrict__ rel, const float* __restrict__ lq1, const float* __restrict__ lk1, const float* __restrict__ lq2,
                                              const float* __restrict__ lk2, const float* __restrict__ subln, float lam_init, float* __restrict__ O) {
    extern __shared__ float Lbuf[];
    const int wave = threadIdx.x >> 6, lane = threadIdx.x & 63;
    float* L1 = Lbuf + wave * 8192; float* L2 = L1 + 4096;
    const int wg = blockIdx.x * 2 + wave, head = wg & 7, row = wg >> 3, b = row / S, qpos = row % S;
    const float lam = __expf(wsum(lq1[lane] * lk1[lane])) - __expf(wsum(lq2[lane] * lk2[lane])) + lam_init;
    float sums[2];
#pragma unroll
    for (int mm = 0; mm < 2; ++mm) {
        const int mi = 2 * head + mm; float* L = mm ? L2 : L1;
        float4 qv[16];
#pragma unroll
        for (int i = 0; i < 16; ++i) qv[i] = ((const float4*)(P + (size_t)row * APROJ + mi * 64))[i];
        float lmax = -INFINITY;
        for (int k = lane; k <= qpos; k += 64) {
            const float4* kp = (const float4*)(P + (size_t)(b * S + k) * APROJ + 1024 + mi * 64);
            float d = 0.f;
#pragma unroll
            for (int i = 0; i < 16; ++i) { const float4 kv = kp[i]; d += qv[i].x * kv.x + qv[i].y * kv.y + qv[i].z * kv.z + qv[i].w * kv.w; }
            const int rd = qpos - k; const int bk = rd < 128 ? BUCKET[rd] : 31;
            const float lg = d * 0.125f + rel[bk * 16 + mi];
            L[k] = lg; lmax = fmaxf(lmax, lg);
        }
        lmax = wmax(lmax);
        float s = 0.f;
        for (int k = lane; k <= qpos; k += 64) { const float e = __expf(L[k] - lmax); L[k] = e; s += e; }
        sums[mm] = wsum(s);
    }
    const float i1 = 1.f / sums[0], i2 = lam / sums[1];
    for (int k = lane; k <= qpos; k += 64) L1[k] = L1[k] * i1 - L2[k] * i2;
    __builtin_amdgcn_s_waitcnt(0);
    float o0 = 0.f, o1 = 0.f;
    const float* vp = P + (size_t)(b * S) * APROJ + 2048 + head * 128;
    for (int k = 0; k <= qpos; ++k) { const float a = L1[k]; o0 += a * vp[(size_t)k * APROJ + lane]; o1 += a * vp[(size_t)k * APROJ + 64 + lane]; }
    const float ss = wsum(o0 * o0 + o1 * o1);
    const float r = rsqrtf(ss * (1.f / 128.f) + 1e-5f) * (1.f - lam_init);
    O[(size_t)row * 1024 + head * 128 + lane] = o0 * r * subln[lane];
    O[(size_t)row * 1024 + head * 128 + 64 + lane] = o1 * r * subln[64 + lane];
}
}
namespace pg8 {
#define PG8_LAS __attribute__((address_space(3)))
typedef unsigned short bf16_t;
typedef short bf16x8 __attribute__((ext_vector_type(8)));
typedef float f32x4 __attribute__((ext_vector_type(4)));
typedef float f32x2 __attribute__((ext_vector_type(2)));
typedef unsigned u32x4 __attribute__((ext_vector_type(4)));
constexpr int BM = 256, BK = 64, HALF = 128, HTB = HALF * BK * 2  , STAGE_BYTES = 8 * HTB, NXCD = 8, WGM = 8;

__host__ __device__ __forceinline__ int lds_byte(int r, int c) { const int st = (r >> 4) * 2 + (c >> 5), rr = r & 15, cc = c & 31, ob = rr * 64 + cc * 2; return st * 1024 + (ob ^ (((ob >> 9) & 1) << 5)); }
__host__ __device__ __forceinline__ void stage_rc(int b, int& R, int& C) { const int st = b / 1024, sb = b % 1024, swz = sb ^ (((sb >> 9) & 1) << 5); R = (st >> 1) * 16 + swz / 64; C = (st & 1) * 32 + (swz % 64) / 2; }
__host__ __device__ __forceinline__ int perm32(int rho) { const int n = rho >> 4, i = rho & 15; return 8 * (i >> 2) + 4 * n + (i & 3); }

struct Unit { int pm, pn; long boff; };
struct Gemm { const bf16_t* A; const bf16_t* Bt; int M, N, K; const int* arow; };

struct StaticOrder {
    int nM, nN, nwg, G, c;
    __host__ __device__ void init(int M, int N, int G_, int c_) { nM = M / BM; nN = N / BM; nwg = nM * nN; G = G_; c = c_; }
    __host__ __device__ bool next(int i, Unit& u) const {
        const long L = (long)i * G + c; if (L >= nwg) return false;
        int wgid = (int)L; { const int q = nwg / NXCD, r = nwg % NXCD, xcd = wgid % NXCD, off = wgid / NXCD; wgid = (xcd < r ? xcd * (q + 1) : r * (q + 1) + (xcd - r) * q) + off; }
        const int nig = WGM * nN, gid = wgid / nig, fm = gid * WGM, gsz = (nM - fm) < WGM ? (nM - fm) : WGM;
        u.pm = fm + ((wgid % nig) % gsz); u.pn = (wgid % nig) / gsz; u.boff = 0; return true;
    }
};
struct GroupOrder {
    int nM, nN, nwg, G, c; const int* blk_e; long wstride;
    __device__ void init(int nM_, int nN_, int G_, int c_, const int* be, long ws) { nM = nM_; nN = nN_; nwg = nM * nN; G = G_; c = c_; blk_e = be; wstride = ws; }
    __device__ bool next(int i, Unit& u) const {
        const long L = (long)i * G + c; if (L >= nwg) return false;
        const int wgid = (int)L;
        const int nig = WGM * nN, gid = wgid / nig, fm = gid * WGM, gsz = (nM - fm) < WGM ? (nM - fm) : WGM;
        u.pm = fm + ((wgid % nig) % gsz); u.pn = (wgid % nig) / gsz; u.boff = (long)blk_e[u.pm] * wstride; return true;
    }
};

__device__ __forceinline__ unsigned cvt_pk_bf16(float lo, float hi) { unsigned r; asm volatile("v_cvt_pk_bf16_f32 %0, %1, %2" : "=v"(r) : "v"(lo), "v"(hi)); return r; }
__device__ __forceinline__ float silu_f(float v) { return v * __builtin_amdgcn_rcpf(1.0f + __builtin_amdgcn_exp2f(-1.4426950408889634f * v)); }

struct EpiBf16 {
    static constexpr bool PERM = true;
    bf16_t* O; int ldc; float scale0; int nscaled;
    __device__ __forceinline__ void operator()(const f32x4 (&acc)[2][2][4][2], const Unit& u, int wr, int wc, int fr, int fq) const {
        const int row0 = u.pm * BM + wr * 64 + fr, col0 = u.pn * BM + wc * 32 + 8 * fq;
        const float sc = (u.pn < nscaled) ? scale0 : 1.f;
#pragma unroll
        for (int ai = 0; ai < 2; ++ai)
#pragma unroll
            for (int m = 0; m < 4; ++m) { bf16_t* rowp = O + (size_t)(row0 + ai * HALF + m * 16) * ldc + col0;
#pragma unroll
                for (int bj = 0; bj < 2; ++bj) { const f32x4 v0 = acc[ai][bj][m][0] * sc, v1 = acc[ai][bj][m][1] * sc;
                    u32x4 w; w.x = cvt_pk_bf16(v0[0], v0[1]); w.y = cvt_pk_bf16(v0[2], v0[3]); w.z = cvt_pk_bf16(v1[0], v1[1]); w.w = cvt_pk_bf16(v1[2], v1[3]);
                    *(u32x4*)(rowp + bj * HALF) = w; } }
    }
};
struct EpiSwiGLU {
    static constexpr bool PERM = true;
    bf16_t* O; int ldc;
    __device__ __forceinline__ void operator()(const f32x4 (&acc)[2][2][4][2], const Unit& u, int wr, int wc, int fr, int fq) const {
        const int row0 = u.pm * BM + wr * 64 + fr, col0 = u.pn * HALF + wc * 32 + 8 * fq;
#pragma unroll
        for (int ai = 0; ai < 2; ++ai)
#pragma unroll
            for (int m = 0; m < 4; ++m) { bf16_t* rowp = O + (size_t)(row0 + ai * HALF + m * 16) * ldc + col0;
                const f32x4 g0 = acc[ai][0][m][0], g1 = acc[ai][0][m][1], u0 = acc[ai][1][m][0], u1 = acc[ai][1][m][1];
                u32x4 w; w.x = cvt_pk_bf16(silu_f(g0[0]) * u0[0], silu_f(g0[1]) * u0[1]); w.y = cvt_pk_bf16(silu_f(g0[2]) * u0[2], silu_f(g0[3]) * u0[3]);
                w.z = cvt_pk_bf16(silu_f(g1[0]) * u1[0], silu_f(g1[1]) * u1[1]); w.w = cvt_pk_bf16(silu_f(g1[2]) * u1[2], silu_f(g1[3]) * u1[3]);
                *(u32x4*)rowp = w; }
    }
};
struct EpiResid {
    static constexpr bool PERM = false;
    float* O; int ldc;
    __device__ __forceinline__ void operator()(const f32x4 (&acc)[2][2][4][2], const Unit& u, int wr, int wc, int fr, int fq) const {
        const int row0 = u.pm * BM + wr * 64 + fr, col0 = u.pn * BM + wc * 32 + 4 * fq;
#pragma unroll
        for (int ai = 0; ai < 2; ++ai)
#pragma unroll
            for (int m = 0; m < 4; ++m) { float* rowp = O + (size_t)(row0 + ai * HALF + m * 16) * ldc + col0;
#pragma unroll
                for (int bj = 0; bj < 2; ++bj)
#pragma unroll
                    for (int n = 0; n < 2; ++n) { f32x4* p = (f32x4*)(rowp + bj * HALF + n * 16); *p = *p + acc[ai][bj][m][n]; }
                asm volatile("" ::: "memory"); }
    }
};

template <class Epi, class Sched, bool ALIGN_EPI, bool GATHER>
__device__ __forceinline__ void gemm_phase(PG8_LAS unsigned char* lds, const Gemm g, const Sched& S, const Epi& E, int wave_id) {
    int tid_; asm volatile("v_mbcnt_lo_u32_b32 %0, -1, 0\n\tv_mbcnt_hi_u32_b32 %0, -1, %0" : "=v"(tid_)); tid_ += wave_id * 64;
    const int tid = tid_, wid = __builtin_amdgcn_readfirstlane(tid >> 6), lane = tid & 63, wr = wid >> 2, wc = wid & 3, fr = lane & 15, fq = lane >> 4;
    const int K = g.K, nt = K / BK;
    unsigned voffA[2], voffB[2]; int rA[2], cA2[2];
#pragma unroll
    for (int i = 0; i < 2; ++i) { int R, C; stage_rc(tid * 16 + i * 8192, R, C); const int Rb = Epi::PERM ? ((R & ~31) + perm32(R & 31)) : R;
        voffA[i] = (unsigned)(R * K + C) * 2u; voffB[i] = (unsigned)(Rb * K + C) * 2u; rA[i] = R; cA2[i] = C * 2; }
    const size_t kstep = (size_t)(BK * 2);
    const size_t hstep = (size_t)HALF * K * 2;
    const size_t tstep = 2 * hstep;
    const unsigned ldsw = (unsigned)wid * 1024u;
    const int aoff = lds_byte(wr * 64 + fr, fq * 8), boff = lds_byte(wc * 32 + fr, fq * 8);
#define PG8_SA(b, h) (((b) * 2 + (h)) * HTB)
#define PG8_SB(b, h) ((4 + (b) * 2 + (h)) * HTB)
#define PG8_STAGE2(bufoff, gbase, v0, v1) do { \
        __builtin_amdgcn_global_load_lds((const unsigned*)((const char*)(gbase) + (v0)), (PG8_LAS unsigned*)(lds + (bufoff) + ldsw), 16, 0, 0); \
        __builtin_amdgcn_global_load_lds((const unsigned*)((const char*)(gbase) + (v1)), (PG8_LAS unsigned*)(lds + (bufoff) + ldsw + 8192), 16, 0, 0); } while (0)
#define PG8_STAGEB(bufoff, gbase) PG8_STAGE2(bufoff, gbase, voffB[0], voffB[1])
#define PG8_LDA(dst, b, h) do { _Pragma("unroll") for (int m = 0; m < 4; ++m) _Pragma("unroll") for (int k = 0; k < 2; ++k) dst[m][k] = *(const PG8_LAS bf16x8*)(lds + PG8_SA(b, h) + aoff + m * 2048 + k * 1024); } while (0)
#define PG8_LDB(dst, b, h) do { _Pragma("unroll") for (int n = 0; n < 2; ++n) _Pragma("unroll") for (int k = 0; k < 2; ++k) dst[n][k] = *(const PG8_LAS bf16x8*)(lds + PG8_SB(b, h) + boff + n * 2048 + k * 1024); } while (0)
#define PG8_MMA(ai, bj, At, Bt) do { __builtin_amdgcn_s_setprio(1); _Pragma("unroll") for (int m = 0; m < 4; ++m) _Pragma("unroll") for (int n = 0; n < 2; ++n) _Pragma("unroll") for (int k = 0; k < 2; ++k) \
        acc[ai][bj][m][n] = __builtin_amdgcn_mfma_f32_16x16x32_bf16(Bt[n][k], At[m][k], acc[ai][bj][m][n], 0, 0, 0); __builtin_amdgcn_s_setprio(0); } while (0)
#define PG8_WAIT_V(n) asm volatile("s_waitcnt vmcnt(" #n ")" ::: "memory")
#define PG8_WAIT_L(n) asm volatile("s_waitcnt lgkmcnt(" #n ")" ::: "memory")
#define PG8_BAR __builtin_amdgcn_s_barrier()
#define PG8_SCHED __builtin_amdgcn_sched_barrier(0)
    Unit cur, nxt; int ui = 0;
    if (!S.next(0, cur)) return;
    f32x4 acc[2][2][4][2];
#pragma unroll
    for (int a = 0; a < 2; ++a)
#pragma unroll
        for (int b = 0; b < 2; ++b)
#pragma unroll
            for (int m = 0; m < 4; ++m)
#pragma unroll
                for (int n = 0; n < 2; ++n) acc[a][b][m][n] = (f32x4){0.f, 0.f, 0.f, 0.f};
    bf16x8 At[4][2], B0[2][2], B1[2][2];
    unsigned c00, c01, c10, c11, n00, n01, n10, n11;
    const char* cA; const char* cB = (const char*)g.Bt + (size_t)cur.boff * 2 + (size_t)cur.pn * tstep;
    if constexpr (GATHER) {
        cA = (const char*)g.A;
        const int* ar = g.arow + cur.pm * BM;
        int t00 = ar[rA[0]], t01 = ar[rA[1]], t10 = ar[HALF + rA[0]], t11 = ar[HALF + rA[1]];
        t00 = t00 < 0 ? 0 : t00; t01 = t01 < 0 ? 0 : t01; t10 = t10 < 0 ? 0 : t10; t11 = t11 < 0 ? 0 : t11;
        c00 = (unsigned)t00 * (unsigned)(K * 2) + cA2[0]; c01 = (unsigned)t01 * (unsigned)(K * 2) + cA2[1]; c10 = (unsigned)t10 * (unsigned)(K * 2) + cA2[0]; c11 = (unsigned)t11 * (unsigned)(K * 2) + cA2[1];
    } else {
        cA = (const char*)g.A + (size_t)cur.pm * tstep;
        c00 = voffA[0]; c01 = voffA[1]; c10 = voffA[0]; c11 = voffA[1];
    }
    const size_t HS = GATHER ? (size_t)0 : hstep;
    n00 = c00; n01 = c01; n10 = c10; n11 = c11;
    PG8_STAGEB(PG8_SB(0, 0), cB); PG8_STAGEB(PG8_SB(0, 1), cB + hstep); PG8_STAGE2(PG8_SA(0, 0), cA, c00, c01); PG8_STAGE2(PG8_SA(0, 1), cA + HS, c10, c11);
    if (wr == 1) PG8_BAR;
    PG8_WAIT_V(2); PG8_BAR;
    PG8_STAGEB(PG8_SB(1, 0), cB + kstep); PG8_STAGE2(PG8_SA(1, 0), cA + kstep, c00, c01); PG8_STAGEB(PG8_SB(1, 1), cB + hstep + kstep);
    PG8_WAIT_V(6); PG8_BAR;
    for (;;) {
        const bool has_next = S.next(ui + 1, nxt);
        const char* nA; const char* nB = has_next ? (const char*)g.Bt + (size_t)nxt.boff * 2 + (size_t)nxt.pn * tstep : cB;
        if constexpr (GATHER) {
            nA = cA;
            if (has_next) {
                const int* ar = g.arow + nxt.pm * BM;
                int t00 = ar[rA[0]], t01 = ar[rA[1]], t10 = ar[HALF + rA[0]], t11 = ar[HALF + rA[1]];
                t00 = t00 < 0 ? 0 : t00; t01 = t01 < 0 ? 0 : t01; t10 = t10 < 0 ? 0 : t10; t11 = t11 < 0 ? 0 : t11;
                n00 = (unsigned)t00 * (unsigned)(K * 2) + cA2[0]; n01 = (unsigned)t01 * (unsigned)(K * 2) + cA2[1]; n10 = (unsigned)t10 * (unsigned)(K * 2) + cA2[0]; n11 = (unsigned)t11 * (unsigned)(K * 2) + cA2[1];
            } else { n00 = c00; n01 = c01; n10 = c10; n11 = c11; }
        } else {
            nA = has_next ? (const char*)g.A + (size_t)nxt.pm * tstep : cA;
        }
        for (int t = 0; t < nt; t += 2) {
            const bool last = (t == nt - 2);
            const char* a1 = cA + (size_t)(t + 1) * kstep;
            const char* a2 = last ? nA : cA + (size_t)(t + 2) * kstep; const char* b2 = last ? nB : cB + (size_t)(t + 2) * kstep;
            const char* a3 = a2 + kstep; const char* b3 = b2 + kstep;
            unsigned x00 = c00, x01 = c01, x10 = c10, x11 = c11;
            if constexpr (GATHER) { if (last) { x00 = n00; x01 = n01; x10 = n10; x11 = n11; } }
            PG8_LDB(B0, 0, 0); PG8_LDB(B1, 0, 1); PG8_SCHED; PG8_LDA(At, 0, 0); PG8_STAGE2(PG8_SA(1, 1), a1 + HS, c10, c11);
            PG8_WAIT_V(8); PG8_WAIT_L(0); PG8_BAR; PG8_MMA(0, 0, At, B0); PG8_MMA(0, 1, At, B1); PG8_BAR; PG8_SCHED;
            PG8_LDA(At, 0, 1); PG8_STAGEB(PG8_SB(0, 0), b2); PG8_STAGEB(PG8_SB(0, 1), b2 + hstep); PG8_STAGE2(PG8_SA(0, 0), a2, x00, x01);
            PG8_WAIT_V(8); PG8_WAIT_L(0); PG8_BAR; PG8_MMA(1, 0, At, B0); PG8_MMA(1, 1, At, B1); PG8_BAR; PG8_SCHED;
            PG8_LDB(B0, 1, 0); PG8_LDB(B1, 1, 1); PG8_SCHED; PG8_LDA(At, 1, 0); PG8_STAGE2(PG8_SA(0, 1), a2 + HS, x10, x11);
            PG8_WAIT_V(8); PG8_WAIT_L(0); PG8_BAR; PG8_MMA(0, 0, At, B0); PG8_MMA(0, 1, At, B1); PG8_BAR; PG8_SCHED;
            PG8_LDA(At, 1, 1); PG8_STAGEB(PG8_SB(1, 0), b3); PG8_STAGEB(PG8_SB(1, 1), b3 + hstep); PG8_STAGE2(PG8_SA(1, 0), a3, x00, x01);
            PG8_WAIT_V(8); PG8_WAIT_L(0); PG8_BAR; PG8_MMA(1, 0, At, B0); PG8_MMA(1, 1, At, B1); PG8_BAR; PG8_SCHED;
        }
        if constexpr (ALIGN_EPI) { if (wr == 0) PG8_BAR; }
        E(acc, cur, wr, wc, fr, fq);
        if (!has_next) break;
#pragma unroll
        for (int a = 0; a < 2; ++a)
#pragma unroll
            for (int b = 0; b < 2; ++b)
#pragma unroll
                for (int m = 0; m < 4; ++m)
#pragma unroll
                    for (int n = 0; n < 2; ++n) acc[a][b][m][n] = (f32x4){0.f, 0.f, 0.f, 0.f};
        cur = nxt; cA = nA; cB = nB; ++ui;
        c00 = n00; c01 = n01; c10 = n10; c11 = n11;
        if constexpr (ALIGN_EPI) { if (wr == 1) PG8_BAR; }
    }
    PG8_WAIT_V(0);
    if constexpr (!ALIGN_EPI) { if (wr == 0) PG8_BAR; }
    PG8_BAR;
#undef PG8_SA
#undef PG8_SB
#undef PG8_STAGE2
#undef PG8_STAGEB
#undef PG8_LDA
#undef PG8_LDB
#undef PG8_MMA
#undef PG8_WAIT_V
#undef PG8_WAIT_L
#undef PG8_BAR
#undef PG8_SCHED
}
}
namespace mk {
constexpr int NWAVES = 8, NTHR = 512;
constexpr int B = 8, S = 4096, D = 1024, M = B * S;
constexpr int FF = 3584, NE = 8, NBLK = 264, NSLOT = NBLK * 256;
constexpr size_t MiB = 1u << 20;
constexpr size_t F_CTL = 0, CTL_ZERO_BYTES = 1 * MiB;
constexpr size_t F_TOPE = 1 * MiB, F_TOPG = F_TOPE + 256 * 1024, F_SLOTTOK = F_TOPG + 256 * 1024, F_TOKSLOT = F_SLOTTOK + 320 * 1024, F_BLKE = F_TOKSLOT + 256 * 1024, F_NUSED = F_BLKE + 2048;
constexpr size_t F_LI = 3 * MiB, F_LF = 3 * MiB + 512 * 1024;
constexpr size_t F_W = 4 * MiB, F_XN = 180 * MiB, F_BIG = 244 * MiB;
constexpr size_t F_P = F_BIG, F_HH = 436 * MiB, F_G = 564 * MiB;
constexpr size_t F_H = F_BIG;
constexpr size_t F_O = 436 * MiB, F_OT = 500 * MiB;
constexpr size_t F_Y = 706 * MiB;
static_assert(F_NUSED + 64 <= 3 * MiB && F_H + (size_t)NSLOT * FF * 2 <= F_Y && F_Y + (size_t)NSLOT * 1024 * 2 <= 840 * MiB, "ws map");
constexpr int CW_TMO = 0, CW_BAR = 4096;
constexpr int MAX_LAUNCH = 40;
constexpr int RING_OFF = 0, RING_BYTES = 131072, LDSCTL_OFF = RING_BYTES, MISC_OFF = LDSCTL_OFF + 320, LDS_BYTES = 147456;

#define GAS __attribute__((address_space(1)))
#define LAS __attribute__((address_space(3)))
typedef unsigned short bf16;
typedef unsigned v4u __attribute__((ext_vector_type(4)));
typedef unsigned v2u __attribute__((ext_vector_type(2)));
typedef float f32x4 __attribute__((ext_vector_type(4)));
typedef GAS unsigned gu32;
#define RLX_AGENT __ATOMIC_RELAXED, __HIP_MEMORY_SCOPE_AGENT
#define LDS_WAIT() asm volatile("s_waitcnt lgkmcnt(0)" ::: "memory")
#define VM_WAIT() asm volatile("s_waitcnt vmcnt(0)" ::: "memory")
__device__ __forceinline__ unsigned f2bf(float f) { unsigned u = __builtin_bit_cast(unsigned, f); return (u + 0x7fffu + ((u >> 16) & 1u)) >> 16; }
__device__ __forceinline__ unsigned pk2(float lo, float hi) { return f2bf(lo) | (f2bf(hi) << 16); }
__device__ __forceinline__ float bf_lo(unsigned w) { return __builtin_bit_cast(float, w << 16); }
__device__ __forceinline__ float bf_hi(unsigned w) { return __builtin_bit_cast(float, w & 0xffff0000u); }

#define XB_TMO      128
#define XB_XCNT(j)  (256  + 64 * (j))
#define XB_XSUB(j)  (1280 + 64 * (j))
#define XB_XGEN(j)  (2304 + 64 * (j))
#define XB_TOP      3328
#define XB_TOPGEN   3392
#define XCD_BAR_WORDS 3456
#define XB_SPIN_CAP (1u << 18)
__device__ __forceinline__ unsigned xb_ld(unsigned* p)              { return __hip_atomic_load(p, __ATOMIC_RELAXED, __HIP_MEMORY_SCOPE_AGENT); }
__device__ __forceinline__ unsigned xb_add(unsigned* p, unsigned v) { return __hip_atomic_fetch_add(p, v, __ATOMIC_RELAXED, __HIP_MEMORY_SCOPE_AGENT); }
__device__ __forceinline__ unsigned xb_xcc_id() { return (unsigned)__builtin_amdgcn_s_getreg((3 << 11) | 20) & 0xFu; }
#define XB_SPIN(cond, bar) do { unsigned _sp = 0; while (cond) { __builtin_amdgcn_s_sleep(1); \
    if ((++_sp & 255u) == 0u) { if (xb_ld(&(bar)[XB_TMO])) break; if (_sp > XB_SPIN_CAP) { atomicAdd(&(bar)[XB_TMO], 1u); break; } } } } while (0)
struct XcdBarrier { unsigned* bar; unsigned x; volatile LAS unsigned* st; };
__device__ __forceinline__ XcdBarrier xcd_barrier_post(unsigned* bar, volatile LAS unsigned* st, bool t0) {
    XcdBarrier b; b.bar = bar; b.x = xb_xcc_id(); b.st = st;
    if (t0) (void)xb_add(&bar[XB_XCNT(b.x)], 1u);
    return b;
}
__device__ __forceinline__ void xcd_barrier_complete(unsigned* bar, unsigned x, unsigned& nloc, unsigned& nx) {
    const unsigned G = gridDim.x * gridDim.y * gridDim.z;
    unsigned sum, cnt, mine, sp = 0u;
    for (;;) {
        sum = 0u; cnt = 0u; mine = 0u;
#pragma unroll
        for (unsigned j = 0; j < 16; ++j) { const unsigned c = xb_ld(&bar[XB_XCNT(j)]); sum += c; cnt += (c > 0u) ? 1u : 0u; mine = (j == x) ? c : mine; }
        if (sum == G) break;
        __builtin_amdgcn_s_sleep(1);
        if ((++sp & 255u) == 0u) { if (xb_ld(&bar[XB_TMO])) break; if (sp > XB_SPIN_CAP) { atomicAdd(&bar[XB_TMO], 1u); break; } }
    }
    nloc = mine > 0u ? mine : 1u; nx = cnt > 0u ? cnt : 1u;
}
__device__ __forceinline__ void xcd_barrier(const XcdBarrier& b, bool t0) {
    asm volatile("s_waitcnt vmcnt(0)" ::: "memory");
    __syncthreads();
    if (t0) {
        unsigned* bar = b.bar;
        __builtin_amdgcn_s_waitcnt(0);
        unsigned nloc = b.st[0], nx = b.st[1];
        if (nloc == 0u) { xcd_barrier_complete(bar, b.x, nloc, nx); b.st[0] = nloc; b.st[1] = nx; }
        const unsigned old = xb_add(&bar[XB_XSUB(b.x)], 1u);
        const unsigned gen = old / nloc;
        if (old + 1u == (gen + 1u) * nloc) {
            __builtin_amdgcn_fence(__ATOMIC_RELEASE, "agent");
            asm volatile("s_waitcnt vmcnt(0)" ::: "memory");
            const unsigned og = xb_add(&bar[XB_TOP], 1u);
            const unsigned tg = og / nx;
            if (og + 1u == (tg + 1u) * nx) xb_add(&bar[XB_TOPGEN], 1u);
            else XB_SPIN(xb_ld(&bar[XB_TOPGEN]) == tg, bar);
            __builtin_amdgcn_fence(__ATOMIC_ACQUIRE, "agent");
            xb_add(&bar[XB_XGEN(b.x)], 1u);
            asm volatile("s_waitcnt vmcnt(0)" ::: "memory");
        } else {
            XB_SPIN(xb_ld(&bar[XB_XGEN(b.x)]) == gen, bar);
            __builtin_amdgcn_fence(__ATOMIC_ACQUIRE, "agent");
            asm volatile("s_waitcnt vmcnt(0)" ::: "memory");
        }
    }
    __syncthreads();
}

struct Frame {
    LAS unsigned char* lds;
    int vcu, G, wave;
};
__device__ __forceinline__ int lane_id() { int l; asm volatile("v_mbcnt_lo_u32_b32 %0, -1, 0\n\tv_mbcnt_hi_u32_b32 %0, -1, %0" : "=v"(l)); return l; }
__device__ __forceinline__ int fresh_tid(const Frame& F) { return F.wave * 64 + lane_id(); }
__device__ __forceinline__ float shfl_idx(float v, int src_lane) { return __builtin_bit_cast(float, __builtin_amdgcn_ds_bpermute(src_lane << 2, __builtin_bit_cast(int, v))); }
__device__ __forceinline__ int shfl_idx_i(int v, int src_lane) { return __builtin_amdgcn_ds_bpermute(src_lane << 2, v); }
__device__ __forceinline__ float wave_sum(float v, int lane) {
#pragma unroll
    for (int o = 1; o < 64; o <<= 1) v += shfl_idx(v, lane ^ o);
    return v;
}

__device__ __forceinline__ void cvt_item(const float* W, int ldw, int K, bf16* WT, int drow0, LAS float* scr, int k0, int n0, int lane) {
#pragma unroll 8
    for (int i = 0; i < 32; ++i) { const int kk = 2 * i + (lane >> 5); scr[kk * 33 + (lane & 31)] = W[(size_t)(k0 + kk) * ldw + n0 + (lane & 31)]; }
    LDS_WAIT(); asm volatile("" ::: "memory");
    const int c = lane & 7;
#pragma unroll
    for (int j = 0; j < 4; ++j) { const int n = (lane >> 3) + 8 * j; const LAS float* s = scr + (8 * c) * 33 + n;
        v4u o; o.x = pk2(s[0 * 33], s[1 * 33]); o.y = pk2(s[2 * 33], s[3 * 33]); o.z = pk2(s[4 * 33], s[5 * 33]); o.w = pk2(s[6 * 33], s[7 * 33]);
        *(GAS v4u*)(WT + (size_t)(drow0 + n) * K + k0 + 8 * c) = o; }
    LDS_WAIT(); asm volatile("" ::: "memory");
}
__device__ __forceinline__ void cvt_job(Frame& F, const float* W, int ldw, int K, int N, int nmat, size_t smat, bf16* WT, size_t dmat, int mode, int rot) {
    const int tid = fresh_tid(F), lane = tid & 63, wave = __builtin_amdgcn_readfirstlane(tid >> 6);
    LAS float* scr = (LAS float*)(F.lds + RING_OFF + wave * 8448);
    const int NGW = F.G * NWAVES; const int gw = (F.vcu * NWAVES + wave + rot) % NGW;
    const int nblk = N / 32, per = (K / 64) * nblk, total = per * nmat;
    for (int it = gw; it < total; it += NGW) {
        const int mat = it / per, r = it % per, kb = r / nblk, nb = r % nblk, n0 = 32 * nb;
        const int drow0 = mode == 0 ? n0 : ((n0 >> 7) * 256 + (n0 & 127) + (mode == 2 ? 128 : 0));
        cvt_item(W + (size_t)mat * smat, ldw, K, WT + (size_t)mat * dmat, drow0, scr, 64 * kb, n0, lane);
    }
}

constexpr int SLAB_OFF_ = 73728;
constexpr int SLAB_OFF = SLAB_OFF_;
struct RowJob {
    const float* xsrc; float* xdst;
    const float* nw;
    bf16* XN; float* outf;
    const bf16* Y; const int* tok_slot; const float* top_g;
    const float* slab; int slab_ld;
    int kind;
    const float* b0; const float* b1; float* LI; float* LF; int* top_e; float* top_g_out; int* wg_cnt;
};
constexpr int EREC_OFF = SLAB_OFF_ + 32768;

__device__ __forceinline__ void row_phase(Frame& F, const RowJob& J) {
    LAS float* slab = (LAS float*)(F.lds + SLAB_OFF);
    const int tid = fresh_tid(F), lane = tid & 63, wave = __builtin_amdgcn_readfirstlane(tid >> 6);
    if (J.slab) { for (int i = tid; i < 8192; i += NTHR) slab[i] = J.slab[(size_t)(i >> 3) * J.slab_ld + (i & 7)]; }
    __syncthreads();
    LAS int* erec = (LAS int*)(F.lds + EREC_OFF);
    const int rpw = M / (F.G * NWAVES), m0 = (F.vcu * NWAVES + wave) * rpw;
    for (int m = m0; m < m0 + rpw; ++m) {
        const GAS f32x4* xr = (const GAS f32x4*)(J.xsrc + (size_t)m * D) + lane;
        f32x4 v[4];
#pragma unroll
        for (int j = 0; j < 4; ++j) v[j] = xr[64 * j];
        if (J.Y) {
            const int s0 = J.tok_slot[m * 2], s1 = J.tok_slot[m * 2 + 1]; const float g0 = J.top_g[m * 2], g1 = J.top_g[m * 2 + 1];
            const GAS v2u* y0 = (const GAS v2u*)(J.Y + (size_t)s0 * D) + lane; const GAS v2u* y1 = (const GAS v2u*)(J.Y + (size_t)s1 * D) + lane;
#pragma unroll
            for (int j = 0; j < 4; ++j) { const v2u a = y0[64 * j], b = y1[64 * j];
                v[j].x += g0 * bf_lo(a.x) + g1 * bf_lo(b.x); v[j].y += g0 * bf_hi(a.x) + g1 * bf_hi(b.x); v[j].z += g0 * bf_lo(a.y) + g1 * bf_lo(b.y); v[j].w += g0 * bf_hi(a.y) + g1 * bf_hi(b.y); }
        }
        if (J.xdst) { GAS f32x4* xo = (GAS f32x4*)(J.xdst + (size_t)m * D) + lane;
#pragma unroll
            for (int j = 0; j < 4; ++j) xo[64 * j] = v[j]; }
        float ss = 0.f;
#pragma unroll
        for (int j = 0; j < 4; ++j) ss += (v[j].x * v[j].x + v[j].y * v[j].y) + (v[j].z * v[j].z + v[j].w * v[j].w);
        const float rstd = 1.0f / sqrtf(wave_sum(ss, lane) * (1.f / D) + 1e-6f);
#pragma unroll
        for (int j = 0; j < 4; ++j) { const f32x4 w = ((const GAS f32x4*)J.nw)[lane + 64 * j]; v[j] = v[j] * rstd * w; }
        if (J.outf) { GAS f32x4* o = (GAS f32x4*)(J.outf + (size_t)m * D) + lane;
#pragma unroll
            for (int j = 0; j < 4; ++j) o[64 * j] = v[j]; }
        if (J.XN) { GAS v2u* o = (GAS v2u*)(J.XN + (size_t)m * D) + lane;
#pragma unroll
            for (int j = 0; j < 4; ++j) { v2u w; w.x = pk2(v[j].x, v[j].y); w.y = pk2(v[j].z, v[j].w); o[64 * j] = w; } }
        if (J.slab) {
            float acc[8];
#pragma unroll
            for (int e = 0; e < 8; ++e) acc[e] = 0.f;
#pragma unroll
            for (int j = 0; j < 4; ++j)
#pragma unroll
                for (int i = 0; i < 4; ++i) { const int k = (lane + 64 * j) * 4 + i; const float xv = v[j][i];
                    const f32x4 w0 = *(const LAS f32x4*)(slab + k * 8), w1 = *(const LAS f32x4*)(slab + k * 8 + 4);
                    acc[0] += xv * w0.x; acc[1] += xv * w0.y; acc[2] += xv * w0.z; acc[3] += xv * w0.w; acc[4] += xv * w1.x; acc[5] += xv * w1.y; acc[6] += xv * w1.z; acc[7] += xv * w1.w; }
#pragma unroll
            for (int e = 0; e < 8; ++e) acc[e] = wave_sum(acc[e], lane);
            if (J.kind == 1) {
                if (lane < 4) { float a = acc[0]; a = lane == 1 ? acc[1] : a; a = lane == 2 ? acc[2] : a; a = lane == 3 ? acc[3] : a; J.LI[m * 4 + lane] = a + J.b0[lane]; }
                else if (lane < 8) { const int h = lane - 4; float a = acc[4]; a = h == 1 ? acc[5] : a; a = h == 2 ? acc[6] : a; a = h == 3 ? acc[7] : a;
                    const float z = a + J.b1[h]; const float ez = __expf(-fabsf(z));
                    const float l1p = ez < 0.06f ? ez * (1.f + ez * (-0.5f + ez * (0.33333333f - 0.25f * ez))) : __logf(1.f + ez);
                    J.LF[m * 4 + h] = fminf(z, 0.f) - l1p; }
            } else if (J.kind == 2) {
                if (lane == 0) {
#pragma unroll
                    for (int e = 0; e < 8; ++e) acc[e] += J.b0[e];
                    int e0 = 0; float l0 = acc[0];
#pragma unroll
                    for (int e = 1; e < 8; ++e) if (acc[e] > l0) { l0 = acc[e]; e0 = e; }
                    int e1 = 0; float l1 = -INFINITY;
#pragma unroll
                    for (int e = 0; e < 8; ++e) if (e != e0 && acc[e] > l1) { l1 = acc[e]; e1 = e; }
                    const float ex = __expf(l1 - l0);
                    J.top_e[m * 2] = e0; J.top_e[m * 2 + 1] = e1; J.top_g_out[m * 2] = 1.f / (1.f + ex); J.top_g_out[m * 2 + 1] = ex / (1.f + ex);
                    const int ml = m - F.vcu * NWAVES * rpw; erec[ml * 2] = e0; erec[ml * 2 + 1] = e1;
                }
            }
        }
    }
    if (J.kind == 2) {
        __syncthreads();
        if (tid < 8) { int c = 0; const int na = 2 * NWAVES * rpw; for (int i = 0; i < na; ++i) c += (erec[i] == tid) ? 1 : 0; J.wg_cnt[F.vcu * 8 + tid] = c; }
    }
}
}
namespace att {
using bf16x8 = __attribute__((ext_vector_type(8))) short;
using s16x4 = __attribute__((ext_vector_type(4))) short;
using f32x16 = __attribute__((ext_vector_type(16))) float;
using u32x4 = __attribute__((ext_vector_type(4))) unsigned;
typedef __attribute__((address_space(3))) const char* lds_cptr;
typedef __attribute__((address_space(3))) char* lds_ptr;
typedef short v4i16_t __attribute__((ext_vector_type(4)));
constexpr int SEQ = 4096, PITCH = 3072, QB = 256, KVBLK = 64, NQB = SEQ / QB;
constexpr int NSLOT = 3, KSLOT = 8192, VSLOT = 16384;
constexpr int LDS_K = 0, LDS_V = NSLOT * KSLOT, LDS_WS = LDS_V + NSLOT * VSLOT, LDS_BT = LDS_WS + 8 * 256, LDS_END = LDS_BT + 512;
constexpr float LOG2E = 1.4426950408889634f;
#define ATT_MFMA(a, b, c) __builtin_amdgcn_mfma_f32_32x32x16_bf16(a, b, c, 0, 0, 0)
__device__ __forceinline__ int crow(int r, int hi) { return (r & 3) + 8 * (r >> 2) + 4 * hi; }
__device__ __forceinline__ void glds16(const void* gsrc, unsigned lds_dst) { unsigned keep;
    asm volatile("s_mov_b32 %0, m0\n\ts_mov_b32 m0, %2\n\ts_nop 0\n\tglobal_load_lds_dwordx4 %1, off\n\ts_mov_b32 m0, %0" : "=&s"(keep) : "v"(gsrc), "s"(lds_dst) : "memory"); }
typedef float f32x2_t __attribute__((ext_vector_type(2))); typedef __bf16 bf16x2_t __attribute__((ext_vector_type(2)));
__device__ __forceinline__ unsigned cvtpk(float lo, float hi) { f32x2_t v = {lo, hi}; bf16x2_t b = __builtin_convertvector(v, bf16x2_t); return __builtin_bit_cast(unsigned, b); }
__device__ __forceinline__ s16x4 vtr(lds_cptr p) { return __builtin_bit_cast(s16x4, __builtin_amdgcn_ds_read_tr16_b64_v4i16((__attribute__((address_space(3))) v4i16_t*)p)); }
#define ATT_MX3(a, b, c) __builtin_fmaxf(__builtin_fmaxf((a), (b)), (c))
__device__ __forceinline__ float rowmax(const f32x16& p0, const f32x16& p1) {
    float a = ATT_MX3(p0[0], p0[1], p1[0]), b = ATT_MX3(p0[2], p0[3], p1[1]); a = ATT_MX3(a, p1[2], p1[3]);
#pragma unroll
    for (int r = 4; r < 16; r += 4) { a = ATT_MX3(a, p0[r], p0[r + 1]); b = ATT_MX3(b, p0[r + 2], p0[r + 3]); a = ATT_MX3(a, p1[r], p1[r + 1]); b = ATT_MX3(b, p1[r + 2], p1[r + 3]); }
    const float m = __builtin_fmaxf(a, b); auto rr = __builtin_amdgcn_permlane32_swap(__float_as_uint(m), __float_as_uint(m), false, false);
    return __builtin_fmaxf(__uint_as_float(rr[0]), __uint_as_float(rr[1])); }
#define ATT_WAIT_BAR(N) asm volatile("s_waitcnt vmcnt(" #N ") lgkmcnt(0)\n\ts_barrier" ::: "memory")

struct Params {
    const unsigned short* QKV; unsigned short* O; float* OT;
    const float* rel; const float* subln; float lam, lam_init;
};

template <int PASS>
__device__ __forceinline__ void attn_pass(int b, int h, int qb, const Params& P, lds_ptr shm, int wid, int lane_in) {
    int lane; asm volatile("v_mbcnt_lo_u32_b32 %0, -1, 0\n\tv_mbcnt_hi_u32_b32 %0, -1, %0" : "=v"(lane));
    (void)lane_in;
    const int r32 = lane & 31, hi = lane >> 5, m = 2 * h + PASS;
    const long rowbase = (long)b * SEQ; const int q0 = qb * QB, NT = (q0 + QB) / KVBLK;
    const unsigned short* Qw = P.QKV + (rowbase + q0 + wid * 32) * PITCH + m * 64;
    const unsigned short* Kh = P.QKV + rowbase * PITCH + 1024 + m * 64; const unsigned short* Vh = P.QKV + rowbase * PITCH + 2048 + h * 128;
    const unsigned lds0 = (unsigned)(uintptr_t)shm;
    __attribute__((address_space(3))) float* wsf = (__attribute__((address_space(3))) float*)(shm + LDS_WS) + wid * 64;
    __attribute__((address_space(3))) float* BT = (__attribute__((address_space(3))) float*)(shm + LDS_BT);
    if (wid < 2) { const int rel = wid * 64 + lane; BT[rel] = P.rel[nv::BUCKET[rel] * 16 + m] * LOG2E; }
    const float c31 = P.rel[31 * 16 + m] * LOG2E;
    const unsigned short* ksrc = Kh + (long)lane * PITCH + wid * 8;
    const unsigned short* vsrc = Vh + (long)(16 * (wid & 3) + (lane >> 2)) * PITCH + (wid >> 2) * 32 + (lane & 3) * 8;
    const unsigned kdst = lds0 + LDS_K + wid * 1024, vdst = lds0 + LDS_V + wid * 1024;
#define ATT_DMA(t, s) do { glds16(ksrc + (long)(t) * KVBLK * PITCH, (unsigned)__builtin_amdgcn_readfirstlane(kdst + (s) * KSLOT)); \
        glds16(vsrc + (long)(t) * KVBLK * PITCH, (unsigned)__builtin_amdgcn_readfirstlane(vdst + (s) * VSLOT)); \
        glds16(vsrc + (long)(t) * KVBLK * PITCH + 64, (unsigned)__builtin_amdgcn_readfirstlane(vdst + (s) * VSLOT + 8192)); } while (0)
    ATT_DMA(0, 0); ATT_DMA(1, 1);
    bf16x8 qr[4];
#pragma unroll
    for (int d0 = 0; d0 < 4; ++d0) qr[d0] = *reinterpret_cast<const bf16x8*>(&Qw[(long)r32 * PITCH + d0 * 16 + hi * 8]);
    float mhat = 0.f, l_reg = 0.f; f32x16 o[4];
#pragma unroll
    for (int d = 0; d < 4; ++d) o[d] = f32x16{};
    f32x16 negm;
#pragma unroll
    for (int r = 0; r < 16; ++r) negm[r] = c31;
    const int qabs = q0 + wid * 32 + r32;
    const lds_cptr kp0 = (lds_cptr)shm + LDS_K + hi * 1024 + r32 * 16;
    const lds_cptr vp0 = (lds_cptr)shm + LDS_V + ((lane >> 4) & 1) * 32 + (lane & 3) * 8 + (4 * hi + ((lane & 15) >> 2)) * 64;
    int slot = 0;
#pragma unroll 1
    for (int t = 0; t < NT; ++t) {
        if (t + 1 < NT) { ATT_WAIT_BAR(3); } else { ATT_WAIT_BAR(0); }
        if (t + 2 < NT) { const int s2 = slot == 0 ? 2 : slot - 1; ATT_DMA(t + 2, s2); }
        const lds_cptr kp = kp0 + slot * KSLOT; const lds_cptr vp = vp0 + slot * VSLOT;
        f32x16 p0, p1;
        if (t + 6 < NT) { p0 = negm; p1 = negm; }
        else {
            const int kb = t * KVBLK + 4 * hi;
#pragma unroll
            for (int r = 0; r < 16; ++r) { const int k0 = kb + (r & 3) + 8 * (r >> 2); int rel0 = qabs - k0, rel1 = rel0 - 32;
                const float b0 = BT[rel0 < 0 ? 0 : (rel0 > 127 ? 127 : rel0)], b1 = BT[rel1 < 0 ? 0 : (rel1 > 127 ? 127 : rel1)];
                p0[r] = rel0 < 0 ? -INFINITY : b0 - mhat; p1[r] = rel1 < 0 ? -INFINITY : b1 - mhat; }
        }
#pragma unroll
        for (int d0 = 0; d0 < 4; ++d0) {
            const bf16x8 k0 = *(const __attribute__((address_space(3))) bf16x8*)(kp + d0 * 2048), k1 = *(const __attribute__((address_space(3))) bf16x8*)(kp + d0 * 2048 + 512);
            p0 = ATT_MFMA(k0, qr[d0], p0); p1 = ATT_MFMA(k1, qr[d0], p1);
            if (d0 & 1) __builtin_amdgcn_sched_barrier(0);
        }
        const float rm = rowmax(p0, p1);
        bool resc = false;
        if (t == 0 || __any(rm > 8.0f)) {
            const float dl = t == 0 ? rm : __builtin_fmaxf(rm, 0.f);
            mhat += dl;
#pragma unroll
            for (int r = 0; r < 16; ++r) { p0[r] -= dl; p1[r] -= dl; }
#pragma unroll
            for (int r = 0; r < 16; ++r) negm[r] = c31 - mhat;
            const float f = __builtin_amdgcn_exp2f(-dl); l_reg *= f; if (hi == 0) wsf[r32] = f; resc = (t != 0);
        }
        float sacc = 0.f;
#pragma unroll
        for (int r = 0; r < 16; ++r) { p0[r] = __builtin_amdgcn_exp2f(p0[r]); p1[r] = __builtin_amdgcn_exp2f(p1[r]); sacc += p0[r] + p1[r]; }
        l_reg += sacc;
        u32x4 pw0 = (u32x4){cvtpk(p0[0], p0[1]), cvtpk(p0[2], p0[3]), cvtpk(p0[4], p0[5]), cvtpk(p0[6], p0[7])};
        u32x4 pw1 = (u32x4){cvtpk(p0[8], p0[9]), cvtpk(p0[10], p0[11]), cvtpk(p0[12], p0[13]), cvtpk(p0[14], p0[15])};
        u32x4 pw2 = (u32x4){cvtpk(p1[0], p1[1]), cvtpk(p1[2], p1[3]), cvtpk(p1[4], p1[5]), cvtpk(p1[6], p1[7])};
        u32x4 pw3 = (u32x4){cvtpk(p1[8], p1[9]), cvtpk(p1[10], p1[11]), cvtpk(p1[12], p1[13]), cvtpk(p1[14], p1[15])};
        __builtin_amdgcn_sched_barrier(0);
        if (resc) {
#pragma unroll
            for (int r = 0; r < 16; ++r) { const float f = wsf[crow(r, hi)];
#pragma unroll
                for (int d = 0; d < 4; ++d) o[d][r] *= f; }
        }
#pragma unroll
        for (int d0 = 0; d0 < 4; ++d0) {
            s16x4 lo[4], hh[4];
#pragma unroll
            for (int ks = 0; ks < 4; ++ks) { lo[ks] = vtr(vp + d0 * 4096 + ks * 1024); hh[ks] = vtr(vp + d0 * 4096 + ks * 1024 + 512); }
#define ATT_PK(k) (bf16x8){lo[k][0], lo[k][1], lo[k][2], lo[k][3], hh[k][0], hh[k][1], hh[k][2], hh[k][3]}
            o[d0] = ATT_MFMA(__builtin_bit_cast(bf16x8, pw0), ATT_PK(0), o[d0]);
            o[d0] = ATT_MFMA(__builtin_bit_cast(bf16x8, pw1), ATT_PK(1), o[d0]);
            o[d0] = ATT_MFMA(__builtin_bit_cast(bf16x8, pw2), ATT_PK(2), o[d0]);
            o[d0] = ATT_MFMA(__builtin_bit_cast(bf16x8, pw3), ATT_PK(3), o[d0]);
            __builtin_amdgcn_sched_barrier(0);
#undef ATT_PK
        }
        slot = slot == 2 ? 0 : slot + 1;
    }
#undef ATT_DMA
    { auto rr = __builtin_amdgcn_permlane32_swap(__float_as_uint(l_reg), __float_as_uint(l_reg), false, false); l_reg = __uint_as_float(rr[0]) + __uint_as_float(rr[1]); }
    if (hi == 0) wsf[32 + r32] = l_reg;
    asm volatile("s_waitcnt lgkmcnt(0)" ::: "memory");
    float rli[16];
#pragma unroll
    for (int r = 0; r < 16; ++r) rli[r] = __builtin_amdgcn_rcpf(wsf[32 + crow(r, hi)]);
    float* OTw = P.OT + (rowbase + q0 + wid * 32) * 1024 + h * 128;
    if (PASS == 0) {
#pragma unroll
        for (int r = 0; r < 16; ++r)
#pragma unroll
            for (int d = 0; d < 4; ++d) OTw[(long)crow(r, hi) * 1024 + d * 32 + r32] = o[d][r] * rli[r];
        asm volatile("s_waitcnt vmcnt(0) lgkmcnt(0)\n\ts_barrier" ::: "memory");
    } else {
        float ss[16];
#pragma unroll
        for (int r = 0; r < 16; ++r) { float s = 0.f;
#pragma unroll
            for (int d = 0; d < 4; ++d) { const float a = OTw[(long)crow(r, hi) * 1024 + d * 32 + r32] - P.lam * (o[d][r] * rli[r]); o[d][r] = a; s += a * a; }
            ss[r] = s; if ((r & 3) == 3) __builtin_amdgcn_sched_barrier(0); }
#pragma unroll
        for (int x = 1; x < 32; x <<= 1)
#pragma unroll
            for (int r = 0; r < 16; ++r) ss[r] += __builtin_bit_cast(float, __builtin_amdgcn_ds_bpermute((lane ^ x) << 2, __builtin_bit_cast(int, ss[r])));
        float sw[4];
#pragma unroll
        for (int d = 0; d < 4; ++d) sw[d] = P.subln[d * 32 + r32] * (1.f - P.lam_init);
        asm volatile("s_waitcnt vmcnt(0) lgkmcnt(0)\n\ts_barrier" ::: "memory");
        __attribute__((address_space(3))) unsigned short* stg = (__attribute__((address_space(3))) unsigned short*)(shm) + wid * 4096;
#pragma unroll
        for (int r = 0; r < 16; ++r) { const float rs = 1.0f / sqrtf(ss[r] * (1.f / 128.f) + 1e-5f); const int orow = crow(r, hi);
#pragma unroll
            for (int d = 0; d < 4; ++d) { const float v = o[d][r] * rs * sw[d]; stg[orow * 128 + d * 32 + r32] = (unsigned short)(cvtpk(v, v) & 0xffffu); } }
        asm volatile("s_waitcnt lgkmcnt(0)" ::: "memory");
        unsigned short* Ow = P.O + (rowbase + q0 + wid * 32) * 1024 + h * 128;
#pragma unroll
        for (int i = 0; i < 8; ++i) { const int row = i * 4 + (lane >> 4), ch = lane & 15; const u32x4 v = *(const __attribute__((address_space(3))) u32x4*)(stg + row * 128 + ch * 8); *(u32x4*)(Ow + (long)row * 1024 + ch * 8) = v; }
        asm volatile("s_waitcnt vmcnt(0) lgkmcnt(0)\n\ts_barrier" ::: "memory");
    }
}
__device__ __forceinline__ void attn_phase(const Params& P, lds_ptr shm, int vcu, int G, int wid, int lane) {
    if (G == 256) {
        const int bh = vcu >> 2, s = vcu & 3;
        for (int i = 0; i < 4; ++i) { const int qb = (i == 0) ? s : (i == 1) ? 7 - s : (i == 2) ? 8 + s : 15 - s;
            attn_pass<0>(bh >> 3, bh & 7, qb, P, shm, wid, lane); attn_pass<1>(bh >> 3, bh & 7, qb, P, shm, wid, lane); }
    } else {
        for (int u = vcu; u < 64 * NQB; u += G) { const int bh = u >> 4, qb = u & 15;
            attn_pass<0>(bh >> 3, bh & 7, qb, P, shm, wid, lane); attn_pass<1>(bh >> 3, bh & 7, qb, P, shm, wid, lane); }
    }
}
}
namespace mls {
using bf16x8 = __attribute__((ext_vector_type(8))) short;
using f32x4 = __attribute__((ext_vector_type(4))) float;
using u32x4 = __attribute__((ext_vector_type(4))) unsigned;
using u32x2 = __attribute__((ext_vector_type(2))) unsigned;
#define MLS_LAS __attribute__((address_space(3)))
typedef MLS_LAS char* lptr;
constexpr int SEQ = 4096, PITCH = 3072, L = 64, NCH = SEQ / L;
constexpr int QSTR = 136, SSTR = 72;
constexpr int QS = 0, KS = QS + 64 * QSTR * 2, KT = KS + 64 * QSTR * 2, VT = KT + 128 * SSTR * 2, VW = VT + 32 * SSTR * 2, SD = VW + 32 * SSTR * 2, CT = SD + 64 * SSTR * 2,
              NV = CT + 32 * QSTR * 2, FV = NV + 256, AV = FV + 256, IV = AV + 256, EV = IV + 256, WV = EV + 256, WB = WV + 256, DC = WB + 128, LDS_END = DC + 16;
static_assert(LDS_END <= 131072, "mLSTM LDS");
#define MLS_MFMA(a, b, c) __builtin_amdgcn_mfma_f32_16x16x32_bf16(a, b, c, 0, 0, 0)
#define MLS_BAR() asm volatile("s_waitcnt lgkmcnt(0)\n\ts_barrier" ::: "memory")
__device__ __forceinline__ unsigned pk(float lo, float hi) { typedef float f2 __attribute__((ext_vector_type(2))); typedef __bf16 b2 __attribute__((ext_vector_type(2))); f2 v = {lo, hi}; b2 b = __builtin_convertvector(v, b2); return __builtin_bit_cast(unsigned, b); }
__device__ __forceinline__ float blo(unsigned w) { return __builtin_bit_cast(float, w << 16); }
__device__ __forceinline__ float bhi(unsigned w) { return __builtin_bit_cast(float, w & 0xffff0000u); }
__device__ __forceinline__ float bperm(float v, int src) { return __builtin_bit_cast(float, __builtin_amdgcn_ds_bpermute(src << 2, __builtin_bit_cast(int, v))); }

struct Params { const unsigned short* P; const float* LI; const float* LF; const float* cw; const float* cb; float* HH; };

__device__ __forceinline__ void scan_unit(int b, int h, int sl, const Params& A, lptr shm, int wid, int lane) {
    const int tid = wid * 64 + lane, lr = lane & 15, lq = lane >> 4;
    const long rowbase = (long)b * SEQ;
    const int o = tid & 31, g = tid >> 5, isk = o >> 4, ch0 = (o & 15) * 8;
    const int pcol = isk * 512 + h * 128 + ch0;
    float cwr[4][8], cbr[8];
#pragma unroll
    for (int j = 0; j < 4; ++j) { const f32x4 a = *(const f32x4*)(A.cw + j * 1024 + pcol), c = *(const f32x4*)(A.cw + j * 1024 + pcol + 4);
        cwr[j][0] = a[0]; cwr[j][1] = a[1]; cwr[j][2] = a[2]; cwr[j][3] = a[3]; cwr[j][4] = c[0]; cwr[j][5] = c[1]; cwr[j][6] = c[2]; cwr[j][7] = c[3]; }
    { const f32x4 a = *(const f32x4*)(A.cb + pcol), c = *(const f32x4*)(A.cb + pcol + 4); cbr[0] = a[0]; cbr[1] = a[1]; cbr[2] = a[2]; cbr[3] = a[3]; cbr[4] = c[0]; cbr[5] = c[1]; cbr[6] = c[2]; cbr[7] = c[3]; }
    const float osc = isk ? 0.08838834764831845f : 1.0f;
    const unsigned short* rawp = A.P + (rowbase + 4 * g - 3) * PITCH + pcol;
    const int vs = tid >> 3, vj = (tid & 7) * 4;
    const unsigned short* vp = A.P + (rowbase + vs) * PITCH + 1024 + h * 256 + sl * 32 + vj;
    const int to = wid >> 1, jo = wid & 1;
    f32x4 Cst[2], nst;
    Cst[0] = (f32x4){0.f, 0.f, 0.f, 0.f}; Cst[1] = Cst[0]; nst = Cst[0];
    for (int i = tid; i < (32 * QSTR * 2 + 256) / 4; i += 512) ((MLS_LAS unsigned*)(shm + CT))[i] = 0u;
    float m_prev = 0.f;
    bf16x8 ones; { const short o1 = (short)0x3f80; ones = (bf16x8){o1, o1, o1, o1, o1, o1, o1, o1}; }
    float* hhp = A.HH + (rowbase + 16 * to + 4 * lq) * 1024 + h * 256 + sl * 32 + 16 * jo + lr;
    u32x4 raw[7]; u32x2 vraw; float gli = 0.f, glf = 0.f;
#pragma unroll
    for (int i = 0; i < 7; ++i) { if (4 * g - 3 + i >= 0) raw[i] = *(const u32x4*)(rawp + (long)i * PITCH); else raw[i] = (u32x4){0u, 0u, 0u, 0u}; }
    vraw = *(const u32x2*)vp;
    if (wid == 7) { gli = A.LI[(rowbase + lane) * 4 + h]; glf = A.LF[(rowbase + lane) * 4 + h]; }
    MLS_BAR();
#pragma unroll 1
    for (int c = 0; c < NCH; ++c) {
        const int t0 = c * L;
        float vv[4]; vv[0] = blo(vraw[0]); vv[1] = bhi(vraw[0]); vv[2] = blo(vraw[1]); vv[3] = bhi(vraw[1]);
        {
            float x[7][8];
#pragma unroll
            for (int i = 0; i < 7; ++i) { x[i][0] = blo(raw[i][0]); x[i][1] = bhi(raw[i][0]); x[i][2] = blo(raw[i][1]); x[i][3] = bhi(raw[i][1]); x[i][4] = blo(raw[i][2]); x[i][5] = bhi(raw[i][2]); x[i][6] = blo(raw[i][3]); x[i][7] = bhi(raw[i][3]); }
            float y[4][8];
#pragma unroll
            for (int r = 0; r < 4; ++r)
#pragma unroll
                for (int e = 0; e < 8; ++e) { float a = cbr[e];
#pragma unroll
                    for (int j = 0; j < 4; ++j) a += cwr[j][e] * x[r + j][e];
                    y[r][e] = osc * a * __builtin_amdgcn_rcpf(1.0f + __builtin_amdgcn_exp2f(-1.4426950408889634f * a)); }
#pragma unroll
            for (int r = 0; r < 4; ++r) { const u32x4 w = (u32x4){pk(y[r][0], y[r][1]), pk(y[r][2], y[r][3]), pk(y[r][4], y[r][5]), pk(y[r][6], y[r][7])};
                *(MLS_LAS u32x4*)(shm + (isk ? KS : QS) + ((4 * g + r) * QSTR + ch0) * 2) = w; }
            if (isk) {
#pragma unroll
                for (int e = 0; e < 8; ++e) { const u32x2 w = (u32x2){pk(y[0][e], y[1][e]), pk(y[2][e], y[3][e])}; *(MLS_LAS u32x2*)(shm + KT + ((ch0 + e) * SSTR + 4 * g) * 2) = w; }
            }
        }
#pragma unroll
        for (int e = 0; e < 4; ++e) *(MLS_LAS unsigned short*)(shm + VT + ((vj + e) * SSTR + vs) * 2) = (unsigned short)(pk(vv[e], vv[e]) & 0xffffu);
        if (wid == 7) {
            float bs = glf;
#pragma unroll
            for (int x = 1; x < 64; x <<= 1) { const float v = bperm(bs, (lane - x) & 63); if (lane >= x) bs += v; }
            const float a = gli - bs;
            float pm = a;
#pragma unroll
            for (int x = 1; x < 64; x <<= 1) { const float v = bperm(pm, (lane - x) & 63); if (lane >= x) pm = fmaxf(pm, v); }
            const float gsum = bperm(bs, 63), amax = bperm(pm, 63);
            const float mref = fmaxf(m_prev, pm);
            const float mt = bs + mref;
            const float mrefn = fmaxf(m_prev, amax);
            const float w = __expf(a - mrefn);
            ((MLS_LAS float*)(shm + FV))[lane] = -mref;
            ((MLS_LAS float*)(shm + AV))[lane] = a;
            ((MLS_LAS float*)(shm + IV))[lane] = __expf(m_prev - mref);
            ((MLS_LAS float*)(shm + EV))[lane] = __expf(-mt);
            ((MLS_LAS float*)(shm + WV))[lane] = w;
            ((MLS_LAS unsigned short*)(shm + WB))[lane] = (unsigned short)(pk(w, w) & 0xffffu);
            if (lane == 0) ((MLS_LAS float*)(shm + DC))[0] = __expf(m_prev - mrefn);
            m_prev = gsum + mrefn;
        }
        if (c + 1 < NCH) {
            const long adv = (long)(t0 + L) * PITCH;
#pragma unroll
            for (int i = 0; i < 7; ++i) raw[i] = *(const u32x4*)(rawp + adv + (long)i * PITCH);
            vraw = *(const u32x2*)(vp + adv);
            if (wid == 7) { gli = A.LI[(rowbase + t0 + L + lane) * 4 + h]; glf = A.LF[(rowbase + t0 + L + lane) * 4 + h]; }
        }
        MLS_BAR();
        { const float w = ((MLS_LAS float*)(shm + WV))[vs];
#pragma unroll
          for (int e = 0; e < 4; ++e) *(MLS_LAS unsigned short*)(shm + VW + ((vj + e) * SSTR + vs) * 2) = (unsigned short)(pk(vv[e] * w, vv[e] * w) & 0xffffu); }
        bf16x8 qa[4];
#pragma unroll
        for (int ks = 0; ks < 4; ++ks) qa[ks] = *(const MLS_LAS bf16x8*)(shm + QS + ((16 * to + lr) * QSTR + 32 * ks + 8 * lq) * 2);
        f32x4 fvr; { const f32x4 t4 = *(const MLS_LAS f32x4*)(shm + FV + (16 * to + 4 * lq) * 4); fvr = t4; }
#pragma unroll
        for (int q = 0; q < 2; ++q) {
            const int si = 2 * jo + q;
            f32x4 s4 = (f32x4){0.f, 0.f, 0.f, 0.f};
            if (si <= to) {
#pragma unroll
                for (int ks = 0; ks < 4; ++ks) { const bf16x8 kb = *(const MLS_LAS bf16x8*)(shm + KS + ((16 * si + lr) * QSTR + 32 * ks + 8 * lq) * 2); s4 = MLS_MFMA(qa[ks], kb, s4); }
                const float av = ((MLS_LAS float*)(shm + AV))[16 * si + lr];
                const int scol = 16 * si + lr, trow = 16 * to + 4 * lq;
#pragma unroll
                for (int r = 0; r < 4; ++r) s4[r] = (scol <= trow + r) ? s4[r] * __expf(fvr[r] + av) : 0.f;
            }
#pragma unroll
            for (int r = 0; r < 4; ++r) *(MLS_LAS unsigned short*)(shm + SD + ((16 * to + 4 * lq + r) * SSTR + 16 * si + lr) * 2) = (unsigned short)(pk(s4[r], s4[r]) & 0xffffu);
        }
        f32x4 qc = (f32x4){0.f, 0.f, 0.f, 0.f}, qn = qc;
#pragma unroll
        for (int ks = 0; ks < 4; ++ks) { const bf16x8 cb8 = *(const MLS_LAS bf16x8*)(shm + CT + ((16 * jo + lr) * QSTR + 32 * ks + 8 * lq) * 2); const bf16x8 nb8 = *(const MLS_LAS bf16x8*)(shm + NV + (32 * ks + 8 * lq) * 2);
            qc = MLS_MFMA(qa[ks], cb8, qc); qn = MLS_MFMA(qa[ks], nb8, qn); }
        MLS_BAR();
        {
            f32x4 sv = (f32x4){0.f, 0.f, 0.f, 0.f}, rs = sv;
#pragma unroll
            for (int ks = 0; ks < 2; ++ks) { const bf16x8 sa = *(const MLS_LAS bf16x8*)(shm + SD + ((16 * to + lr) * SSTR + 32 * ks + 8 * lq) * 2); const bf16x8 vb = *(const MLS_LAS bf16x8*)(shm + VT + ((16 * jo + lr) * SSTR + 32 * ks + 8 * lq) * 2);
                sv = MLS_MFMA(sa, vb, sv); rs = MLS_MFMA(sa, ones, rs); }
            const f32x4 iv = *(const MLS_LAS f32x4*)(shm + IV + (16 * to + 4 * lq) * 4), ev = *(const MLS_LAS f32x4*)(shm + EV + (16 * to + 4 * lq) * 4);
#pragma unroll
            for (int r = 0; r < 4; ++r) { const float num = sv[r] + iv[r] * qc[r], den = rs[r] + iv[r] * qn[r]; hhp[(long)(t0 + r) * 1024] = num / fmaxf(fabsf(den), ev[r]); }
        }
        {
            const float decay = ((MLS_LAS float*)(shm + DC))[0];
            Cst[0] = Cst[0] * decay; Cst[1] = Cst[1] * decay; nst = nst * decay;
#pragma unroll
            for (int ks = 0; ks < 2; ++ks) { const bf16x8 ka = *(const MLS_LAS bf16x8*)(shm + KT + ((16 * wid + lr) * SSTR + 32 * ks + 8 * lq) * 2);
                const bf16x8 v0 = *(const MLS_LAS bf16x8*)(shm + VW + ((lr) * SSTR + 32 * ks + 8 * lq) * 2), v1 = *(const MLS_LAS bf16x8*)(shm + VW + ((16 + lr) * SSTR + 32 * ks + 8 * lq) * 2);
                const bf16x8 wb8 = *(const MLS_LAS bf16x8*)(shm + WB + (32 * ks + 8 * lq) * 2);
                Cst[0] = MLS_MFMA(ka, v0, Cst[0]); Cst[1] = MLS_MFMA(ka, v1, Cst[1]); nst = MLS_MFMA(ka, wb8, nst); }
        }
        MLS_BAR();
#pragma unroll
        for (int jt = 0; jt < 2; ++jt) *(MLS_LAS u32x2*)(shm + CT + ((16 * jt + lr) * QSTR + 16 * wid + 4 * lq) * 2) = (u32x2){pk(Cst[jt][0], Cst[jt][1]), pk(Cst[jt][2], Cst[jt][3])};
        if (lr == 0) *(MLS_LAS u32x2*)(shm + NV + (16 * wid + 4 * lq) * 2) = (u32x2){pk(nst[0], nst[1]), pk(nst[2], nst[3])};
    }
    asm volatile("s_waitcnt vmcnt(0) lgkmcnt(0)\n\ts_barrier" ::: "memory");
}
__device__ __forceinline__ void scan_phase(const Params& A, lptr shm, int vcu, int G, int wid) {
    for (int u = vcu; u < 256; u += G) {
        int lane; asm volatile("v_mbcnt_lo_u32_b32 %0, -1, 0\n\tv_mbcnt_hi_u32_b32 %0, -1, %0" : "=v"(lane));
        const int bh = u >> 3; scan_unit(bh >> 2, bh & 3, u & 7, A, shm, wid, lane);
    }
}
__device__ __forceinline__ void headnorm_phase(const float* HH, const unsigned short* P, const float* hn, unsigned short* Gout, int vcu, int G, int wid, int lane) {
    const int gw = vcu * 8 + wid, NGW = G * 8;
    for (int m = gw; m < 8 * SEQ; m += NGW) {
        const f32x4* hp = (const f32x4*)(HH + (long)m * 1024 + lane * 16);
        f32x4 v[4]; float ss = 0.f;
#pragma unroll
        for (int i = 0; i < 4; ++i) { v[i] = hp[i]; ss += v[i][0] * v[i][0] + v[i][1] * v[i][1] + v[i][2] * v[i][2] + v[i][3] * v[i][3]; }
#pragma unroll
        for (int x = 1; x < 16; x <<= 1) ss += bperm(ss, lane ^ x);
        const float rs = 1.0f / sqrtf(ss * (1.f / 256.f) + 1e-6f);
        const u32x4* op = (const u32x4*)(P + (long)m * PITCH + 2048 + lane * 16); const u32x4 o0 = op[0], o1 = op[1];
        const f32x4* wp = (const f32x4*)(hn + lane * 16);
        float og[16];
#pragma unroll
        for (int i = 0; i < 4; ++i) { og[2 * i] = blo(o0[i]); og[2 * i + 1] = bhi(o0[i]); og[8 + 2 * i] = blo(o1[i]); og[8 + 2 * i + 1] = bhi(o1[i]); }
        float r[16];
#pragma unroll
        for (int i = 0; i < 4; ++i) { const f32x4 w = wp[i];
#pragma unroll
            for (int e = 0; e < 4; ++e) { const float sg = __builtin_amdgcn_rcpf(1.0f + __builtin_amdgcn_exp2f(-1.4426950408889634f * og[4 * i + e])); r[4 * i + e] = sg * v[i][e] * rs * w[e]; } }
        u32x4* gp = (u32x4*)(Gout + (long)m * 1024 + lane * 16);
        gp[0] = (u32x4){pk(r[0], r[1]), pk(r[2], r[3]), pk(r[4], r[5]), pk(r[6], r[7])}; gp[1] = (u32x4){pk(r[8], r[9]), pk(r[10], r[11]), pk(r[12], r[13]), pk(r[14], r[15])};
    }
}
}
#define MK_QSCALE (0.125f * 1.4426950408889634f)
#define MK_ATTENTION { const int tid = fresh_tid(F), lane = tid & 63, wave = __builtin_amdgcn_readfirstlane(tid >> 6); \
    const float lam_init = 0.8f - 0.6f * __expf(-0.3f * (float)(2 * pr + 1)); \
    const float* lq1 = KA_IN(12) + pr * 64; const float* lk1 = KA_IN(13) + pr * 64; const float* lq2 = KA_IN(14) + pr * 64; const float* lk2 = KA_IN(15) + pr * 64; \
    const float lam = __expf(wave_sum(lq1[lane] * lk1[lane], lane)) - __expf(wave_sum(lq2[lane] * lk2[lane], lane)) + lam_init; \
    att::Params AP{(const unsigned short*)(ws + F_P), (unsigned short*)(ws + F_O), (float*)(ws + F_OT), KA_IN(1), KA_IN(16) + pr * 128, lam, lam_init}; \
    att::attn_phase(AP, (att::lds_ptr)(F.lds + RING_OFF), F.vcu, F.G, wave, lane); }
#define MK_MLSTM_SCAN { const int tid = fresh_tid(F); const int wave = __builtin_amdgcn_readfirstlane(tid >> 6); \
    mls::Params MP{(const unsigned short*)(ws + F_P), LI, LF, KA_IN(4) + pr * 4096, KA_IN(5) + pr * 1024, (float*)(ws + F_HH)}; \
    mls::scan_phase(MP, (mls::lptr)(F.lds + RING_OFF), F.vcu, F.G, wave); }
#define MK_MLSTM_HEADNORM { const int tid = fresh_tid(F), lane = tid & 63, wave = __builtin_amdgcn_readfirstlane(tid >> 6); \
    mls::headnorm_phase((const float*)(ws + F_HH), (const unsigned short*)(ws + F_P), KA_IN(8) + pr * 1024, (unsigned short*)(ws + F_G), F.vcu, F.G, wave, lane); }
#ifndef MK_MLSTM_SCAN
#define MK_MLSTM_SCAN
#endif
#ifndef MK_MLSTM_HEADNORM
#define MK_MLSTM_HEADNORM
#endif
#ifndef MK_ATTENTION
#define MK_ATTENTION
#endif
#ifndef MK_QSCALE
#define MK_QSCALE 1.0f
#endif
namespace mk {
__device__ __forceinline__ void assign_phase(Frame& F, const int* top_e, const int* wg_cnt, int* tok_slot, int* blk_expert, int* n_used, const bf16* XN, bf16* XG) {
    LAS int* cnt = (LAS int*)(F.lds + RING_OFF);
    LAS int* base = cnt + 2048; LAS int* pst = base + 8; LAS int* tot = pst + 8; LAS int* ex = tot + 8; LAS int* sl = ex + 256;
    const int t = fresh_tid(F), lane = t & 63, w = __builtin_amdgcn_readfirstlane(t >> 6);
    for (int i = t; i < 2048; i += NTHR) cnt[i] = wg_cnt[i];
    if (t < 256) ex[t] = top_e[F.vcu * 256 + t];
    __syncthreads();
    if (t < 8) { int s = 0, b = 0; for (int v = 0; v < 256; ++v) { const int c = cnt[v * 8 + t]; b += (v < F.vcu) ? c : 0; s += c; } tot[t] = s; base[t] = b; }
    __syncthreads();
    if (t == 0) {
        int acc = 0;
        for (int e = 0; e < 8; ++e) { pst[e] = acc; acc += (tot[e] + 255) / 256 * 256; }
        if (F.vcu == 0) {
            *n_used = acc / 256;
            int e = 0;
            for (int b = 0; b < NBLK; ++b) { while (e < 7 && b * 256 >= pst[e] + (tot[e] + 255) / 256 * 256) ++e; blk_expert[b] = e; }
        }
    }
    __syncthreads();
    if (t < 256) { const int e = ex[t]; int r = 0; for (int i = 0; i < t; ++i) r += (ex[i] == e) ? 1 : 0; const int slot = pst[e] + base[e] + r; sl[t] = slot; tok_slot[F.vcu * 256 + t] = slot; }
    __syncthreads();
    for (int a = w; a < 256; a += NWAVES) {
        const int slot = sl[a], tok = (F.vcu * 256 + a) >> 1;
        const GAS v4u* src = (const GAS v4u*)(XN + (size_t)tok * D) + lane; GAS v4u* dst = (GAS v4u*)(XG + (size_t)slot * D) + lane;
        const v4u v0 = src[0], v1 = src[64]; dst[0] = v0; dst[64] = v1;
    }
    __syncthreads();
}

struct Args { const float* in[29]; float* out; unsigned char* ws; int ph_lo, ph_hi, li, flags; };
constexpr int PH_FINAL = 32, PH_COMBINE = 33;
constexpr float ATT_C2 = 0.125f * 1.4426950408889634f;

typedef const __attribute__((address_space(4))) unsigned char* kaptr_t;
__device__ __forceinline__ kaptr_t ka_fresh() { kaptr_t p = (kaptr_t)__builtin_amdgcn_kernarg_segment_ptr(); asm volatile("" : "+s"(p)); return p; }
#define KA_IN(k) (*(const float* const __attribute__((address_space(4)))*)(ka + 8 * (k)))
#define KA_OUT (*(float* const __attribute__((address_space(4)))*)(ka + 232))
#define KA_WS (*(unsigned char* const __attribute__((address_space(4)))*)(ka + 240))
#define KA_INT(off) (*(const int __attribute__((address_space(4)))*)(ka + (off)))
static_assert(sizeof(Args) == 264, "Args layout (kernarg offsets above)");
#define PHASE_PTRS kaptr_t ka = ka_fresh(); unsigned char* const ws = KA_WS; float* const xo = KA_OUT; bf16* const XN = (bf16*)(ws + F_XN); bf16* const W0 = (bf16*)(ws + F_W); \
    int* const top_e = (int*)(ws + F_TOPE); float* const top_g = (float*)(ws + F_TOPG); int* const slot_tok = (int*)(ws + F_SLOTTOK); int* const tok_slot = (int*)(ws + F_TOKSLOT); \
    int* const blk_e = (int*)(ws + F_BLKE); int* const n_used = (int*)(ws + F_NUSED); float* const LI = (float*)(ws + F_LI); float* const LF = (float*)(ws + F_LF); bf16* const Ybuf = (bf16*)(ws + F_Y); \
    (void)xo; (void)XN; (void)W0; (void)top_e; (void)top_g; (void)slot_tok; (void)tok_slot; (void)blk_e; (void)n_used; (void)LI; (void)LF; (void)Ybuf; (void)ws
__global__ void __launch_bounds__(NTHR, 2) mk_fwd(Args) {
    extern __shared__ __attribute__((aligned(16))) unsigned char lds[];
    Frame F;
    F.lds = (LAS unsigned char*)lds;
    volatile LAS unsigned* MISC = (volatile LAS unsigned*)(F.lds + MISC_OFF);
    F.wave = __builtin_amdgcn_readfirstlane((int)threadIdx.x >> 6);
    F.G = gridDim.x; { const int bx = blockIdx.x; F.vcu = (F.G % 8 == 0) ? (bx % 8) * (F.G / 8) + bx / 8 : bx; }
    for (int u = threadIdx.x; u < (LDS_BYTES - LDSCTL_OFF) / 4; u += NTHR) ((LAS unsigned*)(F.lds + LDSCTL_OFF))[u] = 0u;
    __syncthreads();
    int lo, hi, flags; XcdBarrier bar;
    { kaptr_t ka = ka_fresh(); lo = KA_INT(248); hi = KA_INT(252); flags = KA_INT(260); const int li = KA_INT(256);
      bar = xcd_barrier_post((unsigned*)((gu32*)(KA_WS + F_CTL) + CW_BAR) + li * XCD_BAR_WORDS, MISC + 8, threadIdx.x == 0); }
#define IN(k) (lo <= (k) && (k) < hi)
#define SEAM(k) do { if (IN(k) && IN((k) + 1)) xcd_barrier(bar, F.wave == 0 && lane_id() == 0); } while (0)

    for (int pr = 0; pr < 2; ++pr) {
        const int pb = pr * 16;
        if (IN(pb + 0)) { PHASE_PTRS;
            cvt_job(F, KA_IN(3) + (size_t)pr * 1024 * 3080, 3080, 1024, 3072, 1, 0, W0, 0, 0, 0);
            cvt_job(F, KA_IN(9) + (size_t)pr * 1024 * 1024, 1024, 1024, 1024, 1, 0, W0 + 3072 * 1024, 0, 0, 1536);
            RowJob J{}; const bool first = (pr == 0) && !(flags & 1);
            const bool comb = (pr == 1) && !(flags & 2);
            J.xsrc = first ? KA_IN(0) : xo; J.xdst = (first || comb) ? xo : nullptr; J.nw = KA_IN(2) + pr * 1024; J.XN = XN;
            if (comb) { J.Y = Ybuf; J.tok_slot = tok_slot; J.top_g = top_g; }
            J.slab = KA_IN(3) + (size_t)pr * 1024 * 3080 + 3072; J.slab_ld = 3080; J.kind = 1; J.b0 = KA_IN(6) + pr * 4; J.b1 = KA_IN(7) + pr * 4; J.LI = LI; J.LF = LF;
            row_phase(F, J);
        }
        SEAM(pb + 0);
        if (IN(pb + 1)) { PHASE_PTRS;
            pg8::Gemm g{XN, W0, M, 3072, 1024, nullptr}; pg8::StaticOrder S; S.init(M, 3072, F.G, (int)blockIdx.x);
            pg8::EpiBf16 E{(bf16*)(ws + F_P), 3072, 1.f, 0};
            pg8::gemm_phase<pg8::EpiBf16, pg8::StaticOrder, true, false>(F.lds + RING_OFF, g, S, E, F.wave);
        }
        SEAM(pb + 1);
        if (IN(pb + 2)) { PHASE_PTRS; MK_MLSTM_SCAN }
        SEAM(pb + 2);
        if (IN(pb + 3)) { PHASE_PTRS; MK_MLSTM_HEADNORM }
        SEAM(pb + 3);
        if (IN(pb + 4)) { PHASE_PTRS;
            pg8::Gemm g{(const bf16*)(ws + F_G), W0 + 3072 * 1024, M, 1024, 1024, nullptr}; pg8::StaticOrder S; S.init(M, 1024, F.G, (int)blockIdx.x);
            pg8::EpiResid E{xo, 1024};
            pg8::gemm_phase<pg8::EpiResid, pg8::StaticOrder, true, false>(F.lds + RING_OFF, g, S, E, F.wave);
        }
        SEAM(pb + 4);
        if (IN(pb + 5)) { PHASE_PTRS;
            cvt_job(F, KA_IN(19) + (size_t)pr * 1024 * FF, FF, 1024, FF, 1, 0, W0, 0, 1, 0);
            cvt_job(F, KA_IN(20) + (size_t)pr * 1024 * FF, FF, 1024, FF, 1, 0, W0, 0, 2, 1792);
            cvt_job(F, KA_IN(21) + (size_t)pr * FF * 1024, 1024, FF, 1024, 1, 0, W0 + 7168 * 1024, 0, 0, 1536);
            RowJob J{}; J.xsrc = xo; J.nw = KA_IN(18) + pr * 1024; J.XN = XN;
            row_phase(F, J);
        }
        SEAM(pb + 5);
        if (IN(pb + 6)) { PHASE_PTRS;
            pg8::Gemm g{XN, W0, M, 2 * FF, 1024, nullptr}; pg8::StaticOrder S; S.init(M, 2 * FF, F.G, (int)blockIdx.x);
            pg8::EpiSwiGLU E{(bf16*)(ws + F_H), FF};
            pg8::gemm_phase<pg8::EpiSwiGLU, pg8::StaticOrder, true, false>(F.lds + RING_OFF, g, S, E, F.wave);
        }
        SEAM(pb + 6);
        if (IN(pb + 7)) { PHASE_PTRS;
            pg8::Gemm g{(const bf16*)(ws + F_H), W0 + 7168 * 1024, M, 1024, FF, nullptr}; pg8::StaticOrder S; S.init(M, 1024, F.G, (int)blockIdx.x);
            pg8::EpiResid E{xo, 1024};
            pg8::gemm_phase<pg8::EpiResid, pg8::StaticOrder, true, false>(F.lds + RING_OFF, g, S, E, F.wave);
        }
        SEAM(pb + 7);
        if (IN(pb + 8)) { PHASE_PTRS;
            cvt_job(F, KA_IN(11) + (size_t)pr * 1024 * 3072, 3072, 1024, 3072, 1, 0, W0, 0, 0, 0);
            cvt_job(F, KA_IN(17) + (size_t)pr * 1024 * 1024, 1024, 1024, 1024, 1, 0, W0 + 3072 * 1024, 0, 0, 1536);
            RowJob J{}; J.xsrc = xo; J.nw = KA_IN(10) + pr * 1024; J.XN = XN;
            row_phase(F, J);
        }
        SEAM(pb + 8);
        if (IN(pb + 9)) { PHASE_PTRS;
            pg8::Gemm g{XN, W0, M, 3072, 1024, nullptr}; pg8::StaticOrder S; S.init(M, 3072, F.G, (int)blockIdx.x);
            pg8::EpiBf16 E{(bf16*)(ws + F_P), 3072, MK_QSCALE, 4};
            pg8::gemm_phase<pg8::EpiBf16, pg8::StaticOrder, true, false>(F.lds + RING_OFF, g, S, E, F.wave);
        }
        SEAM(pb + 9);
        if (IN(pb + 10)) { PHASE_PTRS; MK_ATTENTION }
        SEAM(pb + 10);
        if (IN(pb + 11)) { PHASE_PTRS;
            pg8::Gemm g{(const bf16*)(ws + F_O), W0 + 3072 * 1024, M, 1024, 1024, nullptr}; pg8::StaticOrder S; S.init(M, 1024, F.G, (int)blockIdx.x);
            pg8::EpiResid E{xo, 1024};
            pg8::gemm_phase<pg8::EpiResid, pg8::StaticOrder, true, false>(F.lds + RING_OFF, g, S, E, F.wave);
        }
        SEAM(pb + 11);
        if (IN(pb + 12)) { PHASE_PTRS;
            cvt_job(F, KA_IN(25) + (size_t)pr * NE * 1024 * FF, FF, 1024, FF, NE, (size_t)1024 * FF, W0, (size_t)7168 * 1024, 1, 0);
            cvt_job(F, KA_IN(26) + (size_t)pr * NE * 1024 * FF, FF, 1024, FF, NE, (size_t)1024 * FF, W0, (size_t)7168 * 1024, 2, 0);
            cvt_job(F, KA_IN(27) + (size_t)pr * NE * FF * 1024, 1024, FF, 1024, NE, (size_t)FF * 1024, W0 + (size_t)NE * 7168 * 1024, (size_t)1024 * FF, 0, 0);
            RowJob J{}; J.xsrc = xo; J.nw = KA_IN(22) + pr * 1024; J.XN = XN;
            J.slab = KA_IN(23) + (size_t)pr * 8192; J.slab_ld = 8; J.kind = 2; J.b0 = KA_IN(24) + pr * 8; J.top_e = top_e; J.top_g_out = top_g; J.wg_cnt = slot_tok;
            row_phase(F, J);
        }
        SEAM(pb + 12);
        if (IN(pb + 13)) { PHASE_PTRS; assign_phase(F, top_e, slot_tok, tok_slot, blk_e, n_used, XN, Ybuf); }
        SEAM(pb + 13);
        if (IN(pb + 14)) { PHASE_PTRS;
            const int nb = *(volatile int*)n_used;
            pg8::Gemm g{Ybuf, W0, nb * 256, 2 * FF, 1024, nullptr}; pg8::GroupOrder S; S.init(nb, 2 * FF / 256, F.G, (int)blockIdx.x, blk_e, (long)7168 * 1024);
            pg8::EpiSwiGLU E{(bf16*)(ws + F_H), FF};
            pg8::gemm_phase<pg8::EpiSwiGLU, pg8::GroupOrder, true, false>(F.lds + RING_OFF, g, S, E, F.wave);
        }
        SEAM(pb + 14);
        if (IN(pb + 15)) { PHASE_PTRS;
            const int nb = *(volatile int*)n_used;
            pg8::Gemm g{(const bf16*)(ws + F_H), W0 + (size_t)NE * 7168 * 1024, nb * 256, 1024, FF, nullptr}; pg8::GroupOrder S; S.init(nb, 4, F.G, (int)blockIdx.x, blk_e, (long)1024 * FF);
            pg8::EpiBf16 E{Ybuf, 1024, 1.f, 0};
            pg8::gemm_phase<pg8::EpiBf16, pg8::GroupOrder, true, false>(F.lds + RING_OFF, g, S, E, F.wave);
        }
        SEAM(pb + 15);
    }
    if (IN(PH_FINAL)) { PHASE_PTRS;
        RowJob J{}; J.xsrc = xo; J.nw = KA_IN(28); J.outf = xo; if (!(flags & 2)) { J.Y = Ybuf; J.tok_slot = tok_slot; J.top_g = top_g; }
        row_phase(F, J);
    }
    if (IN(PH_COMBINE)) { PHASE_PTRS;
        const int tid = fresh_tid(F), lane = tid & 63, gw = F.vcu * NWAVES + __builtin_amdgcn_readfirstlane(tid >> 6), NGW = F.G * NWAVES;
        for (int m = gw; m < M; m += NGW) {
            GAS f32x4* xr = (GAS f32x4*)(xo + (size_t)m * D) + lane;
            const int s0 = tok_slot[m * 2], s1 = tok_slot[m * 2 + 1]; const float g0 = top_g[m * 2], g1 = top_g[m * 2 + 1];
            const GAS v2u* y0 = (const GAS v2u*)(Ybuf + (size_t)s0 * D) + lane; const GAS v2u* y1 = (const GAS v2u*)(Ybuf + (size_t)s1 * D) + lane;
#pragma unroll
            for (int j = 0; j < 4; ++j) { f32x4 v = xr[64 * j]; const v2u a = y0[64 * j], b = y1[64 * j];
                v.x += g0 * bf_lo(a.x) + g1 * bf_lo(b.x); v.y += g0 * bf_hi(a.x) + g1 * bf_hi(b.x); v.z += g0 * bf_lo(a.y) + g1 * bf_lo(b.y); v.w += g0 * bf_hi(a.y) + g1 * bf_hi(b.y); xr[64 * j] = v; }
        }
    }
#undef IN
#undef SEAM
}
}
namespace nvh {
using namespace nv;
constexpr size_t MiB = 1u << 20;
constexpr size_t N_CTL = 0;
constexpr size_t N_XN = 4 * MiB;
constexpr size_t N_P = 132 * MiB;
constexpr size_t N_QK = 517 * MiB;
constexpr size_t N_HH = 645 * MiB;
constexpr size_t N_G = 773 * MiB;
constexpr size_t N_Y = 363 * MiB;
constexpr size_t C_TOPE = 64 * 1024, C_TOPG = C_TOPE + 65536 * 4, C_SLOTTOK = C_TOPG + 65536 * 4, C_SLOTG = C_SLOTTOK + (size_t)NSLOT * 4, C_TOKSLOT = C_SLOTG + (size_t)NSLOT * 4,
                 C_BLKE = C_TOKSLOT + 65536 * 4, C_NUSED = C_BLKE + 2048, C_LI = 2 * MiB, C_LF = C_LI + (size_t)M * 4 * 4;
static_assert(C_NUSED + 64 <= 2 * MiB && C_LF + (size_t)M * 16 <= 4 * MiB, "ctl map");

struct In { const float* p[29]; };

static inline void gemm(hipStream_t st, const float* A, int lda, const float* W, int ldw, float* C, int ldc, int Mr, int N, int K, int mode, const float* W2 = nullptr, const int* rowidx = nullptr,
                        const int* blk_expert = nullptr, const int* n_used = nullptr, long long wstride = 0, int blk0 = 0) {
    NG g{}; g.A = A; g.rowidx = rowidx; g.W = W; g.W2 = W2; g.C = C; g.blk_expert = blk_expert; g.n_used = n_used; g.wstride = wstride;
    g.lda = lda; g.ldw = ldw; g.ldc = ldc; g.M = Mr; g.N = N; g.K = K; g.mode = mode; g.blk0 = blk0;
    dim3 grid((N + 127) / 128, Mr / 128);
    if (W2) hipLaunchKernelGGL(k_gemm<1>, grid, dim3(256), 0, st, g); else hipLaunchKernelGGL(k_gemm<0>, grid, dim3(256), 0, st, g);
}
static inline void rmsnorm(hipStream_t st, const float* x, const float* w, float* out, float eps) { hipLaunchKernelGGL(k_rmsnorm, dim3(M / 4), dim3(256), 0, st, x, w, out, M, eps); }

static void naive_mlstm(hipStream_t st, const In& in, int s, float* x, unsigned char* ws) {
    float* XN = (float*)(ws + N_XN); float* P = (float*)(ws + N_P); float* QK = (float*)(ws + N_QK); float* HH = (float*)(ws + N_HH); float* G = (float*)(ws + N_G);
    float* LI = (float*)(ws + C_LI); float* LF = (float*)(ws + C_LF);
    rmsnorm(st, x, in.p[2] + s * 1024, XN, 1e-6f);
    gemm(st, XN, 1024, in.p[3] + (size_t)s * 1024 * MPROJ, MPROJ, P, MPROJ, M, MPROJ, 1024, 0);
    hipLaunchKernelGGL(k_mlstm_prep, dim3(M), dim3(256), 0, st, (const float*)P, in.p[4] + s * 4096, in.p[5] + s * 1024, in.p[6] + s * 4, in.p[7] + s * 4, QK, LI, LF);
    hipLaunchKernelGGL(k_mlstm_rec, dim3(256), dim3(256), 0, st, (const float*)QK, (const float*)P, (const float*)LI, (const float*)LF, HH);
    hipLaunchKernelGGL(k_mlstm_post, dim3(M), dim3(256), 0, st, (const float*)HH, (const float*)P, in.p[8] + s * 1024, G);
    gemm(st, G, 1024, in.p[9] + (size_t)s * 1024 * 1024, 1024, x, 1024, M, 1024, 1024, 1);
}
static void naive_ffn(hipStream_t st, const In& in, int s, float* x, unsigned char* ws) {
    float* XN = (float*)(ws + N_XN); float* H = (float*)(ws + N_P);
    rmsnorm(st, x, in.p[18] + s * 1024, XN, 1e-6f);
    gemm(st, XN, 1024, in.p[19] + (size_t)s * 1024 * FF, FF, H, FF, M, FF, 1024, 2, in.p[20] + (size_t)s * 1024 * FF);
    gemm(st, H, FF, in.p[21] + (size_t)s * FF * 1024, 1024, x, 1024, M, 1024, FF, 1);
}
static void naive_attn(hipStream_t st, const In& in, int s, int layer, float* x, unsigned char* ws) {
    float* XN = (float*)(ws + N_XN); float* P = (float*)(ws + N_P); float* O = (float*)(ws + N_HH);
    rmsnorm(st, x, in.p[10] + s * 1024, XN, 1e-6f);
    gemm(st, XN, 1024, in.p[11] + (size_t)s * 1024 * APROJ, APROJ, P, APROJ, M, APROJ, 1024, 0);
    const float lam_init = (float)(0.8 - 0.6 * exp(-0.3 * (double)layer));
    static bool attr = false; if (!attr) { (void)hipFuncSetAttribute((const void*)k_attn, hipFuncAttributeMaxDynamicSharedMemorySize, 65536); attr = true; }
    hipLaunchKernelGGL(k_attn, dim3(M * 8 / 2), dim3(128), 65536, st, (const float*)P, in.p[1], in.p[12] + s * 64, in.p[13] + s * 64, in.p[14] + s * 64, in.p[15] + s * 64, in.p[16] + s * 128, lam_init, O);
    gemm(st, O, 1024, in.p[17] + (size_t)s * 1024 * 1024, 1024, x, 1024, M, 1024, 1024, 1);
}
static void naive_moe(hipStream_t st, const In& in, int s, float* x, unsigned char* ws) {
    float* XN = (float*)(ws + N_XN); float* Hc = (float*)(ws + N_P); float* Y = (float*)(ws + N_Y);
    int* top_e = (int*)(ws + C_TOPE); float* top_g = (float*)(ws + C_TOPG); int* slot_tok = (int*)(ws + C_SLOTTOK); float* slot_g = (float*)(ws + C_SLOTG);
    int* tok_slot = (int*)(ws + C_TOKSLOT); int* blk_e = (int*)(ws + C_BLKE); int* n_used = (int*)(ws + C_NUSED);
    rmsnorm(st, x, in.p[22] + s * 1024, XN, 1e-6f);
    hipLaunchKernelGGL(k_router, dim3(M / 4), dim3(256), 0, st, (const float*)XN, in.p[23] + s * 8192, in.p[24] + s * 8, top_e, top_g);
    hipLaunchKernelGGL(k_assign, dim3(1), dim3(1024), 0, st, (const int*)top_e, (const float*)top_g, slot_tok, slot_g, tok_slot, blk_e, n_used);
    constexpr int CH = 66, CR = CH * 256;
    for (int c = 0; c < 4; ++c) {
        gemm(st, XN, 1024, in.p[25] + (size_t)s * NE * 1024 * FF, FF, Hc, FF, CR, FF, 1024, 2, in.p[26] + (size_t)s * NE * 1024 * FF, slot_tok + c * CR, blk_e, n_used, (long long)1024 * FF, c * CH);
        gemm(st, Hc, FF, in.p[27] + (size_t)s * NE * FF * 1024, 1024, Y + (size_t)c * CR * 1024, 1024, CR, 1024, FF, 0, nullptr, nullptr, blk_e, n_used, (long long)FF * 1024, c * CH);
    }
    hipLaunchKernelGGL(k_combine, dim3(M), dim3(256), 0, st, x, (const float*)Y, (const int*)tok_slot, (const float*)top_g);
}
}
extern "C" void kernel_launch(void* const* d_in, const int* in_sizes, int n_in, void* d_out, int out_size, void* d_ws, size_t ws_size, hipStream_t stream) {
    static int grid = 0;
    if (grid == 0) {
        int dev = 0, cus = 0, per_cu = 0;
        (void)hipGetDevice(&dev); (void)hipDeviceGetAttribute(&cus, hipDeviceAttributeMultiprocessorCount, dev);
        (void)hipFuncSetAttribute((const void*)mk::mk_fwd, hipFuncAttributeMaxDynamicSharedMemorySize, mk::LDS_BYTES);
        (void)hipOccupancyMaxActiveBlocksPerMultiprocessor(&per_cu, (const void*)mk::mk_fwd, mk::NTHR, mk::LDS_BYTES);
        (void)hipGetLastError();
        grid = cus > 0 ? cus : 256;
    }
    mk::Args a{}; for (int i = 0; i < 29; ++i) a.in[i] = (const float*)d_in[i];
    a.out = (float*)d_out; a.ws = (unsigned char*)d_ws; a.ph_lo = 0; a.ph_hi = mk::PH_FINAL + 1; a.li = 0; a.flags = 0;
    (void)hipMemsetAsync((unsigned char*)d_ws + mk::F_CTL, 0, mk::CTL_ZERO_BYTES, stream);
    hipLaunchKernelGGL(mk::mk_fwd, dim3(grid), dim3(mk::NTHR), mk::LDS_BYTES, stream, a);
}
```

```cpp
#include <hip/hip_runtime.h>
#include <cstdio>
#include <cstdint>
#include <cmath>
namespace nv {
constexpr int B = 8, S = 4096, D = 1024, M = B * S;
constexpr int MPROJ = 3080, APROJ = 3072, FF = 3584, NE = 8;
constexpr int NBLK = 264, NSLOT = NBLK * 256;
typedef float f32x16 __attribute__((ext_vector_type(16)));

__device__ __forceinline__ float wsum(float v) {
#pragma unroll
    for (int o = 32; o >= 1; o >>= 1) v += __shfl_xor(v, o);
    return v;
}
__device__ __forceinline__ float wmax(float v) {
#pragma unroll
    for (int o = 32; o >= 1; o >>= 1) v = fmaxf(v, __shfl_xor(v, o));
    return v;
}

__global__ void __launch_bounds__(256) k_rmsnorm(const float* x, const float* __restrict__ w, float* out, int rows, float eps) {
    const int wave = threadIdx.x >> 6, lane = threadIdx.x & 63;
    const int row = blockIdx.x * 4 + wave;
    if (row >= rows) return;
    const float4* xr = (const float4*)(x + (size_t)row * D);
    float4 v[4]; float ss = 0.f;
#pragma unroll
    for (int j = 0; j < 4; ++j) { v[j] = xr[lane + 64 * j]; ss += v[j].x * v[j].x + v[j].y * v[j].y + v[j].z * v[j].z + v[j].w * v[j].w; }
    ss = wsum(ss);
    const float r = rsqrtf(ss * (1.f / D) + eps);
    float4* o = (float4*)(out + (size_t)row * D);
#pragma unroll
    for (int j = 0; j < 4; ++j) { const float4 ww = ((const float4*)w)[lane + 64 * j]; float4 t; t.x = v[j].x * r * ww.x; t.y = v[j].y * r * ww.y; t.z = v[j].z * r * ww.z; t.w = v[j].w * r * ww.w; o[lane + 64 * j] = t; }
}

struct NG {
    const float* A; const int* rowidx; const float* W; const float* W2; float* C;
    const int* blk_expert; const int* n_used; long long wstride;
    int lda, ldw, ldc, M, N, K, mode, blk0;
};
template <int DUAL>
__global__ void __launch_bounds__(256) k_gemm(NG g) {
    __shared__ float As[16][132];
    __shared__ float Bs[16][132];
    __shared__ float Bs2[DUAL ? 16 : 1][132];
    const int t = threadIdx.x, lane = t & 63, w = t >> 6, wm = w >> 1, wn = w & 1;
    const int m0 = blockIdx.y * 128, n0 = blockIdx.x * 128;
    const float* W = g.W; const float* W2 = g.W2;
    if (g.blk_expert) {
        const int blk = g.blk0 + m0 / 256;
        if (blk >= *g.n_used) return;
        const int e = g.blk_expert[blk];
        W += (size_t)e * g.wstride; if (DUAL) W2 += (size_t)e * g.wstride;
    }
    f32x16 acc[2][2], acc2[2][2];
#pragma unroll
    for (int i = 0; i < 2; ++i)
#pragma unroll
        for (int j = 0; j < 2; ++j) { acc[i][j] = f32x16{}; acc2[i][j] = f32x16{}; }
    const int ar = t >> 1, akq = (t & 1) * 8;
    long long asrc = g.rowidx ? (long long)g.rowidx[m0 + ar] : (long long)(m0 + ar);
    const float* ap = (asrc >= 0) ? g.A + (size_t)asrc * g.lda + akq : nullptr;
    for (int k0 = 0; k0 < g.K; k0 += 16) {
        float4 a0 = make_float4(0.f, 0.f, 0.f, 0.f), a1 = a0;
        if (ap) { a0 = *(const float4*)(ap + k0); a1 = *(const float4*)(ap + k0 + 4); }
        As[akq + 0][ar] = a0.x; As[akq + 1][ar] = a0.y; As[akq + 2][ar] = a0.z; As[akq + 3][ar] = a0.w;
        As[akq + 4][ar] = a1.x; As[akq + 5][ar] = a1.y; As[akq + 6][ar] = a1.z; As[akq + 7][ar] = a1.w;
#pragma unroll
        for (int i = 0; i < 2; ++i) {
            const int k = (t >> 5) + 8 * i, c = (t & 31) * 4, col = n0 + c;
            float4 b = make_float4(0.f, 0.f, 0.f, 0.f);
            if (col < g.N) b = *(const float4*)(W + (size_t)(k0 + k) * g.ldw + col);
            Bs[k][c] = b.x; Bs[k][c + 1] = b.y; Bs[k][c + 2] = b.z; Bs[k][c + 3] = b.w;
            if (DUAL) {
                float4 b2 = make_float4(0.f, 0.f, 0.f, 0.f);
                if (col < g.N) b2 = *(const float4*)(W2 + (size_t)(k0 + k) * g.ldw + col);
                Bs2[k][c] = b2.x; Bs2[k][c + 1] = b2.y; Bs2[k][c + 2] = b2.z; Bs2[k][c + 3] = b2.w;
            }
        }
        __syncthreads();
#pragma unroll
        for (int kk = 0; kk < 8; ++kk) {
            const int kl = 2 * kk + (lane >> 5);
            float a[2], b[2], b2[2];
#pragma unroll
            for (int i = 0; i < 2; ++i) { a[i] = As[kl][wm * 64 + i * 32 + (lane & 31)]; b[i] = Bs[kl][wn * 64 + i * 32 + (lane & 31)]; if (DUAL) b2[i] = Bs2[kl][wn * 64 + i * 32 + (lane & 31)]; }
#pragma unroll
            for (int i = 0; i < 2; ++i)
#pragma unroll
                for (int j = 0; j < 2; ++j) {
                    acc[i][j] = __builtin_amdgcn_mfma_f32_32x32x2f32(a[i], b[j], acc[i][j], 0, 0, 0);
                    if (DUAL) acc2[i][j] = __builtin_amdgcn_mfma_f32_32x32x2f32(a[i], b2[j], acc2[i][j], 0, 0, 0);
                }
        }
        __syncthreads();
    }
#pragma unroll
    for (int i = 0; i < 2; ++i)
#pragma unroll
        for (int j = 0; j < 2; ++j) {
            const int col = n0 + wn * 64 + j * 32 + (lane & 31);
            if (col >= g.N) continue;
#pragma unroll
            for (int r = 0; r < 16; ++r) {
                const int row = m0 + wm * 64 + i * 32 + (r & 3) + 8 * (r >> 2) + 4 * (lane >> 5);
                float* cp = g.C + (size_t)row * g.ldc + col;
                const float v = acc[i][j][r];
                if (g.mode == 0) *cp = v;
                else if (g.mode == 1) *cp += v;
                else { const float u = DUAL ? acc2[i][j][r] : 0.f; *cp = v / (1.f + __expf(-v)) * u; }
            }
        }
}

__global__ void __launch_bounds__(256) k_router(const float* __restrict__ xn, const float* __restrict__ wr, const float* __restrict__ br, int* __restrict__ top_e, float* __restrict__ top_g) {
    const int wave = threadIdx.x >> 6, lane = threadIdx.x & 63;
    const int row = blockIdx.x * 4 + wave;
    const float4* xr = (const float4*)(xn + (size_t)row * D);
    float acc[8];
#pragma unroll
    for (int e = 0; e < 8; ++e) acc[e] = 0.f;
#pragma unroll
    for (int j = 0; j < 4; ++j) {
        const float4 v = xr[lane + 64 * j]; const float xv[4] = {v.x, v.y, v.z, v.w};
#pragma unroll
        for (int i = 0; i < 4; ++i) {
            const int k = (lane + 64 * j) * 4 + i;
            const float4 w0 = *(const float4*)(wr + (size_t)k * 8), w1 = *(const float4*)(wr + (size_t)k * 8 + 4);
            acc[0] += xv[i] * w0.x; acc[1] += xv[i] * w0.y; acc[2] += xv[i] * w0.z; acc[3] += xv[i] * w0.w;
            acc[4] += xv[i] * w1.x; acc[5] += xv[i] * w1.y; acc[6] += xv[i] * w1.z; acc[7] += xv[i] * w1.w;
        }
    }
#pragma unroll
    for (int e = 0; e < 8; ++e) acc[e] = wsum(acc[e]) + br[e];
    if (lane == 0) {
        int e0 = 0; float l0 = acc[0];
#pragma unroll
        for (int e = 1; e < 8; ++e) if (acc[e] > l0) { l0 = acc[e]; e0 = e; }
        int e1 = -1; float l1 = -INFINITY;
#pragma unroll
        for (int e = 0; e < 8; ++e) if (e != e0 && acc[e] > l1) { l1 = acc[e]; e1 = e; }
        const float ex = __expf(l1 - l0), g0 = 1.f / (1.f + ex), g1 = ex / (1.f + ex);
        top_e[row * 2] = e0; top_e[row * 2 + 1] = e1; top_g[row * 2] = g0; top_g[row * 2 + 1] = g1;
    }
}
__global__ void __launch_bounds__(1024) k_assign(const int* __restrict__ top_e, const float* __restrict__ top_g, int* __restrict__ slot_token, float* __restrict__ slot_gate,
                                                 int* __restrict__ tok_slot, int* __restrict__ blk_expert, int* __restrict__ n_used) {
    __shared__ int sc[8][1024];
    __shared__ int tot[8], pstart[8];
    const int t = threadIdx.x, lane = t & 63, w = t >> 6;
    for (int i = t; i < NSLOT; i += 1024) { slot_token[i] = -1; slot_gate[i] = 0.f; }
    int c[8];
#pragma unroll
    for (int e = 0; e < 8; ++e) c[e] = 0;
    for (int i = 0; i < 64; ++i) { const int e = top_e[t * 64 + i];
#pragma unroll
        for (int q = 0; q < 8; ++q) c[q] += (e == q) ? 1 : 0; }
#pragma unroll
    for (int e = 0; e < 8; ++e) sc[e][t] = c[e];
    __syncthreads();
    if (w < 8) {
        int loc[16], s = 0;
#pragma unroll
        for (int i = 0; i < 16; ++i) { loc[i] = sc[w][lane * 16 + i]; s += loc[i]; }
        int inc = s;
#pragma unroll
        for (int o = 1; o < 64; o <<= 1) { const int v = __shfl_up(inc, o); if (lane >= o) inc += v; }
        int run = inc - s;
#pragma unroll
        for (int i = 0; i < 16; ++i) { sc[w][lane * 16 + i] = run; run += loc[i]; }
        if (lane == 63) tot[w] = inc;
    }
    __syncthreads();
    if (t == 0) {
        int acc = 0;
        for (int e = 0; e < 8; ++e) { pstart[e] = acc; acc += (tot[e] + 255) / 256 * 256; }
        const int nb = acc / 256; *n_used = nb;
        int e = 0;
        for (int b = 0; b < NBLK; ++b) {
            while (e < 7 && b * 256 >= pstart[e] + (tot[e] + 255) / 256 * 256) ++e;
            blk_expert[b] = e;
        }
    }
    __syncthreads();
    int run[8];
#pragma unroll
    for (int e = 0; e < 8; ++e) run[e] = pstart[e] + sc[e][t];
    for (int i = 0; i < 64; ++i) {
        const int a = t * 64 + i, e = top_e[a];
        int slot = 0;
#pragma unroll
        for (int q = 0; q < 8; ++q) if (e == q) { slot = run[q]; run[q]++; }
        slot_token[slot] = a >> 1; slot_gate[slot] = top_g[a]; tok_slot[a] = slot;
    }
}
__global__ void __launch_bounds__(256) k_combine(float* __restrict__ x, const float* __restrict__ Y, const int* __restrict__ tok_slot, const float* __restrict__ top_g) {
    const int row = blockIdx.x, t = threadIdx.x;
    const int s0 = tok_slot[row * 2], s1 = tok_slot[row * 2 + 1]; const float g0 = top_g[row * 2], g1 = top_g[row * 2 + 1];
    float4* xp = (float4*)(x + (size_t)row * D) + t; const float4 a = ((const float4*)(Y + (size_t)s0 * D))[t], b = ((const float4*)(Y + (size_t)s1 * D))[t];
    float4 v = *xp; v.x += g0 * a.x + g1 * b.x; v.y += g0 * a.y + g1 * b.y; v.z += g0 * a.z + g1 * b.z; v.w += g0 * a.w + g1 * b.w; *xp = v;
}

__global__ void __launch_bounds__(256) k_mlstm_prep(const float* __restrict__ P, const float* __restrict__ cw, const float* __restrict__ cb, const float* __restrict__ bi, const float* __restrict__ bf,
                                                    float* __restrict__ QK, float* __restrict__ LI, float* __restrict__ LF) {
    const int row = blockIdx.x, t = threadIdx.x, tt = row % S;
#pragma unroll
    for (int i = 0; i < 4; ++i) {
        const int c = t + 256 * i;
        float y = cb[c];
#pragma unroll
        for (int j = 0; j < 4; ++j) { const int ts = tt - 3 + j; if (ts >= 0) y += cw[j * 1024 + c] * P[(size_t)(row - 3 + j) * MPROJ + c]; }
        float s = y / (1.f + __expf(-y));
        if (c >= 512) s *= 0.08838834764831845f;
        QK[(size_t)row * 1024 + c] = s;
    }
    if (t < 4) LI[row * 4 + t] = P[(size_t)row * MPROJ + 3072 + t] + bi[t];
    else if (t < 8) { const int h = t - 4; const float z = P[(size_t)row * MPROJ + 3076 + h] + bf[h]; LF[row * 4 + h] = fminf(z, 0.f) - log1pf(__expf(-fabsf(z))); }
}
__global__ void __launch_bounds__(256) k_mlstm_rec(const float* __restrict__ QK, const float* __restrict__ P, const float* __restrict__ LI, const float* __restrict__ LF, float* __restrict__ HH) {
    __shared__ float qs[128], ks[128], part[8][32], red[2];
    const int tid = threadIdx.x, dv = tid & 31, kg = tid >> 5, lane = tid & 63;
    const int bh = blockIdx.x >> 3, sl = blockIdx.x & 7, b = bh >> 2, h = bh & 3, dv0 = sl * 32;
    float C[16];
#pragma unroll
    for (int j = 0; j < 16; ++j) C[j] = 0.f;
    float n = 0.f, m = 0.f;
    for (int t = 0; t < S; ++t) {
        const size_t row = (size_t)b * S + t;
        if (tid < 128) { qs[tid] = QK[row * 1024 + h * 128 + tid]; ks[tid] = QK[row * 1024 + 512 + h * 128 + tid]; }
        const float v = P[row * MPROJ + 1024 + h * 256 + dv0 + dv];
        const float li = LI[row * 4 + h], lf = LF[row * 4 + h];
        const float mn = fmaxf(lf + m, li), fp = __expf(lf + m - mn), ip = __expf(li - mn); m = mn;
        __syncthreads();
        float pn = 0.f;
#pragma unroll
        for (int j = 0; j < 16; ++j) { C[j] = fp * C[j] + ip * ks[kg * 16 + j] * v; pn += C[j] * qs[kg * 16 + j]; }
        part[kg][dv] = pn;
        if (tid < 128) { n = fp * n + ip * ks[tid]; const float d = wsum(n * qs[tid]); if (lane == 0) red[tid >> 6] = d; }
        __syncthreads();
        if (tid < 32) {
            float num = 0.f;
#pragma unroll
            for (int g = 0; g < 8; ++g) num += part[g][tid];
            const float den = red[0] + red[1];
            HH[row * 1024 + h * 256 + dv0 + tid] = num / fmaxf(fabsf(den), __expf(-m));
        }
        __syncthreads();
    }
}
__global__ void __launch_bounds__(256) k_mlstm_post(const float* __restrict__ HH, const float* __restrict__ P, const float* __restrict__ hn, float* __restrict__ G) {
    const int wave = threadIdx.x >> 6, lane = threadIdx.x & 63;
    const int row = blockIdx.x, h = wave;
    const float4 v = ((const float4*)(HH + (size_t)row * 1024 + h * 256))[lane];
    const float ss = wsum(v.x * v.x + v.y * v.y + v.z * v.z + v.w * v.w);
    const float r = rsqrtf(ss * (1.f / 256.f) + 1e-6f);
    const float4 w = ((const float4*)(hn + h * 256))[lane], o = ((const float4*)(P + (size_t)row * MPROJ + 2048 + h * 256))[lane];
    float4 g;
    g.x = v.x * r * w.x / (1.f + __expf(-o.x)); g.y = v.y * r * w.y / (1.f + __expf(-o.y)); g.z = v.z * r * w.z / (1.f + __expf(-o.z)); g.w = v.w * r * w.w / (1.f + __expf(-o.w));
    ((float4*)(G + (size_t)row * 1024 + h * 256))[lane] = g;
}

__device__ const int BUCKET[128] = {0, 1, 2, 3, 4, 5, 6, 7, 8, 9, 10, 11, 12, 13, 14, 15, 16, 16, 16, 17, 17, 18, 18, 18, 19, 19, 19, 20, 20, 20, 20, 21, 21, 21, 21, 22, 22, 22, 22, 22, 23, 23, 23, 23, 23, 23, 24, 24, 24, 24, 24, 24, 25, 25, 25, 25, 25, 25, 25, 26, 26, 26, 26, 26, 26, 26, 26, 27, 27, 27, 27, 27, 27, 27, 27, 27, 27, 28, 28, 28, 28, 28, 28, 28, 28, 28, 28, 29, 29, 29, 29, 29, 29, 29, 29, 29, 29, 29, 29, 30, 30, 30, 30, 30, 30, 30, 30, 30, 30, 30, 30, 30, 30, 31, 31, 31, 31, 31, 31, 31, 31, 31, 31, 31, 31, 31, 31, 31};
__global__ void __launch_bounds__(128) k_attn(const float* __restrict__ P, const float* __restrict__ rel, const float* __restrict__ lq1, const float* __restrict__ lk1, const float* __restrict__ lq2,
                                              const float* __restrict__ lk2, const float* __restrict__ subln, float lam_init, float* __restrict__ O) {
    extern __shared__ float Lbuf[];
    const int wave = threadIdx.x >> 6, lane = threadIdx.x & 63;
    float* L1 = Lbuf + wave * 8192; float* L2 = L1 + 4096;
    const int wg = blockIdx.x * 2 + wave, head = wg & 7, row = wg >> 3, b = row / S, qpos = row % S;
    const float lam = __expf(wsum(lq1[lane] * lk1[lane])) - __expf(wsum(lq2[lane] * lk2[lane])) + lam_init;
    float sums[2];
#pragma unroll
    for (int mm = 0; mm < 2; ++mm) {
        const int mi = 2 * head + mm; float* L = mm ? L2 : L1;
        float4 qv[16];
#pragma unroll
        for (int i = 0; i < 16; ++i) qv[i] = ((const float4*)(P + (size_t)row * APROJ + mi * 64))[i];
        float lmax = -INFINITY;
        for (int k = lane; k <= qpos; k += 64) {
            const float4* kp = (const float4*)(P + (size_t)(b * S + k) * APROJ + 1024 + mi * 64);
            float d = 0.f;
#pragma unroll
            for (int i = 0; i < 16; ++i) { const float4 kv = kp[i]; d += qv[i].x * kv.x + qv[i].y * kv.y + qv[i].z * kv.z + qv[i].w * kv.w; }
            const int rd = qpos - k; const int bk = rd < 128 ? BUCKET[rd] : 31;
            const float lg = d * 0.125f + rel[bk * 16 + mi];
            L[k] = lg; lmax = fmaxf(lmax, lg);
        }
        lmax = wmax(lmax);
        float s = 0.f;
        for (int k = lane; k <= qpos; k += 64) { const float e = __expf(L[k] - lmax); L[k] = e; s += e; }
        sums[mm] = wsum(s);
    }
    const float i1 = 1.f / sums[0], i2 = lam / sums[1];
    for (int k = lane; k <= qpos; k += 64) L1[k] = L1[k] * i1 - L2[k] * i2;
    __builtin_amdgcn_s_waitcnt(0);
    float o0 = 0.f, o1 = 0.f;
    const float* vp = P + (size_t)(b * S) * APROJ + 2048 + head * 128;
    for (int k = 0; k <= qpos; ++k) { const float a = L1[k]; o0 += a * vp[(size_t)k * APROJ + lane]; o1 += a * vp[(size_t)k * APROJ + 64 + lane]; }
    const float ss = wsum(o0 * o0 + o1 * o1);
    const float r = rsqrtf(ss * (1.f / 128.f) + 1e-5f) * (1.f - lam_init);
    O[(size_t)row * 1024 + head * 128 + lane] = o0 * r * subln[lane];
    O[(size_t)row * 1024 + head * 128 + 64 + lane] = o1 * r * subln[64 + lane];
}
}
namespace pg8 {
#define PG8_LAS __attribute__((address_space(3)))
typedef unsigned short bf16_t;
typedef short bf16x8 __attribute__((ext_vector_type(8)));
typedef float f32x4 __attribute__((ext_vector_type(4)));
typedef float f32x2 __attribute__((ext_vector_type(2)));
typedef unsigned u32x4 __attribute__((ext_vector_type(4)));
constexpr int BM = 256, BK = 64, HALF = 128, HTB = HALF * BK * 2  , STAGE_BYTES = 8 * HTB, NXCD = 8, WGM = 8;

__host__ __device__ __forceinline__ int lds_byte(int r, int c) { const int st = (r >> 4) * 2 + (c >> 5), rr = r & 15, cc = c & 31, ob = rr * 64 + cc * 2; return st * 1024 + (ob ^ (((ob >> 9) & 1) << 5)); }
__host__ __device__ __forceinline__ void stage_rc(int b, int& R, int& C) { const int st = b / 1024, sb = b % 1024, swz = sb ^ (((sb >> 9) & 1) << 5); R = (st >> 1) * 16 + swz / 64; C = (st & 1) * 32 + (swz % 64) / 2; }
__host__ __device__ __forceinline__ int perm32(int rho) { const int n = rho >> 4, i = rho & 15; return 8 * (i >> 2) + 4 * n + (i & 3); }

struct Unit { int pm, pn; long boff; };
struct Gemm { const bf16_t* A; const bf16_t* Bt; int M, N, K; const int* arow; };

struct StaticOrder {
    int nM, nN, nwg, G, c;
    __host__ __device__ void init(int M, int N, int G_, int c_) { nM = M / BM; nN = N / BM; nwg = nM * nN; G = G_; c = c_; }
    __host__ __device__ bool next(int i, Unit& u) const {
        const long L = (long)i * G + c; if (L >= nwg) return false;
        int wgid = (int)L; { const int q = nwg / NXCD, r = nwg % NXCD, xcd = wgid % NXCD, off = wgid / NXCD; wgid = (xcd < r ? xcd * (q + 1) : r * (q + 1) + (xcd - r) * q) + off; }
        const int nig = WGM * nN, gid = wgid / nig, fm = gid * WGM, gsz = (nM - fm) < WGM ? (nM - fm) : WGM;
        u.pm = fm + ((wgid % nig) % gsz); u.pn = (wgid % nig) / gsz; u.boff = 0; return true;
    }
};
struct GroupOrder {
    int nM, nN, nwg, G, c; const int* blk_e; long wstride;
    __device__ void init(int nM_, int nN_, int G_, int c_, const int* be, long ws) { nM = nM_; nN = nN_; nwg = nM * nN; G = G_; c = c_; blk_e = be; wstride = ws; }
    __device__ bool next(int i, Unit& u) const {
        const long L = (long)i * G + c; if (L >= nwg) return false;
        const int wgid = (int)L;
        const int nig = WGM * nN, gid = wgid / nig, fm = gid * WGM, gsz = (nM - fm) < WGM ? (nM - fm) : WGM;
        u.pm = fm + ((wgid % nig) % gsz); u.pn = (wgid % nig) / gsz; u.boff = (long)blk_e[u.pm] * wstride; return true;
    }
};

__device__ __forceinline__ unsigned cvt_pk_bf16(float lo, float hi) { unsigned r; asm volatile("v_cvt_pk_bf16_f32 %0, %1, %2" : "=v"(r) : "v"(lo), "v"(hi)); return r; }
__device__ __forceinline__ float silu_f(float v) { return v * __builtin_amdgcn_rcpf(1.0f + __builtin_amdgcn_exp2f(-1.4426950408889634f * v)); }

struct EpiBf16 {
    static constexpr bool PERM = true;
    bf16_t* O; int ldc; float scale0; int nscaled;
    __device__ __forceinline__ void operator()(const f32x4 (&acc)[2][2][4][2], const Unit& u, int wr, int wc, int fr, int fq) const {
        const int row0 = u.pm * BM + wr * 64 + fr, col0 = u.pn * BM + wc * 32 + 8 * fq;
        const float sc = (u.pn < nscaled) ? scale0 : 1.f;
#pragma unroll
        for (int ai = 0; ai < 2; ++ai)
#pragma unroll
            for (int m = 0; m < 4; ++m) { bf16_t* rowp = O + (size_t)(row0 + ai * HALF + m * 16) * ldc + col0;
#pragma unroll
                for (int bj = 0; bj < 2; ++bj) { const f32x4 v0 = acc[ai][bj][m][0] * sc, v1 = acc[ai][bj][m][1] * sc;
                    u32x4 w; w.x = cvt_pk_bf16(v0[0], v0[1]); w.y = cvt_pk_bf16(v0[2], v0[3]); w.z = cvt_pk_bf16(v1[0], v1[1]); w.w = cvt_pk_bf16(v1[2], v1[3]);
                    *(u32x4*)(rowp + bj * HALF) = w; } }
    }
};
struct EpiSwiGLU {
    static constexpr bool PERM = true;
    bf16_t* O; int ldc;
    __device__ __forceinline__ void operator()(const f32x4 (&acc)[2][2][4][2], const Unit& u, int wr, int wc, int fr, int fq) const {
        const int row0 = u.pm * BM + wr * 64 + fr, col0 = u.pn * HALF + wc * 32 + 8 * fq;
#pragma unroll
        for (int ai = 0; ai < 2; ++ai)
#pragma unroll
            for (int m = 0; m < 4; ++m) { bf16_t* rowp = O + (size_t)(row0 + ai * HALF + m * 16) * ldc + col0;
                const f32x4 g0 = acc[ai][0][m][0], g1 = acc[ai][0][m][1], u0 = acc[ai][1][m][0], u1 = acc[ai][1][m][1];
                u32x4 w; w.x = cvt_pk_bf16(silu_f(g0[0]) * u0[0], silu_f(g0[1]) * u0[1]); w.y = cvt_pk_bf16(silu_f(g0[2]) * u0[2], silu_f(g0[3]) * u0[3]);
                w.z = cvt_pk_bf16(silu_f(g1[0]) * u1[0], silu_f(g1[1]) * u1[1]); w.w = cvt_pk_bf16(silu_f(g1[2]) * u1[2], silu_f(g1[3]) * u1[3]);
                *(u32x4*)rowp = w; }
    }
};
struct EpiResid {
    static constexpr bool PERM = false;
    float* O; int ldc;
    __device__ __forceinline__ void operator()(const f32x4 (&acc)[2][2][4][2], const Unit& u, int wr, int wc, int fr, int fq) const {
        const int row0 = u.pm * BM + wr * 64 + fr, col0 = u.pn * BM + wc * 32 + 4 * fq;
#pragma unroll
        for (int ai = 0; ai < 2; ++ai)
#pragma unroll
            for (int m = 0; m < 4; ++m) { float* rowp = O + (size_t)(row0 + ai * HALF + m * 16) * ldc + col0;
#pragma unroll
                for (int bj = 0; bj < 2; ++bj)
#pragma unroll
                    for (int n = 0; n < 2; ++n) { f32x4* p = (f32x4*)(rowp + bj * HALF + n * 16); *p = *p + acc[ai][bj][m][n]; }
                asm volatile("" ::: "memory"); }
    }
};

template <class Epi, class Sched, bool ALIGN_EPI, bool GATHER>
__device__ __forceinline__ void gemm_phase(PG8_LAS unsigned char* lds, const Gemm g, const Sched& S, const Epi& E, int wave_id) {
    int tid_; asm volatile("v_mbcnt_lo_u32_b32 %0, -1, 0\n\tv_mbcnt_hi_u32_b32 %0, -1, %0" : "=v"(tid_)); tid_ += wave_id * 64;
    const int tid = tid_, wid = __builtin_amdgcn_readfirstlane(tid >> 6), lane = tid & 63, wr = wid >> 2, wc = wid & 3, fr = lane & 15, fq = lane >> 4;
    const int K = g.K, nt = K / BK;
    unsigned voffA[2], voffB[2]; int rA[2], cA2[2];
#pragma unroll
    for (int i = 0; i < 2; ++i) { int R, C; stage_rc(tid * 16 + i * 8192, R, C); const int Rb = Epi::PERM ? ((R & ~31) + perm32(R & 31)) : R;
        voffA[i] = (unsigned)(R * K + C) * 2u; voffB[i] = (unsigned)(Rb * K + C) * 2u; rA[i] = R; cA2[i] = C * 2; }
    const size_t kstep = (size_t)(BK * 2);
    const size_t hstep = (size_t)HALF * K * 2;
    const size_t tstep = 2 * hstep;
    const unsigned ldsw = (unsigned)wid * 1024u;
    const int aoff = lds_byte(wr * 64 + fr, fq * 8), boff = lds_byte(wc * 32 + fr, fq * 8);
#define PG8_SA(b, h) (((b) * 2 + (h)) * HTB)
#define PG8_SB(b, h) ((4 + (b) * 2 + (h)) * HTB)
#define PG8_STAGE2(bufoff, gbase, v0, v1) do { \
        __builtin_amdgcn_global_load_lds((const unsigned*)((const char*)(gbase) + (v0)), (PG8_LAS unsigned*)(lds + (bufoff) + ldsw), 16, 0, 0); \
        __builtin_amdgcn_global_load_lds((const unsigned*)((const char*)(gbase) + (v1)), (PG8_LAS unsigned*)(lds + (bufoff) + ldsw + 8192), 16, 0, 0); } while (0)
#define PG8_STAGEB(bufoff, gbase) PG8_STAGE2(bufoff, gbase, voffB[0], voffB[1])
#define PG8_LDA(dst, b, h) do { _Pragma("unroll") for (int m = 0; m < 4; ++m) _Pragma("unroll") for (int k = 0; k < 2; ++k) dst[m][k] = *(const PG8_LAS bf16x8*)(lds + PG8_SA(b, h) + aoff + m * 2048 + k * 1024); } while (0)
#define PG8_LDB(dst, b, h) do { _Pragma("unroll") for (int n = 0; n < 2; ++n) _Pragma("unroll") for (int k = 0; k < 2; ++k) dst[n][k] = *(const PG8_LAS bf16x8*)(lds + PG8_SB(b, h) + boff + n * 2048 + k * 1024); } while (0)
#define PG8_MMA(ai, bj, At, Bt) do { __builtin_amdgcn_s_setprio(1); _Pragma("unroll") for (int m = 0; m < 4; ++m) _Pragma("unroll") for (int n = 0; n < 2; ++n) _Pragma("unroll") for (int k = 0; k < 2; ++k) \
        acc[ai][bj][m][n] = __builtin_amdgcn_mfma_f32_16x16x32_bf16(Bt[n][k], At[m][k], acc[ai][bj][m][n], 0, 0, 0); __builtin_amdgcn_s_setprio(0); } while (0)
#define PG8_WAIT_V(n) asm volatile("s_waitcnt vmcnt(" #n ")" ::: "memory")
#define PG8_WAIT_L(n) asm volatile("s_waitcnt lgkmcnt(" #n ")" ::: "memory")
#define PG8_BAR __builtin_amdgcn_s_barrier()
#define PG8_SCHED __builtin_amdgcn_sched_barrier(0)
    Unit cur, nxt; int ui = 0;
    if (!S.next(0, cur)) return;
    f32x4 acc[2][2][4][2];
#pragma unroll
    for (int a = 0; a < 2; ++a)
#pragma unroll
        for (int b = 0; b < 2; ++b)
#pragma unroll
            for (int m = 0; m < 4; ++m)
#pragma unroll
                for (int n = 0; n < 2; ++n) acc[a][b][m][n] = (f32x4){0.f, 0.f, 0.f, 0.f};
    bf16x8 At[4][2], B0[2][2], B1[2][2];
    unsigned c00, c01, c10, c11, n00, n01, n10, n11;
    const char* cA; const char* cB = (const char*)g.Bt + (size_t)cur.boff * 2 + (size_t)cur.pn * tstep;
    if constexpr (GATHER) {
        cA = (const char*)g.A;
        const int* ar = g.arow + cur.pm * BM;
        int t00 = ar[rA[0]], t01 = ar[rA[1]], t10 = ar[HALF + rA[0]], t11 = ar[HALF + rA[1]];
        t00 = t00 < 0 ? 0 : t00; t01 = t01 < 0 ? 0 : t01; t10 = t10 < 0 ? 0 : t10; t11 = t11 < 0 ? 0 : t11;
        c00 = (unsigned)t00 * (unsigned)(K * 2) + cA2[0]; c01 = (unsigned)t01 * (unsigned)(K * 2) + cA2[1]; c10 = (unsigned)t10 * (unsigned)(K * 2) + cA2[0]; c11 = (unsigned)t11 * (unsigned)(K * 2) + cA2[1];
    } else {
        cA = (const char*)g.A + (size_t)cur.pm * tstep;
        c00 = voffA[0]; c01 = voffA[1]; c10 = voffA[0]; c11 = voffA[1];
    }
    const size_t HS = GATHER ? (size_t)0 : hstep;
    n00 = c00; n01 = c01; n10 = c10; n11 = c11;
    PG8_STAGEB(PG8_SB(0, 0), cB); PG8_STAGEB(PG8_SB(0, 1), cB + hstep); PG8_STAGE2(PG8_SA(0, 0), cA, c00, c01); PG8_STAGE2(PG8_SA(0, 1), cA + HS, c10, c11);
    if (wr == 1) PG8_BAR;
    PG8_WAIT_V(2); PG8_BAR;
    PG8_STAGEB(PG8_SB(1, 0), cB + kstep); PG8_STAGE2(PG8_SA(1, 0), cA + kstep, c00, c01); PG8_STAGEB(PG8_SB(1, 1), cB + hstep + kstep);
    PG8_WAIT_V(6); PG8_BAR;
    for (;;) {
        const bool has_next = S.next(ui + 1, nxt);
        const char* nA; const char* nB = has_next ? (const char*)g.Bt + (size_t)nxt.boff * 2 + (size_t)nxt.pn * tstep : cB;
        if constexpr (GATHER) {
            nA = cA;
            if (has_next) {
                const int* ar = g.arow + nxt.pm * BM;
                int t00 = ar[rA[0]], t01 = ar[rA[1]], t10 = ar[HALF + rA[0]], t11 = ar[HALF + rA[1]];
                t00 = t00 < 0 ? 0 : t00; t01 = t01 < 0 ? 0 : t01; t10 = t10 < 0 ? 0 : t10; t11 = t11 < 0 ? 0 : t11;
                n00 = (unsigned)t00 * (unsigned)(K * 2) + cA2[0]; n01 = (unsigned)t01 * (unsigned)(K * 2) + cA2[1]; n10 = (unsigned)t10 * (unsigned)(K * 2) + cA2[0]; n11 = (unsigned)t11 * (unsigned)(K * 2) + cA2[1];
            } else { n00 = c00; n01 = c01; n10 = c10; n11 = c11; }
        } else {
            nA = has_next ? (const char*)g.A + (size_t)nxt.pm * tstep : cA;
        }
        for (int t = 0; t < nt; t += 2) {
            const bool last = (t == nt - 2);
            const char* a1 = cA + (size_t)(t + 1) * kstep;
            const char* a2 = last ? nA : cA + (size_t)(t + 2) * kstep; const char* b2 = last ? nB : cB + (size_t)(t + 2) * kstep;
            const char* a3 = a2 + kstep; const char* b3 = b2 + kstep;
            unsigned x00 = c00, x01 = c01, x10 = c10, x11 = c11;
            if constexpr (GATHER) { if (last) { x00 = n00; x01 = n01; x10 = n10; x11 = n11; } }
            PG8_LDB(B0, 0, 0); PG8_LDB(B1, 0, 1); PG8_SCHED; PG8_LDA(At, 0, 0); PG8_STAGE2(PG8_SA(1, 1), a1 + HS, c10, c11);
            PG8_WAIT_V(8); PG8_WAIT_L(0); PG8_BAR; PG8_MMA(0, 0, At, B0); PG8_MMA(0, 1, At, B1); PG8_BAR; PG8_SCHED;
            PG8_LDA(At, 0, 1); PG8_STAGEB(PG8_SB(0, 0), b2); PG8_STAGEB(PG8_SB(0, 1), b2 + hstep); PG8_STAGE2(PG8_SA(0, 0), a2, x00, x01);
            PG8_WAIT_V(8); PG8_WAIT_L(0); PG8_BAR; PG8_MMA(1, 0, At, B0); PG8_MMA(1, 1, At, B1); PG8_BAR; PG8_SCHED;
            PG8_LDB(B0, 1, 0); PG8_LDB(B1, 1, 1); PG8_SCHED; PG8_LDA(At, 1, 0); PG8_STAGE2(PG8_SA(0, 1), a2 + HS, x10, x11);
            PG8_WAIT_V(8); PG8_WAIT_L(0); PG8_BAR; PG8_MMA(0, 0, At, B0); PG8_MMA(0, 1, At, B1); PG8_BAR; PG8_SCHED;
            PG8_LDA(At, 1, 1); PG8_STAGEB(PG8_SB(1, 0), b3); PG8_STAGEB(PG8_SB(1, 1), b3 + hstep); PG8_STAGE2(PG8_SA(1, 0), a3, x00, x01);
            PG8_WAIT_V(8); PG8_WAIT_L(0); PG8_BAR; PG8_MMA(1, 0, At, B0); PG8_MMA(1, 1, At, B1); PG8_BAR; PG8_SCHED;
        }
        if constexpr (ALIGN_EPI) { if (wr == 0) PG8_BAR; }
        E(acc, cur, wr, wc, fr, fq);
        if (!has_next) break;
#pragma unroll
        for (int a = 0; a < 2; ++a)
#pragma unroll
            for (int b = 0; b < 2; ++b)
#pragma unroll
                for (int m = 0; m < 4; ++m)
#pragma unroll
                    for (int n = 0; n < 2; ++n) acc[a][b][m][n] = (f32x4){0.f, 0.f, 0.f, 0.f};
        cur = nxt; cA = nA; cB = nB; ++ui;
        c00 = n00; c01 = n01; c10 = n10; c11 = n11;
        if constexpr (ALIGN_EPI) { if (wr == 1) PG8_BAR; }
    }
    PG8_WAIT_V(0);
    if constexpr (!ALIGN_EPI) { if (wr == 0) PG8_BAR; }
    PG8_BAR;
#undef PG8_SA
#undef PG8_SB
#undef PG8_STAGE2
#undef PG8_STAGEB
#undef PG8_LDA
#undef PG8_LDB
#undef PG8_MMA
#undef PG8_WAIT_V
#undef PG8_WAIT_L
#undef PG8_BAR
#undef PG8_SCHED
}
}
namespace mk {
constexpr int NWAVES = 8, NTHR = 512;
constexpr int B = 8, S = 4096, D = 1024, M = B * S;
constexpr int FF = 3584, NE = 8, NBLK = 264, NSLOT = NBLK * 256;
constexpr size_t MiB = 1u << 20;
constexpr size_t F_CTL = 0, CTL_ZERO_BYTES = 1 * MiB;
constexpr size_t F_TOPE = 1 * MiB, F_TOPG = F_TOPE + 256 * 1024, F_SLOTTOK = F_TOPG + 256 * 1024, F_TOKSLOT = F_SLOTTOK + 320 * 1024, F_BLKE = F_TOKSLOT + 256 * 1024, F_NUSED = F_BLKE + 2048;
constexpr size_t F_LI = 3 * MiB, F_LF = 3 * MiB + 512 * 1024;
constexpr size_t F_W = 4 * MiB, F_WS = 172 * MiB, F_XN = 212 * MiB, F_BIG = 276 * MiB;
constexpr size_t F_P = F_BIG, F_HH = 468 * MiB, F_G = 596 * MiB;
constexpr size_t F_H = F_BIG;
constexpr size_t F_O = 468 * MiB, F_OT = 532 * MiB;
constexpr size_t F_Y = 738 * MiB;
static_assert(F_NUSED + 64 <= 3 * MiB && F_H + (size_t)NSLOT * FF * 2 <= F_Y && F_Y + (size_t)NSLOT * 1024 * 2 <= 872 * MiB, "ws map");
constexpr int CW_TMO = 0, CW_BAR = 4096;
constexpr int MAX_LAUNCH = 40;
constexpr int RING_OFF = 0, RING_BYTES = 131072, LDSCTL_OFF = RING_BYTES, MISC_OFF = LDSCTL_OFF + 320, LDS_BYTES = 147456;

#define GAS __attribute__((address_space(1)))
#define LAS __attribute__((address_space(3)))
typedef unsigned short bf16;
typedef unsigned v4u __attribute__((ext_vector_type(4)));
typedef unsigned v2u __attribute__((ext_vector_type(2)));
typedef float f32x4 __attribute__((ext_vector_type(4)));
typedef GAS unsigned gu32;
#define RLX_AGENT __ATOMIC_RELAXED, __HIP_MEMORY_SCOPE_AGENT
#define LDS_WAIT() asm volatile("s_waitcnt lgkmcnt(0)" ::: "memory")
#define VM_WAIT() asm volatile("s_waitcnt vmcnt(0)" ::: "memory")
__device__ __forceinline__ unsigned f2bf(float f) { unsigned u = __builtin_bit_cast(unsigned, f); return (u + 0x7fffu + ((u >> 16) & 1u)) >> 16; }
__device__ __forceinline__ unsigned pk2(float lo, float hi) { return f2bf(lo) | (f2bf(hi) << 16); }
__device__ __forceinline__ float bf_lo(unsigned w) { return __builtin_bit_cast(float, w << 16); }
__device__ __forceinline__ float bf_hi(unsigned w) { return __builtin_bit_cast(float, w & 0xffff0000u); }

#define XB_TMO      128
#define XB_XCNT(j)  (256  + 64 * (j))
#define XB_XSUB(j)  (1280 + 64 * (j))
#define XB_XGEN(j)  (2304 + 64 * (j))
#define XB_TOP      3328
#define XB_TOPGEN   3392
#define XCD_BAR_WORDS 3456
#define XB_SPIN_CAP (1u << 18)
__device__ __forceinline__ unsigned xb_ld(unsigned* p)              { return __hip_atomic_load(p, __ATOMIC_RELAXED, __HIP_MEMORY_SCOPE_AGENT); }
__device__ __forceinline__ unsigned xb_add(unsigned* p, unsigned v) { return __hip_atomic_fetch_add(p, v, __ATOMIC_RELAXED, __HIP_MEMORY_SCOPE_AGENT); }
__device__ __forceinline__ unsigned xb_xcc_id() { return (unsigned)__builtin_amdgcn_s_getreg((3 << 11) | 20) & 0xFu; }
#define XB_SPIN(cond, bar) do { unsigned _sp = 0; while (cond) { __builtin_amdgcn_s_sleep(1); \
    if ((++_sp & 255u) == 0u) { if (xb_ld(&(bar)[XB_TMO])) break; if (_sp > XB_SPIN_CAP) { atomicAdd(&(bar)[XB_TMO], 1u); break; } } } } while (0)
struct XcdBarrier { unsigned* bar; unsigned x; volatile LAS unsigned* st; };
__device__ __forceinline__ XcdBarrier xcd_barrier_post(unsigned* bar, volatile LAS unsigned* st, bool t0) {
    XcdBarrier b; b.bar = bar; b.x = xb_xcc_id(); b.st = st;
    if (t0) (void)xb_add(&bar[XB_XCNT(b.x)], 1u);
    return b;
}
__device__ __forceinline__ void xcd_barrier_complete(unsigned* bar, unsigned x, unsigned& nloc, unsigned& nx) {
    const unsigned G = gridDim.x * gridDim.y * gridDim.z;
    unsigned sum, cnt, mine, sp = 0u;
    for (;;) {
        sum = 0u; cnt = 0u; mine = 0u;
#pragma unroll
        for (unsigned j = 0; j < 16; ++j) { const unsigned c = xb_ld(&bar[XB_XCNT(j)]); sum += c; cnt += (c > 0u) ? 1u : 0u; mine = (j == x) ? c : mine; }
        if (sum == G) break;
        __builtin_amdgcn_s_sleep(1);
        if ((++sp & 255u) == 0u) { if (xb_ld(&bar[XB_TMO])) break; if (sp > XB_SPIN_CAP) { atomicAdd(&bar[XB_TMO], 1u); break; } }
    }
    nloc = mine > 0u ? mine : 1u; nx = cnt > 0u ? cnt : 1u;
}
__device__ __forceinline__ void xcd_barrier(const XcdBarrier& b, bool t0) {
    asm volatile("s_waitcnt vmcnt(0)" ::: "memory");
    __syncthreads();
    if (t0) {
        unsigned* bar = b.bar;
        __builtin_amdgcn_s_waitcnt(0);
        unsigned nloc = b.st[0], nx = b.st[1];
        if (nloc == 0u) { xcd_barrier_complete(bar, b.x, nloc, nx); b.st[0] = nloc; b.st[1] = nx; }
        const unsigned old = xb_add(&bar[XB_XSUB(b.x)], 1u);
        const unsigned gen = old / nloc;
        if (old + 1u == (gen + 1u) * nloc) {
            __builtin_amdgcn_fence(__ATOMIC_RELEASE, "agent");
            asm volatile("s_waitcnt vmcnt(0)" ::: "memory");
            const unsigned og = xb_add(&bar[XB_TOP], 1u);
            const unsigned tg = og / nx;
            if (og + 1u == (tg + 1u) * nx) xb_add(&bar[XB_TOPGEN], 1u);
            else XB_SPIN(xb_ld(&bar[XB_TOPGEN]) == tg, bar);
            __builtin_amdgcn_fence(__ATOMIC_ACQUIRE, "agent");
            xb_add(&bar[XB_XGEN(b.x)], 1u);
            asm volatile("s_waitcnt vmcnt(0)" ::: "memory");
        } else {
            XB_SPIN(xb_ld(&bar[XB_XGEN(b.x)]) == gen, bar);
            __builtin_amdgcn_fence(__ATOMIC_ACQUIRE, "agent");
            asm volatile("s_waitcnt vmcnt(0)" ::: "memory");
        }
    }
    __syncthreads();
}

struct Frame {
    LAS unsigned char* lds;
    int vcu, G, wave;
};
__device__ __forceinline__ int lane_id() { int l; asm volatile("v_mbcnt_lo_u32_b32 %0, -1, 0\n\tv_mbcnt_hi_u32_b32 %0, -1, %0" : "=v"(l)); return l; }
__device__ __forceinline__ int fresh_tid(const Frame& F) { return F.wave * 64 + lane_id(); }
__device__ __forceinline__ float shfl_idx(float v, int src_lane) { return __builtin_bit_cast(float, __builtin_amdgcn_ds_bpermute(src_lane << 2, __builtin_bit_cast(int, v))); }
__device__ __forceinline__ int shfl_idx_i(int v, int src_lane) { return __builtin_amdgcn_ds_bpermute(src_lane << 2, v); }
__device__ __forceinline__ float wave_sum(float v, int lane) {
#pragma unroll
    for (int o = 1; o < 64; o <<= 1) v += shfl_idx(v, lane ^ o);
    return v;
}

__device__ __forceinline__ void cvt_item(const float* W, int ldw, int K, bf16* WT, int drow0, LAS float* scr, int k0, int n0, int lane) {
#pragma unroll 8
    for (int i = 0; i < 32; ++i) { const int kk = 2 * i + (lane >> 5); scr[kk * 33 + (lane & 31)] = W[(size_t)(k0 + kk) * ldw + n0 + (lane & 31)]; }
    LDS_WAIT(); asm volatile("" ::: "memory");
    const int c = lane & 7;
#pragma unroll
    for (int j = 0; j < 4; ++j) { const int n = (lane >> 3) + 8 * j; const LAS float* s = scr + (8 * c) * 33 + n;
        v4u o; o.x = pk2(s[0 * 33], s[1 * 33]); o.y = pk2(s[2 * 33], s[3 * 33]); o.z = pk2(s[4 * 33], s[5 * 33]); o.w = pk2(s[6 * 33], s[7 * 33]);
        *(GAS v4u*)(WT + (size_t)(drow0 + n) * K + k0 + 8 * c) = o; }
    LDS_WAIT(); asm volatile("" ::: "memory");
}
__device__ __forceinline__ void cvt_job(Frame& F, const float* W, int ldw, int K, int N, int nmat, size_t smat, bf16* WT, size_t dmat, int mode, int rot) {
    const int tid = fresh_tid(F), lane = tid & 63, wave = __builtin_amdgcn_readfirstlane(tid >> 6);
    LAS float* scr = (LAS float*)(F.lds + RING_OFF + wave * 8448);
    const int NGW = F.G * NWAVES; const int gw = (F.vcu * NWAVES + wave + rot) % NGW;
    const int nblk = N / 32, per = (K / 64) * nblk, total = per * nmat;
    for (int it = gw; it < total; it += NGW) {
        const int mat = it / per, r = it % per, kb = r / nblk, nb = r % nblk, n0 = 32 * nb;
        const int drow0 = mode == 0 ? n0 : ((n0 >> 7) * 256 + (n0 & 127) + (mode == 2 ? 128 : 0));
        cvt_item(W + (size_t)mat * smat, ldw, K, WT + (size_t)mat * dmat, drow0, scr, 64 * kb, n0, lane);
    }
}

constexpr int SLAB_OFF_ = 73728;
constexpr int SLAB_OFF = SLAB_OFF_;
struct RowJob {
    const float* xsrc; float* xdst;
    const float* nw;
    bf16* XN; float* outf;
    const bf16* Y; const int* tok_slot; const float* top_g;
    const float* slab; int slab_ld;
    int kind;
    const float* b0; const float* b1; float* LI; float* LF; int* top_e; float* top_g_out; int* wg_cnt;
};
constexpr int EREC_OFF = SLAB_OFF_ + 32768;

__device__ __forceinline__ void row_phase(Frame& F, const RowJob& J) {
    LAS float* slab = (LAS float*)(F.lds + SLAB_OFF);
    const int tid = fresh_tid(F), lane = tid & 63, wave = __builtin_amdgcn_readfirstlane(tid >> 6);
    if (J.slab) { for (int i = tid; i < 8192; i += NTHR) slab[i] = J.slab[(size_t)(i >> 3) * J.slab_ld + (i & 7)]; }
    __syncthreads();
    LAS int* erec = (LAS int*)(F.lds + EREC_OFF);
    const int rpw = M / (F.G * NWAVES), m0 = (F.vcu * NWAVES + wave) * rpw;
    for (int m = m0; m < m0 + rpw; ++m) {
        const GAS f32x4* xr = (const GAS f32x4*)(J.xsrc + (size_t)m * D) + lane;
        f32x4 v[4];
#pragma unroll
        for (int j = 0; j < 4; ++j) v[j] = xr[64 * j];
        if (J.Y) {
            const int s0 = J.tok_slot[m * 2], s1 = J.tok_slot[m * 2 + 1]; const float g0 = J.top_g[m * 2], g1 = J.top_g[m * 2 + 1];
            const GAS v2u* y0 = (const GAS v2u*)(J.Y + (size_t)s0 * D) + lane; const GAS v2u* y1 = (const GAS v2u*)(J.Y + (size_t)s1 * D) + lane;
#pragma unroll
            for (int j = 0; j < 4; ++j) { const v2u a = y0[64 * j], b = y1[64 * j];
                v[j].x += g0 * bf_lo(a.x) + g1 * bf_lo(b.x); v[j].y += g0 * bf_hi(a.x) + g1 * bf_hi(b.x); v[j].z += g0 * bf_lo(a.y) + g1 * bf_lo(b.y); v[j].w += g0 * bf_hi(a.y) + g1 * bf_hi(b.y); }
        }
        if (J.xdst) { GAS f32x4* xo = (GAS f32x4*)(J.xdst + (size_t)m * D) + lane;
#pragma unroll
            for (int j = 0; j < 4; ++j) xo[64 * j] = v[j]; }
        float ss = 0.f;
#pragma unroll
        for (int j = 0; j < 4; ++j) ss += (v[j].x * v[j].x + v[j].y * v[j].y) + (v[j].z * v[j].z + v[j].w * v[j].w);
        const float rstd = 1.0f / sqrtf(wave_sum(ss, lane) * (1.f / D) + 1e-6f);
#pragma unroll
        for (int j = 0; j < 4; ++j) { const f32x4 w = ((const GAS f32x4*)J.nw)[lane + 64 * j]; v[j] = v[j] * rstd * w; }
        if (J.outf) { GAS f32x4* o = (GAS f32x4*)(J.outf + (size_t)m * D) + lane;
#pragma unroll
            for (int j = 0; j < 4; ++j) o[64 * j] = v[j]; }
        if (J.XN) { GAS v2u* o = (GAS v2u*)(J.XN + (size_t)m * D) + lane;
#pragma unroll
            for (int j = 0; j < 4; ++j) { v2u w; w.x = pk2(v[j].x, v[j].y); w.y = pk2(v[j].z, v[j].w); o[64 * j] = w; } }
        if (J.slab) {
            float acc[8];
#pragma unroll
            for (int e = 0; e < 8; ++e) acc[e] = 0.f;
#pragma unroll
            for (int j = 0; j < 4; ++j)
#pragma unroll
                for (int i = 0; i < 4; ++i) { const int k = (lane + 64 * j) * 4 + i; const float xv = v[j][i];
                    const f32x4 w0 = *(const LAS f32x4*)(slab + k * 8), w1 = *(const LAS f32x4*)(slab + k * 8 + 4);
                    acc[0] += xv * w0.x; acc[1] += xv * w0.y; acc[2] += xv * w0.z; acc[3] += xv * w0.w; acc[4] += xv * w1.x; acc[5] += xv * w1.y; acc[6] += xv * w1.z; acc[7] += xv * w1.w; }
#pragma unroll
            for (int e = 0; e < 8; ++e) acc[e] = wave_sum(acc[e], lane);
            if (J.kind == 1) {
                if (lane < 4) { float a = acc[0]; a = lane == 1 ? acc[1] : a; a = lane == 2 ? acc[2] : a; a = lane == 3 ? acc[3] : a; J.LI[m * 4 + lane] = a + J.b0[lane]; }
                else if (lane < 8) { const int h = lane - 4; float a = acc[4]; a = h == 1 ? acc[5] : a; a = h == 2 ? acc[6] : a; a = h == 3 ? acc[7] : a;
                    const float z = a + J.b1[h]; const float ez = __expf(-fabsf(z));
                    const float l1p = ez < 0.06f ? ez * (1.f + ez * (-0.5f + ez * (0.33333333f - 0.25f * ez))) : __logf(1.f + ez);
                    J.LF[m * 4 + h] = fminf(z, 0.f) - l1p; }
            } else if (J.kind == 2) {
                if (lane == 0) {
#pragma unroll
                    for (int e = 0; e < 8; ++e) acc[e] += J.b0[e];
                    int e0 = 0; float l0 = acc[0];
#pragma unroll
                    for (int e = 1; e < 8; ++e) if (acc[e] > l0) { l0 = acc[e]; e0 = e; }
                    int e1 = 0; float l1 = -INFINITY;
#pragma unroll
                    for (int e = 0; e < 8; ++e) if (e != e0 && acc[e] > l1) { l1 = acc[e]; e1 = e; }
                    const float ex = __expf(l1 - l0);
                    J.top_e[m * 2] = e0; J.top_e[m * 2 + 1] = e1; J.top_g_out[m * 2] = 1.f / (1.f + ex); J.top_g_out[m * 2 + 1] = ex / (1.f + ex);
                    const int ml = m - F.vcu * NWAVES * rpw; erec[ml * 2] = e0; erec[ml * 2 + 1] = e1;
                }
            }
        }
    }
    if (J.kind == 2) {
        __syncthreads();
        if (tid < 8) { int c = 0; const int na = 2 * NWAVES * rpw; for (int i = 0; i < na; ++i) c += (erec[i] == tid) ? 1 : 0; J.wg_cnt[F.vcu * 8 + tid] = c; }
    }
}
}
namespace att {
using bf16x8 = __attribute__((ext_vector_type(8))) short;
using s16x4 = __attribute__((ext_vector_type(4))) short;
using f32x16 = __attribute__((ext_vector_type(16))) float;
using u32x4 = __attribute__((ext_vector_type(4))) unsigned;
typedef __attribute__((address_space(3))) const char* lds_cptr;
typedef __attribute__((address_space(3))) char* lds_ptr;
typedef short v4i16_t __attribute__((ext_vector_type(4)));
constexpr int SEQ = 4096, PITCH = 3072, QB = 256, KVBLK = 64, NQB = SEQ / QB;
constexpr int NSLOT = 3, KSLOT = 8192, VSLOT = 16384;
constexpr int LDS_K = 0, LDS_V = NSLOT * KSLOT, LDS_WS = LDS_V + NSLOT * VSLOT, LDS_BT = LDS_WS + 8 * 256, LDS_END = LDS_BT + 512;
constexpr float LOG2E = 1.4426950408889634f;
#define ATT_MFMA(a, b, c) __builtin_amdgcn_mfma_f32_32x32x16_bf16(a, b, c, 0, 0, 0)
__device__ __forceinline__ int crow(int r, int hi) { return (r & 3) + 8 * (r >> 2) + 4 * hi; }
__device__ __forceinline__ void glds16(const void* gsrc, unsigned lds_dst) { unsigned keep;
    asm volatile("s_mov_b32 %0, m0\n\ts_mov_b32 m0, %2\n\ts_nop 0\n\tglobal_load_lds_dwordx4 %1, off\n\ts_mov_b32 m0, %0" : "=&s"(keep) : "v"(gsrc), "s"(lds_dst) : "memory"); }
typedef float f32x2_t __attribute__((ext_vector_type(2))); typedef __bf16 bf16x2_t __attribute__((ext_vector_type(2)));
__device__ __forceinline__ unsigned cvtpk(float lo, float hi) { f32x2_t v = {lo, hi}; bf16x2_t b = __builtin_convertvector(v, bf16x2_t); return __builtin_bit_cast(unsigned, b); }
__device__ __forceinline__ s16x4 vtr(lds_cptr p) { return __builtin_bit_cast(s16x4, __builtin_amdgcn_ds_read_tr16_b64_v4i16((__attribute__((address_space(3))) v4i16_t*)p)); }
#define ATT_MX3(a, b, c) __builtin_fmaxf(__builtin_fmaxf((a), (b)), (c))
__device__ __forceinline__ float rowmax(const f32x16& p0, const f32x16& p1) {
    float a = ATT_MX3(p0[0], p0[1], p1[0]), b = ATT_MX3(p0[2], p0[3], p1[1]); a = ATT_MX3(a, p1[2], p1[3]);
#pragma unroll
    for (int r = 4; r < 16; r += 4) { a = ATT_MX3(a, p0[r], p0[r + 1]); b = ATT_MX3(b, p0[r + 2], p0[r + 3]); a = ATT_MX3(a, p1[r], p1[r + 1]); b = ATT_MX3(b, p1[r + 2], p1[r + 3]); }
    const float m = __builtin_fmaxf(a, b); auto rr = __builtin_amdgcn_permlane32_swap(__float_as_uint(m), __float_as_uint(m), false, false);
    return __builtin_fmaxf(__uint_as_float(rr[0]), __uint_as_float(rr[1])); }
#define ATT_WAIT_BAR(N) asm volatile("s_waitcnt vmcnt(" #N ") lgkmcnt(0)\n\ts_barrier" ::: "memory")

struct Params {
    const unsigned short* QKV; unsigned short* O; float* OT;
    const float* rel; const float* subln; float lam, lam_init;
};

template <int PASS>
__device__ __forceinline__ void attn_pass(int b, int h, int qb, const Params& P, lds_ptr shm, int wid, int lane_in) {
    int lane; asm volatile("v_mbcnt_lo_u32_b32 %0, -1, 0\n\tv_mbcnt_hi_u32_b32 %0, -1, %0" : "=v"(lane));
    (void)lane_in;
    const int r32 = lane & 31, hi = lane >> 5, m = 2 * h + PASS;
    const long rowbase = (long)b * SEQ; const int q0 = qb * QB, NT = (q0 + QB) / KVBLK;
    const unsigned short* Qw = P.QKV + (rowbase + q0 + wid * 32) * PITCH + m * 64;
    const unsigned short* Kh = P.QKV + rowbase * PITCH + 1024 + m * 64; const unsigned short* Vh = P.QKV + rowbase * PITCH + 2048 + h * 128;
    const unsigned lds0 = (unsigned)(uintptr_t)shm;
    __attribute__((address_space(3))) float* wsf = (__attribute__((address_space(3))) float*)(shm + LDS_WS) + wid * 64;
    __attribute__((address_space(3))) float* BT = (__attribute__((address_space(3))) float*)(shm + LDS_BT);
    if (wid < 2) { const int rel = wid * 64 + lane; BT[rel] = P.rel[nv::BUCKET[rel] * 16 + m] * LOG2E; }
    const float c31 = P.rel[31 * 16 + m] * LOG2E;
    const unsigned short* ksrc = Kh + (long)lane * PITCH + wid * 8;
    const unsigned short* vsrc = Vh + (long)(16 * (wid & 3) + (lane >> 2)) * PITCH + (wid >> 2) * 32 + (lane & 3) * 8;
    const unsigned kdst = lds0 + LDS_K + wid * 1024, vdst = lds0 + LDS_V + wid * 1024;
#define ATT_DMA(t, s) do { glds16(ksrc + (long)(t) * KVBLK * PITCH, (unsigned)__builtin_amdgcn_readfirstlane(kdst + (s) * KSLOT)); \
        glds16(vsrc + (long)(t) * KVBLK * PITCH, (unsigned)__builtin_amdgcn_readfirstlane(vdst + (s) * VSLOT)); \
        glds16(vsrc + (long)(t) * KVBLK * PITCH + 64, (unsigned)__builtin_amdgcn_readfirstlane(vdst + (s) * VSLOT + 8192)); } while (0)
    ATT_DMA(0, 0); ATT_DMA(1, 1);
    bf16x8 qr[4];
#pragma unroll
    for (int d0 = 0; d0 < 4; ++d0) qr[d0] = *reinterpret_cast<const bf16x8*>(&Qw[(long)r32 * PITCH + d0 * 16 + hi * 8]);
    float c31p = c31;
    asm volatile("" : "+v"(qr[0]), "+v"(qr[1]), "+v"(qr[2]), "+v"(qr[3]), "+v"(c31p));
    float mhat = 0.f, l_reg = 0.f; f32x16 o[4];
#pragma unroll
    for (int d = 0; d < 4; ++d) o[d] = f32x16{};
    f32x16 negm;
#pragma unroll
    for (int r = 0; r < 16; ++r) negm[r] = c31p;
    const int qabs = q0 + wid * 32 + r32;
    const lds_cptr kp0 = (lds_cptr)shm + LDS_K + hi * 1024 + r32 * 16;
    const lds_cptr vp0 = (lds_cptr)shm + LDS_V + ((lane >> 4) & 1) * 32 + (lane & 3) * 8 + (4 * hi + ((lane & 15) >> 2)) * 64;
    int slot = 0;
#pragma unroll 1
    for (int t = 0; t < NT; ++t) {
        if (t + 1 < NT) { ATT_WAIT_BAR(3); } else { ATT_WAIT_BAR(0); }
        if (t + 2 < NT) { const int s2 = slot == 0 ? 2 : slot - 1; ATT_DMA(t + 2, s2); }
        const lds_cptr kp = kp0 + slot * KSLOT; const lds_cptr vp = vp0 + slot * VSLOT;
        f32x16 p0, p1;
        if (t + 6 < NT) { p0 = negm; p1 = negm; }
        else {
            const int kb = t * KVBLK + 4 * hi;
#pragma unroll
            for (int r = 0; r < 16; ++r) { const int k0 = kb + (r & 3) + 8 * (r >> 2); int rel0 = qabs - k0, rel1 = rel0 - 32;
                const float b0 = BT[rel0 < 0 ? 0 : (rel0 > 127 ? 127 : rel0)], b1 = BT[rel1 < 0 ? 0 : (rel1 > 127 ? 127 : rel1)];
                p0[r] = rel0 < 0 ? -INFINITY : b0 - mhat; p1[r] = rel1 < 0 ? -INFINITY : b1 - mhat; }
        }
        {
            bf16x8 kf[8];
#pragma unroll
            for (int d0 = 0; d0 < 4; ++d0) { kf[2 * d0] = *(const __attribute__((address_space(3))) bf16x8*)(kp + d0 * 2048); kf[2 * d0 + 1] = *(const __attribute__((address_space(3))) bf16x8*)(kp + d0 * 2048 + 512); }
#pragma unroll
            for (int d0 = 0; d0 < 4; ++d0) { p0 = ATT_MFMA(kf[2 * d0], qr[d0], p0); p1 = ATT_MFMA(kf[2 * d0 + 1], qr[d0], p1); }
        }
        s16x4 loA[4], hhA[4], loB[4], hhB[4];
#pragma unroll
        for (int ks = 0; ks < 4; ++ks) { loA[ks] = vtr(vp + ks * 1024); hhA[ks] = vtr(vp + ks * 1024 + 512); }
        __builtin_amdgcn_sched_barrier(0);
        const float rm = rowmax(p0, p1);
        bool resc = false;
        if (t == 0 || __any(rm > 8.0f)) {
            const float dl = t == 0 ? rm : __builtin_fmaxf(rm, 0.f);
            mhat += dl;
#pragma unroll
            for (int r = 0; r < 16; ++r) { p0[r] -= dl; p1[r] -= dl; }
#pragma unroll
            for (int r = 0; r < 16; ++r) negm[r] = c31p - mhat;
            const float f = __builtin_amdgcn_exp2f(-dl); l_reg *= f; if (hi == 0) wsf[r32] = f; resc = (t != 0);
        }
        float sacc = 0.f;
#pragma unroll
        for (int r = 0; r < 16; ++r) { p0[r] = __builtin_amdgcn_exp2f(p0[r]); p1[r] = __builtin_amdgcn_exp2f(p1[r]); sacc += p0[r] + p1[r]; }
        l_reg += sacc;
        u32x4 pw0 = (u32x4){cvtpk(p0[0], p0[1]), cvtpk(p0[2], p0[3]), cvtpk(p0[4], p0[5]), cvtpk(p0[6], p0[7])};
        u32x4 pw1 = (u32x4){cvtpk(p0[8], p0[9]), cvtpk(p0[10], p0[11]), cvtpk(p0[12], p0[13]), cvtpk(p0[14], p0[15])};
        u32x4 pw2 = (u32x4){cvtpk(p1[0], p1[1]), cvtpk(p1[2], p1[3]), cvtpk(p1[4], p1[5]), cvtpk(p1[6], p1[7])};
        u32x4 pw3 = (u32x4){cvtpk(p1[8], p1[9]), cvtpk(p1[10], p1[11]), cvtpk(p1[12], p1[13]), cvtpk(p1[14], p1[15])};
        __builtin_amdgcn_sched_barrier(0);
        if (resc) {
#pragma unroll
            for (int r = 0; r < 16; ++r) { const float f = wsf[crow(r, hi)];
#pragma unroll
                for (int d = 0; d < 4; ++d) o[d][r] *= f; }
        }
#define ATT_PKX(L, H, k) (bf16x8){L[k][0], L[k][1], L[k][2], L[k][3], H[k][0], H[k][1], H[k][2], H[k][3]}
#define ATT_RD(L, H, d) do { _Pragma("unroll") for (int ks = 0; ks < 4; ++ks) { L[ks] = vtr(vp + (d) * 4096 + ks * 1024); H[ks] = vtr(vp + (d) * 4096 + ks * 1024 + 512); } } while (0)
#define ATT_MM(L, H, d) do { o[d] = ATT_MFMA(__builtin_bit_cast(bf16x8, pw0), ATT_PKX(L, H, 0), o[d]); o[d] = ATT_MFMA(__builtin_bit_cast(bf16x8, pw1), ATT_PKX(L, H, 1), o[d]); \
        o[d] = ATT_MFMA(__builtin_bit_cast(bf16x8, pw2), ATT_PKX(L, H, 2), o[d]); o[d] = ATT_MFMA(__builtin_bit_cast(bf16x8, pw3), ATT_PKX(L, H, 3), o[d]); } while (0)
        ATT_RD(loB, hhB, 1); __builtin_amdgcn_sched_barrier(0); ATT_MM(loA, hhA, 0); __builtin_amdgcn_sched_barrier(0);
        ATT_RD(loA, hhA, 2); __builtin_amdgcn_sched_barrier(0); ATT_MM(loB, hhB, 1); __builtin_amdgcn_sched_barrier(0);
        ATT_RD(loB, hhB, 3); __builtin_amdgcn_sched_barrier(0); ATT_MM(loA, hhA, 2); __builtin_amdgcn_sched_barrier(0);
        ATT_MM(loB, hhB, 3); __builtin_amdgcn_sched_barrier(0);
#undef ATT_PKX
#undef ATT_RD
#undef ATT_MM
        slot = slot == 2 ? 0 : slot + 1;
    }
#undef ATT_DMA
    { auto rr = __builtin_amdgcn_permlane32_swap(__float_as_uint(l_reg), __float_as_uint(l_reg), false, false); l_reg = __uint_as_float(rr[0]) + __uint_as_float(rr[1]); }
    if (hi == 0) wsf[32 + r32] = l_reg;
    asm volatile("s_waitcnt lgkmcnt(0)" ::: "memory");
    float rli[16];
#pragma unroll
    for (int r = 0; r < 16; ++r) rli[r] = __builtin_amdgcn_rcpf(wsf[32 + crow(r, hi)]);
    float* OTw = P.OT + (rowbase + q0 + wid * 32) * 1024 + h * 128;
    if (PASS == 0) {
#pragma unroll
        for (int r = 0; r < 16; ++r)
#pragma unroll
            for (int d = 0; d < 4; ++d) OTw[(long)crow(r, hi) * 1024 + d * 32 + r32] = o[d][r] * rli[r];
        asm volatile("s_waitcnt vmcnt(0) lgkmcnt(0)\n\ts_barrier" ::: "memory");
    } else {
        float ss[16];
#pragma unroll
        for (int r = 0; r < 16; ++r) { float s = 0.f;
#pragma unroll
            for (int d = 0; d < 4; ++d) { const float a = OTw[(long)crow(r, hi) * 1024 + d * 32 + r32] - P.lam * (o[d][r] * rli[r]); o[d][r] = a; s += a * a; }
            ss[r] = s; if ((r & 3) == 3) __builtin_amdgcn_sched_barrier(0); }
#pragma unroll
        for (int x = 1; x < 32; x <<= 1)
#pragma unroll
            for (int r = 0; r < 16; ++r) ss[r] += __builtin_bit_cast(float, __builtin_amdgcn_ds_bpermute((lane ^ x) << 2, __builtin_bit_cast(int, ss[r])));
        float sw[4];
#pragma unroll
        for (int d = 0; d < 4; ++d) sw[d] = P.subln[d * 32 + r32] * (1.f - P.lam_init);
        asm volatile("s_waitcnt vmcnt(0) lgkmcnt(0)\n\ts_barrier" ::: "memory");
        __attribute__((address_space(3))) unsigned short* stg = (__attribute__((address_space(3))) unsigned short*)(shm) + wid * 4096;
#pragma unroll
        for (int r = 0; r < 16; ++r) { const float rs = 1.0f / sqrtf(ss[r] * (1.f / 128.f) + 1e-5f); const int orow = crow(r, hi);
#pragma unroll
            for (int d = 0; d < 4; ++d) { const float v = o[d][r] * rs * sw[d]; stg[orow * 128 + d * 32 + r32] = (unsigned short)(cvtpk(v, v) & 0xffffu); } }
        asm volatile("s_waitcnt lgkmcnt(0)" ::: "memory");
        unsigned short* Ow = P.O + (rowbase + q0 + wid * 32) * 1024 + h * 128;
#pragma unroll
        for (int i = 0; i < 8; ++i) { const int row = i * 4 + (lane >> 4), ch = lane & 15; const u32x4 v = *(const __attribute__((address_space(3))) u32x4*)(stg + row * 128 + ch * 8); *(u32x4*)(Ow + (long)row * 1024 + ch * 8) = v; }
        asm volatile("s_waitcnt vmcnt(0) lgkmcnt(0)\n\ts_barrier" ::: "memory");
    }
}
__device__ __forceinline__ void attn_phase(const Params& P, lds_ptr shm, int vcu, int G, int wid, int lane) {
    if (G == 256) {
        const int bh = vcu >> 2, s = vcu & 3;
        for (int i = 0; i < 4; ++i) { const int qb = (i == 0) ? s : (i == 1) ? 7 - s : (i == 2) ? 8 + s : 15 - s;
            attn_pass<0>(bh >> 3, bh & 7, qb, P, shm, wid, lane); attn_pass<1>(bh >> 3, bh & 7, qb, P, shm, wid, lane); }
    } else {
        for (int u = vcu; u < 64 * NQB; u += G) { const int bh = u >> 4, qb = u & 15;
            attn_pass<0>(bh >> 3, bh & 7, qb, P, shm, wid, lane); attn_pass<1>(bh >> 3, bh & 7, qb, P, shm, wid, lane); }
    }
}
}
namespace mls {
using bf16x8 = __attribute__((ext_vector_type(8))) short;
using f32x4 = __attribute__((ext_vector_type(4))) float;
using u32x4 = __attribute__((ext_vector_type(4))) unsigned;
using u32x2 = __attribute__((ext_vector_type(2))) unsigned;
#define MLS_LAS __attribute__((address_space(3)))
typedef MLS_LAS char* lptr;
constexpr int SEQ = 4096, PITCH = 3072, L = 64, NCH = SEQ / L;
constexpr int QSTR = 136, SSTR = 72;
constexpr int QS = 0, KS = QS + 64 * QSTR * 2, KT = KS + 64 * QSTR * 2, VT = KT + 128 * SSTR * 2, VW = VT + 32 * SSTR * 2, SD = VW + 32 * SSTR * 2, CT = SD + 64 * SSTR * 2,
              NV = CT + 32 * QSTR * 2, FV = NV + 256, AV = FV + 256, IV = AV + 256, EV = IV + 256, WV = EV + 256, WB = WV + 256, DC = WB + 128, LDS_END = DC + 16;
static_assert(LDS_END <= 131072, "mLSTM LDS");
#define MLS_MFMA(a, b, c) __builtin_amdgcn_mfma_f32_16x16x32_bf16(a, b, c, 0, 0, 0)
#define MLS_BAR() asm volatile("s_waitcnt lgkmcnt(0)\n\ts_barrier" ::: "memory")
__device__ __forceinline__ unsigned pk(float lo, float hi) { typedef float f2 __attribute__((ext_vector_type(2))); typedef __bf16 b2 __attribute__((ext_vector_type(2))); f2 v = {lo, hi}; b2 b = __builtin_convertvector(v, b2); return __builtin_bit_cast(unsigned, b); }
__device__ __forceinline__ float blo(unsigned w) { return __builtin_bit_cast(float, w << 16); }
__device__ __forceinline__ float bhi(unsigned w) { return __builtin_bit_cast(float, w & 0xffff0000u); }
__device__ __forceinline__ float bperm(float v, int src) { return __builtin_bit_cast(float, __builtin_amdgcn_ds_bpermute(src << 2, __builtin_bit_cast(int, v))); }

struct Params { const unsigned short* P; const float* LI; const float* LF; const float* cw; const float* cb; float* HH;
                const float* wg; const float* wu; const float* wd; unsigned short* wt_gu; unsigned short* wt_d; int gw; };
constexpr int CV_SCR = (LDS_END + 127) / 128 * 128;
constexpr int LDS_END2 = CV_SCR + 8 * 4224;
static_assert(LDS_END2 <= 131072, "mLSTM + cvt LDS");
struct CvItem { const float* src; unsigned short* dst; int ldw, K; };
__device__ __forceinline__ CvItem cv_decode(const Params& A, int it) {
    const int type = it / 28672, r = it - type * 28672, mat = r / 3584, r2 = r - mat * 3584;
    CvItem c;
    if (type < 2) { const int kb = r2 / 112, nb = r2 - kb * 112, n0 = 32 * nb; const int drow = (n0 >> 7) * 256 + (n0 & 127) + (type ? 128 : 0);
        c.src = (type ? A.wu : A.wg) + (size_t)mat * 1024 * 3584 + (size_t)(32 * kb) * 3584 + n0; c.ldw = 3584; c.K = 1024; c.dst = A.wt_gu + (size_t)mat * 7168 * 1024 + (size_t)drow * 1024 + 32 * kb; }
    else { const int kb = r2 >> 5, nb = r2 & 31, n0 = 32 * nb;
        c.src = A.wd + (size_t)mat * 3584 * 1024 + (size_t)(32 * kb) * 1024 + n0; c.ldw = 1024; c.K = 3584; c.dst = A.wt_d + (size_t)mat * 1024 * 3584 + (size_t)n0 * 3584 + 32 * kb; }
    return c;
}

__device__ __forceinline__ void scan_unit(int b, int h, int sl, const Params& A, lptr shm, int wid, int lane) {
    const int tid = wid * 64 + lane, lr = lane & 15, lq = lane >> 4;
    const long rowbase = (long)b * SEQ;
    const int o = tid & 31, g = tid >> 5, isk = o >> 4, ch0 = (o & 15) * 8;
    const int pcol = isk * 512 + h * 128 + ch0;
    float cwr[4][8], cbr[8];
#pragma unroll
    for (int j = 0; j < 4; ++j) { const f32x4 a = *(const f32x4*)(A.cw + j * 1024 + pcol), c = *(const f32x4*)(A.cw + j * 1024 + pcol + 4);
        cwr[j][0] = a[0]; cwr[j][1] = a[1]; cwr[j][2] = a[2]; cwr[j][3] = a[3]; cwr[j][4] = c[0]; cwr[j][5] = c[1]; cwr[j][6] = c[2]; cwr[j][7] = c[3]; }
    { const f32x4 a = *(const f32x4*)(A.cb + pcol), c = *(const f32x4*)(A.cb + pcol + 4); cbr[0] = a[0]; cbr[1] = a[1]; cbr[2] = a[2]; cbr[3] = a[3]; cbr[4] = c[0]; cbr[5] = c[1]; cbr[6] = c[2]; cbr[7] = c[3]; }
    const float osc = isk ? 0.08838834764831845f : 1.0f;
    const unsigned short* rawp = A.P + (rowbase + 4 * g - 3) * PITCH + pcol;
    const int vs = tid >> 3, vj = (tid & 7) * 4;
    const unsigned short* vp = A.P + (rowbase + vs) * PITCH + 1024 + h * 256 + sl * 32 + vj;
    const int to = wid >> 1, jo = wid & 1;
    f32x4 Cst[2], nst;
    Cst[0] = (f32x4){0.f, 0.f, 0.f, 0.f}; Cst[1] = Cst[0]; nst = Cst[0];
    for (int i = tid; i < (32 * QSTR * 2 + 256) / 4; i += 512) ((MLS_LAS unsigned*)(shm + CT))[i] = 0u;
    float m_prev = 0.f;
    bf16x8 ones; { const short o1 = (short)0x3f80; ones = (bf16x8){o1, o1, o1, o1, o1, o1, o1, o1}; }
    float* hhp = A.HH + (rowbase + 16 * to + 4 * lq) * 1024 + h * 256 + sl * 32 + 16 * jo + lr;
    f32x4 cvr[4]; unsigned short* cvdst = nullptr; int cvK = 0; bool cvhave = false;
    if (A.gw >= 0) { const CvItem ci = cv_decode(A, A.gw);
#pragma unroll
      for (int i = 0; i < 4; ++i) cvr[i] = *(const f32x4*)(ci.src + (size_t)(8 * i + (lane >> 3)) * ci.ldw + (lane & 7) * 4);
      cvdst = ci.dst; cvK = ci.K; cvhave = true; }
    else { cvr[0] = cvr[1] = cvr[2] = cvr[3] = (f32x4){0.f, 0.f, 0.f, 0.f}; }
    u32x4 raw[7]; u32x2 vraw; float gli = 0.f, glf = 0.f;
#pragma unroll
    for (int i = 0; i < 7; ++i) { if (4 * g - 3 + i >= 0) raw[i] = *(const u32x4*)(rawp + (long)i * PITCH); else raw[i] = (u32x4){0u, 0u, 0u, 0u}; }
    vraw = *(const u32x2*)vp;
    if (wid == 7) { gli = A.LI[(rowbase + lane) * 4 + h]; glf = A.LF[(rowbase + lane) * 4 + h]; }
    MLS_BAR();
#pragma unroll 1
    for (int c = 0; c < NCH; ++c) {
        const int t0 = c * L;
        float vv[4]; vv[0] = blo(vraw[0]); vv[1] = bhi(vraw[0]); vv[2] = blo(vraw[1]); vv[3] = bhi(vraw[1]);
        {
            float x[7][8];
#pragma unroll
            for (int i = 0; i < 7; ++i) { x[i][0] = blo(raw[i][0]); x[i][1] = bhi(raw[i][0]); x[i][2] = blo(raw[i][1]); x[i][3] = bhi(raw[i][1]); x[i][4] = blo(raw[i][2]); x[i][5] = bhi(raw[i][2]); x[i][6] = blo(raw[i][3]); x[i][7] = bhi(raw[i][3]); }
            float y[4][8];
#pragma unroll
            for (int r = 0; r < 4; ++r)
#pragma unroll
                for (int e = 0; e < 8; ++e) { float a = cbr[e];
#pragma unroll
                    for (int j = 0; j < 4; ++j) a += cwr[j][e] * x[r + j][e];
                    y[r][e] = osc * a * __builtin_amdgcn_rcpf(1.0f + __builtin_amdgcn_exp2f(-1.4426950408889634f * a)); }
#pragma unroll
            for (int r = 0; r < 4; ++r) { const u32x4 w = (u32x4){pk(y[r][0], y[r][1]), pk(y[r][2], y[r][3]), pk(y[r][4], y[r][5]), pk(y[r][6], y[r][7])};
                *(MLS_LAS u32x4*)(shm + (isk ? KS : QS) + ((4 * g + r) * QSTR + ch0) * 2) = w; }
            if (isk) {
#pragma unroll
                for (int e = 0; e < 8; ++e) { const u32x2 w = (u32x2){pk(y[0][e], y[1][e]), pk(y[2][e], y[3][e])}; *(MLS_LAS u32x2*)(shm + KT + ((ch0 + e) * SSTR + 4 * g) * 2) = w; }
            }
        }
#pragma unroll
        for (int e = 0; e < 4; ++e) *(MLS_LAS unsigned short*)(shm + VT + ((vj + e) * SSTR + vs) * 2) = (unsigned short)(pk(vv[e], vv[e]) & 0xffffu);
        if (wid == 7) {
            float bs = glf;
#pragma unroll
            for (int x = 1; x < 64; x <<= 1) { const float v = bperm(bs, (lane - x) & 63); if (lane >= x) bs += v; }
            const float a = gli - bs;
            float pm = a;
#pragma unroll
            for (int x = 1; x < 64; x <<= 1) { const float v = bperm(pm, (lane - x) & 63); if (lane >= x) pm = fmaxf(pm, v); }
            const float gsum = bperm(bs, 63), amax = bperm(pm, 63);
            const float mref = fmaxf(m_prev, pm);
            const float mt = bs + mref;
            const float mrefn = fmaxf(m_prev, amax);
            const float w = __expf(a - mrefn);
            ((MLS_LAS float*)(shm + FV))[lane] = -mref;
            ((MLS_LAS float*)(shm + AV))[lane] = a;
            ((MLS_LAS float*)(shm + IV))[lane] = __expf(m_prev - mref);
            ((MLS_LAS float*)(shm + EV))[lane] = __expf(-mt);
            ((MLS_LAS float*)(shm + WV))[lane] = w;
            ((MLS_LAS unsigned short*)(shm + WB))[lane] = (unsigned short)(pk(w, w) & 0xffffu);
            if (lane == 0) ((MLS_LAS float*)(shm + DC))[0] = __expf(m_prev - mrefn);
            m_prev = gsum + mrefn;
        }
        if (cvhave) {
            MLS_LAS float* scr = (MLS_LAS float*)(shm + CV_SCR + wid * 4224);
#pragma unroll
            for (int i = 0; i < 4; ++i)
#pragma unroll
                for (int e = 0; e < 4; ++e) scr[(8 * i + (lane >> 3)) * 33 + (lane & 7) * 4 + e] = cvr[i][e];
            float tv[16];
#pragma unroll
            for (int j = 0; j < 16; ++j) tv[j] = scr[(16 * (lane & 1) + j) * 33 + (lane >> 1)];
            u32x4* dp = (u32x4*)(cvdst + (size_t)(lane >> 1) * cvK + 16 * (lane & 1));
            dp[0] = (u32x4){pk(tv[0], tv[1]), pk(tv[2], tv[3]), pk(tv[4], tv[5]), pk(tv[6], tv[7])}; dp[1] = (u32x4){pk(tv[8], tv[9]), pk(tv[10], tv[11]), pk(tv[12], tv[13]), pk(tv[14], tv[15])};
        }
        cvhave = (c + 1 < 42) && (A.gw >= 0);
        if (cvhave) { const CvItem ci = cv_decode(A, A.gw + 2048 * (c + 1));
#pragma unroll
            for (int i = 0; i < 4; ++i) cvr[i] = *(const f32x4*)(ci.src + (size_t)(8 * i + (lane >> 3)) * ci.ldw + (lane & 7) * 4);
            cvdst = ci.dst; cvK = ci.K; }
        if (c + 1 < NCH) {
            const long adv = (long)(t0 + L) * PITCH;
#pragma unroll
            for (int i = 0; i < 7; ++i) raw[i] = *(const u32x4*)(rawp + adv + (long)i * PITCH);
            vraw = *(const u32x2*)(vp + adv);
            if (wid == 7) { gli = A.LI[(rowbase + t0 + L + lane) * 4 + h]; glf = A.LF[(rowbase + t0 + L + lane) * 4 + h]; }
        }
        MLS_BAR();
        { const float w = ((MLS_LAS float*)(shm + WV))[vs];
#pragma unroll
          for (int e = 0; e < 4; ++e) *(MLS_LAS unsigned short*)(shm + VW + ((vj + e) * SSTR + vs) * 2) = (unsigned short)(pk(vv[e] * w, vv[e] * w) & 0xffffu); }
        bf16x8 qa[4];
#pragma unroll
        for (int ks = 0; ks < 4; ++ks) qa[ks] = *(const MLS_LAS bf16x8*)(shm + QS + ((16 * to + lr) * QSTR + 32 * ks + 8 * lq) * 2);
        f32x4 fvr; { const f32x4 t4 = *(const MLS_LAS f32x4*)(shm + FV + (16 * to + 4 * lq) * 4); fvr = t4; }
#pragma unroll
        for (int q = 0; q < 2; ++q) {
            const int si = 2 * jo + q;
            f32x4 s4 = (f32x4){0.f, 0.f, 0.f, 0.f};
            if (si <= to) {
#pragma unroll
                for (int ks = 0; ks < 4; ++ks) { const bf16x8 kb = *(const MLS_LAS bf16x8*)(shm + KS + ((16 * si + lr) * QSTR + 32 * ks + 8 * lq) * 2); s4 = MLS_MFMA(qa[ks], kb, s4); }
                const float av = ((MLS_LAS float*)(shm + AV))[16 * si + lr];
                const int scol = 16 * si + lr, trow = 16 * to + 4 * lq;
#pragma unroll
                for (int r = 0; r < 4; ++r) s4[r] = (scol <= trow + r) ? s4[r] * __expf(fvr[r] + av) : 0.f;
            }
#pragma unroll
            for (int r = 0; r < 4; ++r) *(MLS_LAS unsigned short*)(shm + SD + ((16 * to + 4 * lq + r) * SSTR + 16 * si + lr) * 2) = (unsigned short)(pk(s4[r], s4[r]) & 0xffffu);
        }
        f32x4 qc = (f32x4){0.f, 0.f, 0.f, 0.f}, qn = qc;
#pragma unroll
        for (int ks = 0; ks < 4; ++ks) { const bf16x8 cb8 = *(const MLS_LAS bf16x8*)(shm + CT + ((16 * jo + lr) * QSTR + 32 * ks + 8 * lq) * 2); const bf16x8 nb8 = *(const MLS_LAS bf16x8*)(shm + NV + (32 * ks + 8 * lq) * 2);
            qc = MLS_MFMA(qa[ks], cb8, qc); qn = MLS_MFMA(qa[ks], nb8, qn); }
        MLS_BAR();
        {
            f32x4 sv = (f32x4){0.f, 0.f, 0.f, 0.f}, rs = sv;
#pragma unroll
            for (int ks = 0; ks < 2; ++ks) { const bf16x8 sa = *(const MLS_LAS bf16x8*)(shm + SD + ((16 * to + lr) * SSTR + 32 * ks + 8 * lq) * 2); const bf16x8 vb = *(const MLS_LAS bf16x8*)(shm + VT + ((16 * jo + lr) * SSTR + 32 * ks + 8 * lq) * 2);
                sv = MLS_MFMA(sa, vb, sv); rs = MLS_MFMA(sa, ones, rs); }
            const f32x4 iv = *(const MLS_LAS f32x4*)(shm + IV + (16 * to + 4 * lq) * 4), ev = *(const MLS_LAS f32x4*)(shm + EV + (16 * to + 4 * lq) * 4);
#pragma unroll
            for (int r = 0; r < 4; ++r) { const float num = sv[r] + iv[r] * qc[r], den = rs[r] + iv[r] * qn[r]; hhp[(long)(t0 + r) * 1024] = num / fmaxf(fabsf(den), ev[r]); }
        }
        {
            const float decay = ((MLS_LAS float*)(shm + DC))[0];
            Cst[0] = Cst[0] * decay; Cst[1] = Cst[1] * decay; nst = nst * decay;
#pragma unroll
            for (int ks = 0; ks < 2; ++ks) { const bf16x8 ka = *(const MLS_LAS bf16x8*)(shm + KT + ((16 * wid + lr) * SSTR + 32 * ks + 8 * lq) * 2);
                const bf16x8 v0 = *(const MLS_LAS bf16x8*)(shm + VW + ((lr) * SSTR + 32 * ks + 8 * lq) * 2), v1 = *(const MLS_LAS bf16x8*)(shm + VW + ((16 + lr) * SSTR + 32 * ks + 8 * lq) * 2);
                const bf16x8 wb8 = *(const MLS_LAS bf16x8*)(shm + WB + (32 * ks + 8 * lq) * 2);
                Cst[0] = MLS_MFMA(ka, v0, Cst[0]); Cst[1] = MLS_MFMA(ka, v1, Cst[1]); nst = MLS_MFMA(ka, wb8, nst); }
        }
        MLS_BAR();
#pragma unroll
        for (int jt = 0; jt < 2; ++jt) *(MLS_LAS u32x2*)(shm + CT + ((16 * jt + lr) * QSTR + 16 * wid + 4 * lq) * 2) = (u32x2){pk(Cst[jt][0], Cst[jt][1]), pk(Cst[jt][2], Cst[jt][3])};
        if (lr == 0) *(MLS_LAS u32x2*)(shm + NV + (16 * wid + 4 * lq) * 2) = (u32x2){pk(nst[0], nst[1]), pk(nst[2], nst[3])};
    }
    asm volatile("s_waitcnt vmcnt(0) lgkmcnt(0)\n\ts_barrier" ::: "memory");
}
__device__ __forceinline__ void scan_phase(const Params& A, lptr shm, int vcu, int G, int wid) {
    for (int u = vcu; u < 256; u += G) {
        int lane; asm volatile("v_mbcnt_lo_u32_b32 %0, -1, 0\n\tv_mbcnt_hi_u32_b32 %0, -1, %0" : "=v"(lane));
        const int bh = u >> 3; scan_unit(bh >> 2, bh & 3, u & 7, A, shm, wid, lane);
    }
}
__device__ __forceinline__ void headnorm_phase(const float* HH, const unsigned short* P, const float* hn, unsigned short* Gout, int vcu, int G, int wid, int lane) {
    const int gw = vcu * 8 + wid, NGW = G * 8;
    for (int m = gw; m < 8 * SEQ; m += NGW) {
        const f32x4* hp = (const f32x4*)(HH + (long)m * 1024 + lane * 16);
        f32x4 v[4]; float ss = 0.f;
#pragma unroll
        for (int i = 0; i < 4; ++i) { v[i] = hp[i]; ss += v[i][0] * v[i][0] + v[i][1] * v[i][1] + v[i][2] * v[i][2] + v[i][3] * v[i][3]; }
#pragma unroll
        for (int x = 1; x < 16; x <<= 1) ss += bperm(ss, lane ^ x);
        const float rs = 1.0f / sqrtf(ss * (1.f / 256.f) + 1e-6f);
        const u32x4* op = (const u32x4*)(P + (long)m * PITCH + 2048 + lane * 16); const u32x4 o0 = op[0], o1 = op[1];
        const f32x4* wp = (const f32x4*)(hn + lane * 16);
        float og[16];
#pragma unroll
        for (int i = 0; i < 4; ++i) { og[2 * i] = blo(o0[i]); og[2 * i + 1] = bhi(o0[i]); og[8 + 2 * i] = blo(o1[i]); og[8 + 2 * i + 1] = bhi(o1[i]); }
        float r[16];
#pragma unroll
        for (int i = 0; i < 4; ++i) { const f32x4 w = wp[i];
#pragma unroll
            for (int e = 0; e < 4; ++e) { const float sg = __builtin_amdgcn_rcpf(1.0f + __builtin_amdgcn_exp2f(-1.4426950408889634f * og[4 * i + e])); r[4 * i + e] = sg * v[i][e] * rs * w[e]; } }
        u32x4* gp = (u32x4*)(Gout + (long)m * 1024 + lane * 16);
        gp[0] = (u32x4){pk(r[0], r[1]), pk(r[2], r[3]), pk(r[4], r[5]), pk(r[6], r[7])}; gp[1] = (u32x4){pk(r[8], r[9]), pk(r[10], r[11]), pk(r[12], r[13]), pk(r[14], r[15])};
    }
}
}
#define MK_QSCALE (0.125f * 1.4426950408889634f)
#define MK_ATTENTION { const int tid = fresh_tid(F), lane = tid & 63, wave = __builtin_amdgcn_readfirstlane(tid >> 6); \
    const float lam_init = 0.8f - 0.6f * __expf(-0.3f * (float)(2 * pr + 1)); \
    const float* lq1 = KA_IN(12) + pr * 64; const float* lk1 = KA_IN(13) + pr * 64; const float* lq2 = KA_IN(14) + pr * 64; const float* lk2 = KA_IN(15) + pr * 64; \
    const float lam = __expf(wave_sum(lq1[lane] * lk1[lane], lane)) - __expf(wave_sum(lq2[lane] * lk2[lane], lane)) + lam_init; \
    att::Params AP{(const unsigned short*)(ws + F_P), (unsigned short*)(ws + F_O), (float*)(ws + F_OT), KA_IN(1), KA_IN(16) + pr * 128, lam, lam_init}; \
    att::attn_phase(AP, (att::lds_ptr)(F.lds + RING_OFF), F.vcu, F.G, wave, lane); }
#define MK_MLSTM_SCAN { const int tid = fresh_tid(F); const int wave = __builtin_amdgcn_readfirstlane(tid >> 6); \
    mls::Params MP{(const unsigned short*)(ws + F_P), LI, LF, KA_IN(4) + pr * 4096, KA_IN(5) + pr * 1024, (float*)(ws + F_HH), \
        KA_IN(25) + (size_t)pr * NE * 1024 * FF, KA_IN(26) + (size_t)pr * NE * 1024 * FF, KA_IN(27) + (size_t)pr * NE * FF * 1024, W0, W0 + (size_t)NE * 7168 * 1024, F.G == 256 ? F.vcu * NWAVES + wave : -1}; \
    mls::scan_phase(MP, (mls::lptr)(F.lds + RING_OFF), F.vcu, F.G, wave); }
#define MK_MLSTM_HEADNORM { const int tid = fresh_tid(F), lane = tid & 63, wave = __builtin_amdgcn_readfirstlane(tid >> 6); \
    mls::headnorm_phase((const float*)(ws + F_HH), (const unsigned short*)(ws + F_P), KA_IN(8) + pr * 1024, (unsigned short*)(ws + F_G), F.vcu, F.G, wave, lane); }
#ifndef MK_MLSTM_SCAN
#define MK_MLSTM_SCAN
#endif
#ifndef MK_MLSTM_HEADNORM
#define MK_MLSTM_HEADNORM
#endif
#ifndef MK_ATTENTION
#define MK_ATTENTION
#endif
#ifndef MK_QSCALE
#define MK_QSCALE 1.0f
#endif
namespace mk {
__device__ __forceinline__ void assign_phase(Frame& F, const int* top_e, const int* wg_cnt, int* tok_slot, int* blk_expert, int* n_used, const bf16* XN, bf16* XG) {
    LAS int* cnt = (LAS int*)(F.lds + RING_OFF);
    LAS int* base = cnt + 2048; LAS int* pst = base + 8; LAS int* tot = pst + 8; LAS int* ex = tot + 8; LAS int* sl = ex + 256;
    const int t = fresh_tid(F), lane = t & 63, w = __builtin_amdgcn_readfirstlane(t >> 6);
    for (int i = t; i < 2048; i += NTHR) cnt[i] = wg_cnt[i];
    if (t < 256) ex[t] = top_e[F.vcu * 256 + t];
    __syncthreads();
    if (t < 8) { int s = 0, b = 0; for (int v = 0; v < 256; ++v) { const int c = cnt[v * 8 + t]; b += (v < F.vcu) ? c : 0; s += c; } tot[t] = s; base[t] = b; }
    __syncthreads();
    if (t == 0) {
        int acc = 0;
        for (int e = 0; e < 8; ++e) { pst[e] = acc; acc += (tot[e] + 255) / 256 * 256; }
        if (F.vcu == 0) {
            *n_used = acc / 256;
            int e = 0;
            for (int b = 0; b < NBLK; ++b) { while (e < 7 && b * 256 >= pst[e] + (tot[e] + 255) / 256 * 256) ++e; blk_expert[b] = e; }
        }
    }
    __syncthreads();
    if (t < 256) { const int e = ex[t]; int r = 0; for (int i = 0; i < t; ++i) r += (ex[i] == e) ? 1 : 0; const int slot = pst[e] + base[e] + r; sl[t] = slot; tok_slot[F.vcu * 256 + t] = slot; }
    __syncthreads();
    for (int a = w; a < 256; a += NWAVES) {
        const int slot = sl[a], tok = (F.vcu * 256 + a) >> 1;
        const GAS v4u* src = (const GAS v4u*)(XN + (size_t)tok * D) + lane; GAS v4u* dst = (GAS v4u*)(XG + (size_t)slot * D) + lane;
        const v4u v0 = src[0], v1 = src[64]; dst[0] = v0; dst[64] = v1;
    }
    __syncthreads();
}

struct Args { const float* in[29]; float* out; unsigned char* ws; int ph_lo, ph_hi, li, flags; };
constexpr int PH_FINAL = 32, PH_COMBINE = 33;
constexpr float ATT_C2 = 0.125f * 1.4426950408889634f;

typedef const __attribute__((address_space(4))) unsigned char* kaptr_t;
__device__ __forceinline__ kaptr_t ka_fresh() { kaptr_t p = (kaptr_t)__builtin_amdgcn_kernarg_segment_ptr(); asm volatile("" : "+s"(p)); return p; }
#define KA_IN(k) (*(const float* const __attribute__((address_space(4)))*)(ka + 8 * (k)))
#define KA_OUT (*(float* const __attribute__((address_space(4)))*)(ka + 232))
#define KA_WS (*(unsigned char* const __attribute__((address_space(4)))*)(ka + 240))
#define KA_INT(off) (*(const int __attribute__((address_space(4)))*)(ka + (off)))
static_assert(sizeof(Args) == 264, "Args layout (kernarg offsets above)");
#define PHASE_PTRS kaptr_t ka = ka_fresh(); unsigned char* const ws = KA_WS; float* const xo = KA_OUT; bf16* const XN = (bf16*)(ws + F_XN); bf16* const W0 = (bf16*)(ws + F_W); bf16* const WS0 = (bf16*)(ws + F_WS); (void)WS0; \
    int* const top_e = (int*)(ws + F_TOPE); float* const top_g = (float*)(ws + F_TOPG); int* const slot_tok = (int*)(ws + F_SLOTTOK); int* const tok_slot = (int*)(ws + F_TOKSLOT); \
    int* const blk_e = (int*)(ws + F_BLKE); int* const n_used = (int*)(ws + F_NUSED); float* const LI = (float*)(ws + F_LI); float* const LF = (float*)(ws + F_LF); bf16* const Ybuf = (bf16*)(ws + F_Y); \
    (void)xo; (void)XN; (void)W0; (void)top_e; (void)top_g; (void)slot_tok; (void)tok_slot; (void)blk_e; (void)n_used; (void)LI; (void)LF; (void)Ybuf; (void)ws
__global__ void __launch_bounds__(NTHR, 2) mk_fwd(Args) {
    extern __shared__ __attribute__((aligned(16))) unsigned char lds[];
    Frame F;
    F.lds = (LAS unsigned char*)lds;
    volatile LAS unsigned* MISC = (volatile LAS unsigned*)(F.lds + MISC_OFF);
    F.wave = __builtin_amdgcn_readfirstlane((int)threadIdx.x >> 6);
    F.G = gridDim.x; { const int bx = blockIdx.x; F.vcu = (F.G % 8 == 0) ? (bx % 8) * (F.G / 8) + bx / 8 : bx; }
    for (int u = threadIdx.x; u < (LDS_BYTES - LDSCTL_OFF) / 4; u += NTHR) ((LAS unsigned*)(F.lds + LDSCTL_OFF))[u] = 0u;
    __syncthreads();
    int lo, hi, flags; XcdBarrier bar;
    { kaptr_t ka = ka_fresh(); lo = KA_INT(248); hi = KA_INT(252); flags = KA_INT(260); const int li = KA_INT(256);
      bar = xcd_barrier_post((unsigned*)((gu32*)(KA_WS + F_CTL) + CW_BAR) + li * XCD_BAR_WORDS, MISC + 8, threadIdx.x == 0); }
#define IN(k) (lo <= (k) && (k) < hi)
#if defined(PROBE_PHASE)
#define REPS(n) ((n) == PROBE_PHASE ? 1 + PROBE_REPS : 1)
#else
#define REPS(n) 1
#endif
#define SEAM(k) do { if (IN(k) && IN((k) + 1)) xcd_barrier(bar, F.wave == 0 && lane_id() == 0); } while (0)

    for (int pr = 0; pr < 2; ++pr) {
        const int pb = pr * 16;
        if (IN(pb + 0)) _Pragma("unroll") for (int rep_ = 0; rep_ < REPS(0); ++rep_) { PHASE_PTRS;
            cvt_job(F, KA_IN(3) + (size_t)pr * 1024 * 3080, 3080, 1024, 3072, 1, 0, WS0, 0, 0, 0);
            cvt_job(F, KA_IN(9) + (size_t)pr * 1024 * 1024, 1024, 1024, 1024, 1, 0, WS0 + 3072 * 1024, 0, 0, 1536);
            RowJob J{}; const bool first = (pr == 0) && !(flags & 1);
            const bool comb = (pr == 1) && !(flags & 2);
            J.xsrc = first ? KA_IN(0) : xo; J.xdst = (first || comb) ? xo : nullptr; J.nw = KA_IN(2) + pr * 1024; J.XN = XN;
            if (comb) { J.Y = Ybuf; J.tok_slot = tok_slot; J.top_g = top_g; }
            J.slab = KA_IN(3) + (size_t)pr * 1024 * 3080 + 3072; J.slab_ld = 3080; J.kind = 1; J.b0 = KA_IN(6) + pr * 4; J.b1 = KA_IN(7) + pr * 4; J.LI = LI; J.LF = LF;
            row_phase(F, J);
        }
        SEAM(pb + 0);
        if (IN(pb + 1)) _Pragma("unroll") for (int rep_ = 0; rep_ < REPS(1); ++rep_) { PHASE_PTRS;
            pg8::Gemm g{XN, WS0, M, 3072, 1024, nullptr}; pg8::StaticOrder S; S.init(M, 3072, F.G, (int)blockIdx.x);
            pg8::EpiBf16 E{(bf16*)(ws + F_P), 3072, 1.f, 0};
            pg8::gemm_phase<pg8::EpiBf16, pg8::StaticOrder, true, false>(F.lds + RING_OFF, g, S, E, F.wave);
        }
        SEAM(pb + 1);
        if (IN(pb + 2)) _Pragma("unroll") for (int rep_ = 0; rep_ < REPS(2); ++rep_) { PHASE_PTRS; MK_MLSTM_SCAN }
        SEAM(pb + 2);
        if (IN(pb + 3)) _Pragma("unroll") for (int rep_ = 0; rep_ < REPS(3); ++rep_) { PHASE_PTRS; MK_MLSTM_HEADNORM }
        SEAM(pb + 3);
        if (IN(pb + 4)) _Pragma("unroll") for (int rep_ = 0; rep_ < REPS(4); ++rep_) { PHASE_PTRS;
            pg8::Gemm g{(const bf16*)(ws + F_G), WS0 + 3072 * 1024, M, 1024, 1024, nullptr}; pg8::StaticOrder S; S.init(M, 1024, F.G, (int)blockIdx.x);
            pg8::EpiResid E{xo, 1024};
            pg8::gemm_phase<pg8::EpiResid, pg8::StaticOrder, true, false>(F.lds + RING_OFF, g, S, E, F.wave);
        }
        SEAM(pb + 4);
        if (IN(pb + 5)) _Pragma("unroll") for (int rep_ = 0; rep_ < REPS(5); ++rep_) { PHASE_PTRS;
            cvt_job(F, KA_IN(19) + (size_t)pr * 1024 * FF, FF, 1024, FF, 1, 0, WS0, 0, 1, 0);
            cvt_job(F, KA_IN(20) + (size_t)pr * 1024 * FF, FF, 1024, FF, 1, 0, WS0, 0, 2, 1792);
            cvt_job(F, KA_IN(21) + (size_t)pr * FF * 1024, 1024, FF, 1024, 1, 0, WS0 + 7168 * 1024, 0, 0, 1536);
            RowJob J{}; J.xsrc = xo; J.nw = KA_IN(18) + pr * 1024; J.XN = XN;
            row_phase(F, J);
        }
        SEAM(pb + 5);
        if (IN(pb + 6)) _Pragma("unroll") for (int rep_ = 0; rep_ < REPS(6); ++rep_) { PHASE_PTRS;
            pg8::Gemm g{XN, WS0, M, 2 * FF, 1024, nullptr}; pg8::StaticOrder S; S.init(M, 2 * FF, F.G, (int)blockIdx.x);
            pg8::EpiSwiGLU E{(bf16*)(ws + F_H), FF};
            pg8::gemm_phase<pg8::EpiSwiGLU, pg8::StaticOrder, true, false>(F.lds + RING_OFF, g, S, E, F.wave);
        }
        SEAM(pb + 6);
        if (IN(pb + 7)) _Pragma("unroll") for (int rep_ = 0; rep_ < REPS(7); ++rep_) { PHASE_PTRS;
            pg8::Gemm g{(const bf16*)(ws + F_H), WS0 + 7168 * 1024, M, 1024, FF, nullptr}; pg8::StaticOrder S; S.init(M, 1024, F.G, (int)blockIdx.x);
            pg8::EpiResid E{xo, 1024};
            pg8::gemm_phase<pg8::EpiResid, pg8::StaticOrder, true, false>(F.lds + RING_OFF, g, S, E, F.wave);
        }
        SEAM(pb + 7);
        if (IN(pb + 8)) _Pragma("unroll") for (int rep_ = 0; rep_ < REPS(8); ++rep_) { PHASE_PTRS;
            cvt_job(F, KA_IN(11) + (size_t)pr * 1024 * 3072, 3072, 1024, 3072, 1, 0, WS0, 0, 0, 0);
            cvt_job(F, KA_IN(17) + (size_t)pr * 1024 * 1024, 1024, 1024, 1024, 1, 0, WS0 + 3072 * 1024, 0, 0, 1536);
            RowJob J{}; J.xsrc = xo; J.nw = KA_IN(10) + pr * 1024; J.XN = XN;
            row_phase(F, J);
        }
        SEAM(pb + 8);
        if (IN(pb + 9)) _Pragma("unroll") for (int rep_ = 0; rep_ < REPS(9); ++rep_) { PHASE_PTRS;
            pg8::Gemm g{XN, WS0, M, 3072, 1024, nullptr}; pg8::StaticOrder S; S.init(M, 3072, F.G, (int)blockIdx.x);
            pg8::EpiBf16 E{(bf16*)(ws + F_P), 3072, MK_QSCALE, 4};
            pg8::gemm_phase<pg8::EpiBf16, pg8::StaticOrder, true, false>(F.lds + RING_OFF, g, S, E, F.wave);
        }
        SEAM(pb + 9);
        if (IN(pb + 10)) _Pragma("unroll") for (int rep_ = 0; rep_ < REPS(10); ++rep_) { PHASE_PTRS; MK_ATTENTION }
        SEAM(pb + 10);
        if (IN(pb + 11)) _Pragma("unroll") for (int rep_ = 0; rep_ < REPS(11); ++rep_) { PHASE_PTRS;
            pg8::Gemm g{(const bf16*)(ws + F_O), WS0 + 3072 * 1024, M, 1024, 1024, nullptr}; pg8::StaticOrder S; S.init(M, 1024, F.G, (int)blockIdx.x);
            pg8::EpiResid E{xo, 1024};
            pg8::gemm_phase<pg8::EpiResid, pg8::StaticOrder, true, false>(F.lds + RING_OFF, g, S, E, F.wave);
        }
        SEAM(pb + 11);
        if (IN(pb + 12)) _Pragma("unroll") for (int rep_ = 0; rep_ < REPS(12); ++rep_) { PHASE_PTRS;
            if (F.G != 256) {
            cvt_job(F, KA_IN(25) + (size_t)pr * NE * 1024 * FF, FF, 1024, FF, NE, (size_t)1024 * FF, W0, (size_t)7168 * 1024, 1, 0);
            cvt_job(F, KA_IN(26) + (size_t)pr * NE * 1024 * FF, FF, 1024, FF, NE, (size_t)1024 * FF, W0, (size_t)7168 * 1024, 2, 0);
            cvt_job(F, KA_IN(27) + (size_t)pr * NE * FF * 1024, 1024, FF, 1024, NE, (size_t)FF * 1024, W0 + (size_t)NE * 7168 * 1024, (size_t)1024 * FF, 0, 0); }
            RowJob J{}; J.xsrc = xo; J.nw = KA_IN(22) + pr * 1024; J.XN = XN;
            J.slab = KA_IN(23) + (size_t)pr * 8192; J.slab_ld = 8; J.kind = 2; J.b0 = KA_IN(24) + pr * 8; J.top_e = top_e; J.top_g_out = top_g; J.wg_cnt = slot_tok;
            row_phase(F, J);
        }
        SEAM(pb + 12);
        if (IN(pb + 13)) _Pragma("unroll") for (int rep_ = 0; rep_ < REPS(13); ++rep_) { PHASE_PTRS; assign_phase(F, top_e, slot_tok, tok_slot, blk_e, n_used, XN, Ybuf); }
        SEAM(pb + 13);
        if (IN(pb + 14)) _Pragma("unroll") for (int rep_ = 0; rep_ < REPS(14); ++rep_) { PHASE_PTRS;
            const int nb = *(volatile int*)n_used;
            pg8::Gemm g{Ybuf, W0, nb * 256, 2 * FF, 1024, nullptr}; pg8::GroupOrder S; S.init(nb, 2 * FF / 256, F.G, (int)blockIdx.x, blk_e, (long)7168 * 1024);
            pg8::EpiSwiGLU E{(bf16*)(ws + F_H), FF};
            pg8::gemm_phase<pg8::EpiSwiGLU, pg8::GroupOrder, true, false>(F.lds + RING_OFF, g, S, E, F.wave);
        }
        SEAM(pb + 14);
        if (IN(pb + 15)) _Pragma("unroll") for (int rep_ = 0; rep_ < REPS(15); ++rep_) { PHASE_PTRS;
            const int nb = *(volatile int*)n_used;
            pg8::Gemm g{(const bf16*)(ws + F_H), W0 + (size_t)NE * 7168 * 1024, nb * 256, 1024, FF, nullptr}; pg8::GroupOrder S; S.init(nb, 4, F.G, (int)blockIdx.x, blk_e, (long)1024 * FF);
            pg8::EpiBf16 E{Ybuf, 1024, 1.f, 0};
            pg8::gemm_phase<pg8::EpiBf16, pg8::GroupOrder, true, false>(F.lds + RING_OFF, g, S, E, F.wave);
        }
        SEAM(pb + 15);
    }
    if (IN(PH_FINAL)) { PHASE_PTRS;
        RowJob J{}; J.xsrc = xo; J.nw = KA_IN(28); J.outf = xo; if (!(flags & 2)) { J.Y = Ybuf; J.tok_slot = tok_slot; J.top_g = top_g; }
        row_phase(F, J);
    }
    if (IN(PH_COMBINE)) { PHASE_PTRS;
        const int tid = fresh_tid(F), lane = tid & 63, gw = F.vcu * NWAVES + __builtin_amdgcn_readfirstlane(tid >> 6), NGW = F.G * NWAVES;
        for (int m = gw; m < M; m += NGW) {
            GAS f32x4* xr = (GAS f32x4*)(xo + (size_t)m * D) + lane;
            const int s0 = tok_slot[m * 2], s1 = tok_slot[m * 2 + 1]; const float g0 = top_g[m * 2], g1 = top_g[m * 2 + 1];
            const GAS v2u* y0 = (const GAS v2u*)(Ybuf + (size_t)s0 * D) + lane; const GAS v2u* y1 = (const GAS v2u*)(Ybuf + (size_t)s1 * D) + lane;
#pragma unroll
            for (int j = 0; j < 4; ++j) { f32x4 v = xr[64 * j]; const v2u a = y0[64 * j], b = y1[64 * j];
                v.x += g0 * bf_lo(a.x) + g1 * bf_lo(b.x); v.y += g0 * bf_hi(a.x) + g1 * bf_hi(b.x); v.z += g0 * bf_lo(a.y) + g1 * bf_lo(b.y); v.w += g0 * bf_hi(a.y) + g1 * bf_hi(b.y); xr[64 * j] = v; }
        }
    }
#undef IN
#undef SEAM
}
}
namespace nvh {
using namespace nv;
constexpr size_t MiB = 1u << 20;
constexpr size_t N_CTL = 0;
constexpr size_t N_XN = 4 * MiB;
constexpr size_t N_P = 132 * MiB;
constexpr size_t N_QK = 517 * MiB;
constexpr size_t N_HH = 645 * MiB;
constexpr size_t N_G = 773 * MiB;
constexpr size_t N_Y = 363 * MiB;
constexpr size_t C_TOPE = 64 * 1024, C_TOPG = C_TOPE + 65536 * 4, C_SLOTTOK = C_TOPG + 65536 * 4, C_SLOTG = C_SLOTTOK + (size_t)NSLOT * 4, C_TOKSLOT = C_SLOTG + (size_t)NSLOT * 4,
                 C_BLKE = C_TOKSLOT + 65536 * 4, C_NUSED = C_BLKE + 2048, C_LI = 2 * MiB, C_LF = C_LI + (size_t)M * 4 * 4;
static_assert(C_NUSED + 64 <= 2 * MiB && C_LF + (size_t)M * 16 <= 4 * MiB, "ctl map");

struct In { const float* p[29]; };

static inline void gemm(hipStream_t st, const float* A, int lda, const float* W, int ldw, float* C, int ldc, int Mr, int N, int K, int mode, const float* W2 = nullptr, const int* rowidx = nullptr,
                        const int* blk_expert = nullptr, const int* n_used = nullptr, long long wstride = 0, int blk0 = 0) {
    NG g{}; g.A = A; g.rowidx = rowidx; g.W = W; g.W2 = W2; g.C = C; g.blk_expert = blk_expert; g.n_used = n_used; g.wstride = wstride;
    g.lda = lda; g.ldw = ldw; g.ldc = ldc; g.M = Mr; g.N = N; g.K = K; g.mode = mode; g.blk0 = blk0;
    dim3 grid((N + 127) / 128, Mr / 128);
    if (W2) hipLaunchKernelGGL(k_gemm<1>, grid, dim3(256), 0, st, g); else hipLaunchKernelGGL(k_gemm<0>, grid, dim3(256), 0, st, g);
}
static inline void rmsnorm(hipStream_t st, const float* x, const float* w, float* out, float eps) { hipLaunchKernelGGL(k_rmsnorm, dim3(M / 4), dim3(256), 0, st, x, w, out, M, eps); }

static void naive_mlstm(hipStream_t st, const In& in, int s, float* x, unsigned char* ws) {
    float* XN = (float*)(ws + N_XN); float* P = (float*)(ws + N_P); float* QK = (float*)(ws + N_QK); float* HH = (float*)(ws + N_HH); float* G = (float*)(ws + N_G);
    float* LI = (float*)(ws + C_LI); float* LF = (float*)(ws + C_LF);
    rmsnorm(st, x, in.p[2] + s * 1024, XN, 1e-6f);
    gemm(st, XN, 1024, in.p[3] + (size_t)s * 1024 * MPROJ, MPROJ, P, MPROJ, M, MPROJ, 1024, 0);
    hipLaunchKernelGGL(k_mlstm_prep, dim3(M), dim3(256), 0, st, (const float*)P, in.p[4] + s * 4096, in.p[5] + s * 1024, in.p[6] + s * 4, in.p[7] + s * 4, QK, LI, LF);
    hipLaunchKernelGGL(k_mlstm_rec, dim3(256), dim3(256), 0, st, (const float*)QK, (const float*)P, (const float*)LI, (const float*)LF, HH);
    hipLaunchKernelGGL(k_mlstm_post, dim3(M), dim3(256), 0, st, (const float*)HH, (const float*)P, in.p[8] + s * 1024, G);
    gemm(st, G, 1024, in.p[9] + (size_t)s * 1024 * 1024, 1024, x, 1024, M, 1024, 1024, 1);
}
static void naive_ffn(hipStream_t st, const In& in, int s, float* x, unsigned char* ws) {
    float* XN = (float*)(ws + N_XN); float* H = (float*)(ws + N_P);
    rmsnorm(st, x, in.p[18] + s * 1024, XN, 1e-6f);
    gemm(st, XN, 1024, in.p[19] + (size_t)s * 1024 * FF, FF, H, FF, M, FF, 1024, 2, in.p[20] + (size_t)s * 1024 * FF);
    gemm(st, H, FF, in.p[21] + (size_t)s * FF * 1024, 1024, x, 1024, M, 1024, FF, 1);
}
static void naive_attn(hipStream_t st, const In& in, int s, int layer, float* x, unsigned char* ws) {
    float* XN = (float*)(ws + N_XN); float* P = (float*)(ws + N_P); float* O = (float*)(ws + N_HH);
    rmsnorm(st, x, in.p[10] + s * 1024, XN, 1e-6f);
    gemm(st, XN, 1024, in.p[11] + (size_t)s * 1024 * APROJ, APROJ, P, APROJ, M, APROJ, 1024, 0);
    const float lam_init = (float)(0.8 - 0.6 * exp(-0.3 * (double)layer));
    static bool attr = false; if (!attr) { (void)hipFuncSetAttribute((const void*)k_attn, hipFuncAttributeMaxDynamicSharedMemorySize, 65536); attr = true; }
    hipLaunchKernelGGL(k_attn, dim3(M * 8 / 2), dim3(128), 65536, st, (const float*)P, in.p[1], in.p[12] + s * 64, in.p[13] + s * 64, in.p[14] + s * 64, in.p[15] + s * 64, in.p[16] + s * 128, lam_init, O);
    gemm(st, O, 1024, in.p[17] + (size_t)s * 1024 * 1024, 1024, x, 1024, M, 1024, 1024, 1);
}
static void naive_moe(hipStream_t st, const In& in, int s, float* x, unsigned char* ws) {
    float* XN = (float*)(ws + N_XN); float* Hc = (float*)(ws + N_P); float* Y = (float*)(ws + N_Y);
    int* top_e = (int*)(ws + C_TOPE); float* top_g = (float*)(ws + C_TOPG); int* slot_tok = (int*)(ws + C_SLOTTOK); float* slot_g = (float*)(ws + C_SLOTG);
    int* tok_slot = (int*)(ws + C_TOKSLOT); int* blk_e = (int*)(ws + C_BLKE); int* n_used = (int*)(ws + C_NUSED);
    rmsnorm(st, x, in.p[22] + s * 1024, XN, 1e-6f);
    hipLaunchKernelGGL(k_router, dim3(M / 4), dim3(256), 0, st, (const float*)XN, in.p[23] + s * 8192, in.p[24] + s * 8, top_e, top_g);
    hipLaunchKernelGGL(k_assign, dim3(1), dim3(1024), 0, st, (const int*)top_e, (const float*)top_g, slot_tok, slot_g, tok_slot, blk_e, n_used);
    constexpr int CH = 66, CR = CH * 256;
    for (int c = 0; c < 4; ++c) {
        gemm(st, XN, 1024, in.p[25] + (size_t)s * NE * 1024 * FF, FF, Hc, FF, CR, FF, 1024, 2, in.p[26] + (size_t)s * NE * 1024 * FF, slot_tok + c * CR, blk_e, n_used, (long long)1024 * FF, c * CH);
        gemm(st, Hc, FF, in.p[27] + (size_t)s * NE * FF * 1024, 1024, Y + (size_t)c * CR * 1024, 1024, CR, 1024, FF, 0, nullptr, nullptr, blk_e, n_used, (long long)FF * 1024, c * CH);
    }
    hipLaunchKernelGGL(k_combine, dim3(M), dim3(256), 0, st, x, (const float*)Y, (const int*)tok_slot, (const float*)top_g);
}
}
extern "C" void kernel_launch(void* const* d_in, const int* in_sizes, int n_in, void* d_out, int out_size, void* d_ws, size_t ws_size, hipStream_t stream) {
    static int grid = 0;
    if (grid == 0) {
        int dev = 0, cus = 0, per_cu = 0;
        (void)hipGetDevice(&dev); (void)hipDeviceGetAttribute(&cus, hipDeviceAttributeMultiprocessorCount, dev);
        (void)hipFuncSetAttribute((const void*)mk::mk_fwd, hipFuncAttributeMaxDynamicSharedMemorySize, mk::LDS_BYTES);
        (void)hipOccupancyMaxActiveBlocksPerMultiprocessor(&per_cu, (const void*)mk::mk_fwd, mk::NTHR, mk::LDS_BYTES);
        (void)hipGetLastError();
        grid = cus > 0 ? cus : 256;
    }
    mk::Args a{}; for (int i = 0; i < 29; ++i) a.in[i] = (const float*)d_in[i];
    a.out = (float*)d_out; a.ws = (unsigned char*)d_ws; a.ph_lo = 0; a.ph_hi = mk::PH_FINAL + 1; a.li = 0; a.flags = 0;
    (void)hipMemsetAsync((unsigned char*)d_ws + mk::F_CTL, 0, mk::CTL_ZERO_BYTES, stream);
    hipLaunchKernelGGL(mk::mk_fwd, dim3(grid), dim3(mk::NTHR), mk::LDS_BYTES, stream, a);
}
```

```cpp
#include <hip/hip_runtime.h>
#include <cstdio>
#include <cstdint>
#include <cmath>
namespace nv {
__device__ const int BUCKET[128] = {0, 1, 2, 3, 4, 5, 6, 7, 8, 9, 10, 11, 12, 13, 14, 15, 16, 16, 16, 17, 17, 18, 18, 18, 19, 19, 19, 20, 20, 20, 20, 21, 21, 21, 21, 22, 22, 22, 22, 22, 23, 23, 23, 23, 23, 23, 24, 24, 24, 24, 24, 24, 25, 25, 25, 25, 25, 25, 25, 26, 26, 26, 26, 26, 26, 26, 26, 27, 27, 27, 27, 27, 27, 27, 27, 27, 27, 28, 28, 28, 28, 28, 28, 28, 28, 28, 28, 29, 29, 29, 29, 29, 29, 29, 29, 29, 29, 29, 29, 30, 30, 30, 30, 30, 30, 30, 30, 30, 30, 30, 30, 30, 30, 31, 31, 31, 31, 31, 31, 31, 31, 31, 31, 31, 31, 31, 31, 31};
}
namespace pg8 {
#define PG8_LAS __attribute__((address_space(3)))
typedef unsigned short bf16_t;
typedef short bf16x8 __attribute__((ext_vector_type(8)));
typedef float f32x4 __attribute__((ext_vector_type(4)));
typedef float f32x2 __attribute__((ext_vector_type(2)));
typedef unsigned u32x4 __attribute__((ext_vector_type(4)));
#ifndef PG8_WGM
#define PG8_WGM 8
#endif
#ifndef PG8_GROUP_XCD
#define PG8_GROUP_XCD 1
#endif
constexpr int BM = 256, BK = 64, HALF = 128, HTB = HALF * BK * 2  , STAGE_BYTES = 8 * HTB, NXCD = 8, WGM = PG8_WGM;

__host__ __device__ __forceinline__ int lds_byte(int r, int c) { const int st = (r >> 4) * 2 + (c >> 5), rr = r & 15, cc = c & 31, ob = rr * 64 + cc * 2; return st * 1024 + (ob ^ (((ob >> 9) & 1) << 5)); }
__host__ __device__ __forceinline__ void stage_rc(int b, int& R, int& C) { const int st = b / 1024, sb = b % 1024, swz = sb ^ (((sb >> 9) & 1) << 5); R = (st >> 1) * 16 + swz / 64; C = (st & 1) * 32 + (swz % 64) / 2; }
__host__ __device__ __forceinline__ int perm32(int rho) { const int n = rho >> 4, i = rho & 15; return 8 * (i >> 2) + 4 * n + (i & 3); }

struct Unit { int pm, pn; long boff; };
struct Gemm { const bf16_t* A; const bf16_t* Bt; int M, N, K; const int* arow; };

struct StaticOrder {
    int nM, nN, nwg, G, c;
    __host__ __device__ void init(int M, int N, int G_, int c_) { nM = M / BM; nN = N / BM; nwg = nM * nN; G = G_; c = c_; }
    __host__ __device__ bool next(int i, Unit& u) const {
        const long L = (long)i * G + c; if (L >= nwg) return false;
        int wgid = (int)L; { const int q = nwg / NXCD, r = nwg % NXCD, xcd = wgid % NXCD, off = wgid / NXCD; wgid = (xcd < r ? xcd * (q + 1) : r * (q + 1) + (xcd - r) * q) + off; }
        const int nig = WGM * nN, gid = wgid / nig, fm = gid * WGM, gsz = (nM - fm) < WGM ? (nM - fm) : WGM;
        u.pm = fm + ((wgid % nig) % gsz); u.pn = (wgid % nig) / gsz; u.boff = 0; return true;
    }
};
struct GroupOrder {
    int nM, nN, nwg, G, c; const int* blk_e; long wstride;
    __device__ void init(int nM_, int nN_, int G_, int c_, const int* be, long ws) { nM = nM_; nN = nN_; nwg = nM * nN; G = G_; c = c_; blk_e = be; wstride = ws; }
    __device__ bool next(int i, Unit& u) const {
        const long L = (long)i * G + c; if (L >= nwg) return false;
        int wgid = (int)L;
        if (PG8_GROUP_XCD) { const int q = nwg / NXCD, r = nwg % NXCD, xcd = wgid % NXCD, off = wgid / NXCD; wgid = (xcd < r ? xcd * (q + 1) : r * (q + 1) + (xcd - r) * q) + off; }
        const int nig = WGM * nN, gid = wgid / nig, fm = gid * WGM, gsz = (nM - fm) < WGM ? (nM - fm) : WGM;
        u.pm = fm + ((wgid % nig) % gsz); u.pn = (wgid % nig) / gsz; u.boff = (long)blk_e[u.pm] * wstride; return true;
    }
};

__device__ __forceinline__ unsigned cvt_pk_bf16(float lo, float hi) { unsigned r; asm volatile("v_cvt_pk_bf16_f32 %0, %1, %2" : "=v"(r) : "v"(lo), "v"(hi)); return r; }
__device__ __forceinline__ float silu_f(float v) { return v * __builtin_amdgcn_rcpf(1.0f + __builtin_amdgcn_exp2f(-1.4426950408889634f * v)); }

template <bool RSC> struct EpiBf16T {
    static constexpr bool PERM = true;
    bf16_t* O; int ldc; float scale0; int nscaled;
    __device__ __forceinline__ void operator()(const f32x4 (&acc)[2][2][4][2], const Unit& u, int wr, int wc, int fr, int fq, const PG8_LAS float* rs) const {
        const int row0 = u.pm * BM + wr * 64 + fr, col0 = u.pn * BM + wc * 32 + 8 * fq;
        const float sc0 = (u.pn < nscaled) ? scale0 : 1.f;
#pragma unroll
        for (int ai = 0; ai < 2; ++ai)
#pragma unroll
            for (int m = 0; m < 4; ++m) { bf16_t* rowp = O + (size_t)(row0 + ai * HALF + m * 16) * ldc + col0;
                const float sc = RSC ? sc0 * rs[ai * HALF + wr * 64 + m * 16 + fr] : sc0;
#pragma unroll
                for (int bj = 0; bj < 2; ++bj) { const f32x4 v0 = acc[ai][bj][m][0] * sc, v1 = acc[ai][bj][m][1] * sc;
                    u32x4 w; w.x = cvt_pk_bf16(v0[0], v0[1]); w.y = cvt_pk_bf16(v0[2], v0[3]); w.z = cvt_pk_bf16(v1[0], v1[1]); w.w = cvt_pk_bf16(v1[2], v1[3]);
                    *(u32x4*)(rowp + bj * HALF) = w; } }
    }
};
typedef EpiBf16T<false> EpiBf16;
template <bool RSC> struct EpiSwiGLUT {
    static constexpr bool PERM = true;
    bf16_t* O; int ldc;
    __device__ __forceinline__ void operator()(const f32x4 (&acc)[2][2][4][2], const Unit& u, int wr, int wc, int fr, int fq, const PG8_LAS float* rs) const {
        const int row0 = u.pm * BM + wr * 64 + fr, col0 = u.pn * HALF + wc * 32 + 8 * fq;
#pragma unroll
        for (int ai = 0; ai < 2; ++ai)
#pragma unroll
            for (int m = 0; m < 4; ++m) { bf16_t* rowp = O + (size_t)(row0 + ai * HALF + m * 16) * ldc + col0;
                const float rsc = RSC ? rs[ai * HALF + wr * 64 + m * 16 + fr] : 1.f;
                const f32x4 g0 = acc[ai][0][m][0] * rsc, g1 = acc[ai][0][m][1] * rsc, u0 = acc[ai][1][m][0] * rsc, u1 = acc[ai][1][m][1] * rsc;
                u32x4 w; w.x = cvt_pk_bf16(silu_f(g0[0]) * u0[0], silu_f(g0[1]) * u0[1]); w.y = cvt_pk_bf16(silu_f(g0[2]) * u0[2], silu_f(g0[3]) * u0[3]);
                w.z = cvt_pk_bf16(silu_f(g1[0]) * u1[0], silu_f(g1[1]) * u1[1]); w.w = cvt_pk_bf16(silu_f(g1[2]) * u1[2], silu_f(g1[3]) * u1[3]);
                *(u32x4*)rowp = w; }
    }
};
typedef EpiSwiGLUT<false> EpiSwiGLU;
template <bool XB> struct EpiResidT {
    static constexpr bool PERM = false;
    float* O; int ldc; bf16_t* xb; float* ssq; const float* base;
    __device__ __forceinline__ void operator()(const f32x4 (&acc)[2][2][4][2], const Unit& u, int wr, int wc, int fr, int fq, const PG8_LAS float*) const {
        const int row0 = u.pm * BM + wr * 64 + fr, col0 = u.pn * BM + wc * 32 + 4 * fq, lane = fr + 16 * fq;
#pragma unroll
        for (int ai = 0; ai < 2; ++ai) {
            f32x4 xv[4][2][2];
#pragma unroll
            for (int m = 0; m < 4; ++m) { const float* rowp = base + (size_t)(row0 + ai * HALF + m * 16) * ldc + col0;
#pragma unroll
                for (int bj = 0; bj < 2; ++bj)
#pragma unroll
                    for (int n = 0; n < 2; ++n) xv[m][bj][n] = *(const f32x4*)(rowp + bj * HALF + n * 16); }
#pragma unroll
            for (int m = 0; m < 4; ++m) { float* rowp = O + (size_t)(row0 + ai * HALF + m * 16) * ldc + col0;
#pragma unroll
                for (int bj = 0; bj < 2; ++bj)
#pragma unroll
                    for (int n = 0; n < 2; ++n) { xv[m][bj][n] = xv[m][bj][n] + acc[ai][bj][m][n]; *(f32x4*)(rowp + bj * HALF + n * 16) = xv[m][bj][n]; } }
            if (XB) {
#pragma unroll
                for (int m = 0; m < 4; ++m) { const size_t ro = (size_t)(row0 + ai * HALF + m * 16); float sq = 0.f;
#pragma unroll
                    for (int bj = 0; bj < 2; ++bj)
#pragma unroll
                        for (int n = 0; n < 2; ++n) { const f32x4 v = xv[m][bj][n]; sq += (v[0] * v[0] + v[1] * v[1]) + (v[2] * v[2] + v[3] * v[3]);
                            typedef unsigned u32x2 __attribute__((ext_vector_type(2))); *(u32x2*)(xb + ro * ldc + col0 + bj * HALF + n * 16) = (u32x2){cvt_pk_bf16(v[0], v[1]), cvt_pk_bf16(v[2], v[3])}; }
                    sq += __builtin_bit_cast(float, __builtin_amdgcn_ds_bpermute((lane ^ 16) << 2, __builtin_bit_cast(int, sq)));
                    sq += __builtin_bit_cast(float, __builtin_amdgcn_ds_bpermute((lane ^ 32) << 2, __builtin_bit_cast(int, sq)));
                    if (fq == 0) ssq[ro * 16 + u.pn * 4 + wc] = sq; }
            }
            asm volatile("" ::: "memory");
        }
    }
};
typedef EpiResidT<false> EpiResid;

template <class Epi, class Sched, bool ALIGN_EPI, bool GATHER, bool RS = false>
__device__ __forceinline__ void gemm_phase(PG8_LAS unsigned char* lds, const Gemm g, const Sched& S, const Epi& E, int wave_id, const float* ssq = nullptr, PG8_LAS float* rtab = nullptr) {
    int tid_; asm volatile("v_mbcnt_lo_u32_b32 %0, -1, 0\n\tv_mbcnt_hi_u32_b32 %0, -1, %0" : "=v"(tid_)); tid_ += wave_id * 64;
    const int tid = tid_, wid = __builtin_amdgcn_readfirstlane(tid >> 6), lane = tid & 63, wr = wid >> 2, wc = wid & 3, fr = lane & 15, fq = lane >> 4;
    const int K = g.K, nt = K / BK;
    unsigned voffA[2], voffB[2]; int rA[2], cA2[2];
#pragma unroll
    for (int i = 0; i < 2; ++i) { int R, C; stage_rc(tid * 16 + i * 8192, R, C); const int Rb = Epi::PERM ? ((R & ~31) + perm32(R & 31)) : R;
        voffA[i] = (unsigned)(R * K + C) * 2u; voffB[i] = (unsigned)(Rb * K + C) * 2u; rA[i] = R; cA2[i] = C * 2; }
    const size_t kstep = (size_t)(BK * 2);
    const size_t hstep = (size_t)HALF * K * 2;
    const size_t tstep = 2 * hstep;
    const unsigned ldsw = (unsigned)wid * 1024u;
    const int aoff = lds_byte(wr * 64 + fr, fq * 8), boff = lds_byte(wc * 32 + fr, fq * 8);
#define PG8_SA(b, h) (((b) * 2 + (h)) * HTB)
#define PG8_SB(b, h) ((4 + (b) * 2 + (h)) * HTB)
#define PG8_STAGE2(bufoff, gbase, v0, v1) do { \
        __builtin_amdgcn_global_load_lds((const unsigned*)((const char*)(gbase) + (v0)), (PG8_LAS unsigned*)(lds + (bufoff) + ldsw), 16, 0, 0); \
        __builtin_amdgcn_global_load_lds((const unsigned*)((const char*)(gbase) + (v1)), (PG8_LAS unsigned*)(lds + (bufoff) + ldsw + 8192), 16, 0, 0); } while (0)
#define PG8_STAGEB(bufoff, gbase) PG8_STAGE2(bufoff, gbase, voffB[0], voffB[1])
#define PG8_LDA(dst, b, h) do { _Pragma("unroll") for (int m = 0; m < 4; ++m) _Pragma("unroll") for (int k = 0; k < 2; ++k) dst[m][k] = *(const PG8_LAS bf16x8*)(lds + PG8_SA(b, h) + aoff + m * 2048 + k * 1024); } while (0)
#define PG8_LDB(dst, b, h) do { _Pragma("unroll") for (int n = 0; n < 2; ++n) _Pragma("unroll") for (int k = 0; k < 2; ++k) dst[n][k] = *(const PG8_LAS bf16x8*)(lds + PG8_SB(b, h) + boff + n * 2048 + k * 1024); } while (0)
#define PG8_MMA(ai, bj, At, Bt) do { __builtin_amdgcn_s_setprio(1); _Pragma("unroll") for (int m = 0; m < 4; ++m) _Pragma("unroll") for (int n = 0; n < 2; ++n) _Pragma("unroll") for (int k = 0; k < 2; ++k) \
        acc[ai][bj][m][n] = __builtin_amdgcn_mfma_f32_16x16x32_bf16(Bt[n][k], At[m][k], acc[ai][bj][m][n], 0, 0, 0); __builtin_amdgcn_s_setprio(0); } while (0)
#define PG8_WAIT_V(n) asm volatile("s_waitcnt vmcnt(" #n ")" ::: "memory")
#define PG8_WAIT_L(n) asm volatile("s_waitcnt lgkmcnt(" #n ")" ::: "memory")
#define PG8_BAR __builtin_amdgcn_s_barrier()
#define PG8_SCHED __builtin_amdgcn_sched_barrier(0)
    Unit cur, nxt; int ui = 0;
    if (!S.next(0, cur)) return;
    f32x4 acc[2][2][4][2];
#pragma unroll
    for (int a = 0; a < 2; ++a)
#pragma unroll
        for (int b = 0; b < 2; ++b)
#pragma unroll
            for (int m = 0; m < 4; ++m)
#pragma unroll
                for (int n = 0; n < 2; ++n) acc[a][b][m][n] = (f32x4){0.f, 0.f, 0.f, 0.f};
    bf16x8 At[4][2], B0[2][2], B1[2][2];
    unsigned c00, c01, c10, c11, n00, n01, n10, n11;
    const char* cA; const char* cB = (const char*)g.Bt + (size_t)cur.boff * 2 + (size_t)cur.pn * tstep;
    if constexpr (GATHER) {
        cA = (const char*)g.A;
        const int* ar = g.arow + cur.pm * BM;
        int t00 = ar[rA[0]], t01 = ar[rA[1]], t10 = ar[HALF + rA[0]], t11 = ar[HALF + rA[1]];
        t00 = t00 < 0 ? 0 : t00; t01 = t01 < 0 ? 0 : t01; t10 = t10 < 0 ? 0 : t10; t11 = t11 < 0 ? 0 : t11;
        c00 = (unsigned)t00 * (unsigned)(K * 2) + cA2[0]; c01 = (unsigned)t01 * (unsigned)(K * 2) + cA2[1]; c10 = (unsigned)t10 * (unsigned)(K * 2) + cA2[0]; c11 = (unsigned)t11 * (unsigned)(K * 2) + cA2[1];
    } else {
        cA = (const char*)g.A + (size_t)cur.pm * tstep;
        c00 = voffA[0]; c01 = voffA[1]; c10 = voffA[0]; c11 = voffA[1];
    }
    const size_t HS = GATHER ? (size_t)0 : hstep;
    n00 = c00; n01 = c01; n10 = c10; n11 = c11;
    f32x4 rsld[4];
    if constexpr (RS) { if (wr == 0) { const f32x4* sp = (const f32x4*)(ssq + ((size_t)cur.pm * BM + tid) * 16); const f32x4 a = sp[0], b = sp[1], c = sp[2], d = sp[3];
            const f32x4 t = (a + b) + (c + d); rtab[tid] = 1.0f / sqrtf(((t[0] + t[1]) + (t[2] + t[3])) * (1.0f / 1024.0f) + 1e-6f); } }
    PG8_STAGEB(PG8_SB(0, 0), cB); PG8_STAGEB(PG8_SB(0, 1), cB + hstep); PG8_STAGE2(PG8_SA(0, 0), cA, c00, c01); PG8_STAGE2(PG8_SA(0, 1), cA + HS, c10, c11);
    if (wr == 1) PG8_BAR;
    PG8_WAIT_V(2); PG8_BAR;
    PG8_STAGEB(PG8_SB(1, 0), cB + kstep); PG8_STAGE2(PG8_SA(1, 0), cA + kstep, c00, c01); PG8_STAGEB(PG8_SB(1, 1), cB + hstep + kstep);
    PG8_WAIT_V(6); PG8_BAR;
    for (;;) {
        const bool has_next = S.next(ui + 1, nxt);
        const char* nA; const char* nB = has_next ? (const char*)g.Bt + (size_t)nxt.boff * 2 + (size_t)nxt.pn * tstep : cB;
        if constexpr (GATHER) {
            nA = cA;
            if (has_next) {
                const int* ar = g.arow + nxt.pm * BM;
                int t00 = ar[rA[0]], t01 = ar[rA[1]], t10 = ar[HALF + rA[0]], t11 = ar[HALF + rA[1]];
                t00 = t00 < 0 ? 0 : t00; t01 = t01 < 0 ? 0 : t01; t10 = t10 < 0 ? 0 : t10; t11 = t11 < 0 ? 0 : t11;
                n00 = (unsigned)t00 * (unsigned)(K * 2) + cA2[0]; n01 = (unsigned)t01 * (unsigned)(K * 2) + cA2[1]; n10 = (unsigned)t10 * (unsigned)(K * 2) + cA2[0]; n11 = (unsigned)t11 * (unsigned)(K * 2) + cA2[1];
            } else { n00 = c00; n01 = c01; n10 = c10; n11 = c11; }
        } else {
            nA = has_next ? (const char*)g.A + (size_t)nxt.pm * tstep : cA;
        }
        if constexpr (RS) { if (has_next && wr == 0) { const f32x4* sp = (const f32x4*)(ssq + ((size_t)nxt.pm * BM + tid) * 16); rsld[0] = sp[0]; rsld[1] = sp[1]; rsld[2] = sp[2]; rsld[3] = sp[3]; } }
        for (int t = 0; t < nt; t += 2) {
            const bool last = (t == nt - 2);
            const char* a1 = cA + (size_t)(t + 1) * kstep;
            const char* a2 = last ? nA : cA + (size_t)(t + 2) * kstep; const char* b2 = last ? nB : cB + (size_t)(t + 2) * kstep;
            const char* a3 = a2 + kstep; const char* b3 = b2 + kstep;
            unsigned x00 = c00, x01 = c01, x10 = c10, x11 = c11;
            if constexpr (GATHER) { if (last) { x00 = n00; x01 = n01; x10 = n10; x11 = n11; } }
            PG8_LDB(B0, 0, 0); PG8_LDB(B1, 0, 1); PG8_SCHED; PG8_LDA(At, 0, 0); PG8_STAGE2(PG8_SA(1, 1), a1 + HS, c10, c11);
            PG8_WAIT_V(8); PG8_WAIT_L(0); PG8_BAR; PG8_MMA(0, 0, At, B0); PG8_MMA(0, 1, At, B1); PG8_BAR; PG8_SCHED;
            PG8_LDA(At, 0, 1); PG8_STAGEB(PG8_SB(0, 0), b2); PG8_STAGEB(PG8_SB(0, 1), b2 + hstep); PG8_STAGE2(PG8_SA(0, 0), a2, x00, x01);
            PG8_WAIT_V(8); PG8_WAIT_L(0); PG8_BAR; PG8_MMA(1, 0, At, B0); PG8_MMA(1, 1, At, B1); PG8_BAR; PG8_SCHED;
            PG8_LDB(B0, 1, 0); PG8_LDB(B1, 1, 1); PG8_SCHED; PG8_LDA(At, 1, 0); PG8_STAGE2(PG8_SA(0, 1), a2 + HS, x10, x11);
            PG8_WAIT_V(8); PG8_WAIT_L(0); PG8_BAR; PG8_MMA(0, 0, At, B0); PG8_MMA(0, 1, At, B1); PG8_BAR; PG8_SCHED;
            PG8_LDA(At, 1, 1); PG8_STAGEB(PG8_SB(1, 0), b3); PG8_STAGEB(PG8_SB(1, 1), b3 + hstep); PG8_STAGE2(PG8_SA(1, 0), a3, x00, x01);
            PG8_WAIT_V(8); PG8_WAIT_L(0); PG8_BAR; PG8_MMA(1, 0, At, B0); PG8_MMA(1, 1, At, B1); PG8_BAR; PG8_SCHED;
        }
        if constexpr (ALIGN_EPI) { if (wr == 0) PG8_BAR; }
        E(acc, cur, wr, wc, fr, fq, RS ? rtab + (ui & 1) * 256 : (PG8_LAS float*)nullptr);
        if (!has_next) break;
        if constexpr (RS) { if (wr == 0) { const f32x4 t = (rsld[0] + rsld[1]) + (rsld[2] + rsld[3]); rtab[((ui + 1) & 1) * 256 + tid] = 1.0f / sqrtf(((t[0] + t[1]) + (t[2] + t[3])) * (1.0f / 1024.0f) + 1e-6f); } }
#pragma unroll
        for (int a = 0; a < 2; ++a)
#pragma unroll
            for (int b = 0; b < 2; ++b)
#pragma unroll
                for (int m = 0; m < 4; ++m)
#pragma unroll
                    for (int n = 0; n < 2; ++n) acc[a][b][m][n] = (f32x4){0.f, 0.f, 0.f, 0.f};
        cur = nxt; cA = nA; cB = nB; ++ui;
        c00 = n00; c01 = n01; c10 = n10; c11 = n11;
        if constexpr (ALIGN_EPI) { if (wr == 1) PG8_BAR; }
    }
    PG8_WAIT_V(0);
    if constexpr (!ALIGN_EPI) { if (wr == 0) PG8_BAR; }
    PG8_BAR;
#undef PG8_SA
#undef PG8_SB
#undef PG8_STAGE2
#undef PG8_STAGEB
#undef PG8_LDA
#undef PG8_LDB
#undef PG8_MMA
#undef PG8_WAIT_V
#undef PG8_WAIT_L
#undef PG8_BAR
#undef PG8_SCHED
}
}
namespace mk {
constexpr int NWAVES = 8, NTHR = 512;
constexpr int B = 8, S = 4096, D = 1024, M = B * S;
constexpr int FF = 3584, NE = 8, NBLK = 264, NSLOT = NBLK * 256;
constexpr size_t MiB = 1u << 20;
constexpr size_t F_CTL = 0, CTL_ZERO_BYTES = 1 * MiB;
constexpr size_t F_TOPE = 1 * MiB, F_TOPG = F_TOPE + 256 * 1024, F_SLOTTOK = F_TOPG + 256 * 1024, F_TOKSLOT = F_SLOTTOK + 320 * 1024, F_BLKE = F_TOKSLOT + 256 * 1024, F_NUSED = F_BLKE + 2048;
constexpr size_t F_LI = 3 * MiB, F_LF = 3 * MiB + 512 * 1024;
constexpr size_t F_W = 4 * MiB, F_WS = 172 * MiB, F_XN = 212 * MiB, F_BIG = 276 * MiB;
constexpr size_t F_P = F_BIG, F_HH = 468 * MiB, F_G = 596 * MiB, F_QKC = 660 * MiB;
constexpr size_t F_H = F_BIG;
constexpr size_t F_O = 468 * MiB, F_OT = 532 * MiB;
constexpr size_t F_Y = 738 * MiB, F_SSQ = 870 * MiB, F_GB = 872 * MiB;
static_assert(F_NUSED + 64 <= 3 * MiB && F_H + (size_t)NSLOT * FF * 2 <= F_Y && F_Y + (size_t)NSLOT * 1024 * 2 <= 872 * MiB, "ws map");
constexpr int CW_TMO = 0, CW_BAR = 4096;
constexpr int MAX_LAUNCH = 40;
constexpr int RING_OFF = 0, RING_BYTES = 131072, LDSCTL_OFF = RING_BYTES, MISC_OFF = LDSCTL_OFF + 320, LDS_BYTES = 147456;

#define GAS __attribute__((address_space(1)))
#define LAS __attribute__((address_space(3)))
typedef unsigned short bf16;
typedef unsigned v4u __attribute__((ext_vector_type(4)));
typedef unsigned v2u __attribute__((ext_vector_type(2)));
typedef float f32x4 __attribute__((ext_vector_type(4)));
typedef GAS unsigned gu32;
#define RLX_AGENT __ATOMIC_RELAXED, __HIP_MEMORY_SCOPE_AGENT
#define LDS_WAIT() asm volatile("s_waitcnt lgkmcnt(0)" ::: "memory")
#define VM_WAIT() asm volatile("s_waitcnt vmcnt(0)" ::: "memory")
__device__ __forceinline__ unsigned f2bf(float f) { unsigned u = __builtin_bit_cast(unsigned, f); return (u + 0x7fffu + ((u >> 16) & 1u)) >> 16; }
__device__ __forceinline__ unsigned pk2(float lo, float hi) { return f2bf(lo) | (f2bf(hi) << 16); }
__device__ __forceinline__ float bf_lo(unsigned w) { return __builtin_bit_cast(float, w << 16); }
__device__ __forceinline__ float bf_hi(unsigned w) { return __builtin_bit_cast(float, w & 0xffff0000u); }

#define XB_TMO      128
#define XB_XCNT(j)  (256  + 64 * (j))
#define XB_XSUB(j)  (1280 + 64 * (j))
#define XB_XGEN(j)  (2304 + 64 * (j))
#define XB_TOP      3328
#define XB_TOPGEN   3392
#define XCD_BAR_WORDS 3456
#define XB_SPIN_CAP (1u << 18)
__device__ __forceinline__ unsigned xb_ld(unsigned* p)              { return __hip_atomic_load(p, __ATOMIC_RELAXED, __HIP_MEMORY_SCOPE_AGENT); }
__device__ __forceinline__ unsigned xb_add(unsigned* p, unsigned v) { return __hip_atomic_fetch_add(p, v, __ATOMIC_RELAXED, __HIP_MEMORY_SCOPE_AGENT); }
__device__ __forceinline__ unsigned xb_xcc_id() { return (unsigned)__builtin_amdgcn_s_getreg((3 << 11) | 20) & 0xFu; }
#define XB_SPIN(cond, bar) do { unsigned _sp = 0; while (cond) { __builtin_amdgcn_s_sleep(1); \
    if ((++_sp & 255u) == 0u) { if (xb_ld(&(bar)[XB_TMO])) break; if (_sp > XB_SPIN_CAP) { atomicAdd(&(bar)[XB_TMO], 1u); break; } } } } while (0)
struct XcdBarrier { unsigned* bar; unsigned x; volatile LAS unsigned* st; };
__device__ __forceinline__ XcdBarrier xcd_barrier_post(unsigned* bar, volatile LAS unsigned* st, bool t0) {
    XcdBarrier b; b.bar = bar; b.x = xb_xcc_id(); b.st = st;
    if (t0) (void)xb_add(&bar[XB_XCNT(b.x)], 1u);
    return b;
}
__device__ __forceinline__ void xcd_barrier_complete(unsigned* bar, unsigned x, unsigned& nloc, unsigned& nx) {
    const unsigned G = gridDim.x * gridDim.y * gridDim.z;
    unsigned sum, cnt, mine, sp = 0u;
    for (;;) {
        sum = 0u; cnt = 0u; mine = 0u;
#pragma unroll
        for (unsigned j = 0; j < 16; ++j) { const unsigned c = xb_ld(&bar[XB_XCNT(j)]); sum += c; cnt += (c > 0u) ? 1u : 0u; mine = (j == x) ? c : mine; }
        if (sum == G) break;
        __builtin_amdgcn_s_sleep(1);
        if ((++sp & 255u) == 0u) { if (xb_ld(&bar[XB_TMO])) break; if (sp > XB_SPIN_CAP) { atomicAdd(&bar[XB_TMO], 1u); break; } }
    }
    nloc = mine > 0u ? mine : 1u; nx = cnt > 0u ? cnt : 1u;
}
__device__ __forceinline__ void xcd_barrier(const XcdBarrier& b, bool t0) {
    asm volatile("s_waitcnt vmcnt(0)" ::: "memory");
    __syncthreads();
    if (t0) {
        unsigned* bar = b.bar;
        __builtin_amdgcn_s_waitcnt(0);
        unsigned nloc = b.st[0], nx = b.st[1];
        if (nloc == 0u) { xcd_barrier_complete(bar, b.x, nloc, nx); b.st[0] = nloc; b.st[1] = nx; }
        const unsigned old = xb_add(&bar[XB_XSUB(b.x)], 1u);
        const unsigned gen = old / nloc;
        if (old + 1u == (gen + 1u) * nloc) {
            __builtin_amdgcn_fence(__ATOMIC_RELEASE, "agent");
            asm volatile("s_waitcnt vmcnt(0)" ::: "memory");
            const unsigned og = xb_add(&bar[XB_TOP], 1u);
            const unsigned tg = og / nx;
            if (og + 1u == (tg + 1u) * nx) xb_add(&bar[XB_TOPGEN], 1u);
            else XB_SPIN(xb_ld(&bar[XB_TOPGEN]) == tg, bar);
            __builtin_amdgcn_fence(__ATOMIC_ACQUIRE, "agent");
            xb_add(&bar[XB_XGEN(b.x)], 1u);
            asm volatile("s_waitcnt vmcnt(0)" ::: "memory");
        } else {
            XB_SPIN(xb_ld(&bar[XB_XGEN(b.x)]) == gen, bar);
            __builtin_amdgcn_fence(__ATOMIC_ACQUIRE, "agent");
            asm volatile("s_waitcnt vmcnt(0)" ::: "memory");
        }
    }
    __syncthreads();
}

struct Frame {
    LAS unsigned char* lds;
    int vcu, G, wave;
};
__device__ __forceinline__ int lane_id() { int l; asm volatile("v_mbcnt_lo_u32_b32 %0, -1, 0\n\tv_mbcnt_hi_u32_b32 %0, -1, %0" : "=v"(l)); return l; }
__device__ __forceinline__ int fresh_tid(const Frame& F) { return F.wave * 64 + lane_id(); }
__device__ __forceinline__ float shfl_idx(float v, int src_lane) { return __builtin_bit_cast(float, __builtin_amdgcn_ds_bpermute(src_lane << 2, __builtin_bit_cast(int, v))); }
__device__ __forceinline__ int shfl_idx_i(int v, int src_lane) { return __builtin_amdgcn_ds_bpermute(src_lane << 2, v); }
__device__ __forceinline__ float wave_sum(float v, int lane) {
#pragma unroll
    for (int o = 1; o < 64; o <<= 1) v += shfl_idx(v, lane ^ o);
    return v;
}

__device__ __forceinline__ void cvt_item(const float* W, int ldw, int K, bf16* WT, int drow0, LAS float* scr, int k0, int n0, int lane) {
#pragma unroll 8
    for (int i = 0; i < 32; ++i) { const int kk = 2 * i + (lane >> 5); scr[kk * 33 + (lane & 31)] = W[(size_t)(k0 + kk) * ldw + n0 + (lane & 31)]; }
    LDS_WAIT(); asm volatile("" ::: "memory");
    const int c = lane & 7;
#pragma unroll
    for (int j = 0; j < 4; ++j) { const int n = (lane >> 3) + 8 * j; const LAS float* s = scr + (8 * c) * 33 + n;
        v4u o; o.x = pk2(s[0 * 33], s[1 * 33]); o.y = pk2(s[2 * 33], s[3 * 33]); o.z = pk2(s[4 * 33], s[5 * 33]); o.w = pk2(s[6 * 33], s[7 * 33]);
        *(GAS v4u*)(WT + (size_t)(drow0 + n) * K + k0 + 8 * c) = o; }
    LDS_WAIT(); asm volatile("" ::: "memory");
}
__device__ __forceinline__ void cvt_job(Frame& F, const float* W, int ldw, int K, int N, int nmat, size_t smat, bf16* WT, size_t dmat, int mode, int rot) {
    const int tid = fresh_tid(F), lane = tid & 63, wave = __builtin_amdgcn_readfirstlane(tid >> 6);
    LAS float* scr = (LAS float*)(F.lds + RING_OFF + wave * 8448);
    const int NGW = F.G * NWAVES; const int gw = (F.vcu * NWAVES + wave + rot) % NGW;
    const int nblk = N / 32, per = (K / 64) * nblk, total = per * nmat;
    for (int it = gw; it < total; it += NGW) {
        const int mat = it / per, r = it % per, kb = r / nblk, nb = r % nblk, n0 = 32 * nb;
        const int drow0 = mode == 0 ? n0 : ((n0 >> 7) * 256 + (n0 & 127) + (mode == 2 ? 128 : 0));
        cvt_item(W + (size_t)mat * smat, ldw, K, WT + (size_t)mat * dmat, drow0, scr, 64 * kb, n0, lane);
    }
}

constexpr int SLAB_OFF_ = 73728;
constexpr int SLAB_OFF = SLAB_OFF_;
struct RowJob {
    const float* xsrc; float* xdst;
    const float* nw;
    bf16* XN; float* outf;
    const bf16* Y; const int* tok_slot; const float* top_g;
    const float* slab; int slab_ld;
    int kind;
    const float* b0; const float* b1; float* LI; float* LF; int* top_e; float* top_g_out; int* wg_cnt;
};
constexpr int EREC_OFF = SLAB_OFF_ + 32768;

__device__ __forceinline__ void row_phase(Frame& F, const RowJob& J) {
    LAS float* slab = (LAS float*)(F.lds + SLAB_OFF);
    const int tid = fresh_tid(F), lane = tid & 63, wave = __builtin_amdgcn_readfirstlane(tid >> 6);
    if (J.slab) { for (int i = tid; i < 8192; i += NTHR) slab[i] = J.slab[(size_t)(i >> 3) * J.slab_ld + (i & 7)]; }
    __syncthreads();
    LAS int* erec = (LAS int*)(F.lds + EREC_OFF);
    const int rpw = M / (F.G * NWAVES), m0 = (F.vcu * NWAVES + wave) * rpw;
    f32x4 nx[4]; v2u nya[4], nyb[4]; float ng0 = 0.f, ng1 = 0.f;
    {
        const GAS f32x4* xr = (const GAS f32x4*)(J.xsrc + (size_t)m0 * D) + lane;
#pragma unroll
        for (int j = 0; j < 4; ++j) nx[j] = xr[64 * j];
        if (J.Y) { const int s0 = J.tok_slot[m0 * 2], s1 = J.tok_slot[m0 * 2 + 1]; ng0 = J.top_g[m0 * 2]; ng1 = J.top_g[m0 * 2 + 1];
            const GAS v2u* y0 = (const GAS v2u*)(J.Y + (size_t)s0 * D) + lane; const GAS v2u* y1 = (const GAS v2u*)(J.Y + (size_t)s1 * D) + lane;
#pragma unroll
            for (int j = 0; j < 4; ++j) { nya[j] = y0[64 * j]; nyb[j] = y1[64 * j]; } }
    }
    for (int m = m0; m < m0 + rpw; ++m) {
        f32x4 v[4]; v2u ya[4], yb[4]; const float g0 = ng0, g1 = ng1;
#pragma unroll
        for (int j = 0; j < 4; ++j) { v[j] = nx[j]; ya[j] = nya[j]; yb[j] = nyb[j]; }
        if (m + 1 < m0 + rpw) {
            const GAS f32x4* xr = (const GAS f32x4*)(J.xsrc + (size_t)(m + 1) * D) + lane;
#pragma unroll
            for (int j = 0; j < 4; ++j) nx[j] = xr[64 * j];
            if (J.Y) { const int s0 = J.tok_slot[(m + 1) * 2], s1 = J.tok_slot[(m + 1) * 2 + 1]; ng0 = J.top_g[(m + 1) * 2]; ng1 = J.top_g[(m + 1) * 2 + 1];
                const GAS v2u* y0 = (const GAS v2u*)(J.Y + (size_t)s0 * D) + lane; const GAS v2u* y1 = (const GAS v2u*)(J.Y + (size_t)s1 * D) + lane;
#pragma unroll
                for (int j = 0; j < 4; ++j) { nya[j] = y0[64 * j]; nyb[j] = y1[64 * j]; } }
        }
        if (J.Y) {
#pragma unroll
            for (int j = 0; j < 4; ++j) { const v2u a = ya[j], b = yb[j];
                v[j].x += g0 * bf_lo(a.x) + g1 * bf_lo(b.x); v[j].y += g0 * bf_hi(a.x) + g1 * bf_hi(b.x); v[j].z += g0 * bf_lo(a.y) + g1 * bf_lo(b.y); v[j].w += g0 * bf_hi(a.y) + g1 * bf_hi(b.y); }
        }
        if (J.xdst) { GAS f32x4* xo = (GAS f32x4*)(J.xdst + (size_t)m * D) + lane;
#pragma unroll
            for (int j = 0; j < 4; ++j) xo[64 * j] = v[j]; }
        float ss = 0.f;
#pragma unroll
        for (int j = 0; j < 4; ++j) ss += (v[j].x * v[j].x + v[j].y * v[j].y) + (v[j].z * v[j].z + v[j].w * v[j].w);
        const float rstd = 1.0f / sqrtf(wave_sum(ss, lane) * (1.f / D) + 1e-6f);
#pragma unroll
        for (int j = 0; j < 4; ++j) { const f32x4 w = ((const GAS f32x4*)J.nw)[lane + 64 * j]; v[j] = v[j] * rstd * w; }
        if (J.outf) { GAS f32x4* o = (GAS f32x4*)(J.outf + (size_t)m * D) + lane;
#pragma unroll
            for (int j = 0; j < 4; ++j) o[64 * j] = v[j]; }
        if (J.XN) { GAS v2u* o = (GAS v2u*)(J.XN + (size_t)m * D) + lane;
#pragma unroll
            for (int j = 0; j < 4; ++j) { v2u w; w.x = pk2(v[j].x, v[j].y); w.y = pk2(v[j].z, v[j].w); o[64 * j] = w; } }
        if (J.slab) {
            float acc[8];
#pragma unroll
            for (int e = 0; e < 8; ++e) acc[e] = 0.f;
#pragma unroll
            for (int j = 0; j < 4; ++j)
#pragma unroll
                for (int i = 0; i < 4; ++i) { const int k = (lane + 64 * j) * 4 + i; const float xv = v[j][i];
                    const f32x4 w0 = *(const LAS f32x4*)(slab + k * 8), w1 = *(const LAS f32x4*)(slab + k * 8 + 4);
                    acc[0] += xv * w0.x; acc[1] += xv * w0.y; acc[2] += xv * w0.z; acc[3] += xv * w0.w; acc[4] += xv * w1.x; acc[5] += xv * w1.y; acc[6] += xv * w1.z; acc[7] += xv * w1.w; }
#pragma unroll
            for (int e = 0; e < 8; ++e) acc[e] = wave_sum(acc[e], lane);
            if (J.kind == 1) {
                if (lane < 4) { float a = acc[0]; a = lane == 1 ? acc[1] : a; a = lane == 2 ? acc[2] : a; a = lane == 3 ? acc[3] : a; J.LI[m * 4 + lane] = a + J.b0[lane]; }
                else if (lane < 8) { const int h = lane - 4; float a = acc[4]; a = h == 1 ? acc[5] : a; a = h == 2 ? acc[6] : a; a = h == 3 ? acc[7] : a;
                    const float z = a + J.b1[h]; const float ez = __expf(-fabsf(z));
                    const float l1p = ez < 0.06f ? ez * (1.f + ez * (-0.5f + ez * (0.33333333f - 0.25f * ez))) : __logf(1.f + ez);
                    J.LF[m * 4 + h] = fminf(z, 0.f) - l1p; }
            } else if (J.kind == 2) {
                if (lane == 0) {
#pragma unroll
                    for (int e = 0; e < 8; ++e) acc[e] += J.b0[e];
                    int e0 = 0; float l0 = acc[0];
#pragma unroll
                    for (int e = 1; e < 8; ++e) if (acc[e] > l0) { l0 = acc[e]; e0 = e; }
                    int e1 = 0; float l1 = -INFINITY;
#pragma unroll
                    for (int e = 0; e < 8; ++e) if (e != e0 && acc[e] > l1) { l1 = acc[e]; e1 = e; }
                    const float ex = __expf(l1 - l0);
                    J.top_e[m * 2] = e0; J.top_e[m * 2 + 1] = e1; J.top_g_out[m * 2] = 1.f / (1.f + ex); J.top_g_out[m * 2 + 1] = ex / (1.f + ex);
                    const int ml = m - F.vcu * NWAVES * rpw; erec[ml * 2] = e0; erec[ml * 2 + 1] = e1;
                }
            }
        }
    }
    if (J.kind == 2) {
        __syncthreads();
        if (tid < 8) { int c = 0; const int na = 2 * NWAVES * rpw; for (int i = 0; i < na; ++i) c += (erec[i] == tid) ? 1 : 0; J.wg_cnt[F.vcu * 8 + tid] = c; }
    }
}
}
namespace att {
using bf16x8 = __attribute__((ext_vector_type(8))) short;
using s16x4 = __attribute__((ext_vector_type(4))) short;
using f32x16 = __attribute__((ext_vector_type(16))) float;
using u32x4 = __attribute__((ext_vector_type(4))) unsigned;
typedef __attribute__((address_space(3))) const char* lds_cptr;
typedef __attribute__((address_space(3))) char* lds_ptr;
typedef short v4i16_t __attribute__((ext_vector_type(4)));
constexpr int SEQ = 4096, PITCH = 3072, QB = 256, KVBLK = 64, NQB = SEQ / QB;
constexpr int NSLOT = 3, KSLOT = 8192, VSLOT = 16384;
constexpr int LDS_K = 0, LDS_V = NSLOT * KSLOT, LDS_WS = LDS_V + NSLOT * VSLOT, LDS_BT = LDS_WS + 8 * 256, LDS_END = LDS_BT + 512;
constexpr float LOG2E = 1.4426950408889634f;
#define ATT_MFMA(a, b, c) __builtin_amdgcn_mfma_f32_32x32x16_bf16(a, b, c, 0, 0, 0)
__device__ __forceinline__ int crow(int r, int hi) { return (r & 3) + 8 * (r >> 2) + 4 * hi; }
__device__ __forceinline__ void glds16(const void* gsrc, unsigned lds_dst) { unsigned keep;
    asm volatile("s_mov_b32 %0, m0\n\ts_mov_b32 m0, %2\n\ts_nop 0\n\tglobal_load_lds_dwordx4 %1, off\n\ts_mov_b32 m0, %0" : "=&s"(keep) : "v"(gsrc), "s"(lds_dst) : "memory"); }
typedef float f32x2_t __attribute__((ext_vector_type(2))); typedef __bf16 bf16x2_t __attribute__((ext_vector_type(2)));
__device__ __forceinline__ unsigned cvtpk(float lo, float hi) { f32x2_t v = {lo, hi}; bf16x2_t b = __builtin_convertvector(v, bf16x2_t); return __builtin_bit_cast(unsigned, b); }
__device__ __forceinline__ s16x4 vtr(lds_cptr p) { return __builtin_bit_cast(s16x4, __builtin_amdgcn_ds_read_tr16_b64_v4i16((__attribute__((address_space(3))) v4i16_t*)p)); }
#define ATT_MX3(a, b, c) __builtin_fmaxf(__builtin_fmaxf((a), (b)), (c))
__device__ __forceinline__ float rowmax(const f32x16& p0, const f32x16& p1) {
    float a = ATT_MX3(p0[0], p0[1], p1[0]), b = ATT_MX3(p0[2], p0[3], p1[1]); a = ATT_MX3(a, p1[2], p1[3]);
#pragma unroll
    for (int r = 4; r < 16; r += 4) { a = ATT_MX3(a, p0[r], p0[r + 1]); b = ATT_MX3(b, p0[r + 2], p0[r + 3]); a = ATT_MX3(a, p1[r], p1[r + 1]); b = ATT_MX3(b, p1[r + 2], p1[r + 3]); }
    const float m = __builtin_fmaxf(a, b); auto rr = __builtin_amdgcn_permlane32_swap(__float_as_uint(m), __float_as_uint(m), false, false);
    return __builtin_fmaxf(__uint_as_float(rr[0]), __uint_as_float(rr[1])); }
#define ATT_WAIT_BAR(N) asm volatile("s_waitcnt vmcnt(" #N ") lgkmcnt(0)\n\ts_barrier" ::: "memory")

struct Params {
    const unsigned short* QKV; unsigned short* O; float* OT;
    const float* rel; const float* subln; float lam, lam_init;
};

template <int PASS>
__device__ __forceinline__ void attn_pass(int b, int h, int qb, const Params& P, lds_ptr shm, int wid, int lane_in) {
    int lane; asm volatile("v_mbcnt_lo_u32_b32 %0, -1, 0\n\tv_mbcnt_hi_u32_b32 %0, -1, %0" : "=v"(lane));
    (void)lane_in;
    const int r32 = lane & 31, hi = lane >> 5, m = 2 * h + PASS;
    const long rowbase = (long)b * SEQ; const int q0 = qb * QB, NT = (q0 + QB) / KVBLK;
    const unsigned short* Qw = P.QKV + (rowbase + q0 + wid * 32) * PITCH + m * 64;
    const unsigned short* Kh = P.QKV + rowbase * PITCH + 1024 + m * 64; const unsigned short* Vh = P.QKV + rowbase * PITCH + 2048 + h * 128;
    const unsigned lds0 = (unsigned)(uintptr_t)shm;
    __attribute__((address_space(3))) float* wsf = (__attribute__((address_space(3))) float*)(shm + LDS_WS) + wid * 64;
    __attribute__((address_space(3))) float* BT = (__attribute__((address_space(3))) float*)(shm + LDS_BT);
    if (wid < 2) { const int rel = wid * 64 + lane; BT[rel] = P.rel[nv::BUCKET[rel] * 16 + m] * LOG2E; }
    const float c31 = P.rel[31 * 16 + m] * LOG2E;
    const unsigned short* ksrc = Kh + (long)lane * PITCH + wid * 8;
    const unsigned short* vsrc = Vh + (long)(16 * (wid & 3) + (lane >> 2)) * PITCH + (wid >> 2) * 32 + (lane & 3) * 8;
    const unsigned kdst = lds0 + LDS_K + wid * 1024, vdst = lds0 + LDS_V + wid * 1024;
#define ATT_DMA(t, s) do { glds16(ksrc + (long)(t) * KVBLK * PITCH, (unsigned)__builtin_amdgcn_readfirstlane(kdst + (s) * KSLOT)); \
        glds16(vsrc + (long)(t) * KVBLK * PITCH, (unsigned)__builtin_amdgcn_readfirstlane(vdst + (s) * VSLOT)); \
        glds16(vsrc + (long)(t) * KVBLK * PITCH + 64, (unsigned)__builtin_amdgcn_readfirstlane(vdst + (s) * VSLOT + 8192)); } while (0)
    ATT_DMA(0, 0); ATT_DMA(1, 1);
    bf16x8 qr[4];
#pragma unroll
    for (int d0 = 0; d0 < 4; ++d0) qr[d0] = *reinterpret_cast<const bf16x8*>(&Qw[(long)r32 * PITCH + d0 * 16 + hi * 8]);
    float c31p = c31;
    asm volatile("" : "+v"(qr[0]), "+v"(qr[1]), "+v"(qr[2]), "+v"(qr[3]), "+v"(c31p));
    float mhat = 0.f, l_reg = 0.f; f32x16 o[4];
#pragma unroll
    for (int d = 0; d < 4; ++d) o[d] = f32x16{};
    f32x16 negm;
#pragma unroll
    for (int r = 0; r < 16; ++r) negm[r] = c31p;
    const int qabs = q0 + wid * 32 + r32;
    const lds_cptr kp0 = (lds_cptr)shm + LDS_K + hi * 1024 + r32 * 16;
    const lds_cptr vp0 = (lds_cptr)shm + LDS_V + ((lane >> 4) & 1) * 32 + (lane & 3) * 8 + (4 * hi + ((lane & 15) >> 2)) * 64;
    int slot = 0;
#pragma unroll 1
    for (int t = 0; t < NT; ++t) {
        if (t + 1 < NT) { ATT_WAIT_BAR(3); } else { ATT_WAIT_BAR(0); }
        if (t + 2 < NT) { const int s2 = slot == 0 ? 2 : slot - 1; ATT_DMA(t + 2, s2); }
        const lds_cptr kp = kp0 + slot * KSLOT; const lds_cptr vp = vp0 + slot * VSLOT;
        f32x16 p0, p1;
        if (t + 6 < NT) { p0 = negm; p1 = negm; }
        else {
            const int kb = t * KVBLK + 4 * hi;
#pragma unroll
            for (int r = 0; r < 16; ++r) { const int k0 = kb + (r & 3) + 8 * (r >> 2); int rel0 = qabs - k0, rel1 = rel0 - 32;
                const float b0 = BT[rel0 < 0 ? 0 : (rel0 > 127 ? 127 : rel0)], b1 = BT[rel1 < 0 ? 0 : (rel1 > 127 ? 127 : rel1)];
                p0[r] = rel0 < 0 ? -INFINITY : b0 - mhat; p1[r] = rel1 < 0 ? -INFINITY : b1 - mhat; }
        }
        {
            bf16x8 kf[8];
#pragma unroll
            for (int d0 = 0; d0 < 4; ++d0) { kf[2 * d0] = *(const __attribute__((address_space(3))) bf16x8*)(kp + d0 * 2048); kf[2 * d0 + 1] = *(const __attribute__((address_space(3))) bf16x8*)(kp + d0 * 2048 + 512); }
#pragma unroll
            for (int d0 = 0; d0 < 4; ++d0) { p0 = ATT_MFMA(kf[2 * d0], qr[d0], p0); p1 = ATT_MFMA(kf[2 * d0 + 1], qr[d0], p1); }
        }
        s16x4 loA[4], hhA[4], loB[4], hhB[4];
#pragma unroll
        for (int ks = 0; ks < 4; ++ks) { loA[ks] = vtr(vp + ks * 1024); hhA[ks] = vtr(vp + ks * 1024 + 512); }
        __builtin_amdgcn_sched_barrier(0);
        const float rm = rowmax(p0, p1);
        bool resc = false;
        if (t == 0 || __any(rm > 8.0f)) {
            const float dl = t == 0 ? rm : __builtin_fmaxf(rm, 0.f);
            mhat += dl;
#pragma unroll
            for (int r = 0; r < 16; ++r) { p0[r] -= dl; p1[r] -= dl; }
#pragma unroll
            for (int r = 0; r < 16; ++r) negm[r] = c31p - mhat;
            const float f = __builtin_amdgcn_exp2f(-dl); l_reg *= f; if (hi == 0) wsf[r32] = f; resc = (t != 0);
        }
        float sacc = 0.f;
#pragma unroll
        for (int r = 0; r < 16; ++r) { p0[r] = __builtin_amdgcn_exp2f(p0[r]); p1[r] = __builtin_amdgcn_exp2f(p1[r]); sacc += p0[r] + p1[r]; }
        l_reg += sacc;
        u32x4 pw0 = (u32x4){cvtpk(p0[0], p0[1]), cvtpk(p0[2], p0[3]), cvtpk(p0[4], p0[5]), cvtpk(p0[6], p0[7])};
        u32x4 pw1 = (u32x4){cvtpk(p0[8], p0[9]), cvtpk(p0[10], p0[11]), cvtpk(p0[12], p0[13]), cvtpk(p0[14], p0[15])};
        u32x4 pw2 = (u32x4){cvtpk(p1[0], p1[1]), cvtpk(p1[2], p1[3]), cvtpk(p1[4], p1[5]), cvtpk(p1[6], p1[7])};
        u32x4 pw3 = (u32x4){cvtpk(p1[8], p1[9]), cvtpk(p1[10], p1[11]), cvtpk(p1[12], p1[13]), cvtpk(p1[14], p1[15])};
        __builtin_amdgcn_sched_barrier(0);
        if (resc) {
#pragma unroll
            for (int r = 0; r < 16; ++r) { const float f = wsf[crow(r, hi)];
#pragma unroll
                for (int d = 0; d < 4; ++d) o[d][r] *= f; }
        }
#define ATT_PKX(L, H, k) (bf16x8){L[k][0], L[k][1], L[k][2], L[k][3], H[k][0], H[k][1], H[k][2], H[k][3]}
#define ATT_RD(L, H, d) do { _Pragma("unroll") for (int ks = 0; ks < 4; ++ks) { L[ks] = vtr(vp + (d) * 4096 + ks * 1024); H[ks] = vtr(vp + (d) * 4096 + ks * 1024 + 512); } } while (0)
#define ATT_MM(L, H, d) do { o[d] = ATT_MFMA(__builtin_bit_cast(bf16x8, pw0), ATT_PKX(L, H, 0), o[d]); o[d] = ATT_MFMA(__builtin_bit_cast(bf16x8, pw1), ATT_PKX(L, H, 1), o[d]); \
        o[d] = ATT_MFMA(__builtin_bit_cast(bf16x8, pw2), ATT_PKX(L, H, 2), o[d]); o[d] = ATT_MFMA(__builtin_bit_cast(bf16x8, pw3), ATT_PKX(L, H, 3), o[d]); } while (0)
        ATT_RD(loB, hhB, 1); __builtin_amdgcn_sched_barrier(0); ATT_MM(loA, hhA, 0); __builtin_amdgcn_sched_barrier(0);
        ATT_RD(loA, hhA, 2); __builtin_amdgcn_sched_barrier(0); ATT_MM(loB, hhB, 1); __builtin_amdgcn_sched_barrier(0);
        ATT_RD(loB, hhB, 3); __builtin_amdgcn_sched_barrier(0); ATT_MM(loA, hhA, 2); __builtin_amdgcn_sched_barrier(0);
        ATT_MM(loB, hhB, 3); __builtin_amdgcn_sched_barrier(0);
#undef ATT_PKX
#undef ATT_RD
#undef ATT_MM
        slot = slot == 2 ? 0 : slot + 1;
    }
#undef ATT_DMA
    { auto rr = __builtin_amdgcn_permlane32_swap(__float_as_uint(l_reg), __float_as_uint(l_reg), false, false); l_reg = __uint_as_float(rr[0]) + __uint_as_float(rr[1]); }
    if (hi == 0) wsf[32 + r32] = l_reg;
    asm volatile("s_waitcnt lgkmcnt(0)" ::: "memory");
    float rli[16];
#pragma unroll
    for (int r = 0; r < 16; ++r) rli[r] = __builtin_amdgcn_rcpf(wsf[32 + crow(r, hi)]);
    float* OTw = P.OT + (rowbase + q0 + wid * 32) * 1024 + h * 128;
    if (PASS == 0) {
#pragma unroll
        for (int r = 0; r < 16; ++r)
#pragma unroll
            for (int d = 0; d < 4; ++d) OTw[(long)crow(r, hi) * 1024 + d * 32 + r32] = o[d][r] * rli[r];
        asm volatile("s_waitcnt vmcnt(0) lgkmcnt(0)\n\ts_barrier" ::: "memory");
    } else {
        float ss[16];
#pragma unroll
        for (int r = 0; r < 16; ++r) { float s = 0.f;
#pragma unroll
            for (int d = 0; d < 4; ++d) { const float a = OTw[(long)crow(r, hi) * 1024 + d * 32 + r32] - P.lam * (o[d][r] * rli[r]); o[d][r] = a; s += a * a; }
            ss[r] = s; if ((r & 3) == 3) __builtin_amdgcn_sched_barrier(0); }
#pragma unroll
        for (int x = 1; x < 32; x <<= 1)
#pragma unroll
            for (int r = 0; r < 16; ++r) ss[r] += __builtin_bit_cast(float, __builtin_amdgcn_ds_bpermute((lane ^ x) << 2, __builtin_bit_cast(int, ss[r])));
        float sw[4];
#pragma unroll
        for (int d = 0; d < 4; ++d) sw[d] = P.subln[d * 32 + r32] * (1.f - P.lam_init);
        asm volatile("s_waitcnt vmcnt(0) lgkmcnt(0)\n\ts_barrier" ::: "memory");
        __attribute__((address_space(3))) unsigned short* stg = (__attribute__((address_space(3))) unsigned short*)(shm) + wid * 4096;
#pragma unroll
        for (int r = 0; r < 16; ++r) { const float rs = 1.0f / sqrtf(ss[r] * (1.f / 128.f) + 1e-5f); const int orow = crow(r, hi);
#pragma unroll
            for (int d = 0; d < 4; ++d) { const float v = o[d][r] * rs * sw[d]; stg[orow * 128 + d * 32 + r32] = (unsigned short)(cvtpk(v, v) & 0xffffu); } }
        asm volatile("s_waitcnt lgkmcnt(0)" ::: "memory");
        unsigned short* Ow = P.O + (rowbase + q0 + wid * 32) * 1024 + h * 128;
#pragma unroll
        for (int i = 0; i < 8; ++i) { const int row = i * 4 + (lane >> 4), ch = lane & 15; const u32x4 v = *(const __attribute__((address_space(3))) u32x4*)(stg + row * 128 + ch * 8); *(u32x4*)(Ow + (long)row * 1024 + ch * 8) = v; }
        asm volatile("s_waitcnt vmcnt(0) lgkmcnt(0)\n\ts_barrier" ::: "memory");
    }
}
__device__ __forceinline__ void attn_phase(const Params& P, lds_ptr shm, int vcu, int G, int wid, int lane) {
    if (G == 256) {
        const int bh = vcu >> 2, s = vcu & 3;
        for (int i = 0; i < 4; ++i) { const int qb = (i == 0) ? s : (i == 1) ? 7 - s : (i == 2) ? 8 + s : 15 - s;
            attn_pass<0>(bh >> 3, bh & 7, qb, P, shm, wid, lane); attn_pass<1>(bh >> 3, bh & 7, qb, P, shm, wid, lane); }
    } else {
        for (int u = vcu; u < 64 * NQB; u += G) { const int bh = u >> 4, qb = u & 15;
            attn_pass<0>(bh >> 3, bh & 7, qb, P, shm, wid, lane); attn_pass<1>(bh >> 3, bh & 7, qb, P, shm, wid, lane); }
    }
}
}
namespace mls {
using bf16x8 = __attribute__((ext_vector_type(8))) short;
using f32x4 = __attribute__((ext_vector_type(4))) float;
using u32x4 = __attribute__((ext_vector_type(4))) unsigned;
using u32x2 = __attribute__((ext_vector_type(2))) unsigned;
#define MLS_LAS __attribute__((address_space(3)))
typedef MLS_LAS char* lptr;
constexpr int SEQ = 4096, PITCH = 3072, L = 64, NCH = SEQ / L;
constexpr int QSTR = 136, SSTR = 72;
constexpr int QS = 0, KS = QS + 64 * QSTR * 2, KT = KS + 64 * QSTR * 2, VT = KT + 128 * SSTR * 2, VW = VT + 32 * SSTR * 2, SD = VW + 32 * SSTR * 2, CT = SD + 64 * SSTR * 2,
              NV = CT + 32 * QSTR * 2, FV = NV + 256, AV = FV + 256, IV = AV + 256, EV = IV + 256, WV = EV + 256, WB = WV + 256, DC = WB + 128, LDS_END = DC + 16;
static_assert(LDS_END <= 131072, "mLSTM LDS");
#define MLS_MFMA(a, b, c) __builtin_amdgcn_mfma_f32_16x16x32_bf16(a, b, c, 0, 0, 0)
#define MLS_BAR() asm volatile("s_waitcnt lgkmcnt(0)\n\ts_barrier" ::: "memory")
__device__ __forceinline__ unsigned pk(float lo, float hi) { typedef float f2 __attribute__((ext_vector_type(2))); typedef __bf16 b2 __attribute__((ext_vector_type(2))); f2 v = {lo, hi}; b2 b = __builtin_convertvector(v, b2); return __builtin_bit_cast(unsigned, b); }
__device__ __forceinline__ float blo(unsigned w) { return __builtin_bit_cast(float, w << 16); }
__device__ __forceinline__ float bhi(unsigned w) { return __builtin_bit_cast(float, w & 0xffff0000u); }
__device__ __forceinline__ float bperm(float v, int src) { return __builtin_bit_cast(float, __builtin_amdgcn_ds_bpermute(src << 2, __builtin_bit_cast(int, v))); }

struct Params { const unsigned short* P; const unsigned short* QKC; const float* GB; const float* GA; const float* GP; float* HH;
                const float* wg; const float* wu; const float* wd; unsigned short* wt_gu; unsigned short* wt_d; int gw;
                const float* fg; const float* fu; const float* fd; const float* ai; const float* ao; unsigned short* ws_small; const float* ks_ffn; const float* ks_att; };
constexpr int CV_MOE = 86016, CV_TOTAL = CV_MOE + 3 * 3584 + 3072 + 1024, CV_ITERS = (CV_TOTAL + 2047) / 2048;
constexpr size_t WS_FGU = (size_t)4096 * 1024, WS_FD = (size_t)11264 * 1024, WS_AI = (size_t)14848 * 1024, WS_AO = (size_t)17920 * 1024;
constexpr int CV_SCR = (LDS_END + 127) / 128 * 128;
constexpr int LDS_END2 = CV_SCR + 8 * 4224;
static_assert(LDS_END2 <= 131072, "mLSTM + cvt LDS");
struct CvItem { const float* src; unsigned short* dst; const float* ks; int ldw, K; };
__device__ __forceinline__ CvItem cv_decode(const Params& A, int it) {
    CvItem c; c.ks = nullptr;
    if (it >= CV_MOE) {
        int r = it - CV_MOE;
        if (r < 2 * 3584) { const int up = r >= 3584; r -= up * 3584; const int kb = r / 112, nb = r - kb * 112, n0 = 32 * nb, drow = (n0 >> 7) * 256 + (n0 & 127) + (up ? 128 : 0);
            c.src = (up ? A.fu : A.fg) + (size_t)(32 * kb) * 3584 + n0; c.ldw = 3584; c.K = 1024; c.dst = A.ws_small + WS_FGU + (size_t)drow * 1024 + 32 * kb; c.ks = A.ks_ffn ? A.ks_ffn + 32 * kb : nullptr; return c; }
        r -= 2 * 3584;
        if (r < 3584) { const int kb = r >> 5, nb = r & 31; c.src = A.fd + (size_t)(32 * kb) * 1024 + 32 * nb; c.ldw = 1024; c.K = 3584; c.dst = A.ws_small + WS_FD + (size_t)(32 * nb) * 3584 + 32 * kb; return c; }
        r -= 3584;
        if (r < 3072) { const int kb = r / 96, nb = r - kb * 96; c.src = A.ai + (size_t)(32 * kb) * 3072 + 32 * nb; c.ldw = 3072; c.K = 1024; c.dst = A.ws_small + WS_AI + (size_t)(32 * nb) * 1024 + 32 * kb; c.ks = A.ks_att ? A.ks_att + 32 * kb : nullptr; return c; }
        r -= 3072;
        if (r >= 1024) r = 1023;
        { const int kb = r >> 5, nb = r & 31; c.src = A.ao + (size_t)(32 * kb) * 1024 + 32 * nb; c.ldw = 1024; c.K = 1024; c.dst = A.ws_small + WS_AO + (size_t)(32 * nb) * 1024 + 32 * kb; return c; }
    }
    const int type = it / 28672, r = it - type * 28672, mat = r / 3584, r2 = r - mat * 3584;
    if (type < 2) { const int kb = r2 / 112, nb = r2 - kb * 112, n0 = 32 * nb; const int drow = (n0 >> 7) * 256 + (n0 & 127) + (type ? 128 : 0);
        c.src = (type ? A.wu : A.wg) + (size_t)mat * 1024 * 3584 + (size_t)(32 * kb) * 3584 + n0; c.ldw = 3584; c.K = 1024; c.dst = A.wt_gu + (size_t)mat * 7168 * 1024 + (size_t)drow * 1024 + 32 * kb; }
    else { const int kb = r2 >> 5, nb = r2 & 31, n0 = 32 * nb;
        c.src = A.wd + (size_t)mat * 3584 * 1024 + (size_t)(32 * kb) * 1024 + n0; c.ldw = 1024; c.K = 3584; c.dst = A.wt_d + (size_t)mat * 1024 * 3584 + (size_t)n0 * 3584 + 32 * kb; }
    return c;
}

__device__ __forceinline__ void scan_unit(int b, int h, int sl, const Params& A, lptr shm, int wid, int lane) {
    const int tid = wid * 64 + lane, lr = lane & 15, lq = lane >> 4;
    const long rowbase = (long)b * SEQ;
    const int o = tid & 31, g = tid >> 5, isk = o >> 4, ch0 = (o & 15) * 8;
    const int pcol = isk * 512 + h * 128 + ch0;
    const unsigned short* rawp = A.QKC + (rowbase + 4 * g) * 1024 + pcol;
    const int vs = tid >> 3, vj = (tid & 7) * 4;
    const unsigned short* vp = A.P + (rowbase + vs) * PITCH + 1024 + h * 256 + sl * 32 + vj;
    const int to = wid >> 1, jo = wid & 1;
    f32x4 Cst[2], nst;
    Cst[0] = (f32x4){0.f, 0.f, 0.f, 0.f}; Cst[1] = Cst[0]; nst = Cst[0];
    for (int i = tid; i < (32 * QSTR * 2 + 256) / 4; i += 512) ((MLS_LAS unsigned*)(shm + CT))[i] = 0u;
    float m_prev = 0.f;
    bf16x8 ones; { const short o1 = (short)0x3f80; ones = (bf16x8){o1, o1, o1, o1, o1, o1, o1, o1}; }
    float* hhp = A.HH + (rowbase + 16 * to + 4 * lq) * 1024 + h * 256 + sl * 32 + 16 * jo + lr;
    f32x4 cvr[4]; float cvs[4] = {1.f, 1.f, 1.f, 1.f}; unsigned short* cvdst = nullptr; int cvK = 0; bool cvhave = false;
#ifndef MK_CV_FIRST
#define MK_CV_FIRST 0
#endif
    if (A.gw >= 0) { const CvItem ci = cv_decode(A, MK_CV_FIRST + A.gw);
#pragma unroll
      for (int i = 0; i < 4; ++i) cvr[i] = *(const f32x4*)(ci.src + (size_t)(8 * i + (lane >> 3)) * ci.ldw + (lane & 7) * 4);
      cvdst = ci.dst; cvK = ci.K; cvhave = true;
#pragma unroll
      for (int i = 0; i < 4; ++i) cvs[i] = ci.ks ? ci.ks[8 * i + (lane >> 3)] : 1.f; }
    else { cvr[0] = cvr[1] = cvr[2] = cvr[3] = (f32x4){0.f, 0.f, 0.f, 0.f}; }
    u32x4 raw[4]; u32x2 vraw; float gb = 0.f, ga = 0.f, gp = 0.f;
#pragma unroll
    for (int i = 0; i < 4; ++i) raw[i] = *(const u32x4*)(rawp + (long)i * 1024);
    vraw = *(const u32x2*)vp;
    if (wid == 7) { gb = A.GB[(rowbase + lane) * 4 + h]; ga = A.GA[(rowbase + lane) * 4 + h]; gp = A.GP[(rowbase + lane) * 4 + h]; }
    float hout[4] = {0.f, 0.f, 0.f, 0.f};
    MLS_BAR();
#pragma unroll 1
    for (int c = 0; c < NCH; ++c) {
        const int t0 = c * L;
        if (c > 0) {
#pragma unroll
            for (int r = 0; r < 4; ++r) hhp[(long)(t0 - L + r) * 1024] = hout[r];
        }
        float vv[4]; vv[0] = blo(vraw[0]); vv[1] = bhi(vraw[0]); vv[2] = blo(vraw[1]); vv[3] = bhi(vraw[1]);
        {
#pragma unroll
            for (int r = 0; r < 4; ++r) *(MLS_LAS u32x4*)(shm + (isk ? KS : QS) + ((4 * g + r) * QSTR + ch0) * 2) = raw[r];
            if (isk) {
#pragma unroll
                for (int e = 0; e < 8; ++e) { const int dw = e >> 1, sh = (e & 1) * 16;
                    const unsigned a0 = (raw[0][dw] >> sh) & 0xffffu, a1 = (raw[1][dw] >> sh) & 0xffffu, a2 = (raw[2][dw] >> sh) & 0xffffu, a3 = (raw[3][dw] >> sh) & 0xffffu;
                    *(MLS_LAS u32x2*)(shm + KT + ((ch0 + e) * SSTR + 4 * g) * 2) = (u32x2){a0 | (a1 << 16), a2 | (a3 << 16)}; }
            }
        }
#pragma unroll
        for (int e = 0; e < 4; ++e) *(MLS_LAS unsigned short*)(shm + VT + ((vj + e) * SSTR + vs) * 2) = (unsigned short)(pk(vv[e], vv[e]) & 0xffffu);
        if (wid == 7) {
            const float bs = gb, a = ga, pm = gp;
            const float gsum = __builtin_bit_cast(float, __builtin_amdgcn_readlane(__builtin_bit_cast(int, bs), 63)), amax = __builtin_bit_cast(float, __builtin_amdgcn_readlane(__builtin_bit_cast(int, pm), 63));
            const float mref = fmaxf(m_prev, pm);
            const float mt = bs + mref;
            const float mrefn = fmaxf(m_prev, amax);
            const float w = __expf(a - mrefn);
            ((MLS_LAS float*)(shm + FV))[lane] = -mref;
            ((MLS_LAS float*)(shm + AV))[lane] = a;
            ((MLS_LAS float*)(shm + IV))[lane] = __expf(m_prev - mref);
            ((MLS_LAS float*)(shm + EV))[lane] = __expf(-mt);
            ((MLS_LAS float*)(shm + WV))[lane] = w;
            ((MLS_LAS unsigned short*)(shm + WB))[lane] = (unsigned short)(pk(w, w) & 0xffffu);
            if (lane == 0) ((MLS_LAS float*)(shm + DC))[0] = __expf(m_prev - mrefn);
            m_prev = gsum + mrefn;
        }
        if (cvhave) {
            MLS_LAS float* scr = (MLS_LAS float*)(shm + CV_SCR + wid * 4224);
#pragma unroll
            for (int i = 0; i < 4; ++i)
#pragma unroll
                for (int e = 0; e < 4; ++e) scr[(8 * i + (lane >> 3)) * 33 + (lane & 7) * 4 + e] = cvr[i][e] * cvs[i];
            float tv[16];
#pragma unroll
            for (int j = 0; j < 16; ++j) tv[j] = scr[(16 * (lane & 1) + j) * 33 + (lane >> 1)];
            u32x4* dp = (u32x4*)(cvdst + (size_t)(lane >> 1) * cvK + 16 * (lane & 1));
            dp[0] = (u32x4){pk(tv[0], tv[1]), pk(tv[2], tv[3]), pk(tv[4], tv[5]), pk(tv[6], tv[7])}; dp[1] = (u32x4){pk(tv[8], tv[9]), pk(tv[10], tv[11]), pk(tv[12], tv[13]), pk(tv[14], tv[15])};
        }
        cvhave = (MK_CV_FIRST + 2048 * (c + 1) < CV_TOTAL + 2047) && (c + 1 < CV_ITERS) && (A.gw >= 0);
        if (cvhave) { const CvItem ci = cv_decode(A, MK_CV_FIRST + A.gw + 2048 * (c + 1));
#pragma unroll
            for (int i = 0; i < 4; ++i) cvs[i] = ci.ks ? ci.ks[8 * i + (lane >> 3)] : 1.f;
#pragma unroll
            for (int i = 0; i < 4; ++i) cvr[i] = *(const f32x4*)(ci.src + (size_t)(8 * i + (lane >> 3)) * ci.ldw + (lane & 7) * 4);
            cvdst = ci.dst; cvK = ci.K; }
        if (c + 1 < NCH) {
            const long adv = (long)(t0 + L) * PITCH;
#pragma unroll
            for (int i = 0; i < 4; ++i) raw[i] = *(const u32x4*)(rawp + (long)(t0 + L) * 1024 + (long)i * 1024);
            vraw = *(const u32x2*)(vp + adv);
            if (wid == 7) { const long gi = (rowbase + t0 + L + lane) * 4 + h; gb = A.GB[gi]; ga = A.GA[gi]; gp = A.GP[gi]; }
        }
        MLS_BAR();
        { const float w = ((MLS_LAS float*)(shm + WV))[vs];
#pragma unroll
          for (int e = 0; e < 4; ++e) *(MLS_LAS unsigned short*)(shm + VW + ((vj + e) * SSTR + vs) * 2) = (unsigned short)(pk(vv[e] * w, vv[e] * w) & 0xffffu); }
        bf16x8 qa[4];
#pragma unroll
        for (int ks = 0; ks < 4; ++ks) qa[ks] = *(const MLS_LAS bf16x8*)(shm + QS + ((16 * to + lr) * QSTR + 32 * ks + 8 * lq) * 2);
        f32x4 fvr; { const f32x4 t4 = *(const MLS_LAS f32x4*)(shm + FV + (16 * to + 4 * lq) * 4); fvr = t4; }
#pragma unroll
        for (int q = 0; q < 2; ++q) {
            const int si = 2 * jo + q;
            f32x4 s4 = (f32x4){0.f, 0.f, 0.f, 0.f};
            if (si <= to) {
#pragma unroll
                for (int ks = 0; ks < 4; ++ks) { const bf16x8 kb = *(const MLS_LAS bf16x8*)(shm + KS + ((16 * si + lr) * QSTR + 32 * ks + 8 * lq) * 2); s4 = MLS_MFMA(qa[ks], kb, s4); }
                const float av = ((MLS_LAS float*)(shm + AV))[16 * si + lr];
                const int scol = 16 * si + lr, trow = 16 * to + 4 * lq;
#pragma unroll
                for (int r = 0; r < 4; ++r) s4[r] = (scol <= trow + r) ? s4[r] * __expf(fvr[r] + av) : 0.f;
            }
#pragma unroll
            for (int r = 0; r < 4; ++r) *(MLS_LAS unsigned short*)(shm + SD + ((16 * to + 4 * lq + r) * SSTR + 16 * si + lr) * 2) = (unsigned short)(pk(s4[r], s4[r]) & 0xffffu);
        }
        f32x4 qc = (f32x4){0.f, 0.f, 0.f, 0.f}, qn = qc;
#pragma unroll
        for (int ks = 0; ks < 4; ++ks) { const bf16x8 cb8 = *(const MLS_LAS bf16x8*)(shm + CT + ((16 * jo + lr) * QSTR + 32 * ks + 8 * lq) * 2); const bf16x8 nb8 = *(const MLS_LAS bf16x8*)(shm + NV + (32 * ks + 8 * lq) * 2);
            qc = MLS_MFMA(qa[ks], cb8, qc); qn = MLS_MFMA(qa[ks], nb8, qn); }
        MLS_BAR();
        {
            f32x4 sv = (f32x4){0.f, 0.f, 0.f, 0.f}, rs = sv;
#pragma unroll
            for (int ks = 0; ks < 2; ++ks) { const bf16x8 sa = *(const MLS_LAS bf16x8*)(shm + SD + ((16 * to + lr) * SSTR + 32 * ks + 8 * lq) * 2); const bf16x8 vb = *(const MLS_LAS bf16x8*)(shm + VT + ((16 * jo + lr) * SSTR + 32 * ks + 8 * lq) * 2);
                sv = MLS_MFMA(sa, vb, sv); rs = MLS_MFMA(sa, ones, rs); }
            const f32x4 iv = *(const MLS_LAS f32x4*)(shm + IV + (16 * to + 4 * lq) * 4), ev = *(const MLS_LAS f32x4*)(shm + EV + (16 * to + 4 * lq) * 4);
#pragma unroll
            for (int r = 0; r < 4; ++r) { const float num = sv[r] + iv[r] * qc[r], den = rs[r] + iv[r] * qn[r]; hout[r] = num * __builtin_amdgcn_rcpf(fmaxf(fabsf(den), ev[r])); }
        }
        {
            const float decay = ((MLS_LAS float*)(shm + DC))[0];
            Cst[0] = Cst[0] * decay; Cst[1] = Cst[1] * decay; nst = nst * decay;
#pragma unroll
            for (int ks = 0; ks < 2; ++ks) { const bf16x8 ka = *(const MLS_LAS bf16x8*)(shm + KT + ((16 * wid + lr) * SSTR + 32 * ks + 8 * lq) * 2);
                const bf16x8 v0 = *(const MLS_LAS bf16x8*)(shm + VW + ((lr) * SSTR + 32 * ks + 8 * lq) * 2), v1 = *(const MLS_LAS bf16x8*)(shm + VW + ((16 + lr) * SSTR + 32 * ks + 8 * lq) * 2);
                const bf16x8 wb8 = *(const MLS_LAS bf16x8*)(shm + WB + (32 * ks + 8 * lq) * 2);
                Cst[0] = MLS_MFMA(ka, v0, Cst[0]); Cst[1] = MLS_MFMA(ka, v1, Cst[1]); nst = MLS_MFMA(ka, wb8, nst); }
        }
        MLS_BAR();
#pragma unroll
        for (int jt = 0; jt < 2; ++jt) *(MLS_LAS u32x2*)(shm + CT + ((16 * jt + lr) * QSTR + 16 * wid + 4 * lq) * 2) = (u32x2){pk(Cst[jt][0], Cst[jt][1]), pk(Cst[jt][2], Cst[jt][3])};
        if (lr == 0) *(MLS_LAS u32x2*)(shm + NV + (16 * wid + 4 * lq) * 2) = (u32x2){pk(nst[0], nst[1]), pk(nst[2], nst[3])};
    }
#pragma unroll
    for (int r = 0; r < 4; ++r) hhp[(long)(SEQ - L + r) * 1024] = hout[r];
    asm volatile("s_waitcnt vmcnt(0) lgkmcnt(0)\n\ts_barrier" ::: "memory");
}
__device__ __forceinline__ void scan_phase(const Params& A, lptr shm, int vcu, int G, int wid) {
    for (int u = vcu; u < 256; u += G) {
        int lane; asm volatile("v_mbcnt_lo_u32_b32 %0, -1, 0\n\tv_mbcnt_hi_u32_b32 %0, -1, %0" : "=v"(lane));
        const int bh = u >> 3; scan_unit(bh >> 2, bh & 3, u & 7, A, shm, wid, lane);
    }
}
__device__ __forceinline__ void conv_phase(const unsigned short* P, const float* cw, const float* cb, unsigned short* QKC, const float* LI, const float* LF, float* GB, float* GA, float* GP, int vcu, int G, int tid) {
    const int o = tid & 127, g = tid >> 7, c0 = o * 8;
    float cwr[4][8], cbr[8];
#pragma unroll
    for (int j = 0; j < 4; ++j) { const f32x4 a = *(const f32x4*)(cw + j * 1024 + c0), c = *(const f32x4*)(cw + j * 1024 + c0 + 4);
        cwr[j][0] = a[0]; cwr[j][1] = a[1]; cwr[j][2] = a[2]; cwr[j][3] = a[3]; cwr[j][4] = c[0]; cwr[j][5] = c[1]; cwr[j][6] = c[2]; cwr[j][7] = c[3]; }
    { const f32x4 a = *(const f32x4*)(cb + c0), c = *(const f32x4*)(cb + c0 + 4); cbr[0] = a[0]; cbr[1] = a[1]; cbr[2] = a[2]; cbr[3] = a[3]; cbr[4] = c[0]; cbr[5] = c[1]; cbr[6] = c[2]; cbr[7] = c[3]; }
    const float osc = c0 >= 512 ? 0.08838834764831845f : 1.0f;
    for (int blk = vcu; blk < 8 * SEQ / 128; blk += G) {
        {
            const int w = tid >> 6, lane = tid & 63; const long gi = ((long)blk * 128 + (w >> 2) * 64 + lane) * 4 + (w & 3);
            float bs = LF[gi]; const float li = LI[gi];
#pragma unroll
            for (int x = 1; x < 64; x <<= 1) { const float v = bperm(bs, (lane - x) & 63); if (lane >= x) bs += v; }
            const float a = li - bs; float pm = a;
#pragma unroll
            for (int x = 1; x < 64; x <<= 1) { const float v = bperm(pm, (lane - x) & 63); if (lane >= x) pm = fmaxf(pm, v); }
            GB[gi] = bs; GA[gi] = a; GP[gi] = pm;
        }
        const long r0 = (long)blk * 128 + 32 * g;
        float x[3][8];
#pragma unroll
        for (int i = 0; i < 3; ++i) { const long rr = r0 - 3 + i; u32x4 w = (u32x4){0u, 0u, 0u, 0u}; if ((r0 & (SEQ - 1)) != 0) w = *(const u32x4*)(P + rr * PITCH + c0);
            x[i][0] = blo(w[0]); x[i][1] = bhi(w[0]); x[i][2] = blo(w[1]); x[i][3] = bhi(w[1]); x[i][4] = blo(w[2]); x[i][5] = bhi(w[2]); x[i][6] = blo(w[3]); x[i][7] = bhi(w[3]); }
#pragma unroll 4
        for (int r = 0; r < 32; ++r) {
            const u32x4 w = *(const u32x4*)(P + (r0 + r) * PITCH + c0);
            float xn[8]; xn[0] = blo(w[0]); xn[1] = bhi(w[0]); xn[2] = blo(w[1]); xn[3] = bhi(w[1]); xn[4] = blo(w[2]); xn[5] = bhi(w[2]); xn[6] = blo(w[3]); xn[7] = bhi(w[3]);
            float y[8];
#pragma unroll
            for (int e = 0; e < 8; ++e) { const float a = cbr[e] + cwr[0][e] * x[0][e] + cwr[1][e] * x[1][e] + cwr[2][e] * x[2][e] + cwr[3][e] * xn[e];
                y[e] = osc * a * __builtin_amdgcn_rcpf(1.0f + __builtin_amdgcn_exp2f(-1.4426950408889634f * a)); x[0][e] = x[1][e]; x[1][e] = x[2][e]; x[2][e] = xn[e]; }
            *(u32x4*)(QKC + (r0 + r) * 1024 + c0) = (u32x4){pk(y[0], y[1]), pk(y[2], y[3]), pk(y[4], y[5]), pk(y[6], y[7])};
        }
    }
}
__device__ __forceinline__ void headnorm_phase(const float* HH, const unsigned short* P, const float* hn, unsigned short* Gout, int vcu, int G, int wid, int lane) {
    const int gw = vcu * 8 + wid, NGW = G * 8;
    f32x4 nv[4]; u32x4 no0, no1;
    { const f32x4* hp = (const f32x4*)(HH + (long)gw * 1024 + lane * 16);
#pragma unroll
      for (int i = 0; i < 4; ++i) nv[i] = hp[i];
      const u32x4* op = (const u32x4*)(P + (long)gw * PITCH + 2048 + lane * 16); no0 = op[0]; no1 = op[1]; }
    for (int m = gw; m < 8 * SEQ; m += NGW) {
        f32x4 v[4]; float ss = 0.f; const u32x4 o0 = no0, o1 = no1;
#pragma unroll
        for (int i = 0; i < 4; ++i) { v[i] = nv[i]; ss += v[i][0] * v[i][0] + v[i][1] * v[i][1] + v[i][2] * v[i][2] + v[i][3] * v[i][3]; }
        if (m + NGW < 8 * SEQ) { const f32x4* hp = (const f32x4*)(HH + (long)(m + NGW) * 1024 + lane * 16);
#pragma unroll
            for (int i = 0; i < 4; ++i) nv[i] = hp[i];
            const u32x4* op = (const u32x4*)(P + (long)(m + NGW) * PITCH + 2048 + lane * 16); no0 = op[0]; no1 = op[1]; }
#pragma unroll
        for (int x = 1; x < 16; x <<= 1) ss += bperm(ss, lane ^ x);
        const float rs = 1.0f / sqrtf(ss * (1.f / 256.f) + 1e-6f);
        const f32x4* wp = (const f32x4*)(hn + lane * 16);
        float og[16];
#pragma unroll
        for (int i = 0; i < 4; ++i) { og[2 * i] = blo(o0[i]); og[2 * i + 1] = bhi(o0[i]); og[8 + 2 * i] = blo(o1[i]); og[8 + 2 * i + 1] = bhi(o1[i]); }
        float r[16];
#pragma unroll
        for (int i = 0; i < 4; ++i) { const f32x4 w = wp[i];
#pragma unroll
            for (int e = 0; e < 4; ++e) { const float sg = __builtin_amdgcn_rcpf(1.0f + __builtin_amdgcn_exp2f(-1.4426950408889634f * og[4 * i + e])); r[4 * i + e] = sg * v[i][e] * rs * w[e]; } }
        u32x4* gp = (u32x4*)(Gout + (long)m * 1024 + lane * 16);
        gp[0] = (u32x4){pk(r[0], r[1]), pk(r[2], r[3]), pk(r[4], r[5]), pk(r[6], r[7])}; gp[1] = (u32x4){pk(r[8], r[9]), pk(r[10], r[11]), pk(r[12], r[13]), pk(r[14], r[15])};
    }
}
}
#define MK_KS_FFN (KA_IN(18) + pr * 1024)
#define MK_KS_ATT (KA_IN(10) + pr * 1024)
#define MK_QSCALE (0.125f * 1.4426950408889634f)
#define MK_ATTENTION { const int tid = fresh_tid(F), lane = tid & 63, wave = __builtin_amdgcn_readfirstlane(tid >> 6); \
    const float lam_init = 0.8f - 0.6f * __expf(-0.3f * (float)(2 * pr + 1)); \
    const float* lq1 = KA_IN(12) + pr * 64; const float* lk1 = KA_IN(13) + pr * 64; const float* lq2 = KA_IN(14) + pr * 64; const float* lk2 = KA_IN(15) + pr * 64; \
    const float lam = __expf(wave_sum(lq1[lane] * lk1[lane], lane)) - __expf(wave_sum(lq2[lane] * lk2[lane], lane)) + lam_init; \
    att::Params AP{(const unsigned short*)(ws + F_P), (unsigned short*)(ws + F_O), (float*)(ws + F_OT), KA_IN(1), KA_IN(16) + pr * 128, lam, lam_init}; \
    att::attn_phase(AP, (att::lds_ptr)(F.lds + RING_OFF), F.vcu, F.G, wave, lane); }
#define MK_MLSTM_CONV { const int tid = fresh_tid(F); mls::conv_phase((const unsigned short*)(ws + F_P), KA_IN(4) + pr * 4096, KA_IN(5) + pr * 1024, (unsigned short*)(ws + F_QKC), LI, LF, (float*)(ws + F_GB), (float*)(ws + F_GB) + M * 4, (float*)(ws + F_GB) + 2 * M * 4, F.vcu, F.G, tid); }
#define MK_MLSTM_SCAN { const int tid = fresh_tid(F); const int wave = __builtin_amdgcn_readfirstlane(tid >> 6); \
    mls::Params MP{(const unsigned short*)(ws + F_P), (const unsigned short*)(ws + F_QKC), (const float*)(ws + F_GB), (const float*)(ws + F_GB) + M * 4, (const float*)(ws + F_GB) + 2 * M * 4, (float*)(ws + F_HH), \
        KA_IN(25) + (size_t)pr * NE * 1024 * FF, KA_IN(26) + (size_t)pr * NE * 1024 * FF, KA_IN(27) + (size_t)pr * NE * FF * 1024, W0, W0 + (size_t)NE * 7168 * 1024, F.G == 256 ? F.vcu * NWAVES + wave : -1, \
        KA_IN(19) + (size_t)pr * 1024 * FF, KA_IN(20) + (size_t)pr * 1024 * FF, KA_IN(21) + (size_t)pr * FF * 1024, KA_IN(11) + (size_t)pr * 1024 * 3072, KA_IN(17) + (size_t)pr * 1024 * 1024, WS0, MK_KS_FFN, MK_KS_ATT}; \
    mls::scan_phase(MP, (mls::lptr)(F.lds + RING_OFF), F.vcu, F.G, wave); }
#define MK_MLSTM_HEADNORM { const int tid = fresh_tid(F), lane = tid & 63, wave = __builtin_amdgcn_readfirstlane(tid >> 6); \
    mls::headnorm_phase((const float*)(ws + F_HH), (const unsigned short*)(ws + F_P), KA_IN(8) + pr * 1024, (unsigned short*)(ws + F_G), F.vcu, F.G, wave, lane); }
#ifndef MK_MLSTM_SCAN
#define MK_MLSTM_SCAN
#endif
#ifndef MK_MLSTM_HEADNORM
#define MK_MLSTM_HEADNORM
#endif
#ifndef MK_ATTENTION
#define MK_ATTENTION
#endif
#ifndef MK_QSCALE
#define MK_KS_FFN (KA_IN(18) + pr * 1024)
#define MK_KS_ATT (KA_IN(10) + pr * 1024)
#define MK_QSCALE 1.0f
#endif
namespace mk {
__device__ __forceinline__ void assign_phase(Frame& F, const int* top_e, const int* wg_cnt, int* tok_slot, int* blk_expert, int* n_used, const bf16* XN, bf16* XG) {
    LAS int* cnt = (LAS int*)(F.lds + RING_OFF);
    LAS int* base = cnt + 2048; LAS int* pst = base + 8; LAS int* tot = pst + 8; LAS int* ex = tot + 8; LAS int* sl = ex + 256;
    const int t = fresh_tid(F), lane = t & 63, w = __builtin_amdgcn_readfirstlane(t >> 6);
    for (int i = t; i < 2048; i += NTHR) cnt[i] = wg_cnt[i];
    if (t < 256) ex[t] = top_e[F.vcu * 256 + t];
    __syncthreads();
    if (t < 8) { int s = 0, b = 0; for (int v = 0; v < 256; ++v) { const int c = cnt[v * 8 + t]; b += (v < F.vcu) ? c : 0; s += c; } tot[t] = s; base[t] = b; }
    __syncthreads();
    if (t == 0) {
        int acc = 0;
        for (int e = 0; e < 8; ++e) { pst[e] = acc; acc += (tot[e] + 255) / 256 * 256; }
        if (F.vcu == 0) {
            *n_used = acc / 256;
            int e = 0;
            for (int b = 0; b < NBLK; ++b) { while (e < 7 && b * 256 >= pst[e] + (tot[e] + 255) / 256 * 256) ++e; blk_expert[b] = e; }
        }
    }
    __syncthreads();
    if (t < 256) { const int e = ex[t]; int r = 0; for (int i = 0; i < t; ++i) r += (ex[i] == e) ? 1 : 0; const int slot = pst[e] + base[e] + r; sl[t] = slot; tok_slot[F.vcu * 256 + t] = slot; }
    __syncthreads();
    for (int a = w; a < 256; a += NWAVES) {
        const int slot = sl[a], tok = (F.vcu * 256 + a) >> 1;
        const GAS v4u* src = (const GAS v4u*)(XN + (size_t)tok * D) + lane; GAS v4u* dst = (GAS v4u*)(XG + (size_t)slot * D) + lane;
        const v4u v0 = src[0], v1 = src[64]; dst[0] = v0; dst[64] = v1;
    }
    __syncthreads();
}

struct Args { const float* in[29]; float* out; unsigned char* ws; int ph_lo, ph_hi, li, flags; };
constexpr int PH_FINAL = 34, PH_COMBINE = 35;
constexpr float ATT_C2 = 0.125f * 1.4426950408889634f;

typedef const __attribute__((address_space(4))) unsigned char* kaptr_t;
__device__ __forceinline__ kaptr_t ka_fresh() { kaptr_t p = (kaptr_t)__builtin_amdgcn_kernarg_segment_ptr(); asm volatile("" : "+s"(p)); return p; }
#define KA_IN(k) (*(const float* const __attribute__((address_space(4)))*)(ka + 8 * (k)))
#define KA_OUT (*(float* const __attribute__((address_space(4)))*)(ka + 232))
#define KA_WS (*(unsigned char* const __attribute__((address_space(4)))*)(ka + 240))
#define KA_INT(off) (*(const int __attribute__((address_space(4)))*)(ka + (off)))
static_assert(sizeof(Args) == 264, "Args layout (kernarg offsets above)");
#define PHASE_PTRS kaptr_t ka = ka_fresh(); unsigned char* const ws = KA_WS; float* const xo = KA_OUT; bf16* const XN = (bf16*)(ws + F_XN); bf16* const W0 = (bf16*)(ws + F_W); bf16* const WS0 = (bf16*)(ws + F_WS); (void)WS0; \
    int* const top_e = (int*)(ws + F_TOPE); float* const top_g = (float*)(ws + F_TOPG); int* const slot_tok = (int*)(ws + F_SLOTTOK); int* const tok_slot = (int*)(ws + F_TOKSLOT); \
    int* const blk_e = (int*)(ws + F_BLKE); int* const n_used = (int*)(ws + F_NUSED); float* const LI = (float*)(ws + F_LI); float* const LF = (float*)(ws + F_LF); bf16* const Ybuf = (bf16*)(ws + F_Y); \
    (void)xo; (void)XN; (void)W0; (void)top_e; (void)top_g; (void)slot_tok; (void)tok_slot; (void)blk_e; (void)n_used; (void)LI; (void)LF; (void)Ybuf; (void)ws
__global__ void __launch_bounds__(NTHR, 2) mk_fwd(Args) {
    extern __shared__ __attribute__((aligned(16))) unsigned char lds[];
    Frame F;
    F.lds = (LAS unsigned char*)lds;
    volatile LAS unsigned* MISC = (volatile LAS unsigned*)(F.lds + MISC_OFF);
    F.wave = __builtin_amdgcn_readfirstlane((int)threadIdx.x >> 6);
    F.G = gridDim.x; { const int bx = blockIdx.x; F.vcu = (F.G % 8 == 0) ? (bx % 8) * (F.G / 8) + bx / 8 : bx; }
    for (int u = threadIdx.x; u < (LDS_BYTES - LDSCTL_OFF) / 4; u += NTHR) ((LAS unsigned*)(F.lds + LDSCTL_OFF))[u] = 0u;
    __syncthreads();
    int lo, hi, flags; XcdBarrier bar;
    { kaptr_t ka = ka_fresh(); lo = KA_INT(248); hi = KA_INT(252); flags = KA_INT(260); const int li = KA_INT(256);
      bar = xcd_barrier_post((unsigned*)((gu32*)(KA_WS + F_CTL) + CW_BAR) + li * XCD_BAR_WORDS, MISC + 8, threadIdx.x == 0); }
#define IN(k) (lo <= (k) && (k) < hi)
#if defined(PROBE_PHASE)
#define REPS(n) ((n) == PROBE_PHASE ? 1 + PROBE_REPS : 1)
#else
#define REPS(n) 1
#endif
#define SEAM(k) do { if (IN(k) && IN((k) + 1)) xcd_barrier(bar, F.wave == 0 && lane_id() == 0); } while (0)

    for (int pr = 0; pr < 2; ++pr) {
        const int pb = pr * 17;
        if (IN(pb + 0)) _Pragma("unroll") for (int rep_ = 0; rep_ < REPS(0); ++rep_) { PHASE_PTRS;
            cvt_job(F, KA_IN(3) + (size_t)pr * 1024 * 3080, 3080, 1024, 3072, 1, 0, WS0, 0, 0, 0);
            cvt_job(F, KA_IN(9) + (size_t)pr * 1024 * 1024, 1024, 1024, 1024, 1, 0, WS0 + 3072 * 1024, 0, 0, 1536);
            RowJob J{}; const bool first = (pr == 0) && !(flags & 1);
            const bool comb = (pr == 1) && !(flags & 2);
            J.xsrc = first ? KA_IN(0) : xo; J.xdst = (first || comb) ? xo : nullptr; J.nw = KA_IN(2) + pr * 1024; J.XN = XN;
            if (comb) { J.Y = Ybuf; J.tok_slot = tok_slot; J.top_g = top_g; }
            J.slab = KA_IN(3) + (size_t)pr * 1024 * 3080 + 3072; J.slab_ld = 3080; J.kind = 1; J.b0 = KA_IN(6) + pr * 4; J.b1 = KA_IN(7) + pr * 4; J.LI = LI; J.LF = LF;
            row_phase(F, J);
        }
        SEAM(pb + 0);
        if (IN(pb + 1)) _Pragma("unroll") for (int rep_ = 0; rep_ < REPS(1); ++rep_) { PHASE_PTRS;
            pg8::Gemm g{XN, WS0, M, 3072, 1024, nullptr}; pg8::StaticOrder S; S.init(M, 3072, F.G, (int)blockIdx.x);
            pg8::EpiBf16 E{(bf16*)(ws + F_P), 3072, 1.f, 0};
            pg8::gemm_phase<pg8::EpiBf16, pg8::StaticOrder, true, false>(F.lds + RING_OFF, g, S, E, F.wave);
        }
        SEAM(pb + 1);
        if (IN(pb + 2)) _Pragma("unroll") for (int rep_ = 0; rep_ < REPS(2); ++rep_) { PHASE_PTRS; MK_MLSTM_CONV }
        SEAM(pb + 2);
        if (IN(pb + 3)) _Pragma("unroll") for (int rep_ = 0; rep_ < REPS(3); ++rep_) { PHASE_PTRS; MK_MLSTM_SCAN }
        SEAM(pb + 3);
        if (IN(pb + 4)) _Pragma("unroll") for (int rep_ = 0; rep_ < REPS(4); ++rep_) { PHASE_PTRS; MK_MLSTM_HEADNORM }
        SEAM(pb + 4);
        if (IN(pb + 5)) _Pragma("unroll") for (int rep_ = 0; rep_ < REPS(5); ++rep_) { PHASE_PTRS;
            pg8::Gemm g{(const bf16*)(ws + F_G), WS0 + 3072 * 1024, M, 1024, 1024, nullptr}; pg8::StaticOrder S; S.init(M, 1024, F.G, (int)blockIdx.x);
            pg8::EpiResidT<true> E{xo, 1024, XN, (float*)(ws + F_SSQ), xo};
            pg8::gemm_phase<pg8::EpiResidT<true>, pg8::StaticOrder, true, false>(F.lds + RING_OFF, g, S, E, F.wave);
        }
        SEAM(pb + 5);
        if (IN(pb + 7)) _Pragma("unroll") for (int rep_ = 0; rep_ < REPS(7); ++rep_) { PHASE_PTRS;
            pg8::Gemm g{XN, WS0 + mls::WS_FGU, M, 2 * FF, 1024, nullptr}; pg8::StaticOrder S; S.init(M, 2 * FF, F.G, (int)blockIdx.x);
            pg8::EpiSwiGLUT<true> E{(bf16*)(ws + F_H), FF};
            pg8::gemm_phase<pg8::EpiSwiGLUT<true>, pg8::StaticOrder, true, false, true>(F.lds + RING_OFF, g, S, E, F.wave, (const float*)(ws + F_SSQ), (PG8_LAS float*)(F.lds + LDSCTL_OFF + 1024));
        }
        SEAM(pb + 7);
        if (IN(pb + 8)) _Pragma("unroll") for (int rep_ = 0; rep_ < REPS(8); ++rep_) { PHASE_PTRS;
            pg8::Gemm g{(const bf16*)(ws + F_H), WS0 + mls::WS_FD, M, 1024, FF, nullptr}; pg8::StaticOrder S; S.init(M, 1024, F.G, (int)blockIdx.x);
            pg8::EpiResidT<true> E{xo, 1024, XN, (float*)(ws + F_SSQ), xo};
            pg8::gemm_phase<pg8::EpiResidT<true>, pg8::StaticOrder, true, false>(F.lds + RING_OFF, g, S, E, F.wave);
        }
        SEAM(pb + 8);
        if (IN(pb + 10)) _Pragma("unroll") for (int rep_ = 0; rep_ < REPS(10); ++rep_) { PHASE_PTRS;
            pg8::Gemm g{XN, WS0 + mls::WS_AI, M, 3072, 1024, nullptr}; pg8::StaticOrder S; S.init(M, 3072, F.G, (int)blockIdx.x);
            pg8::EpiBf16T<true> E{(bf16*)(ws + F_P), 3072, MK_QSCALE, 4};
            pg8::gemm_phase<pg8::EpiBf16T<true>, pg8::StaticOrder, true, false, true>(F.lds + RING_OFF, g, S, E, F.wave, (const float*)(ws + F_SSQ), (PG8_LAS float*)(F.lds + LDSCTL_OFF + 1024));
        }
        SEAM(pb + 10);
        if (IN(pb + 11)) _Pragma("unroll") for (int rep_ = 0; rep_ < REPS(11); ++rep_) { PHASE_PTRS; MK_ATTENTION }
        SEAM(pb + 11);
        if (IN(pb + 12)) _Pragma("unroll") for (int rep_ = 0; rep_ < REPS(12); ++rep_) { PHASE_PTRS;
            pg8::Gemm g{(const bf16*)(ws + F_O), WS0 + mls::WS_AO, M, 1024, 1024, nullptr}; pg8::StaticOrder S; S.init(M, 1024, F.G, (int)blockIdx.x);
            pg8::EpiResid E{xo, 1024, nullptr, nullptr, xo};
            pg8::gemm_phase<pg8::EpiResid, pg8::StaticOrder, true, false>(F.lds + RING_OFF, g, S, E, F.wave);
        }
        SEAM(pb + 12);
        if (IN(pb + 13)) _Pragma("unroll") for (int rep_ = 0; rep_ < REPS(13); ++rep_) { PHASE_PTRS;
#ifndef MK_CV_FIRST
#define MK_CV_FIRST 0
#endif
            if (F.G != 256 || MK_CV_FIRST != 0) {
            cvt_job(F, KA_IN(25) + (size_t)pr * NE * 1024 * FF, FF, 1024, FF, NE, (size_t)1024 * FF, W0, (size_t)7168 * 1024, 1, 0);
            cvt_job(F, KA_IN(26) + (size_t)pr * NE * 1024 * FF, FF, 1024, FF, NE, (size_t)1024 * FF, W0, (size_t)7168 * 1024, 2, 0);
            cvt_job(F, KA_IN(27) + (size_t)pr * NE * FF * 1024, 1024, FF, 1024, NE, (size_t)FF * 1024, W0 + (size_t)NE * 7168 * 1024, (size_t)1024 * FF, 0, 0); }
            RowJob J{}; J.xsrc = xo; J.nw = KA_IN(22) + pr * 1024; J.XN = XN;
            J.slab = KA_IN(23) + (size_t)pr * 8192; J.slab_ld = 8; J.kind = 2; J.b0 = KA_IN(24) + pr * 8; J.top_e = top_e; J.top_g_out = top_g; J.wg_cnt = slot_tok;
            row_phase(F, J);
        }
        SEAM(pb + 13);
        if (IN(pb + 14)) _Pragma("unroll") for (int rep_ = 0; rep_ < REPS(14); ++rep_) { PHASE_PTRS; assign_phase(F, top_e, slot_tok, tok_slot, blk_e, n_used, XN, Ybuf); }
        SEAM(pb + 14);
        if (IN(pb + 15)) _Pragma("unroll") for (int rep_ = 0; rep_ < REPS(15); ++rep_) { PHASE_PTRS;
            const int nb = __builtin_amdgcn_readfirstlane(*(volatile int*)n_used);
            pg8::Gemm g{Ybuf, W0, nb * 256, 2 * FF, 1024, nullptr}; pg8::GroupOrder S; S.init(nb, 2 * FF / 256, F.G, (int)blockIdx.x, blk_e, (long)7168 * 1024);
            pg8::EpiSwiGLU E{(bf16*)(ws + F_H), FF};
            pg8::gemm_phase<pg8::EpiSwiGLU, pg8::GroupOrder, true, false>(F.lds + RING_OFF, g, S, E, F.wave);
        }
        SEAM(pb + 15);
        if (IN(pb + 16)) _Pragma("unroll") for (int rep_ = 0; rep_ < REPS(16); ++rep_) { PHASE_PTRS;
            const int nb = __builtin_amdgcn_readfirstlane(*(volatile int*)n_used);
            pg8::Gemm g{(const bf16*)(ws + F_H), W0 + (size_t)NE * 7168 * 1024, nb * 256, 1024, FF, nullptr}; pg8::GroupOrder S; S.init(nb, 4, F.G, (int)blockIdx.x, blk_e, (long)1024 * FF);
            pg8::EpiBf16 E{Ybuf, 1024, 1.f, 0};
            pg8::gemm_phase<pg8::EpiBf16, pg8::GroupOrder, true, false>(F.lds + RING_OFF, g, S, E, F.wave);
        }
        SEAM(pb + 16);
    }
    if (IN(PH_FINAL)) { PHASE_PTRS;
        RowJob J{}; J.xsrc = xo; J.nw = KA_IN(28); J.outf = xo; if (!(flags & 2)) { J.Y = Ybuf; J.tok_slot = tok_slot; J.top_g = top_g; }
        row_phase(F, J);
    }
    if (IN(PH_COMBINE)) { PHASE_PTRS;
        const int tid = fresh_tid(F), lane = tid & 63, gw = F.vcu * NWAVES + __builtin_amdgcn_readfirstlane(tid >> 6), NGW = F.G * NWAVES;
        for (int m = gw; m < M; m += NGW) {
            GAS f32x4* xr = (GAS f32x4*)(xo + (size_t)m * D) + lane;
            const int s0 = tok_slot[m * 2], s1 = tok_slot[m * 2 + 1]; const float g0 = top_g[m * 2], g1 = top_g[m * 2 + 1];
            const GAS v2u* y0 = (const GAS v2u*)(Ybuf + (size_t)s0 * D) + lane; const GAS v2u* y1 = (const GAS v2u*)(Ybuf + (size_t)s1 * D) + lane;
#pragma unroll
            for (int j = 0; j < 4; ++j) { f32x4 v = xr[64 * j]; const v2u a = y0[64 * j], b = y1[64 * j];
                v.x += g0 * bf_lo(a.x) + g1 * bf_lo(b.x); v.y += g0 * bf_hi(a.x) + g1 * bf_hi(b.x); v.z += g0 * bf_lo(a.y) + g1 * bf_lo(b.y); v.w += g0 * bf_hi(a.y) + g1 * bf_hi(b.y); xr[64 * j] = v; }
        }
    }
#undef IN
#undef SEAM
}
}
extern "C" void kernel_launch(void* const* d_in, const int* in_sizes, int n_in, void* d_out, int out_size, void* d_ws, size_t ws_size, hipStream_t stream) {
    static int grid = 0;
    if (grid == 0) {
        int dev = 0, cus = 0, per_cu = 0;
        (void)hipGetDevice(&dev); (void)hipDeviceGetAttribute(&cus, hipDeviceAttributeMultiprocessorCount, dev);
        (void)hipFuncSetAttribute((const void*)mk::mk_fwd, hipFuncAttributeMaxDynamicSharedMemorySize, mk::LDS_BYTES);
        (void)hipOccupancyMaxActiveBlocksPerMultiprocessor(&per_cu, (const void*)mk::mk_fwd, mk::NTHR, mk::LDS_BYTES);
        (void)hipGetLastError();
        grid = cus > 0 ? cus : 256;
    }
    mk::Args a{}; for (int i = 0; i < 29; ++i) a.in[i] = (const float*)d_in[i];
    a.out = (float*)d_out; a.ws = (unsigned char*)d_ws; a.ph_lo = 0; a.ph_hi = mk::PH_FINAL + 1; a.li = 0; a.flags = 0;
    (void)hipMemsetAsync((unsigned char*)d_ws + mk::F_CTL, 0, mk::CTL_ZERO_BYTES, stream);
    hipLaunchKernelGGL(mk::mk_fwd, dim3(grid), dim3(mk::NTHR), mk::LDS_BYTES, stream, a);
}
```

```cpp
#include <hip/hip_runtime.h>
#include <cstdio>
#include <cstdint>
#include <cmath>
namespace nv {
__device__ const int BUCKET[128] = {0, 1, 2, 3, 4, 5, 6, 7, 8, 9, 10, 11, 12, 13, 14, 15, 16, 16, 16, 17, 17, 18, 18, 18, 19, 19, 19, 20, 20, 20, 20, 21, 21, 21, 21, 22, 22, 22, 22, 22, 23, 23, 23, 23, 23, 23, 24, 24, 24, 24, 24, 24, 25, 25, 25, 25, 25, 25, 25, 26, 26, 26, 26, 26, 26, 26, 26, 27, 27, 27, 27, 27, 27, 27, 27, 27, 27, 28, 28, 28, 28, 28, 28, 28, 28, 28, 28, 29, 29, 29, 29, 29, 29, 29, 29, 29, 29, 29, 29, 30, 30, 30, 30, 30, 30, 30, 30, 30, 30, 30, 30, 30, 30, 31, 31, 31, 31, 31, 31, 31, 31, 31, 31, 31, 31, 31, 31, 31};
}
namespace pg8 {
#define PG8_LAS __attribute__((address_space(3)))
typedef unsigned short bf16_t;
typedef short bf16x8 __attribute__((ext_vector_type(8)));
typedef float f32x4 __attribute__((ext_vector_type(4)));
typedef float f32x2 __attribute__((ext_vector_type(2)));
typedef unsigned u32x4 __attribute__((ext_vector_type(4)));
#ifndef PG8_WGM
#define PG8_WGM 8
#endif
#ifndef PG8_GWGM
#define PG8_GWGM 8
#endif
#ifndef PG8_GROUP_XCD
#define PG8_GROUP_XCD 1
#endif
constexpr int BM = 256, BK = 64, HALF = 128, HTB = HALF * BK * 2  , STAGE_BYTES = 8 * HTB, NXCD = 8, WGM = PG8_WGM;

__host__ __device__ __forceinline__ int lds_byte(int r, int c) { const int st = (r >> 4) * 2 + (c >> 5), rr = r & 15, cc = c & 31, ob = rr * 64 + cc * 2; return st * 1024 + (ob ^ (((ob >> 9) & 1) << 5)); }
__host__ __device__ __forceinline__ void stage_rc(int b, int& R, int& C) { const int st = b / 1024, sb = b % 1024, swz = sb ^ (((sb >> 9) & 1) << 5); R = (st >> 1) * 16 + swz / 64; C = (st & 1) * 32 + (swz % 64) / 2; }
__host__ __device__ __forceinline__ int perm32(int rho) { const int n = rho >> 4, i = rho & 15; return 8 * (i >> 2) + 4 * n + (i & 3); }

struct Unit { int pm, pn; long boff; long aoff; };
struct Gemm { const bf16_t* A; const bf16_t* Bt; int M, N, K; const int* arow; int arows; int ld; };

struct StaticOrder {
    int nM, nN, nwg, G, c, gw;
    __host__ __device__ void init(int M, int N, int G_, int c_, int gw_ = WGM) { nM = M / BM; nN = N / BM; nwg = nM * nN; G = G_; c = c_; gw = gw_; }
    __host__ __device__ bool next(int i, Unit& u) const {
        const long L = (long)i * G + c; if (L >= nwg) return false;
        int wgid = (int)L; { const int q = nwg / NXCD, r = nwg % NXCD, xcd = wgid % NXCD, off = wgid / NXCD; wgid = (xcd < r ? xcd * (q + 1) : r * (q + 1) + (xcd - r) * q) + off; }
        const int nig = gw * nN, gid = wgid / nig, fm = gid * gw, gsz = (nM - fm) < gw ? (nM - fm) : gw;
        u.pm = fm + ((wgid % nig) % gsz); u.pn = (wgid % nig) / gsz; u.boff = 0; return true;
    }
};
struct GroupOrder {
    int nM, nN, nwg, G, c, gw; const int* blk_e; long wstride;
    __device__ void init(int nM_, int nN_, int G_, int c_, const int* be, long ws, int gw_) { nM = nM_; nN = nN_; nwg = nM * nN; G = G_; c = c_; blk_e = be; wstride = ws; gw = gw_; }
    __device__ bool next(int i, Unit& u) const {
        const long L = (long)i * G + c; if (L >= nwg) return false;
        int wgid = (int)L;
        if (PG8_GROUP_XCD) { const int q = nwg / NXCD, r = nwg % NXCD, xcd = wgid % NXCD, off = wgid / NXCD; wgid = (xcd < r ? xcd * (q + 1) : r * (q + 1) + (xcd - r) * q) + off; }
        const int nig = gw * nN, gid = wgid / nig, fm = gid * gw, gsz = (nM - fm) < gw ? (nM - fm) : gw;
        u.pm = fm + ((wgid % nig) % gsz); u.pn = (wgid % nig) / gsz; u.boff = (long)blk_e[u.pm] * wstride; return true;
    }
};

struct SplitOrder {
    int pm0, nN, ns, kc_len, nwg, G, c; const int* blk_e; long wstride;
    __device__ void init(int pm0_, int nx, int nN_, int ns_, int kc_len_, int G_, int c_, const int* be, long ws) { pm0 = pm0_; nN = nN_; ns = ns_; kc_len = kc_len_; nwg = nx > 0 ? nx * nN_ * ns_ : 0; G = G_; c = c_; blk_e = be; wstride = ws; }
    __device__ bool next(int i, Unit& u) const {
        const long L = (long)i * G + c; if (L >= nwg) return false;
        const int l = (int)L, kc = l % ns, r = l / ns; u.pn = r % nN; u.pm = pm0 + r / nN; u.aoff = (long)kc * kc_len; u.boff = (long)blk_e[u.pm] * wstride + u.aoff; return true;
    }
};

__device__ __forceinline__ unsigned cvt_pk_bf16(float lo, float hi) { unsigned r; asm volatile("v_cvt_pk_bf16_f32 %0, %1, %2" : "=v"(r) : "v"(lo), "v"(hi)); return r; }
__device__ __forceinline__ float silu_f(float v) { return v * __builtin_amdgcn_rcpf(1.0f + __builtin_amdgcn_exp2f(-1.4426950408889634f * v)); }

#ifndef PG8_WT
#define PG8_WT 0
#endif
template <class V> __device__ __forceinline__ void st16(void* p, const V& v) {
#if PG8_WT == 1
    asm volatile("global_store_dwordx4 %0, %1, off sc1\n\ts_nop 1" :: "v"(p), "v"(v) : "memory");
#elif PG8_WT == 2
    asm volatile("global_store_dwordx4 %0, %1, off sc0 sc1\n\ts_nop 1" :: "v"(p), "v"(v) : "memory");
#elif PG8_WT == 3
    asm volatile("global_store_dwordx4 %0, %1, off nt\n\ts_nop 1" :: "v"(p), "v"(v) : "memory");
#else
    *(V*)p = v;
#endif
}
template <bool RSC> struct EpiBf16T {
    static constexpr bool PERM = true;
    bf16_t* O; int ldc; float scale0; int nscaled;
    __device__ __forceinline__ void operator()(const f32x4 (&acc)[2][2][4][2], const Unit& u, int wr, int wc, int fr, int fq, const PG8_LAS float* rs) const {
        const int row0 = u.pm * BM + wr * 64 + fr, col0 = u.pn * BM + wc * 32 + 8 * fq;
        const float sc0 = (u.pn < nscaled) ? scale0 : 1.f;
#pragma unroll
        for (int ai = 0; ai < 2; ++ai)
#pragma unroll
            for (int m = 0; m < 4; ++m) { bf16_t* rowp = O + (size_t)(row0 + ai * HALF + m * 16) * ldc + col0;
                const float sc = RSC ? sc0 * rs[ai * HALF + wr * 64 + m * 16 + fr] : sc0;
#pragma unroll
                for (int bj = 0; bj < 2; ++bj) { const f32x4 v0 = acc[ai][bj][m][0] * sc, v1 = acc[ai][bj][m][1] * sc;
                    u32x4 w; w.x = cvt_pk_bf16(v0[0], v0[1]); w.y = cvt_pk_bf16(v0[2], v0[3]); w.z = cvt_pk_bf16(v1[0], v1[1]); w.w = cvt_pk_bf16(v1[2], v1[3]);
                    st16(rowp + bj * HALF, w); } }
    }
};
typedef EpiBf16T<false> EpiBf16;
struct EpiBf16Part {
    static constexpr bool PERM = true;
    bf16_t* O; int ldc, pm0, prow, kc_len;
    __device__ __forceinline__ void operator()(const f32x4 (&acc)[2][2][4][2], const Unit& u, int wr, int wc, int fr, int fq, const PG8_LAS float*) const {
        const int kc = (int)u.aoff / kc_len, row0 = kc * prow + (u.pm - pm0) * BM + wr * 64 + fr, col0 = u.pn * BM + wc * 32 + 8 * fq;
#pragma unroll
        for (int ai = 0; ai < 2; ++ai)
#pragma unroll
            for (int m = 0; m < 4; ++m) { bf16_t* rowp = O + (size_t)(row0 + ai * HALF + m * 16) * ldc + col0;
#pragma unroll
                for (int bj = 0; bj < 2; ++bj) { const f32x4 v0 = acc[ai][bj][m][0], v1 = acc[ai][bj][m][1];
                    u32x4 w; w.x = cvt_pk_bf16(v0[0], v0[1]); w.y = cvt_pk_bf16(v0[2], v0[3]); w.z = cvt_pk_bf16(v1[0], v1[1]); w.w = cvt_pk_bf16(v1[2], v1[3]);
                    st16(rowp + bj * HALF, w); } }
    }
};
template <bool RSC> struct EpiSwiGLUT {
    static constexpr bool PERM = true;
    bf16_t* O; int ldc;
    __device__ __forceinline__ void operator()(const f32x4 (&acc)[2][2][4][2], const Unit& u, int wr, int wc, int fr, int fq, const PG8_LAS float* rs) const {
        const int row0 = u.pm * BM + wr * 64 + fr, col0 = u.pn * HALF + wc * 32 + 8 * fq;
#pragma unroll
        for (int ai = 0; ai < 2; ++ai)
#pragma unroll
            for (int m = 0; m < 4; ++m) { bf16_t* rowp = O + (size_t)(row0 + ai * HALF + m * 16) * ldc + col0;
                const float rsc = RSC ? rs[ai * HALF + wr * 64 + m * 16 + fr] : 1.f;
                const f32x4 g0 = acc[ai][0][m][0] * rsc, g1 = acc[ai][0][m][1] * rsc, u0 = acc[ai][1][m][0] * rsc, u1 = acc[ai][1][m][1] * rsc;
                u32x4 w; w.x = cvt_pk_bf16(silu_f(g0[0]) * u0[0], silu_f(g0[1]) * u0[1]); w.y = cvt_pk_bf16(silu_f(g0[2]) * u0[2], silu_f(g0[3]) * u0[3]);
                w.z = cvt_pk_bf16(silu_f(g1[0]) * u1[0], silu_f(g1[1]) * u1[1]); w.w = cvt_pk_bf16(silu_f(g1[2]) * u1[2], silu_f(g1[3]) * u1[3]);
                st16(rowp, w); }
    }
};
typedef EpiSwiGLUT<false> EpiSwiGLU;
template <bool XB> struct EpiResidT {
    static constexpr bool PERM = true;
    float* O; int ldc; bf16_t* xb; float* ssq; const float* base;
    __device__ __forceinline__ void operator()(const f32x4 (&acc)[2][2][4][2], const Unit& u, int wr, int wc, int fr, int fq, const PG8_LAS float*) const {
        const int row0 = u.pm * BM + wr * 64 + fr, col0 = u.pn * BM + wc * 32 + 8 * fq, lane = fr + 16 * fq;
#pragma unroll
        for (int ai = 0; ai < 2; ++ai) {
            f32x4 xv[4][2][2];
#pragma unroll
            for (int m = 0; m < 4; ++m) { const float* rowp = base + (size_t)(row0 + ai * HALF + m * 16) * ldc + col0;
#pragma unroll
                for (int bj = 0; bj < 2; ++bj)
#pragma unroll
                    for (int n = 0; n < 2; ++n) xv[m][bj][n] = *(const f32x4*)(rowp + bj * HALF + n * 4); }
#pragma unroll
            for (int m = 0; m < 4; ++m) { float* rowp = O + (size_t)(row0 + ai * HALF + m * 16) * ldc + col0;
#pragma unroll
                for (int bj = 0; bj < 2; ++bj)
#pragma unroll
                    for (int n = 0; n < 2; ++n) { xv[m][bj][n] = xv[m][bj][n] + acc[ai][bj][m][n]; st16(rowp + bj * HALF + n * 4, xv[m][bj][n]); } }
            if (XB) {
#pragma unroll
                for (int m = 0; m < 4; ++m) { const size_t ro = (size_t)(row0 + ai * HALF + m * 16); float sq = 0.f;
#pragma unroll
                    for (int bj = 0; bj < 2; ++bj) { const f32x4 v0 = xv[m][bj][0], v1 = xv[m][bj][1];
                        sq += ((v0[0] * v0[0] + v0[1] * v0[1]) + (v0[2] * v0[2] + v0[3] * v0[3])) + ((v1[0] * v1[0] + v1[1] * v1[1]) + (v1[2] * v1[2] + v1[3] * v1[3]));
                        u32x4 w; w.x = cvt_pk_bf16(v0[0], v0[1]); w.y = cvt_pk_bf16(v0[2], v0[3]); w.z = cvt_pk_bf16(v1[0], v1[1]); w.w = cvt_pk_bf16(v1[2], v1[3]);
                        st16(xb + ro * ldc + col0 + bj * HALF, w); }
                    sq += __builtin_bit_cast(float, __builtin_amdgcn_ds_bpermute((lane ^ 16) << 2, __builtin_bit_cast(int, sq)));
                    sq += __builtin_bit_cast(float, __builtin_amdgcn_ds_bpermute((lane ^ 32) << 2, __builtin_bit_cast(int, sq)));
                    if (fq == 0) ssq[ro * 16 + u.pn * 4 + wc] = sq; }
            }
            asm volatile("" ::: "memory");
        }
    }
};
typedef EpiResidT<false> EpiResid;
template <bool SSQ> struct EpiResidB {
    static constexpr bool PERM = true;
    bf16_t* xb; int ldc; float* ssq;
    __device__ __forceinline__ void operator()(const f32x4 (&acc)[2][2][4][2], const Unit& u, int wr, int wc, int fr, int fq, const PG8_LAS float*) const {
        const int row0 = u.pm * BM + wr * 64 + fr, col0 = u.pn * BM + wc * 32 + 8 * fq, lane = fr + 16 * fq;
        u32x4 xv[2][4][2];
#pragma unroll
        for (int ai = 0; ai < 2; ++ai)
#pragma unroll
            for (int m = 0; m < 4; ++m)
#pragma unroll
                for (int bj = 0; bj < 2; ++bj) xv[ai][m][bj] = *(const u32x4*)(xb + (size_t)(row0 + ai * HALF + m * 16) * ldc + col0 + bj * HALF);
#pragma unroll
        for (int ai = 0; ai < 2; ++ai) {
#pragma unroll
            for (int m = 0; m < 4; ++m) { const size_t ro = (size_t)(row0 + ai * HALF + m * 16); float sq = 0.f;
#pragma unroll
                for (int bj = 0; bj < 2; ++bj) { const u32x4 r = xv[ai][m][bj]; const f32x4 a0 = acc[ai][bj][m][0], a1 = acc[ai][bj][m][1];
                    const float v0 = __builtin_bit_cast(float, r.x << 16) + a0[0], v1 = __builtin_bit_cast(float, r.x & 0xffff0000u) + a0[1];
                    const float v2 = __builtin_bit_cast(float, r.y << 16) + a0[2], v3 = __builtin_bit_cast(float, r.y & 0xffff0000u) + a0[3];
                    const float v4 = __builtin_bit_cast(float, r.z << 16) + a1[0], v5 = __builtin_bit_cast(float, r.z & 0xffff0000u) + a1[1];
                    const float v6 = __builtin_bit_cast(float, r.w << 16) + a1[2], v7 = __builtin_bit_cast(float, r.w & 0xffff0000u) + a1[3];
                    if (SSQ) sq += ((v0 * v0 + v1 * v1) + (v2 * v2 + v3 * v3)) + ((v4 * v4 + v5 * v5) + (v6 * v6 + v7 * v7));
                    u32x4 w; w.x = cvt_pk_bf16(v0, v1); w.y = cvt_pk_bf16(v2, v3); w.z = cvt_pk_bf16(v4, v5); w.w = cvt_pk_bf16(v6, v7);
                    st16(xb + ro * ldc + col0 + bj * HALF, w); }
                if (SSQ) {
                    sq += __builtin_bit_cast(float, __builtin_amdgcn_ds_bpermute((lane ^ 16) << 2, __builtin_bit_cast(int, sq)));
                    sq += __builtin_bit_cast(float, __builtin_amdgcn_ds_bpermute((lane ^ 32) << 2, __builtin_bit_cast(int, sq)));
                    if (fq == 0) ssq[ro * 16 + u.pn * 4 + wc] = sq; }
            }
        }
    }
};

template <class Epi, class Sched, bool ALIGN_EPI, bool GATHER, bool RS = false, bool SPLITK = false>
__device__ __forceinline__ void gemm_phase(PG8_LAS unsigned char* lds, const Gemm g, const Sched& S, const Epi& E, int wave_id, const float* ssq = nullptr, PG8_LAS float* rtab = nullptr, PG8_LAS int* gtab = nullptr) {
    int tid_; asm volatile("v_mbcnt_lo_u32_b32 %0, -1, 0\n\tv_mbcnt_hi_u32_b32 %0, -1, %0" : "=v"(tid_)); tid_ += wave_id * 64;
    const int tid = tid_, wid = __builtin_amdgcn_readfirstlane(tid >> 6), lane = tid & 63, wr = wid >> 2, wc = wid & 3, fr = lane & 15, fq = lane >> 4;
    const int K = g.K, nt = K / BK, LD = SPLITK ? g.ld : g.K;
    unsigned voffA[2], voffB[2]; int rA[2], cA2[2];
#pragma unroll
    for (int i = 0; i < 2; ++i) { int R, C; stage_rc(tid * 16 + i * 8192, R, C); const int Rb = Epi::PERM ? ((R & ~31) + perm32(R & 31)) : R;
        voffA[i] = (unsigned)(R * LD + C) * 2u; voffB[i] = (unsigned)(Rb * LD + C) * 2u; rA[i] = R; cA2[i] = C * 2; }
    const size_t kstep = (size_t)(BK * 2);
    const size_t hstep = (size_t)HALF * LD * 2;
    const size_t tstep = 2 * hstep;
    const unsigned ldsw = (unsigned)wid * 1024u;
    const int aoff = lds_byte(wr * 64 + fr, fq * 8), boff = lds_byte(wc * 32 + fr, fq * 8);
#define PG8_SA(b, h) (((b) * 2 + (h)) * HTB)
#define PG8_SB(b, h) ((4 + (b) * 2 + (h)) * HTB)
#define PG8_STAGE2(bufoff, gbase, v0, v1) do { \
        __builtin_amdgcn_global_load_lds((const unsigned*)((const char*)(gbase) + (v0)), (PG8_LAS unsigned*)(lds + (bufoff) + ldsw), 16, 0, 0); \
        __builtin_amdgcn_global_load_lds((const unsigned*)((const char*)(gbase) + (v1)), (PG8_LAS unsigned*)(lds + (bufoff) + ldsw + 8192), 16, 0, 0); } while (0)
#define PG8_STAGEB(bufoff, gbase) PG8_STAGE2(bufoff, gbase, voffB[0], voffB[1])
#define PG8_LDA(dst, b, h) do { _Pragma("unroll") for (int m = 0; m < 4; ++m) _Pragma("unroll") for (int k = 0; k < 2; ++k) dst[m][k] = *(const PG8_LAS bf16x8*)(lds + PG8_SA(b, h) + aoff + m * 2048 + k * 1024); } while (0)
#define PG8_LDB(dst, b, h) do { _Pragma("unroll") for (int n = 0; n < 2; ++n) _Pragma("unroll") for (int k = 0; k < 2; ++k) dst[n][k] = *(const PG8_LAS bf16x8*)(lds + PG8_SB(b, h) + boff + n * 2048 + k * 1024); } while (0)
#define PG8_MMA(ai, bj, At, Bt) do { __builtin_amdgcn_s_setprio(1); _Pragma("unroll") for (int m = 0; m < 4; ++m) _Pragma("unroll") for (int n = 0; n < 2; ++n) _Pragma("unroll") for (int k = 0; k < 2; ++k) \
        acc[ai][bj][m][n] = __builtin_amdgcn_mfma_f32_16x16x32_bf16(Bt[n][k], At[m][k], acc[ai][bj][m][n], 0, 0, 0); __builtin_amdgcn_s_setprio(0); } while (0)
#define PG8_WAIT_V(n) asm volatile("s_waitcnt vmcnt(" #n ")" ::: "memory")
#define PG8_WAIT_L(n) asm volatile("s_waitcnt lgkmcnt(" #n ")" ::: "memory")
#define PG8_BAR __builtin_amdgcn_s_barrier()
#define PG8_SCHED __builtin_amdgcn_sched_barrier(0)
    Unit cur, nxt; int ui = 0;
    if (!S.next(0, cur)) return;
    f32x4 acc[2][2][4][2];
#pragma unroll
    for (int a = 0; a < 2; ++a)
#pragma unroll
        for (int b = 0; b < 2; ++b)
#pragma unroll
            for (int m = 0; m < 4; ++m)
#pragma unroll
                for (int n = 0; n < 2; ++n) acc[a][b][m][n] = (f32x4){0.f, 0.f, 0.f, 0.f};
    bf16x8 At[4][2], B0[2][2], B1[2][2];
    unsigned c00, c01, c10, c11, n00, n01, n10, n11;
    const char* cA; const char* cB = (const char*)g.Bt + (size_t)cur.boff * 2 + (size_t)cur.pn * tstep;
    if constexpr (GATHER) {
        cA = (const char*)g.A;
        const int* ar = g.arow + cur.pm * BM;
        int t00 = ar[rA[0]], t01 = ar[rA[1]], t10 = ar[HALF + rA[0]], t11 = ar[HALF + rA[1]];
        t00 = (unsigned)t00 >= (unsigned)g.arows ? 0 : t00; t01 = (unsigned)t01 >= (unsigned)g.arows ? 0 : t01; t10 = (unsigned)t10 >= (unsigned)g.arows ? 0 : t10; t11 = (unsigned)t11 >= (unsigned)g.arows ? 0 : t11;
        c00 = (unsigned)t00 * (unsigned)(K * 2) + cA2[0]; c01 = (unsigned)t01 * (unsigned)(K * 2) + cA2[1]; c10 = (unsigned)t10 * (unsigned)(K * 2) + cA2[0]; c11 = (unsigned)t11 * (unsigned)(K * 2) + cA2[1];
    } else {
        cA = (const char*)g.A + (size_t)cur.pm * tstep + (SPLITK ? (size_t)cur.aoff * 2 : (size_t)0);
        c00 = voffA[0]; c01 = voffA[1]; c10 = voffA[0]; c11 = voffA[1];
    }
    const size_t HS = GATHER ? (size_t)0 : hstep;
    n00 = c00; n01 = c01; n10 = c10; n11 = c11;
    f32x4 rsld[4];
    if constexpr (RS) { if (wr == 0) { const f32x4* sp = (const f32x4*)(ssq + ((size_t)cur.pm * BM + tid) * 16); const f32x4 a = sp[0], b = sp[1], c = sp[2], d = sp[3];
            const f32x4 t = (a + b) + (c + d); rtab[tid] = 1.0f / sqrtf(((t[0] + t[1]) + (t[2] + t[3])) * (1.0f / 1024.0f) + 1e-6f); } }
    PG8_STAGEB(PG8_SB(0, 0), cB); PG8_STAGEB(PG8_SB(0, 1), cB + hstep); PG8_STAGE2(PG8_SA(0, 0), cA, c00, c01); PG8_STAGE2(PG8_SA(0, 1), cA + HS, c10, c11);
    if (wr == 1) PG8_BAR;
    PG8_WAIT_V(2); PG8_BAR;
    PG8_STAGEB(PG8_SB(1, 0), cB + kstep); PG8_STAGE2(PG8_SA(1, 0), cA + kstep, c00, c01); PG8_STAGEB(PG8_SB(1, 1), cB + hstep + kstep);
    PG8_WAIT_V(6); PG8_BAR;
    for (;;) {
        const bool has_next = S.next(ui + 1, nxt);
        const char* nA; const char* nB = has_next ? (const char*)g.Bt + (size_t)nxt.boff * 2 + (size_t)nxt.pn * tstep : cB;
        if constexpr (GATHER) {
            nA = cA;
            if (has_next && wid < 4)
                __builtin_amdgcn_global_load_lds((const unsigned*)(g.arow + nxt.pm * BM + tid), (PG8_LAS unsigned*)(gtab + ((ui + 1) & 1) * 256 + wid * 64), 4, 0, 0);
        } else {
            nA = has_next ? (const char*)g.A + (size_t)nxt.pm * tstep + (SPLITK ? (size_t)nxt.aoff * 2 : (size_t)0) : cA;
        }
        if constexpr (RS) { if (has_next && wr == 0) { const f32x4* sp = (const f32x4*)(ssq + ((size_t)nxt.pm * BM + tid) * 16); rsld[0] = sp[0]; rsld[1] = sp[1]; rsld[2] = sp[2]; rsld[3] = sp[3]; } }
        for (int t = 0; t < nt; t += 2) {
            const bool last = (t == nt - 2);
            const char* a1 = cA + (size_t)(t + 1) * kstep;
            const char* a2 = last ? nA : cA + (size_t)(t + 2) * kstep; const char* b2 = last ? nB : cB + (size_t)(t + 2) * kstep;
            const char* a3 = a2 + kstep; const char* b3 = b2 + kstep;
            unsigned x00 = c00, x01 = c01, x10 = c10, x11 = c11;
            if constexpr (GATHER) { if (last) {
                if (has_next) { const unsigned gb = (unsigned)(__SIZE_TYPE__)(gtab + ((ui + 1) & 1) * 256); int t00, t01, t10, t11;
                    asm volatile("ds_read_b32 %0, %4\n\tds_read_b32 %1, %5\n\tds_read_b32 %2, %4 offset:512\n\tds_read_b32 %3, %5 offset:512\n\ts_waitcnt lgkmcnt(0)"
                                 : "=&v"(t00), "=&v"(t01), "=&v"(t10), "=&v"(t11) : "v"(gb + 4u * (unsigned)rA[0]), "v"(gb + 4u * (unsigned)rA[1]) : "memory");
                    t00 = (unsigned)t00 >= (unsigned)g.arows ? 0 : t00; t01 = (unsigned)t01 >= (unsigned)g.arows ? 0 : t01; t10 = (unsigned)t10 >= (unsigned)g.arows ? 0 : t10; t11 = (unsigned)t11 >= (unsigned)g.arows ? 0 : t11;
                    n00 = (unsigned)t00 * (unsigned)(K * 2) + cA2[0]; n01 = (unsigned)t01 * (unsigned)(K * 2) + cA2[1]; n10 = (unsigned)t10 * (unsigned)(K * 2) + cA2[0]; n11 = (unsigned)t11 * (unsigned)(K * 2) + cA2[1]; }
                x00 = n00; x01 = n01; x10 = n10; x11 = n11; } }
            PG8_LDB(B0, 0, 0); PG8_LDB(B1, 0, 1); PG8_SCHED; PG8_LDA(At, 0, 0); PG8_STAGE2(PG8_SA(1, 1), a1 + HS, c10, c11);
            PG8_WAIT_V(8); PG8_WAIT_L(0); PG8_BAR; PG8_MMA(0, 0, At, B0); PG8_MMA(0, 1, At, B1); PG8_BAR; PG8_SCHED;
            PG8_LDA(At, 0, 1); PG8_STAGEB(PG8_SB(0, 0), b2); PG8_STAGEB(PG8_SB(0, 1), b2 + hstep); PG8_STAGE2(PG8_SA(0, 0), a2, x00, x01);
            PG8_WAIT_V(8); PG8_WAIT_L(0); PG8_BAR; PG8_MMA(1, 0, At, B0); PG8_MMA(1, 1, At, B1); PG8_BAR; PG8_SCHED;
            PG8_LDB(B0, 1, 0); PG8_LDB(B1, 1, 1); PG8_SCHED; PG8_LDA(At, 1, 0); PG8_STAGE2(PG8_SA(0, 1), a2 + HS, x10, x11);
            PG8_WAIT_V(8); PG8_WAIT_L(0); PG8_BAR; PG8_MMA(0, 0, At, B0); PG8_MMA(0, 1, At, B1); PG8_BAR; PG8_SCHED;
            PG8_LDA(At, 1, 1); PG8_STAGEB(PG8_SB(1, 0), b3); PG8_STAGEB(PG8_SB(1, 1), b3 + hstep); PG8_STAGE2(PG8_SA(1, 0), a3, x00, x01);
            PG8_WAIT_V(8); PG8_WAIT_L(0); PG8_BAR; PG8_MMA(1, 0, At, B0); PG8_MMA(1, 1, At, B1); PG8_BAR; PG8_SCHED;
        }
        if constexpr (ALIGN_EPI) { if (wr == 0) PG8_BAR; }
        if constexpr (RS) { if (has_next && wr == 0) { const f32x4 t = (rsld[0] + rsld[1]) + (rsld[2] + rsld[3]); rtab[((ui + 1) & 1) * 256 + tid] = 1.0f / sqrtf(((t[0] + t[1]) + (t[2] + t[3])) * (1.0f / 1024.0f) + 1e-6f); } }
        E(acc, cur, wr, wc, fr, fq, RS ? rtab + (ui & 1) * 256 : (PG8_LAS float*)nullptr);
        if (!has_next) break;
#pragma unroll
        for (int a = 0; a < 2; ++a)
#pragma unroll
            for (int b = 0; b < 2; ++b)
#pragma unroll
                for (int m = 0; m < 4; ++m)
#pragma unroll
                    for (int n = 0; n < 2; ++n) acc[a][b][m][n] = (f32x4){0.f, 0.f, 0.f, 0.f};
        cur = nxt; cA = nA; cB = nB; ++ui;
        c00 = n00; c01 = n01; c10 = n10; c11 = n11;
        if constexpr (ALIGN_EPI) { if (wr == 1) PG8_BAR; }
    }
    PG8_WAIT_V(0);
    if constexpr (!ALIGN_EPI) { if (wr == 0) PG8_BAR; }
    PG8_BAR;
#undef PG8_SA
#undef PG8_SB
#undef PG8_STAGE2
#undef PG8_STAGEB
#undef PG8_LDA
#undef PG8_LDB
#undef PG8_MMA
#undef PG8_WAIT_V
#undef PG8_WAIT_L
#undef PG8_BAR
#undef PG8_SCHED
}
}
namespace mk {
constexpr int NWAVES = 8, NTHR = 512;
constexpr int B = 8, S = 4096, D = 1024, M = B * S;
constexpr int FF = 3584, NE = 8, NBLK = 264, NSLOT = NBLK * 256;
constexpr size_t MiB = 1u << 20;
constexpr size_t F_CTL = 0, CTL_ZERO_BYTES = 1 * MiB;
constexpr size_t F_TOPE = 1 * MiB, F_TOPG = F_TOPE + 256 * 1024, F_SLOTTOK = F_TOPG + 256 * 1024, F_TOKSLOT = F_SLOTTOK + 320 * 1024, F_BLKE = F_TOKSLOT + 256 * 1024, F_NUSED = F_BLKE + 2048;
constexpr size_t F_LI = 3 * MiB, F_LF = 3 * MiB + 512 * 1024;
constexpr size_t F_W = 4 * MiB, F_WS = 172 * MiB, F_XN = 212 * MiB, F_BIG = 276 * MiB;
constexpr size_t F_P = F_BIG, F_HH = 468 * MiB, F_G = 596 * MiB, F_QKC = 660 * MiB;
constexpr size_t F_YP = F_WS + 9 * MiB;
constexpr int YP_SLOT0 = 65536, YP_ROWS = 2048, YP_NS = 7, YP_KC = 512;
constexpr size_t F_H = F_BIG;
constexpr size_t F_O = 468 * MiB, F_OT = 532 * MiB;
constexpr size_t F_Y = 738 * MiB, F_SSQ = 870 * MiB, F_GB = 872 * MiB;
static_assert(F_NUSED + 64 <= 3 * MiB && F_H + (size_t)NSLOT * FF * 2 <= F_Y && F_Y + (size_t)NSLOT * 1024 * 2 <= 872 * MiB, "ws map");
constexpr int CW_TMO = 0, CW_BAR = 4096, CW_GRP = 150016, CW_YP = 160000;
constexpr int MAX_LAUNCH = 40;
static_assert(CW_BAR + MAX_LAUNCH * 3456 <= CW_GRP && (CW_GRP + 64 * 64) * 4 <= (int)CTL_ZERO_BYTES, "ctl words");
constexpr int RING_OFF = 0, RING_BYTES = 131072, LDSCTL_OFF = RING_BYTES, MISC_OFF = LDSCTL_OFF + 320, LDS_BYTES = 147456;

#define GAS __attribute__((address_space(1)))
#define LAS __attribute__((address_space(3)))
typedef unsigned short bf16;
typedef unsigned v4u __attribute__((ext_vector_type(4)));
typedef unsigned v2u __attribute__((ext_vector_type(2)));
typedef float f32x4 __attribute__((ext_vector_type(4)));
typedef GAS unsigned gu32;
#define RLX_AGENT __ATOMIC_RELAXED, __HIP_MEMORY_SCOPE_AGENT
#define LDS_WAIT() asm volatile("s_waitcnt lgkmcnt(0)" ::: "memory")
#define VM_WAIT() asm volatile("s_waitcnt vmcnt(0)" ::: "memory")
__device__ __forceinline__ unsigned f2bf(float f) { unsigned u = __builtin_bit_cast(unsigned, f); return (u + 0x7fffu + ((u >> 16) & 1u)) >> 16; }
__device__ __forceinline__ unsigned pk2(float lo, float hi) { return f2bf(lo) | (f2bf(hi) << 16); }
__device__ __forceinline__ float bf_lo(unsigned w) { return __builtin_bit_cast(float, w << 16); }
__device__ __forceinline__ float bf_hi(unsigned w) { return __builtin_bit_cast(float, w & 0xffff0000u); }

#define XB_TMO      128
#define XB_XCNT(j)  (256  + 64 * (j))
#define XB_XSUB(j)  (1280 + 64 * (j))
#define XB_XGEN(j)  (2304 + 64 * (j))
#define XB_TOP      3328
#define XB_TOPGEN   3392
#define XCD_BAR_WORDS 3456
#define XB_SPIN_CAP (1u << 18)
__device__ __forceinline__ unsigned xb_ld(unsigned* p)              { return __hip_atomic_load(p, __ATOMIC_RELAXED, __HIP_MEMORY_SCOPE_AGENT); }
__device__ __forceinline__ unsigned xb_add(unsigned* p, unsigned v) { return __hip_atomic_fetch_add(p, v, __ATOMIC_RELAXED, __HIP_MEMORY_SCOPE_AGENT); }
__device__ __forceinline__ unsigned xb_xcc_id() { return (unsigned)__builtin_amdgcn_s_getreg((3 << 11) | 20) & 0xFu; }
#define XB_SPIN(cond, bar) do { unsigned _sp = 0; while (cond) { __builtin_amdgcn_s_sleep(1); \
    if ((++_sp & 255u) == 0u) { if (xb_ld(&(bar)[XB_TMO])) break; if (_sp > XB_SPIN_CAP) { atomicAdd(&(bar)[XB_TMO], 1u); break; } } } } while (0)
struct XcdBarrier { unsigned* bar; unsigned x; volatile LAS unsigned* st; };
__device__ __forceinline__ XcdBarrier xcd_barrier_post(unsigned* bar, volatile LAS unsigned* st, bool t0) {
    XcdBarrier b; b.bar = bar; b.x = xb_xcc_id(); b.st = st;
    if (t0) (void)xb_add(&bar[XB_XCNT(b.x)], 1u);
    return b;
}
__device__ __forceinline__ void xcd_barrier_complete(unsigned* bar, unsigned x, unsigned& nloc, unsigned& nx) {
    const unsigned G = gridDim.x * gridDim.y * gridDim.z;
    unsigned sum, cnt, mine, sp = 0u;
    for (;;) {
        sum = 0u; cnt = 0u; mine = 0u;
#pragma unroll
        for (unsigned j = 0; j < 16; ++j) { const unsigned c = xb_ld(&bar[XB_XCNT(j)]); sum += c; cnt += (c > 0u) ? 1u : 0u; mine = (j == x) ? c : mine; }
        if (sum == G) break;
        __builtin_amdgcn_s_sleep(1);
        if ((++sp & 255u) == 0u) { if (xb_ld(&bar[XB_TMO])) break; if (sp > XB_SPIN_CAP) { atomicAdd(&bar[XB_TMO], 1u); break; } }
    }
    nloc = mine > 0u ? mine : 1u; nx = cnt > 0u ? cnt : 1u;
}
__device__ __forceinline__ void xcd_barrier(const XcdBarrier& b, bool t0) {
    asm volatile("s_waitcnt vmcnt(0)" ::: "memory");
    __syncthreads();
    if (t0) {
        unsigned* bar = b.bar;
        __builtin_amdgcn_s_waitcnt(0);
        unsigned nloc = b.st[0], nx = b.st[1];
        if (nloc == 0u) { xcd_barrier_complete(bar, b.x, nloc, nx); b.st[0] = nloc; b.st[1] = nx; }
#if defined(MK_EARLY_WB)
        __builtin_amdgcn_fence(__ATOMIC_RELEASE, "agent"); asm volatile("s_waitcnt vmcnt(0)" ::: "memory");
#endif
        const unsigned old = xb_add(&bar[XB_XSUB(b.x)], 1u);
        const unsigned gen = old / nloc;
        if (old + 1u == (gen + 1u) * nloc) {
            __builtin_amdgcn_fence(__ATOMIC_RELEASE, "agent");
            asm volatile("s_waitcnt vmcnt(0)" ::: "memory");
            const unsigned og = xb_add(&bar[XB_TOP], 1u);
            const unsigned tg = og / nx;
            if (og + 1u != (tg + 1u) * nx) XB_SPIN(xb_ld(&bar[XB_TOP]) < (tg + 1u) * nx, bar);
            xb_add(&bar[XB_XGEN(b.x)], 1u);
            __builtin_amdgcn_fence(__ATOMIC_ACQUIRE, "agent");
            asm volatile("s_waitcnt vmcnt(0)" ::: "memory");
        } else {
            XB_SPIN(xb_ld(&bar[XB_XGEN(b.x)]) == gen, bar);
            __builtin_amdgcn_fence(__ATOMIC_ACQUIRE, "agent");
            asm volatile("s_waitcnt vmcnt(0)" ::: "memory");
        }
    }
    __syncthreads();
}

struct Frame {
    LAS unsigned char* lds;
    int vcu, G, wave;
};
__device__ __forceinline__ int lane_id() { int l; asm volatile("v_mbcnt_lo_u32_b32 %0, -1, 0\n\tv_mbcnt_hi_u32_b32 %0, -1, %0" : "=v"(l)); return l; }
__device__ __forceinline__ int fresh_tid(const Frame& F) { return F.wave * 64 + lane_id(); }
__device__ __forceinline__ float shfl_idx(float v, int src_lane) { return __builtin_bit_cast(float, __builtin_amdgcn_ds_bpermute(src_lane << 2, __builtin_bit_cast(int, v))); }
__device__ __forceinline__ int shfl_idx_i(int v, int src_lane) { return __builtin_amdgcn_ds_bpermute(src_lane << 2, v); }
__device__ __forceinline__ float wave_sum(float v, int lane) {
#pragma unroll
    for (int o = 1; o < 64; o <<= 1) v += shfl_idx(v, lane ^ o);
    return v;
}

__device__ __forceinline__ void cvt_item(const float* W, int ldw, int K, bf16* WT, int drow0, LAS float* scr, int k0, int n0, int lane) {
#pragma unroll 8
    for (int i = 0; i < 32; ++i) { const int kk = 2 * i + (lane >> 5); scr[kk * 33 + (lane & 31)] = W[(size_t)(k0 + kk) * ldw + n0 + (lane & 31)]; }
    LDS_WAIT(); asm volatile("" ::: "memory");
    const int c = lane & 7;
#pragma unroll
    for (int j = 0; j < 4; ++j) { const int n = (lane >> 3) + 8 * j; const LAS float* s = scr + (8 * c) * 33 + n;
        v4u o; o.x = pk2(s[0 * 33], s[1 * 33]); o.y = pk2(s[2 * 33], s[3 * 33]); o.z = pk2(s[4 * 33], s[5 * 33]); o.w = pk2(s[6 * 33], s[7 * 33]);
        *(GAS v4u*)(WT + (size_t)(drow0 + n) * K + k0 + 8 * c) = o; }
    LDS_WAIT(); asm volatile("" ::: "memory");
}
__device__ __forceinline__ void cvt_job(Frame& F, const float* W, int ldw, int K, int N, int nmat, size_t smat, bf16* WT, size_t dmat, int mode, int rot) {
    const int tid = fresh_tid(F), lane = tid & 63, wave = __builtin_amdgcn_readfirstlane(tid >> 6);
    LAS float* scr = (LAS float*)(F.lds + RING_OFF + wave * 8448);
    const int NGW = F.G * NWAVES; const int gw = (F.vcu * NWAVES + wave + rot) % NGW;
    const int nblk = N / 32, per = (K / 64) * nblk, total = per * nmat;
    for (int it = gw; it < total; it += NGW) {
        const int mat = it / per, r = it % per, kb = r / nblk, nb = r % nblk, n0 = 32 * nb;
        const int drow0 = mode == 0 ? n0 : ((n0 >> 7) * 256 + (n0 & 127) + (mode == 2 ? 128 : 0));
        cvt_item(W + (size_t)mat * smat, ldw, K, WT + (size_t)mat * dmat, drow0, scr, 64 * kb, n0, lane);
    }
}

constexpr int SLAB_OFF_ = 73728;
constexpr int SLAB_OFF = SLAB_OFF_;
struct RowJob {
    const float* xsrc;
    const bf16* xbsrc; bf16* xbdst;
    const float* nw;
    bf16* XN; float* outf;
    const bf16* Y; const int* tok_slot; const float* top_g;
    const float* slab; int slab_ld;
    int kind;
    const float* b0; const float* b1; float* LI; float* LF; int* top_e; float* top_g_out; int* wg_cnt;
};
constexpr int EREC_OFF = SLAB_OFF_ + 32768;

__device__ __forceinline__ void row_phase(Frame& F, const RowJob& J) {
    LAS float* slab = (LAS float*)(F.lds + SLAB_OFF);
    const int tid = fresh_tid(F), lane = tid & 63, wave = __builtin_amdgcn_readfirstlane(tid >> 6);
    if (J.slab) { float sv[16];
#pragma unroll
        for (int q = 0; q < 16; ++q) { const int i = tid + q * NTHR; sv[q] = J.slab[(size_t)(i >> 3) * J.slab_ld + (i & 7)]; }
#pragma unroll
        for (int q = 0; q < 16; ++q) { const int i = tid + q * NTHR, k = i >> 3, e = i & 7, kk = ((k >> 8) * 4 + (k & 3)) * 64 + ((k & 255) >> 2);
            slab[(e >> 2) * 4096 + kk * 4 + (e & 3)] = sv[q]; } }
    __syncthreads();
    LAS int* erec = (LAS int*)(F.lds + EREC_OFF);
    const int rpw = M / (F.G * NWAVES), m0 = (F.vcu * NWAVES + wave) * rpw;
    f32x4 nx[4]; v2u nxb[4], nya[4], nyb[4]; float ng0 = 0.f, ng1 = 0.f;
    {
        if (J.xsrc) { const GAS f32x4* xr = (const GAS f32x4*)(J.xsrc + (size_t)m0 * D) + lane;
#pragma unroll
            for (int j = 0; j < 4; ++j) nx[j] = xr[64 * j]; }
        else { const GAS v2u* xr = (const GAS v2u*)(J.xbsrc + (size_t)m0 * D) + lane;
#pragma unroll
            for (int j = 0; j < 4; ++j) nxb[j] = xr[64 * j]; }
        if (J.Y) { const int s0 = J.tok_slot[m0 * 2], s1 = J.tok_slot[m0 * 2 + 1]; ng0 = J.top_g[m0 * 2]; ng1 = J.top_g[m0 * 2 + 1];
            const GAS v2u* y0 = (const GAS v2u*)(J.Y + (size_t)s0 * D) + lane; const GAS v2u* y1 = (const GAS v2u*)(J.Y + (size_t)s1 * D) + lane;
#pragma unroll
            for (int j = 0; j < 4; ++j) { nya[j] = y0[64 * j]; nyb[j] = y1[64 * j]; } }
    }
    for (int m = m0; m < m0 + rpw; ++m) {
        f32x4 v[4]; v2u ya[4], yb[4]; const float g0 = ng0, g1 = ng1;
#pragma unroll
        for (int j = 0; j < 4; ++j) { ya[j] = nya[j]; yb[j] = nyb[j];
            if (J.xsrc) v[j] = nx[j];
            else { const v2u r = nxb[j]; v[j].x = bf_lo(r.x); v[j].y = bf_hi(r.x); v[j].z = bf_lo(r.y); v[j].w = bf_hi(r.y); } }
        if (m + 1 < m0 + rpw) {
            if (J.xsrc) { const GAS f32x4* xr = (const GAS f32x4*)(J.xsrc + (size_t)(m + 1) * D) + lane;
#pragma unroll
                for (int j = 0; j < 4; ++j) nx[j] = xr[64 * j]; }
            else { const GAS v2u* xr = (const GAS v2u*)(J.xbsrc + (size_t)(m + 1) * D) + lane;
#pragma unroll
                for (int j = 0; j < 4; ++j) nxb[j] = xr[64 * j]; }
            if (J.Y) { const int s0 = J.tok_slot[(m + 1) * 2], s1 = J.tok_slot[(m + 1) * 2 + 1]; ng0 = J.top_g[(m + 1) * 2]; ng1 = J.top_g[(m + 1) * 2 + 1];
                const GAS v2u* y0 = (const GAS v2u*)(J.Y + (size_t)s0 * D) + lane; const GAS v2u* y1 = (const GAS v2u*)(J.Y + (size_t)s1 * D) + lane;
#pragma unroll
                for (int j = 0; j < 4; ++j) { nya[j] = y0[64 * j]; nyb[j] = y1[64 * j]; } }
        }
        if (J.Y) {
#pragma unroll
            for (int j = 0; j < 4; ++j) { const v2u a = ya[j], b = yb[j];
                v[j].x += g0 * bf_lo(a.x) + g1 * bf_lo(b.x); v[j].y += g0 * bf_hi(a.x) + g1 * bf_hi(b.x); v[j].z += g0 * bf_lo(a.y) + g1 * bf_lo(b.y); v[j].w += g0 * bf_hi(a.y) + g1 * bf_hi(b.y); }
        }
        if (J.xbdst) { GAS v2u* xo = (GAS v2u*)(J.xbdst + (size_t)m * D) + lane;
#pragma unroll
            for (int j = 0; j < 4; ++j) { v2u w; w.x = pk2(v[j].x, v[j].y); w.y = pk2(v[j].z, v[j].w); xo[64 * j] = w; } }
        float ss = 0.f;
#pragma unroll
        for (int j = 0; j < 4; ++j) ss += (v[j].x * v[j].x + v[j].y * v[j].y) + (v[j].z * v[j].z + v[j].w * v[j].w);
#pragma unroll
        for (int j = 0; j < 4; ++j) v[j] = v[j] * ((const GAS f32x4*)J.nw)[lane + 64 * j];
        float a1 = 0.f;
        if (J.slab) {
            float acc[8];
#pragma unroll
            for (int e = 0; e < 8; ++e) acc[e] = 0.f;
#pragma unroll
            for (int j = 0; j < 4; ++j)
#pragma unroll
                for (int i = 0; i < 4; ++i) { const int kk = (4 * j + i) * 64 + lane; const float xv = v[j][i];
                    const f32x4 w0 = *(const LAS f32x4*)(slab + kk * 4), w1 = *(const LAS f32x4*)(slab + 4096 + kk * 4);
                    acc[0] += xv * w0.x; acc[1] += xv * w0.y; acc[2] += xv * w0.z; acc[3] += xv * w0.w; acc[4] += xv * w1.x; acc[5] += xv * w1.y; acc[6] += xv * w1.z; acc[7] += xv * w1.w; }
            const bool h5 = (lane & 32) != 0, h4 = (lane & 16) != 0, h3 = (lane & 8) != 0;
            float a4[4], a2[2];
#pragma unroll
            for (int i = 0; i < 4; ++i) { const float send = h5 ? acc[i] : acc[i + 4], keep = h5 ? acc[i + 4] : acc[i]; a4[i] = keep + shfl_idx(send, lane ^ 32); }
#pragma unroll
            for (int i = 0; i < 2; ++i) { const float send = h4 ? a4[i] : a4[i + 2], keep = h4 ? a4[i + 2] : a4[i]; a2[i] = keep + shfl_idx(send, lane ^ 16); }
            { const float send = h3 ? a2[0] : a2[1], keep = h3 ? a2[1] : a2[0]; a1 = keep + shfl_idx(send, lane ^ 8); }
            a1 += shfl_idx(a1, lane ^ 1); a1 += shfl_idx(a1, lane ^ 2); a1 += shfl_idx(a1, lane ^ 4);
        }
        const float sst = wave_sum(ss, lane);
        const float rstd = 1.0f / sqrtf(sst * (1.f / D) + 1e-6f);
#pragma unroll
        for (int j = 0; j < 4; ++j) v[j] = v[j] * rstd;
        if (J.outf) { GAS f32x4* o = (GAS f32x4*)(J.outf + (size_t)m * D) + lane;
#pragma unroll
            for (int j = 0; j < 4; ++j) o[64 * j] = v[j]; }
        if (J.XN) { GAS v2u* o = (GAS v2u*)(J.XN + (size_t)m * D) + lane;
#pragma unroll
            for (int j = 0; j < 4; ++j) { v2u w; w.x = pk2(v[j].x, v[j].y); w.y = pk2(v[j].z, v[j].w); o[64 * j] = w; } }
        if (J.slab) {
            a1 *= rstd;
            if (J.kind == 1) {
                if ((lane & 7) == 0) { const int e = lane >> 3;
                    if (e < 4) J.LI[m * 4 + e] = a1 + J.b0[e];
                    else { const int h = e - 4; const float z = a1 + J.b1[h]; const float ez = __expf(-fabsf(z));
                        const float l1p = ez < 0.06f ? ez * (1.f + ez * (-0.5f + ez * (0.33333333f - 0.25f * ez))) : __logf(1.f + ez);
                        J.LF[m * 4 + h] = fminf(z, 0.f) - l1p; } }
            } else if (J.kind == 2) {
                float acc[8];
#pragma unroll
                for (int e = 0; e < 8; ++e) acc[e] = __builtin_bit_cast(float, __builtin_amdgcn_readlane(__builtin_bit_cast(int, a1), 8 * e)) + J.b0[e];
                int e0 = 0; float l0 = acc[0];
#pragma unroll
                for (int e = 1; e < 8; ++e) if (acc[e] > l0) { l0 = acc[e]; e0 = e; }
                int e1 = 0; float l1 = -INFINITY;
#pragma unroll
                for (int e = 0; e < 8; ++e) if (e != e0 && acc[e] > l1) { l1 = acc[e]; e1 = e; }
                if (lane == 0) {
                    const float ex = __expf(l1 - l0);
                    J.top_e[m * 2] = e0; J.top_e[m * 2 + 1] = e1; J.top_g_out[m * 2] = 1.f / (1.f + ex); J.top_g_out[m * 2 + 1] = ex / (1.f + ex);
                    const int ml = m - F.vcu * NWAVES * rpw; erec[ml * 2] = e0; erec[ml * 2 + 1] = e1;
                }
            }
        }
    }
    if (J.kind == 2) {
        __syncthreads();
        { const int na = 2 * NWAVES * rpw;
          LAS int* wc = erec + 2 * NWAVES * 64;
          const int ev = tid < na ? erec[tid] : -1;
#pragma unroll
          for (int e = 0; e < 8; ++e) { const unsigned long long b = __builtin_amdgcn_ballot_w64(ev == e); if (lane == 0) wc[wave * 8 + e] = __builtin_popcountll(b); }
          __syncthreads();
          if (tid < 8) { int c = 0;
#pragma unroll
              for (int w = 0; w < NWAVES; ++w) c += wc[w * 8 + tid]; J.wg_cnt[F.vcu * 8 + tid] = c; } }
    }
}
}
namespace att {
using bf16x8 = __attribute__((ext_vector_type(8))) short;
using s16x4 = __attribute__((ext_vector_type(4))) short;
using f32x16 = __attribute__((ext_vector_type(16))) float;
using u32x4 = __attribute__((ext_vector_type(4))) unsigned;
typedef __attribute__((address_space(3))) const char* lds_cptr;
typedef __attribute__((address_space(3))) char* lds_ptr;
typedef short v4i16_t __attribute__((ext_vector_type(4)));
constexpr int SEQ = 4096, PITCH = 3072, QB = 256, KVBLK = 64, NQB = SEQ / QB;
constexpr int NSLOT = 3, KSLOT = 8192, VSLOT = 16384;
constexpr int LDS_K = 0, LDS_V = NSLOT * KSLOT, LDS_WS = LDS_V + NSLOT * VSLOT, LDS_BT = LDS_WS + 8 * 256, LDS_END = LDS_BT + 512;
constexpr float LOG2E = 1.4426950408889634f;
#ifndef ATT_THR
#define ATT_THR 8.0f
#endif
#define ATT_MFMA(a, b, c) __builtin_amdgcn_mfma_f32_32x32x16_bf16(a, b, c, 0, 0, 0)
__device__ __forceinline__ int crow(int r, int hi) { return (r & 3) + 8 * (r >> 2) + 4 * hi; }
__device__ __forceinline__ void glds16(const void* gsrc, unsigned lds_dst) { unsigned keep;
    asm volatile("s_mov_b32 %0, m0\n\ts_mov_b32 m0, %2\n\ts_nop 0\n\tglobal_load_lds_dwordx4 %1, off\n\ts_mov_b32 m0, %0" : "=&s"(keep) : "v"(gsrc), "s"(lds_dst) : "memory"); }
typedef float f32x2_t __attribute__((ext_vector_type(2))); typedef __bf16 bf16x2_t __attribute__((ext_vector_type(2)));
__device__ __forceinline__ unsigned cvtpk(float lo, float hi) { f32x2_t v = {lo, hi}; bf16x2_t b = __builtin_convertvector(v, bf16x2_t); return __builtin_bit_cast(unsigned, b); }
__device__ __forceinline__ s16x4 vtr(lds_cptr p) { return __builtin_bit_cast(s16x4, __builtin_amdgcn_ds_read_tr16_b64_v4i16((__attribute__((address_space(3))) v4i16_t*)p)); }
#define ATT_MX3(a, b, c) __builtin_fmaxf(__builtin_fmaxf((a), (b)), (c))
__device__ __forceinline__ float rowmax(const f32x16& p0, const f32x16& p1) {
    float a = ATT_MX3(p0[0], p0[1], p1[0]), b = ATT_MX3(p0[2], p0[3], p1[1]); a = ATT_MX3(a, p1[2], p1[3]);
#pragma unroll
    for (int r = 4; r < 16; r += 4) { a = ATT_MX3(a, p0[r], p0[r + 1]); b = ATT_MX3(b, p0[r + 2], p0[r + 3]); a = ATT_MX3(a, p1[r], p1[r + 1]); b = ATT_MX3(b, p1[r + 2], p1[r + 3]); }
    const float m = __builtin_fmaxf(a, b); auto rr = __builtin_amdgcn_permlane32_swap(__float_as_uint(m), __float_as_uint(m), false, false);
    return __builtin_fmaxf(__uint_as_float(rr[0]), __uint_as_float(rr[1])); }
#define ATT_WAIT_BAR(N) asm volatile("s_waitcnt vmcnt(" #N ") lgkmcnt(0)\n\ts_barrier" ::: "memory")

struct Params {
    const unsigned short* QKV; unsigned short* O; float* OT;
    const float* rel; const float* subln; float lam, lam_init;
};

template <int PASS>
__device__ __forceinline__ void attn_pass(int b, int h, int qb, const Params& P, lds_ptr shm, int wid, int lane_in, unsigned (&o1p)[4][8]) {
    int lane; asm volatile("v_mbcnt_lo_u32_b32 %0, -1, 0\n\tv_mbcnt_hi_u32_b32 %0, -1, %0" : "=v"(lane));
    (void)lane_in;
    const int r32 = lane & 31, hi = lane >> 5, m = 2 * h + PASS;
    const long rowbase = (long)b * SEQ; const int q0 = qb * QB, NT = (q0 + QB) / KVBLK;
    const unsigned short* Qw = P.QKV + (rowbase + q0 + wid * 32) * PITCH + m * 64;
    const unsigned short* Kh = P.QKV + rowbase * PITCH + 1024 + m * 64; const unsigned short* Vh = P.QKV + rowbase * PITCH + 2048 + h * 128;
    const unsigned lds0 = (unsigned)(uintptr_t)shm;
    __attribute__((address_space(3))) float* wsf = (__attribute__((address_space(3))) float*)(shm + LDS_WS) + wid * 64;
    __attribute__((address_space(3))) float* BT = (__attribute__((address_space(3))) float*)(shm + LDS_BT);
    if (wid < 2) { const int rel = wid * 64 + lane; BT[rel] = P.rel[nv::BUCKET[rel] * 16 + m] * LOG2E; }
    const float c31 = P.rel[31 * 16 + m] * LOG2E;
    const unsigned short* ksrc = Kh + (long)lane * PITCH + wid * 8;
    const unsigned short* vsrc = Vh + (long)(16 * (wid & 3) + (lane >> 2)) * PITCH + (wid >> 2) * 32 + (lane & 3) * 8;
    const unsigned kdst = lds0 + LDS_K + wid * 1024, vdst = lds0 + LDS_V + wid * 1024;
#define ATT_DMA(t, s) do { glds16(ksrc + (long)(t) * KVBLK * PITCH, (unsigned)__builtin_amdgcn_readfirstlane(kdst + (s) * KSLOT)); \
        glds16(vsrc + (long)(t) * KVBLK * PITCH, (unsigned)__builtin_amdgcn_readfirstlane(vdst + (s) * VSLOT)); \
        glds16(vsrc + (long)(t) * KVBLK * PITCH + 64, (unsigned)__builtin_amdgcn_readfirstlane(vdst + (s) * VSLOT + 8192)); } while (0)
    ATT_DMA(0, 0); ATT_DMA(1, 1);
    bf16x8 qr[4];
#pragma unroll
    for (int d0 = 0; d0 < 4; ++d0) qr[d0] = *reinterpret_cast<const bf16x8*>(&Qw[(long)r32 * PITCH + d0 * 16 + hi * 8]);
    float c31p = c31;
    asm volatile("" : "+v"(qr[0]), "+v"(qr[1]), "+v"(qr[2]), "+v"(qr[3]), "+v"(c31p));
    float mhat = 0.f, l_reg = 0.f; f32x16 o[4];
#pragma unroll
    for (int d = 0; d < 4; ++d) o[d] = f32x16{};
    const int qabs = q0 + wid * 32 + r32;
    const lds_cptr kp0 = (lds_cptr)shm + LDS_K + hi * 1024 + r32 * 16;
    const lds_cptr vp0 = (lds_cptr)shm + LDS_V + ((lane >> 4) & 1) * 32 + (lane & 3) * 8 + (4 * hi + ((lane & 15) >> 2)) * 64;
    int slot = 0;
#pragma unroll 1
    for (int t = 0; t < NT; ++t) {
        if (t + 1 < NT) { ATT_WAIT_BAR(3); } else { ATT_WAIT_BAR(0); }
        const lds_cptr kp = kp0 + slot * KSLOT; const lds_cptr vp = vp0 + slot * VSLOT;
        f32x16 p0, p1;
        bf16x8 kf[8];
#pragma unroll
        for (int d0 = 0; d0 < 4; ++d0) { kf[2 * d0] = *(const __attribute__((address_space(3))) bf16x8*)(kp + d0 * 2048); kf[2 * d0 + 1] = *(const __attribute__((address_space(3))) bf16x8*)(kp + d0 * 2048 + 512); }
        if (t + 6 < NT) {
            p0 = ATT_MFMA(kf[0], qr[0], (f32x16{})); p1 = ATT_MFMA(kf[1], qr[0], (f32x16{}));
        } else {
            const int kb = t * KVBLK + 4 * hi;
#pragma unroll
            for (int r = 0; r < 16; ++r) { const int k0 = kb + (r & 3) + 8 * (r >> 2); int rel0 = qabs - k0, rel1 = rel0 - 32;
                const float b0 = BT[rel0 < 0 ? 0 : (rel0 > 127 ? 127 : rel0)], b1 = BT[rel1 < 0 ? 0 : (rel1 > 127 ? 127 : rel1)];
                p0[r] = rel0 < 0 ? -INFINITY : b0; p1[r] = rel1 < 0 ? -INFINITY : b1; }
            p0 = ATT_MFMA(kf[0], qr[0], p0); p1 = ATT_MFMA(kf[1], qr[0], p1);
        }
#pragma unroll
        for (int d0 = 1; d0 < 4; ++d0) { p0 = ATT_MFMA(kf[2 * d0], qr[d0], p0); p1 = ATT_MFMA(kf[2 * d0 + 1], qr[d0], p1); }
        if (t + 2 < NT) { const int s2 = slot == 0 ? 2 : slot - 1; ATT_DMA(t + 2, s2); }
        s16x4 loA[4], hhA[4], loB[4], hhB[4];
#pragma unroll
        for (int ks = 0; ks < 4; ++ks) { loA[ks] = vtr(vp + ks * 1024); hhA[ks] = vtr(vp + ks * 1024 + 512); }
        __builtin_amdgcn_sched_barrier(0);
        const float base = (t + 6 < NT) ? c31p : 0.f;
        const float rm = rowmax(p0, p1) + base - mhat;
        bool resc = false;
        if (t == 0 || __any(rm > ATT_THR)) {
            const float dl = t == 0 ? rm : __builtin_fmaxf(rm, 0.f);
            mhat += dl;
            const float f = __builtin_amdgcn_exp2f(-dl); l_reg *= f; if (hi == 0) wsf[r32] = f; resc = (t != 0);
        }
        const float ref = base - mhat;
        float sacc = 0.f;
#pragma unroll
        for (int r = 0; r < 16; ++r) { p0[r] = __builtin_amdgcn_exp2f(p0[r] + ref); p1[r] = __builtin_amdgcn_exp2f(p1[r] + ref); sacc += p0[r] + p1[r]; }
        l_reg += sacc;
        u32x4 pw0 = (u32x4){cvtpk(p0[0], p0[1]), cvtpk(p0[2], p0[3]), cvtpk(p0[4], p0[5]), cvtpk(p0[6], p0[7])};
        u32x4 pw1 = (u32x4){cvtpk(p0[8], p0[9]), cvtpk(p0[10], p0[11]), cvtpk(p0[12], p0[13]), cvtpk(p0[14], p0[15])};
        u32x4 pw2 = (u32x4){cvtpk(p1[0], p1[1]), cvtpk(p1[2], p1[3]), cvtpk(p1[4], p1[5]), cvtpk(p1[6], p1[7])};
        u32x4 pw3 = (u32x4){cvtpk(p1[8], p1[9]), cvtpk(p1[10], p1[11]), cvtpk(p1[12], p1[13]), cvtpk(p1[14], p1[15])};
        __builtin_amdgcn_sched_barrier(0);
        if (resc) {
#pragma unroll
            for (int r = 0; r < 16; ++r) { const float f = wsf[crow(r, hi)];
#pragma unroll
                for (int d = 0; d < 4; ++d) o[d][r] *= f; }
        }
#define ATT_PKX(L, H, k) (bf16x8){L[k][0], L[k][1], L[k][2], L[k][3], H[k][0], H[k][1], H[k][2], H[k][3]}
#define ATT_RD(L, H, d) do { _Pragma("unroll") for (int ks = 0; ks < 4; ++ks) { L[ks] = vtr(vp + (d) * 4096 + ks * 1024); H[ks] = vtr(vp + (d) * 4096 + ks * 1024 + 512); } } while (0)
#define ATT_MM(L, H, d) do { o[d] = ATT_MFMA(__builtin_bit_cast(bf16x8, pw0), ATT_PKX(L, H, 0), o[d]); o[d] = ATT_MFMA(__builtin_bit_cast(bf16x8, pw1), ATT_PKX(L, H, 1), o[d]); \
        o[d] = ATT_MFMA(__builtin_bit_cast(bf16x8, pw2), ATT_PKX(L, H, 2), o[d]); o[d] = ATT_MFMA(__builtin_bit_cast(bf16x8, pw3), ATT_PKX(L, H, 3), o[d]); } while (0)
        ATT_RD(loB, hhB, 1); __builtin_amdgcn_sched_barrier(0); ATT_MM(loA, hhA, 0); __builtin_amdgcn_sched_barrier(0);
        ATT_RD(loA, hhA, 2); __builtin_amdgcn_sched_barrier(0); ATT_MM(loB, hhB, 1); __builtin_amdgcn_sched_barrier(0);
        ATT_RD(loB, hhB, 3); __builtin_amdgcn_sched_barrier(0); ATT_MM(loA, hhA, 2); __builtin_amdgcn_sched_barrier(0);
        ATT_MM(loB, hhB, 3); __builtin_amdgcn_sched_barrier(0);
#undef ATT_PKX
#undef ATT_RD
#undef ATT_MM
        slot = slot == 2 ? 0 : slot + 1;
    }
#undef ATT_DMA
    { auto rr = __builtin_amdgcn_permlane32_swap(__float_as_uint(l_reg), __float_as_uint(l_reg), false, false); l_reg = __uint_as_float(rr[0]) + __uint_as_float(rr[1]); }
    if (hi == 0) wsf[32 + r32] = l_reg;
    asm volatile("s_waitcnt lgkmcnt(0)" ::: "memory");
    if (PASS == 0) {
#pragma unroll
        for (int r = 0; r < 16; r += 2) { const float i0 = __builtin_amdgcn_rcpf(wsf[32 + crow(r, hi)]), i1 = __builtin_amdgcn_rcpf(wsf[32 + crow(r + 1, hi)]);
#pragma unroll
            for (int d = 0; d < 4; ++d) o1p[d][r >> 1] = cvtpk(o[d][r] * i0, o[d][r + 1] * i1); }
        asm volatile("s_waitcnt vmcnt(0) lgkmcnt(0)\n\ts_barrier" ::: "memory");
    } else {
        float sw[4];
#pragma unroll
        for (int d = 0; d < 4; ++d) sw[d] = P.subln[d * 32 + r32] * (1.f - P.lam_init);
        asm volatile("s_waitcnt vmcnt(0) lgkmcnt(0)\n\ts_barrier" ::: "memory");
        __attribute__((address_space(3))) unsigned short* stg = (__attribute__((address_space(3))) unsigned short*)(shm) + wid * 4096;
#pragma unroll
        for (int r0 = 0; r0 < 16; r0 += 4) {
            float ss[4];
#pragma unroll
            for (int q = 0; q < 4; ++q) { const int r = r0 + q; const float il = __builtin_amdgcn_rcpf(wsf[32 + crow(r, hi)]); float sq = 0.f;
#pragma unroll
                for (int d = 0; d < 4; ++d) { const unsigned w_ = o1p[d][r >> 1]; const float o1v = __builtin_bit_cast(float, (r & 1) ? (w_ & 0xffff0000u) : (w_ << 16));
                    const float a = o1v - P.lam * (o[d][r] * il); o[d][r] = a; sq += a * a; }
                ss[q] = sq; }
#pragma unroll
            for (int x = 1; x < 32; x <<= 1)
#pragma unroll
                for (int q = 0; q < 4; ++q) ss[q] += __builtin_bit_cast(float, __builtin_amdgcn_ds_bpermute((lane ^ x) << 2, __builtin_bit_cast(int, ss[q])));
#pragma unroll
            for (int q = 0; q < 4; ++q) { const int r = r0 + q; const float rs = 1.0f / sqrtf(ss[q] * (1.f / 128.f) + 1e-5f); const int orow = crow(r, hi);
#pragma unroll
                for (int d = 0; d < 4; ++d) { const float v = o[d][r] * rs * sw[d]; stg[orow * 128 + d * 32 + r32] = (unsigned short)(cvtpk(v, v) & 0xffffu); } }
            __builtin_amdgcn_sched_barrier(0);
        }
        asm volatile("s_waitcnt lgkmcnt(0)" ::: "memory");
        unsigned short* Ow = P.O + (rowbase + q0 + wid * 32) * 1024 + h * 128;
#pragma unroll
        for (int i = 0; i < 8; ++i) { const int row = i * 4 + (lane >> 4), ch = lane & 15; const u32x4 v = *(const __attribute__((address_space(3))) u32x4*)(stg + row * 128 + ch * 8); *(u32x4*)(Ow + (long)row * 1024 + ch * 8) = v; }
        asm volatile("s_waitcnt vmcnt(0) lgkmcnt(0)\n\ts_barrier" ::: "memory");
    }
}
__device__ __forceinline__ void attn_phase(const Params& P, lds_ptr shm, int vcu, int G, int wid, int lane) {
    if (G == 256) {
        const int bh = vcu >> 2, s = vcu & 3;
        for (int i = 0; i < 4; ++i) { const int qb = (i == 0) ? s : (i == 1) ? 7 - s : (i == 2) ? 8 + s : 15 - s;
            unsigned o1p[4][8]; attn_pass<0>(bh >> 3, bh & 7, qb, P, shm, wid, lane, o1p); attn_pass<1>(bh >> 3, bh & 7, qb, P, shm, wid, lane, o1p); }
    } else {
        for (int u = vcu; u < 64 * NQB; u += G) { const int bh = u >> 4, qb = u & 15;
            unsigned o1p[4][8]; attn_pass<0>(bh >> 3, bh & 7, qb, P, shm, wid, lane, o1p); attn_pass<1>(bh >> 3, bh & 7, qb, P, shm, wid, lane, o1p); }
    }
}
}
namespace mls {
using bf16x8 = __attribute__((ext_vector_type(8))) short;
using f32x4 = __attribute__((ext_vector_type(4))) float;
using u32x4 = __attribute__((ext_vector_type(4))) unsigned;
using u32x2 = __attribute__((ext_vector_type(2))) unsigned;
#define MLS_LAS __attribute__((address_space(3)))
typedef MLS_LAS char* lptr;
constexpr int SEQ = 4096, PITCH = 3072, L = 64, NCH = SEQ / L;
constexpr int QSTR = 136, SSTR = 72;
constexpr int QS = 0, KS = QS + 64 * QSTR * 2, KT = KS + 64 * QSTR * 2, VT = KT + 128 * SSTR * 2, VW = VT + 32 * SSTR * 2, SD = VW + 32 * SSTR * 2, CT = SD + 64 * SSTR * 2,
              NV = CT + 32 * QSTR * 2, FV = NV + 256, AV = FV + 256, IV = AV + 256, EV = IV + 256, WV = EV + 256, WB = WV + 256, DC = WB + 128, LDS_END = DC + 16;
static_assert(LDS_END <= 131072, "mLSTM LDS");
#define MLS_MFMA(a, b, c) __builtin_amdgcn_mfma_f32_16x16x32_bf16(a, b, c, 0, 0, 0)
#ifndef MK_NT_CVT
#define MK_NT_CVT 1
#endif
#if MK_NT_CVT
#define MLS_NTLOAD(p) __builtin_nontemporal_load(p)
#else
#define MLS_NTLOAD(p) (*(p))
#endif
#define MLS_BAR() asm volatile("s_waitcnt lgkmcnt(0)\n\ts_barrier" ::: "memory")
__device__ __forceinline__ unsigned pk(float lo, float hi) { typedef float f2 __attribute__((ext_vector_type(2))); typedef __bf16 b2 __attribute__((ext_vector_type(2))); f2 v = {lo, hi}; b2 b = __builtin_convertvector(v, b2); return __builtin_bit_cast(unsigned, b); }
__device__ __forceinline__ float blo(unsigned w) { return __builtin_bit_cast(float, w << 16); }
__device__ __forceinline__ float bhi(unsigned w) { return __builtin_bit_cast(float, w & 0xffff0000u); }
__device__ __forceinline__ float bperm(float v, int src) { return __builtin_bit_cast(float, __builtin_amdgcn_ds_bpermute(src << 2, __builtin_bit_cast(int, v))); }

struct Params { const unsigned short* P; const unsigned short* QKC; const float* GB; const float* GA; const float* GP; float* HH;
                const float* wg; const float* wu; const float* wd; unsigned short* wt_gu; unsigned short* wt_d; int gw;
                const float* fg; const float* fu; const float* fd; const float* ai; const float* ao; unsigned short* ws_small; const float* ks_ffn; const float* ks_att; };
constexpr int CV_MOE = 86016, CV_TOTAL = CV_MOE + 3 * 3584 + 3072 + 1024, CV_ITERS = (CV_TOTAL + 2047) / 2048;
constexpr size_t WS_FGU = (size_t)4096 * 1024, WS_FD = (size_t)11264 * 1024, WS_AI = (size_t)14848 * 1024, WS_AO = (size_t)17920 * 1024;
constexpr int CV_SCR = (LDS_END + 127) / 128 * 128;
constexpr int LDS_END2 = CV_SCR + 8 * 4224;
static_assert(LDS_END2 <= 131072, "mLSTM + cvt LDS");
struct CvItem { const float* src; unsigned short* dst; const float* ks; int ldw, K; };
__device__ __forceinline__ CvItem cv_decode(const Params& A, int it) {
    CvItem c; c.ks = nullptr;
    if (it >= CV_MOE) {
        int r = it - CV_MOE;
        if (r < 2 * 3584) { const int up = r >= 3584; r -= up * 3584; const int kb = r / 112, nb = r - kb * 112, n0 = 32 * nb, drow = (n0 >> 7) * 256 + (n0 & 127) + (up ? 128 : 0);
            c.src = (up ? A.fu : A.fg) + (size_t)(32 * kb) * 3584 + n0; c.ldw = 3584; c.K = 1024; c.dst = A.ws_small + WS_FGU + (size_t)drow * 1024 + 32 * kb; c.ks = A.ks_ffn ? A.ks_ffn + 32 * kb : nullptr; return c; }
        r -= 2 * 3584;
        if (r < 3584) { const int kb = r >> 5, nb = r & 31; c.src = A.fd + (size_t)(32 * kb) * 1024 + 32 * nb; c.ldw = 1024; c.K = 3584; c.dst = A.ws_small + WS_FD + (size_t)(32 * nb) * 3584 + 32 * kb; return c; }
        r -= 3584;
        if (r < 3072) { const int kb = r / 96, nb = r - kb * 96; c.src = A.ai + (size_t)(32 * kb) * 3072 + 32 * nb; c.ldw = 3072; c.K = 1024; c.dst = A.ws_small + WS_AI + (size_t)(32 * nb) * 1024 + 32 * kb; c.ks = A.ks_att ? A.ks_att + 32 * kb : nullptr; return c; }
        r -= 3072;
        if (r >= 1024) r = 1023;
        { const int kb = r >> 5, nb = r & 31; c.src = A.ao + (size_t)(32 * kb) * 1024 + 32 * nb; c.ldw = 1024; c.K = 1024; c.dst = A.ws_small + WS_AO + (size_t)(32 * nb) * 1024 + 32 * kb; return c; }
    }
    const int type = it / 28672, r = it - type * 28672, mat = r / 3584, r2 = r - mat * 3584;
    if (type < 2) { const int kb = r2 / 112, nb = r2 - kb * 112, n0 = 32 * nb; const int drow = (n0 >> 7) * 256 + (n0 & 127) + (type ? 128 : 0);
        c.src = (type ? A.wu : A.wg) + (size_t)mat * 1024 * 3584 + (size_t)(32 * kb) * 3584 + n0; c.ldw = 3584; c.K = 1024; c.dst = A.wt_gu + (size_t)mat * 7168 * 1024 + (size_t)drow * 1024 + 32 * kb; }
    else { const int kb = r2 >> 5, nb = r2 & 31, n0 = 32 * nb;
        c.src = A.wd + (size_t)mat * 3584 * 1024 + (size_t)(32 * kb) * 1024 + n0; c.ldw = 1024; c.K = 3584; c.dst = A.wt_d + (size_t)mat * 1024 * 3584 + (size_t)n0 * 3584 + 32 * kb; }
    return c;
}

__device__ __forceinline__ void scan_unit(int b, int h, int sl, const Params& A, lptr shm, int wid, int lane) {
    const int tid = wid * 64 + lane, lr = lane & 15, lq = lane >> 4;
    const long rowbase = (long)b * SEQ;
    const int o = tid & 31, g = tid >> 5, isk = o >> 4, ch0 = (o & 15) * 8;
    const int pcol = isk * 512 + h * 128 + ch0;
    const unsigned short* rawp = A.QKC + (rowbase + 4 * g) * 1024 + pcol;
    const int vs = tid >> 3, vj = (tid & 7) * 4;
    const unsigned short* vp = A.P + (rowbase + vs) * PITCH + 1024 + h * 256 + sl * 32 + vj;
    const int to = wid >> 1, jo = wid & 1;
    f32x4 Cst[2], nst;
    Cst[0] = (f32x4){0.f, 0.f, 0.f, 0.f}; Cst[1] = Cst[0]; nst = Cst[0];
    for (int i = tid; i < (32 * QSTR * 2 + 256) / 4; i += 512) ((MLS_LAS unsigned*)(shm + CT))[i] = 0u;
    float m_prev = 0.f;
    bf16x8 ones; { const short o1 = (short)0x3f80; ones = (bf16x8){o1, o1, o1, o1, o1, o1, o1, o1}; }
    float* hhp = A.HH + (rowbase + 16 * to + 4 * lq) * 1024 + h * 256 + sl * 32 + 16 * jo + lr;
    f32x4 cvr[4]; float cvs[4] = {1.f, 1.f, 1.f, 1.f}; unsigned short* cvdst = nullptr; int cvK = 0; bool cvhave = false;
#ifndef MK_CV_FIRST
#define MK_CV_FIRST 0
#endif
    if (A.gw >= 0) { const CvItem ci = cv_decode(A, MK_CV_FIRST + A.gw);
#pragma unroll
      for (int i = 0; i < 4; ++i) cvr[i] = MLS_NTLOAD((const f32x4*)(ci.src + (size_t)(8 * i + (lane >> 3)) * ci.ldw + (lane & 7) * 4));
      cvdst = ci.dst; cvK = ci.K; cvhave = true;
#pragma unroll
      for (int i = 0; i < 4; ++i) cvs[i] = ci.ks ? ci.ks[8 * i + (lane >> 3)] : 1.f; }
    else { cvr[0] = cvr[1] = cvr[2] = cvr[3] = (f32x4){0.f, 0.f, 0.f, 0.f}; }
    u32x4 raw[4]; u32x2 vraw; float gb = 0.f, ga = 0.f, gp = 0.f;
#pragma unroll
    for (int i = 0; i < 4; ++i) raw[i] = *(const u32x4*)(rawp + (long)i * 1024);
    vraw = *(const u32x2*)vp;
    if (wid == 7) { gb = A.GB[(rowbase + lane) * 4 + h]; ga = A.GA[(rowbase + lane) * 4 + h]; gp = A.GP[(rowbase + lane) * 4 + h]; }
    float hout[4] = {0.f, 0.f, 0.f, 0.f};
    MLS_BAR();
#pragma unroll 1
    for (int c = 0; c < NCH; ++c) {
        const int t0 = c * L;
        if (c > 0) {
#pragma unroll
            for (int r = 0; r < 4; ++r) hhp[(long)(t0 - L + r) * 1024] = hout[r];
        }
        float vv[4]; vv[0] = blo(vraw[0]); vv[1] = bhi(vraw[0]); vv[2] = blo(vraw[1]); vv[3] = bhi(vraw[1]);
        {
#pragma unroll
            for (int r = 0; r < 4; ++r) *(MLS_LAS u32x4*)(shm + (isk ? KS : QS) + ((4 * g + r) * QSTR + ch0) * 2) = raw[r];
            if (isk) {
#pragma unroll
                for (int e = 0; e < 8; ++e) { const int dw = e >> 1, sh = (e & 1) * 16;
                    const unsigned a0 = (raw[0][dw] >> sh) & 0xffffu, a1 = (raw[1][dw] >> sh) & 0xffffu, a2 = (raw[2][dw] >> sh) & 0xffffu, a3 = (raw[3][dw] >> sh) & 0xffffu;
                    *(MLS_LAS u32x2*)(shm + KT + ((ch0 + e) * SSTR + 4 * g) * 2) = (u32x2){a0 | (a1 << 16), a2 | (a3 << 16)}; }
            }
        }
#pragma unroll
        for (int e = 0; e < 4; ++e) *(MLS_LAS unsigned short*)(shm + VT + ((vj + e) * SSTR + vs) * 2) = (unsigned short)(pk(vv[e], vv[e]) & 0xffffu);
        if (wid == 7) {
            const float bs = gb, a = ga, pm = gp;
            const float gsum = __builtin_bit_cast(float, __builtin_amdgcn_readlane(__builtin_bit_cast(int, bs), 63)), amax = __builtin_bit_cast(float, __builtin_amdgcn_readlane(__builtin_bit_cast(int, pm), 63));
            const float mref = fmaxf(m_prev, pm);
            const float mt = bs + mref;
            const float mrefn = fmaxf(m_prev, amax);
            const float w = __expf(a - mrefn);
            ((MLS_LAS float*)(shm + FV))[lane] = -mref;
            ((MLS_LAS float*)(shm + AV))[lane] = a;
            ((MLS_LAS float*)(shm + IV))[lane] = __expf(m_prev - mref);
            ((MLS_LAS float*)(shm + EV))[lane] = __expf(-mt);
            ((MLS_LAS float*)(shm + WV))[lane] = w;
            ((MLS_LAS unsigned short*)(shm + WB))[lane] = (unsigned short)(pk(w, w) & 0xffffu);
            if (lane == 0) ((MLS_LAS float*)(shm + DC))[0] = __expf(m_prev - mrefn);
            m_prev = gsum + mrefn;
        }
        if (cvhave) {
            MLS_LAS float* scr = (MLS_LAS float*)(shm + CV_SCR + wid * 4224);
#pragma unroll
            for (int i = 0; i < 4; ++i)
#pragma unroll
                for (int e = 0; e < 4; ++e) scr[(8 * i + (lane >> 3)) * 33 + (lane & 7) * 4 + e] = cvr[i][e] * cvs[i];
            float tv[16];
#pragma unroll
            for (int j = 0; j < 16; ++j) tv[j] = scr[(16 * (lane & 1) + j) * 33 + (lane >> 1)];
            u32x4* dp = (u32x4*)(cvdst + (size_t)(lane >> 1) * cvK + 16 * (lane & 1));
            dp[0] = (u32x4){pk(tv[0], tv[1]), pk(tv[2], tv[3]), pk(tv[4], tv[5]), pk(tv[6], tv[7])}; dp[1] = (u32x4){pk(tv[8], tv[9]), pk(tv[10], tv[11]), pk(tv[12], tv[13]), pk(tv[14], tv[15])};
        }
        cvhave = (MK_CV_FIRST + 2048 * (c + 1) < CV_TOTAL + 2047) && (c + 1 < CV_ITERS) && (A.gw >= 0);
        if (cvhave) { const CvItem ci = cv_decode(A, MK_CV_FIRST + A.gw + 2048 * (c + 1));
#pragma unroll
            for (int i = 0; i < 4; ++i) cvs[i] = ci.ks ? ci.ks[8 * i + (lane >> 3)] : 1.f;
#pragma unroll
            for (int i = 0; i < 4; ++i) cvr[i] = MLS_NTLOAD((const f32x4*)(ci.src + (size_t)(8 * i + (lane >> 3)) * ci.ldw + (lane & 7) * 4));
            cvdst = ci.dst; cvK = ci.K; }
        if (c + 1 < NCH) {
            const long adv = (long)(t0 + L) * PITCH;
#pragma unroll
            for (int i = 0; i < 4; ++i) raw[i] = *(const u32x4*)(rawp + (long)(t0 + L) * 1024 + (long)i * 1024);
            vraw = *(const u32x2*)(vp + adv);
            if (wid == 7) { const long gi = (rowbase + t0 + L + lane) * 4 + h; gb = A.GB[gi]; ga = A.GA[gi]; gp = A.GP[gi]; }
        }
        MLS_BAR();
        { const float w = ((MLS_LAS float*)(shm + WV))[vs];
#pragma unroll
          for (int e = 0; e < 4; ++e) *(MLS_LAS unsigned short*)(shm + VW + ((vj + e) * SSTR + vs) * 2) = (unsigned short)(pk(vv[e] * w, vv[e] * w) & 0xffffu); }
        bf16x8 qa[4];
#pragma unroll
        for (int ks = 0; ks < 4; ++ks) qa[ks] = *(const MLS_LAS bf16x8*)(shm + QS + ((16 * to + lr) * QSTR + 32 * ks + 8 * lq) * 2);
        f32x4 fvr; { const f32x4 t4 = *(const MLS_LAS f32x4*)(shm + FV + (16 * to + 4 * lq) * 4); fvr = t4; }
#pragma unroll
        for (int q = 0; q < 2; ++q) {
            const int si = 2 * jo + q;
            f32x4 s4 = (f32x4){0.f, 0.f, 0.f, 0.f};
            if (si <= to) {
#pragma unroll
                for (int ks = 0; ks < 4; ++ks) { const bf16x8 kb = *(const MLS_LAS bf16x8*)(shm + KS + ((16 * si + lr) * QSTR + 32 * ks + 8 * lq) * 2); s4 = MLS_MFMA(qa[ks], kb, s4); }
                const float av = ((MLS_LAS float*)(shm + AV))[16 * si + lr];
                const int scol = 16 * si + lr, trow = 16 * to + 4 * lq;
#pragma unroll
                for (int r = 0; r < 4; ++r) s4[r] = (scol <= trow + r) ? s4[r] * __expf(fvr[r] + av) : 0.f;
            }
#pragma unroll
            for (int r = 0; r < 4; ++r) *(MLS_LAS unsigned short*)(shm + SD + ((16 * to + 4 * lq + r) * SSTR + 16 * si + lr) * 2) = (unsigned short)(pk(s4[r], s4[r]) & 0xffffu);
        }
        f32x4 qc = (f32x4){0.f, 0.f, 0.f, 0.f}, qn = qc;
#pragma unroll
        for (int ks = 0; ks < 4; ++ks) { const bf16x8 cb8 = *(const MLS_LAS bf16x8*)(shm + CT + ((16 * jo + lr) * QSTR + 32 * ks + 8 * lq) * 2); const bf16x8 nb8 = *(const MLS_LAS bf16x8*)(shm + NV + (32 * ks + 8 * lq) * 2);
            qc = MLS_MFMA(qa[ks], cb8, qc); qn = MLS_MFMA(qa[ks], nb8, qn); }
        MLS_BAR();
        {
            f32x4 sv = (f32x4){0.f, 0.f, 0.f, 0.f}, rs = sv;
#pragma unroll
            for (int ks = 0; ks < 2; ++ks) { const bf16x8 sa = *(const MLS_LAS bf16x8*)(shm + SD + ((16 * to + lr) * SSTR + 32 * ks + 8 * lq) * 2); const bf16x8 vb = *(const MLS_LAS bf16x8*)(shm + VT + ((16 * jo + lr) * SSTR + 32 * ks + 8 * lq) * 2);
                sv = MLS_MFMA(sa, vb, sv); rs = MLS_MFMA(sa, ones, rs); }
            const f32x4 iv = *(const MLS_LAS f32x4*)(shm + IV + (16 * to + 4 * lq) * 4), ev = *(const MLS_LAS f32x4*)(shm + EV + (16 * to + 4 * lq) * 4);
#pragma unroll
            for (int r = 0; r < 4; ++r) { const float num = sv[r] + iv[r] * qc[r], den = rs[r] + iv[r] * qn[r]; hout[r] = num * __builtin_amdgcn_rcpf(fmaxf(fabsf(den), ev[r])); }
        }
        {
            const float decay = ((MLS_LAS float*)(shm + DC))[0];
            Cst[0] = Cst[0] * decay; Cst[1] = Cst[1] * decay; nst = nst * decay;
#pragma unroll
            for (int ks = 0; ks < 2; ++ks) { const bf16x8 ka = *(const MLS_LAS bf16x8*)(shm + KT + ((16 * wid + lr) * SSTR + 32 * ks + 8 * lq) * 2);
                const bf16x8 v0 = *(const MLS_LAS bf16x8*)(shm + VW + ((lr) * SSTR + 32 * ks + 8 * lq) * 2), v1 = *(const MLS_LAS bf16x8*)(shm + VW + ((16 + lr) * SSTR + 32 * ks + 8 * lq) * 2);
                const bf16x8 wb8 = *(const MLS_LAS bf16x8*)(shm + WB + (32 * ks + 8 * lq) * 2);
                Cst[0] = MLS_MFMA(ka, v0, Cst[0]); Cst[1] = MLS_MFMA(ka, v1, Cst[1]); nst = MLS_MFMA(ka, wb8, nst); }
        }
        MLS_BAR();
#pragma unroll
        for (int jt = 0; jt < 2; ++jt) *(MLS_LAS u32x2*)(shm + CT + ((16 * jt + lr) * QSTR + 16 * wid + 4 * lq) * 2) = (u32x2){pk(Cst[jt][0], Cst[jt][1]), pk(Cst[jt][2], Cst[jt][3])};
        if (lr == 0) *(MLS_LAS u32x2*)(shm + NV + (16 * wid + 4 * lq) * 2) = (u32x2){pk(nst[0], nst[1]), pk(nst[2], nst[3])};
    }
#pragma unroll
    for (int r = 0; r < 4; ++r) hhp[(long)(SEQ - L + r) * 1024] = hout[r];
    asm volatile("s_waitcnt vmcnt(0) lgkmcnt(0)\n\ts_barrier" ::: "memory");
}
__device__ __forceinline__ void scan_phase(const Params& A, lptr shm, int vcu, int G, int wid) {
    for (int u = vcu; u < 256; u += G) {
        int lane; asm volatile("v_mbcnt_lo_u32_b32 %0, -1, 0\n\tv_mbcnt_hi_u32_b32 %0, -1, %0" : "=v"(lane));
        const int bh = u >> 3; scan_unit(bh >> 2, bh & 3, u & 7, A, shm, wid, lane);
    }
}
__device__ __forceinline__ void conv_phase(const unsigned short* P, const float* cw, const float* cb, unsigned short* QKC, const float* LI, const float* LF, float* GB, float* GA, float* GP, int vcu, int G, int tid) {
    const int o = tid & 127, g = tid >> 7, c0 = o * 8;
    float cwr[4][8], cbr[8];
#pragma unroll
    for (int j = 0; j < 4; ++j) { const f32x4 a = *(const f32x4*)(cw + j * 1024 + c0), c = *(const f32x4*)(cw + j * 1024 + c0 + 4);
        cwr[j][0] = a[0]; cwr[j][1] = a[1]; cwr[j][2] = a[2]; cwr[j][3] = a[3]; cwr[j][4] = c[0]; cwr[j][5] = c[1]; cwr[j][6] = c[2]; cwr[j][7] = c[3]; }
    { const f32x4 a = *(const f32x4*)(cb + c0), c = *(const f32x4*)(cb + c0 + 4); cbr[0] = a[0]; cbr[1] = a[1]; cbr[2] = a[2]; cbr[3] = a[3]; cbr[4] = c[0]; cbr[5] = c[1]; cbr[6] = c[2]; cbr[7] = c[3]; }
    const float osc = c0 >= 512 ? 0.08838834764831845f : 1.0f;
    for (int blk = vcu; blk < 8 * SEQ / 128; blk += G) {
        {
            const int w = tid >> 6, lane = tid & 63; const long gi = ((long)blk * 128 + (w >> 2) * 64 + lane) * 4 + (w & 3);
            float bs = LF[gi]; const float li = LI[gi];
#pragma unroll
            for (int x = 1; x < 64; x <<= 1) { const float v = bperm(bs, (lane - x) & 63); if (lane >= x) bs += v; }
            const float a = li - bs; float pm = a;
#pragma unroll
            for (int x = 1; x < 64; x <<= 1) { const float v = bperm(pm, (lane - x) & 63); if (lane >= x) pm = fmaxf(pm, v); }
            GB[gi] = bs; GA[gi] = a; GP[gi] = pm;
        }
        const long r0 = (long)blk * 128 + 32 * g;
        float x[3][8];
#pragma unroll
        for (int i = 0; i < 3; ++i) { const long rr = r0 - 3 + i; u32x4 w = (u32x4){0u, 0u, 0u, 0u}; if ((r0 & (SEQ - 1)) != 0) w = *(const u32x4*)(P + rr * PITCH + c0);
            x[i][0] = blo(w[0]); x[i][1] = bhi(w[0]); x[i][2] = blo(w[1]); x[i][3] = bhi(w[1]); x[i][4] = blo(w[2]); x[i][5] = bhi(w[2]); x[i][6] = blo(w[3]); x[i][7] = bhi(w[3]); }
#pragma unroll 4
        for (int r = 0; r < 32; ++r) {
            const u32x4 w = *(const u32x4*)(P + (r0 + r) * PITCH + c0);
            float xn[8]; xn[0] = blo(w[0]); xn[1] = bhi(w[0]); xn[2] = blo(w[1]); xn[3] = bhi(w[1]); xn[4] = blo(w[2]); xn[5] = bhi(w[2]); xn[6] = blo(w[3]); xn[7] = bhi(w[3]);
            float y[8];
#pragma unroll
            for (int e = 0; e < 8; ++e) { const float a = cbr[e] + cwr[0][e] * x[0][e] + cwr[1][e] * x[1][e] + cwr[2][e] * x[2][e] + cwr[3][e] * xn[e];
                y[e] = osc * a * __builtin_amdgcn_rcpf(1.0f + __builtin_amdgcn_exp2f(-1.4426950408889634f * a)); x[0][e] = x[1][e]; x[1][e] = x[2][e]; x[2][e] = xn[e]; }
            *(u32x4*)(QKC + (r0 + r) * 1024 + c0) = (u32x4){pk(y[0], y[1]), pk(y[2], y[3]), pk(y[4], y[5]), pk(y[6], y[7])};
        }
    }
}
__device__ __forceinline__ void headnorm_phase(const float* HH, const unsigned short* P, const float* hn, unsigned short* Gout, int vcu, int G, int wid, int lane) {
    const int gw = vcu * 8 + wid, NGW = G * 8;
    f32x4 nv[4]; u32x4 no0, no1;
    { const f32x4* hp = (const f32x4*)(HH + (long)gw * 1024 + lane * 16);
#pragma unroll
      for (int i = 0; i < 4; ++i) nv[i] = hp[i];
      const u32x4* op = (const u32x4*)(P + (long)gw * PITCH + 2048 + lane * 16); no0 = op[0]; no1 = op[1]; }
    for (int m = gw; m < 8 * SEQ; m += NGW) {
        f32x4 v[4]; float ss = 0.f; const u32x4 o0 = no0, o1 = no1;
#pragma unroll
        for (int i = 0; i < 4; ++i) { v[i] = nv[i]; ss += v[i][0] * v[i][0] + v[i][1] * v[i][1] + v[i][2] * v[i][2] + v[i][3] * v[i][3]; }
        if (m + NGW < 8 * SEQ) { const f32x4* hp = (const f32x4*)(HH + (long)(m + NGW) * 1024 + lane * 16);
#pragma unroll
            for (int i = 0; i < 4; ++i) nv[i] = hp[i];
            const u32x4* op = (const u32x4*)(P + (long)(m + NGW) * PITCH + 2048 + lane * 16); no0 = op[0]; no1 = op[1]; }
#pragma unroll
        for (int x = 1; x < 16; x <<= 1) ss += bperm(ss, lane ^ x);
        const float rs = 1.0f / sqrtf(ss * (1.f / 256.f) + 1e-6f);
        const f32x4* wp = (const f32x4*)(hn + lane * 16);
        float og[16];
#pragma unroll
        for (int i = 0; i < 4; ++i) { og[2 * i] = blo(o0[i]); og[2 * i + 1] = bhi(o0[i]); og[8 + 2 * i] = blo(o1[i]); og[8 + 2 * i + 1] = bhi(o1[i]); }
        float r[16];
#pragma unroll
        for (int i = 0; i < 4; ++i) { const f32x4 w = wp[i];
#pragma unroll
            for (int e = 0; e < 4; ++e) { const float sg = __builtin_amdgcn_rcpf(1.0f + __builtin_amdgcn_exp2f(-1.4426950408889634f * og[4 * i + e])); r[4 * i + e] = sg * v[i][e] * rs * w[e]; } }
        u32x4* gp = (u32x4*)(Gout + (long)m * 1024 + lane * 16);
        gp[0] = (u32x4){pk(r[0], r[1]), pk(r[2], r[3]), pk(r[4], r[5]), pk(r[6], r[7])}; gp[1] = (u32x4){pk(r[8], r[9]), pk(r[10], r[11]), pk(r[12], r[13]), pk(r[14], r[15])};
    }
}
}
#define MK_KS_FFN (KA_IN(18) + pr * 1024)
#define MK_KS_ATT (KA_IN(10) + pr * 1024)
#define MK_QSCALE (0.125f * 1.4426950408889634f)
#define MK_ATTENTION { const int tid = fresh_tid(F), lane = tid & 63, wave = __builtin_amdgcn_readfirstlane(tid >> 6); \
    const float lam_init = 0.8f - 0.6f * __expf(-0.3f * (float)(2 * pr + 1)); \
    const float* lq1 = KA_IN(12) + pr * 64; const float* lk1 = KA_IN(13) + pr * 64; const float* lq2 = KA_IN(14) + pr * 64; const float* lk2 = KA_IN(15) + pr * 64; \
    const float lam = __expf(wave_sum(lq1[lane] * lk1[lane], lane)) - __expf(wave_sum(lq2[lane] * lk2[lane], lane)) + lam_init; \
    att::Params AP{(const unsigned short*)(ws + F_P), (unsigned short*)(ws + F_O), (float*)(ws + F_OT), KA_IN(1), KA_IN(16) + pr * 128, lam, lam_init}; \
    att::attn_phase(AP, (att::lds_ptr)(F.lds + RING_OFF), F.vcu, F.G, wave, lane); }
#define MK_MLSTM_CONV { const int tid = fresh_tid(F); mls::conv_phase((const unsigned short*)(ws + F_P), KA_IN(4) + pr * 4096, KA_IN(5) + pr * 1024, (unsigned short*)(ws + F_QKC), LI, LF, (float*)(ws + F_GB), (float*)(ws + F_GB) + M * 4, (float*)(ws + F_GB) + 2 * M * 4, F.vcu, F.G, tid); }
#define MK_MLSTM_SCAN { const int tid = fresh_tid(F); const int wave = __builtin_amdgcn_readfirstlane(tid >> 6); \
    mls::Params MP{(const unsigned short*)(ws + F_P), (const unsigned short*)(ws + F_QKC), (const float*)(ws + F_GB), (const float*)(ws + F_GB) + M * 4, (const float*)(ws + F_GB) + 2 * M * 4, (float*)(ws + F_HH), \
        KA_IN(25) + (size_t)pr * NE * 1024 * FF, KA_IN(26) + (size_t)pr * NE * 1024 * FF, KA_IN(27) + (size_t)pr * NE * FF * 1024, W0, W0 + (size_t)NE * 7168 * 1024, F.G == 256 ? F.vcu * NWAVES + wave : -1, \
        KA_IN(19) + (size_t)pr * 1024 * FF, KA_IN(20) + (size_t)pr * 1024 * FF, KA_IN(21) + (size_t)pr * FF * 1024, KA_IN(11) + (size_t)pr * 1024 * 3072, KA_IN(17) + (size_t)pr * 1024 * 1024, WS0, MK_KS_FFN, MK_KS_ATT}; \
    mls::scan_phase(MP, (mls::lptr)(F.lds + RING_OFF), F.vcu, F.G, wave); }
#define MK_MLSTM_HEADNORM { const int tid = fresh_tid(F), lane = tid & 63, wave = __builtin_amdgcn_readfirstlane(tid >> 6); \
    mls::headnorm_phase((const float*)(ws + F_HH), (const unsigned short*)(ws + F_P), KA_IN(8) + pr * 1024, (unsigned short*)(ws + F_G), F.vcu, F.G, wave, lane); }
#ifndef MK_MLSTM_SCAN
#define MK_MLSTM_SCAN
#endif
#ifndef MK_MLSTM_HEADNORM
#define MK_MLSTM_HEADNORM
#endif
#ifndef MK_ATTENTION
#define MK_ATTENTION
#endif
#ifndef MK_QSCALE
#define MK_KS_FFN (KA_IN(18) + pr * 1024)
#define MK_KS_ATT (KA_IN(10) + pr * 1024)
#define MK_QSCALE 1.0f
#endif
#ifndef MK_GW_QKV
#define MK_GW_QKV 8
#endif
#ifndef MK_GW_RES
#define MK_GW_RES 8
#endif
#ifndef MK_GW_F1
#define MK_GW_F1 8
#endif
#ifndef MK_GW_E2
#define MK_GW_E2 4
#endif
#ifndef MK_GW_E3
#define MK_GW_E3 4
#endif
#ifndef MK_ALIGN_SWI
#define MK_ALIGN_SWI true
#endif
#ifndef MK_ALIGN_RESID
#define MK_ALIGN_RESID true
#endif
namespace mk {
__device__ __forceinline__ void assign_phase(Frame& F, const int* top_e, const int* wg_cnt, int* tok_slot, int* blk_expert, int* n_used, int* slot_row) {
    LAS int* cnt = (LAS int*)(F.lds + RING_OFF);
    LAS int* base = cnt + 2048; LAS int* tot = base + 8; LAS int* wcnt = tot + 8;
    const int t = fresh_tid(F), lane = t & 63, w = __builtin_amdgcn_readfirstlane(t >> 6);
    int c4[4];
#pragma unroll
    for (int q = 0; q < 4; ++q) c4[q] = wg_cnt[t + q * NTHR];
    const int e_own = t < 256 ? top_e[F.vcu * 256 + t] : -1;
#pragma unroll
    for (int q = 0; q < 4; ++q) cnt[t + q * NTHR] = c4[q];
    unsigned long long mym = 0ull;
#pragma unroll
    for (int e = 0; e < 8; ++e) { const unsigned long long bm = __builtin_amdgcn_ballot_w64(e_own == e); mym = (e_own == e) ? bm : mym; if (w < 4 && lane == 0) wcnt[w * 8 + e] = __builtin_popcountll(bm); }
    __syncthreads();
    { int s = 0, b = 0;
#pragma unroll
      for (int q = 0; q < 4; ++q) { const int v = lane * 4 + q, c = cnt[v * 8 + w]; s += c; b += (v < F.vcu) ? c : 0; }
#pragma unroll
      for (int o = 1; o < 64; o <<= 1) { s += shfl_idx_i(s, lane ^ o); b += shfl_idx_i(b, lane ^ o); }
      if (lane == 0) { tot[w] = s; base[w] = b; } }
    __syncthreads();
    int pstv[9]; { int acc = 0;
#pragma unroll
      for (int e = 0; e < 8; ++e) { pstv[e] = acc; acc += (tot[e] + 255) / 256 * 256; }
      pstv[8] = acc; }
    if (F.vcu == 0) {
        if (t == 0) *n_used = pstv[8] / 256;
        if (t < NBLK) { int e = 0;
#pragma unroll
            for (int q = 1; q < 8; ++q) e += (t * 256 >= pstv[q]) ? 1 : 0;
            blk_expert[t] = e; }
    }
    if (t < 256) { const int e = e_own; int r = __builtin_popcountll(mym & ((1ull << lane) - 1ull)), p = 0, bs = 0;
#pragma unroll
        for (int w2 = 0; w2 < 4; ++w2) r += (w2 < w) ? wcnt[w2 * 8 + e] : 0;
#pragma unroll
        for (int q = 0; q < 8; ++q) { p = (e == q) ? pstv[q] : p; }
        bs = base[e];
        const int slot = p + bs + r; tok_slot[F.vcu * 256 + t] = slot; slot_row[slot] = (F.vcu * 256 + t) >> 1; }
    __syncthreads();
}

struct Args { const float* in[29]; float* out; unsigned char* ws; int ph_lo, ph_hi, li, flags; };
constexpr int PH_FINAL = 34, PH_COMBINE = 35;
constexpr float ATT_C2 = 0.125f * 1.4426950408889634f;

typedef const __attribute__((address_space(4))) unsigned char* kaptr_t;
__device__ __forceinline__ kaptr_t ka_fresh() { kaptr_t p = (kaptr_t)__builtin_amdgcn_kernarg_segment_ptr(); asm volatile("" : "+s"(p)); return p; }
#define KA_IN(k) (*(const float* const __attribute__((address_space(4)))*)(ka + 8 * (k)))
#define KA_OUT (*(float* const __attribute__((address_space(4)))*)(ka + 232))
#define KA_WS (*(unsigned char* const __attribute__((address_space(4)))*)(ka + 240))
#define KA_INT(off) (*(const int __attribute__((address_space(4)))*)(ka + (off)))
static_assert(sizeof(Args) == 264, "Args layout (kernarg offsets above)");
#define PHASE_PTRS kaptr_t ka = ka_fresh(); unsigned char* const ws = KA_WS; float* const xo = KA_OUT; bf16* const XN = (bf16*)xo; bf16* const XB = (bf16*)(ws + F_XN); bf16* const W0 = (bf16*)(ws + F_W); bf16* const WS0 = (bf16*)(ws + F_WS); (void)WS0; \
    int* const top_e = (int*)(ws + F_TOPE); float* const top_g = (float*)(ws + F_TOPG); int* const slot_tok = (int*)(ws + F_SLOTTOK); int* const tok_slot = (int*)(ws + F_TOKSLOT); \
    int* const blk_e = (int*)(ws + F_BLKE); int* const n_used = (int*)(ws + F_NUSED); float* const LI = (float*)(ws + F_LI); float* const LF = (float*)(ws + F_LF); bf16* const Ybuf = (bf16*)(ws + F_Y); \
    (void)xo; (void)XN; (void)XB; (void)W0; (void)top_e; (void)top_g; (void)slot_tok; (void)tok_slot; (void)blk_e; (void)n_used; (void)LI; (void)LF; (void)Ybuf; (void)ws
__global__ void __launch_bounds__(NTHR, 2) mk_fwd(Args) {
    extern __shared__ __attribute__((aligned(16))) unsigned char lds[];
    Frame F;
    F.lds = (LAS unsigned char*)lds;
    volatile LAS unsigned* MISC = (volatile LAS unsigned*)(F.lds + MISC_OFF);
    F.wave = __builtin_amdgcn_readfirstlane((int)threadIdx.x >> 6);
    F.G = gridDim.x; { const int bx = blockIdx.x; F.vcu = (F.G % 8 == 0) ? (bx % 8) * (F.G / 8) + bx / 8 : bx; }
    for (int u = threadIdx.x; u < (LDS_BYTES - LDSCTL_OFF) / 4; u += NTHR) ((LAS unsigned*)(F.lds + LDSCTL_OFF))[u] = 0u;
    __syncthreads();
    int lo, hi, flags; XcdBarrier bar;
    { kaptr_t ka = ka_fresh(); lo = KA_INT(248); hi = KA_INT(252); flags = KA_INT(260); const int li = KA_INT(256);
      bar = xcd_barrier_post((unsigned*)((gu32*)(KA_WS + F_CTL) + CW_BAR) + li * XCD_BAR_WORDS, MISC + 8, threadIdx.x == 0); }
#define IN(k) (lo <= (k) && (k) < hi)
#if defined(PROBE_PHSET)
#ifndef PROBE_PAIR
#define PROBE_PAIR pr
#endif
#define PT0(n) if (((PROBE_PHSET >> (n)) & 1) && pr == PROBE_PAIR) pt0_ = __builtin_amdgcn_s_memrealtime();
#define PT1(n) if (((PROBE_PHSET >> (n)) & 1) && pr == PROBE_PAIR) { asm volatile("s_waitcnt vmcnt(0) lgkmcnt(0)" ::: "memory"); probe_acc += (unsigned)(__builtin_amdgcn_s_memrealtime() - pt0_); }
#else
#define PT0(n)
#define PT1(n)
#endif
#if defined(PROBE_PHASE)
#define REPS(n) ((n) == PROBE_PHASE ? 1 + PROBE_REPS : 1)
#else
#define REPS(n) 1
#endif
#if defined(PROBE_BARWAIT)
#define SEAM(k) do { if (IN(k) && IN((k) + 1)) { const unsigned long long t0_ = __builtin_amdgcn_s_memrealtime(); xcd_barrier(bar, F.wave == 0 && lane_id() == 0); probe_acc += (unsigned)(__builtin_amdgcn_s_memrealtime() - t0_); } } while (0)
#else
#define SEAM(k) do { PT1((k) - pb) if (IN(k) && IN((k) + 1)) xcd_barrier(bar, F.wave == 0 && lane_id() == 0); } while (0)
#endif

    unsigned probe_acc = 0u; (void)probe_acc; unsigned long long pt0_ = 0; (void)pt0_;
    for (int pr = 0; pr < 2; ++pr) {
        const int pb = pr * 17;
        if (IN(pb + 0)) _Pragma("unroll") for (int rep_ = 0; rep_ < REPS(0); ++rep_) { PHASE_PTRS; PT0(0)
            cvt_job(F, KA_IN(3) + (size_t)pr * 1024 * 3080, 3080, 1024, 3072, 1, 0, WS0, 0, 0, 0);
            cvt_job(F, KA_IN(9) + (size_t)pr * 1024 * 1024, 1024, 1024, 1024, 1, 0, WS0 + 3072 * 1024, 0, 0, 1536);
            RowJob J{}; const bool first = (pr == 0) && !(flags & 1);
            const bool comb = (pr == 1) && !(flags & 2);
            J.xsrc = first ? KA_IN(0) : nullptr; J.xbsrc = XB; J.xbdst = (first || comb) ? XB : nullptr; J.nw = KA_IN(2) + pr * 1024; J.XN = XN;
            if (comb) { J.Y = Ybuf; J.tok_slot = tok_slot; J.top_g = top_g; }
            J.slab = KA_IN(3) + (size_t)pr * 1024 * 3080 + 3072; J.slab_ld = 3080; J.kind = 1; J.b0 = KA_IN(6) + pr * 4; J.b1 = KA_IN(7) + pr * 4; J.LI = LI; J.LF = LF;
            row_phase(F, J);
        }
        SEAM(pb + 0);
        if (IN(pb + 1)) _Pragma("unroll") for (int rep_ = 0; rep_ < REPS(1); ++rep_) { PHASE_PTRS; PT0(1)
            pg8::Gemm g{XN, WS0, M, 3072, 1024, nullptr}; pg8::StaticOrder S; S.init(M, 3072, F.G, (int)blockIdx.x, MK_GW_QKV);
            pg8::EpiBf16 E{(bf16*)(ws + F_P), 3072, 1.f, 0};
            pg8::gemm_phase<pg8::EpiBf16, pg8::StaticOrder, true, false>(F.lds + RING_OFF, g, S, E, F.wave);
        }
        SEAM(pb + 1);
        if (IN(pb + 2)) _Pragma("unroll") for (int rep_ = 0; rep_ < REPS(2); ++rep_) { PHASE_PTRS; PT0(2) MK_MLSTM_CONV }
        SEAM(pb + 2);
        if (IN(pb + 3)) _Pragma("unroll") for (int rep_ = 0; rep_ < REPS(3); ++rep_) { PHASE_PTRS; PT0(3) MK_MLSTM_SCAN }
        SEAM(pb + 3);
        if (IN(pb + 4)) _Pragma("unroll") for (int rep_ = 0; rep_ < REPS(4); ++rep_) { PHASE_PTRS; PT0(4) MK_MLSTM_HEADNORM }
        SEAM(pb + 4);
        if (IN(pb + 5)) _Pragma("unroll") for (int rep_ = 0; rep_ < REPS(5); ++rep_) { PHASE_PTRS; PT0(5)
            pg8::Gemm g{(const bf16*)(ws + F_G), WS0 + 3072 * 1024, M, 1024, 1024, nullptr}; pg8::StaticOrder S; S.init(M, 1024, F.G, (int)blockIdx.x, MK_GW_RES);
            pg8::EpiResidB<true> E{XB, 1024, (float*)(ws + F_SSQ)};
            pg8::gemm_phase<pg8::EpiResidB<true>, pg8::StaticOrder, MK_ALIGN_RESID, false>(F.lds + RING_OFF, g, S, E, F.wave);
        }
        SEAM(pb + 5);
        if (IN(pb + 7)) _Pragma("unroll") for (int rep_ = 0; rep_ < REPS(7); ++rep_) { PHASE_PTRS; PT0(7)
            pg8::Gemm g{XB, WS0 + mls::WS_FGU, M, 2 * FF, 1024, nullptr}; pg8::StaticOrder S; S.init(M, 2 * FF, F.G, (int)blockIdx.x, MK_GW_F1);
            pg8::EpiSwiGLUT<true> E{(bf16*)(ws + F_H), FF};
            pg8::gemm_phase<pg8::EpiSwiGLUT<true>, pg8::StaticOrder, MK_ALIGN_SWI, false, true>(F.lds + RING_OFF, g, S, E, F.wave, (const float*)(ws + F_SSQ), (PG8_LAS float*)(F.lds + LDSCTL_OFF + 1024));
        }
        SEAM(pb + 7);
        if (IN(pb + 8)) _Pragma("unroll") for (int rep_ = 0; rep_ < REPS(8); ++rep_) { PHASE_PTRS; PT0(8)
            pg8::Gemm g{(const bf16*)(ws + F_H), WS0 + mls::WS_FD, M, 1024, FF, nullptr}; pg8::StaticOrder S; S.init(M, 1024, F.G, (int)blockIdx.x, MK_GW_RES);
            pg8::EpiResidB<true> E{XB, 1024, (float*)(ws + F_SSQ)};
            pg8::gemm_phase<pg8::EpiResidB<true>, pg8::StaticOrder, MK_ALIGN_RESID, false>(F.lds + RING_OFF, g, S, E, F.wave);
        }
        SEAM(pb + 8);
        if (IN(pb + 10)) _Pragma("unroll") for (int rep_ = 0; rep_ < REPS(10); ++rep_) { PHASE_PTRS; PT0(10)
            pg8::Gemm g{XB, WS0 + mls::WS_AI, M, 3072, 1024, nullptr}; pg8::StaticOrder S; S.init(M, 3072, F.G, (int)blockIdx.x, MK_GW_QKV);
            pg8::EpiBf16T<true> E{(bf16*)(ws + F_P), 3072, MK_QSCALE, 4};
            pg8::gemm_phase<pg8::EpiBf16T<true>, pg8::StaticOrder, true, false, true>(F.lds + RING_OFF, g, S, E, F.wave, (const float*)(ws + F_SSQ), (PG8_LAS float*)(F.lds + LDSCTL_OFF + 1024));
        }
        SEAM(pb + 10);
        if (IN(pb + 11)) _Pragma("unroll") for (int rep_ = 0; rep_ < REPS(11); ++rep_) { PHASE_PTRS; PT0(11) MK_ATTENTION }
        SEAM(pb + 11);
        if (IN(pb + 12)) _Pragma("unroll") for (int rep_ = 0; rep_ < REPS(12); ++rep_) { PHASE_PTRS; PT0(12)
            pg8::Gemm g{(const bf16*)(ws + F_O), WS0 + mls::WS_AO, M, 1024, 1024, nullptr}; pg8::StaticOrder S; S.init(M, 1024, F.G, (int)blockIdx.x, MK_GW_RES);
            pg8::EpiResidB<false> E{XB, 1024, nullptr};
            pg8::gemm_phase<pg8::EpiResidB<false>, pg8::StaticOrder, MK_ALIGN_RESID, false>(F.lds + RING_OFF, g, S, E, F.wave);
        }
        SEAM(pb + 12);
        if (IN(pb + 13)) _Pragma("unroll") for (int rep_ = 0; rep_ < REPS(13); ++rep_) { PHASE_PTRS; PT0(13)
#ifndef MK_CV_FIRST
#define MK_CV_FIRST 0
#endif
            if (F.G != 256 || MK_CV_FIRST != 0) {
            cvt_job(F, KA_IN(25) + (size_t)pr * NE * 1024 * FF, FF, 1024, FF, NE, (size_t)1024 * FF, W0, (size_t)7168 * 1024, 1, 0);
            cvt_job(F, KA_IN(26) + (size_t)pr * NE * 1024 * FF, FF, 1024, FF, NE, (size_t)1024 * FF, W0, (size_t)7168 * 1024, 2, 0);
            cvt_job(F, KA_IN(27) + (size_t)pr * NE * FF * 1024, 1024, FF, 1024, NE, (size_t)FF * 1024, W0 + (size_t)NE * 7168 * 1024, (size_t)1024 * FF, 0, 0); }
            RowJob J{}; J.xbsrc = XB; J.nw = KA_IN(22) + pr * 1024; J.XN = XN;
            J.slab = KA_IN(23) + (size_t)pr * 8192; J.slab_ld = 8; J.kind = 2; J.b0 = KA_IN(24) + pr * 8; J.top_e = top_e; J.top_g_out = top_g; J.wg_cnt = slot_tok;
            row_phase(F, J);
        }
        SEAM(pb + 13);
        if (IN(pb + 14)) _Pragma("unroll") for (int rep_ = 0; rep_ < REPS(14); ++rep_) { PHASE_PTRS; PT0(14) assign_phase(F, top_e, slot_tok, tok_slot, blk_e, n_used, slot_tok + 4096); }
        SEAM(pb + 14);
        if (IN(pb + 15)) _Pragma("unroll") for (int rep_ = 0; rep_ < REPS(15); ++rep_) { PHASE_PTRS; PT0(15)
            const int nb = __builtin_amdgcn_readfirstlane(*(volatile int*)n_used);
            pg8::Gemm g{XN, W0, nb * 256, 2 * FF, 1024, slot_tok + 4096, M}; pg8::GroupOrder S; S.init(nb, 2 * FF / 256, F.G, (int)blockIdx.x, blk_e, (long)7168 * 1024, MK_GW_E2);
            pg8::EpiSwiGLU E{(bf16*)(ws + F_H), FF};
            pg8::gemm_phase<pg8::EpiSwiGLU, pg8::GroupOrder, MK_ALIGN_SWI, true>(F.lds + RING_OFF, g, S, E, F.wave, nullptr, nullptr, (PG8_LAS int*)(F.lds + LDSCTL_OFF + 4096));
        }
        SEAM(pb + 15);
        if (IN(pb + 16)) _Pragma("unroll") for (int rep_ = 0; rep_ < REPS(16); ++rep_) { PHASE_PTRS; PT0(16)
            const int nb = __builtin_amdgcn_readfirstlane(*(volatile int*)n_used);
            const int nmain = nb < 256 ? nb : 256;
            pg8::Gemm g{(const bf16*)(ws + F_H), W0 + (size_t)NE * 7168 * 1024, nb * 256, 1024, FF, nullptr}; pg8::GroupOrder S; S.init(nmain, 4, F.G, (int)blockIdx.x, blk_e, (long)1024 * FF, MK_GW_E3);
            pg8::EpiBf16 E{Ybuf, 1024, 1.f, 0};
            pg8::gemm_phase<pg8::EpiBf16, pg8::GroupOrder, true, false>(F.lds + RING_OFF, g, S, E, F.wave);
            __syncthreads();
            { pg8::Gemm g2{(const bf16*)(ws + F_H), W0 + (size_t)NE * 7168 * 1024, nb * 256, 1024, YP_KC, nullptr, 0, FF}; pg8::SplitOrder S2; S2.init(256, nb - 256, 4, YP_NS, YP_KC, F.G, (int)blockIdx.x, blk_e, (long)1024 * FF);
              pg8::EpiBf16Part E2{(bf16*)(ws + F_YP), 1024, 256, YP_ROWS, YP_KC};
              pg8::gemm_phase<pg8::EpiBf16Part, pg8::SplitOrder, true, false, false, true>(F.lds + RING_OFF, g2, S2, E2, F.wave);
              const int nsu = (nb - 256) * 4 * YP_NS, tid = fresh_tid(F);
              for (int L = (int)blockIdx.x; L < nsu; L += F.G) {
                  asm volatile("s_waitcnt vmcnt(0)" ::: "memory"); __syncthreads();
                  const int tile = L / YP_NS;
                  if (tid == 0) { __builtin_amdgcn_fence(__ATOMIC_RELEASE, "agent"); asm volatile("s_waitcnt vmcnt(0)" ::: "memory");
                      const unsigned old = __hip_atomic_fetch_add((unsigned*)((gu32*)(ws + F_CTL) + CW_YP + pr * 32 + tile), 1u, RLX_AGENT);
                      if (old == (unsigned)(YP_NS - 1)) { __builtin_amdgcn_fence(__ATOMIC_ACQUIRE, "agent"); asm volatile("s_waitcnt vmcnt(0)" ::: "memory"); }
                      MISC[13] = old; }
                  __syncthreads();
                  if (MISC[13] == (unsigned)(YP_NS - 1)) {
                      const int x = tile >> 2, pn = tile & 3; const bf16* pl = (const bf16*)(ws + F_YP);
                      for (int q = tid; q < 256 * 32; q += NTHR) { const int r = q >> 5, c8 = (q & 31) * 8; float t[8];
#pragma unroll
                          for (int e = 0; e < 8; ++e) t[e] = 0.f;
#pragma unroll
                          for (int kc = 0; kc < YP_NS; ++kc) { const v4u v = *(const GAS v4u*)(pl + ((size_t)kc * YP_ROWS + x * 256 + r) * 1024 + pn * 256 + c8);
                              t[0] += bf_lo(v.x); t[1] += bf_hi(v.x); t[2] += bf_lo(v.y); t[3] += bf_hi(v.y); t[4] += bf_lo(v.z); t[5] += bf_hi(v.z); t[6] += bf_lo(v.w); t[7] += bf_hi(v.w); }
                          v4u o; o.x = pk2(t[0], t[1]); o.y = pk2(t[2], t[3]); o.z = pk2(t[4], t[5]); o.w = pk2(t[6], t[7]);
                          *(GAS v4u*)(Ybuf + ((size_t)(256 + x) * 256 + r) * 1024 + pn * 256 + c8) = o; } }
                  __syncthreads();
              } }
        }
        SEAM(pb + 16);
    }
    if (IN(PH_FINAL)) { PHASE_PTRS;
        RowJob J{}; J.xbsrc = XB; J.nw = KA_IN(28); J.outf = xo; if (!(flags & 2)) { J.Y = Ybuf; J.tok_slot = tok_slot; J.top_g = top_g; }
        row_phase(F, J);
    }
#if defined(PROBE_BARWAIT) || defined(PROBE_PHSET)
#ifndef PROBE_BARWAIT
#define PROBE_BARWAIT 0
#endif
#ifndef PROBE_SCALE
#define PROBE_SCALE 0.001f
#endif
#ifndef PROBE_OFFS
#define PROBE_OFFS 0.f
#endif
    if (IN(PH_FINAL)) { PHASE_PTRS; __syncthreads(); asm volatile("s_waitcnt vmcnt(0)" ::: "memory"); if (blockIdx.x == PROBE_BARWAIT && F.wave == 0 && lane_id() == 0) xo[0] += (float)probe_acc * PROBE_SCALE - PROBE_OFFS; }
#endif
#undef IN
#undef SEAM
}
}
extern "C" void kernel_launch(void* const* d_in, const int* in_sizes, int n_in, void* d_out, int out_size, void* d_ws, size_t ws_size, hipStream_t stream) {
    static int grid = 0;
    if (grid == 0) {
        int dev = 0, cus = 0, per_cu = 0;
        (void)hipGetDevice(&dev); (void)hipDeviceGetAttribute(&cus, hipDeviceAttributeMultiprocessorCount, dev);
        (void)hipFuncSetAttribute((const void*)mk::mk_fwd, hipFuncAttributeMaxDynamicSharedMemorySize, mk::LDS_BYTES);
        (void)hipOccupancyMaxActiveBlocksPerMultiprocessor(&per_cu, (const void*)mk::mk_fwd, mk::NTHR, mk::LDS_BYTES);
        (void)hipGetLastError();
        grid = cus > 0 ? cus : 256;
    }
    mk::Args a{}; for (int i = 0; i < 29; ++i) a.in[i] = (const float*)d_in[i];
    a.out = (float*)d_out; a.ws = (unsigned char*)d_ws; a.ph_lo = 0; a.ph_hi = mk::PH_FINAL + 1; a.li = 0; a.flags = 0;
    (void)hipMemsetAsync((unsigned char*)d_ws + mk::F_CTL, 0, mk::CTL_ZERO_BYTES, stream);
    hipLaunchKernelGGL(mk::mk_fwd, dim3(grid), dim3(mk::NTHR), mk::LDS_BYTES, stream, a);
}
```

```cpp
#include <hip/hip_runtime.h>
#include <cstdio>
#include <cstdint>
#include <cmath>
namespace nv {
__device__ const int BUCKET[128] = {0, 1, 2, 3, 4, 5, 6, 7, 8, 9, 10, 11, 12, 13, 14, 15, 16, 16, 16, 17, 17, 18, 18, 18, 19, 19, 19, 20, 20, 20, 20, 21, 21, 21, 21, 22, 22, 22, 22, 22, 23, 23, 23, 23, 23, 23, 24, 24, 24, 24, 24, 24, 25, 25, 25, 25, 25, 25, 25, 26, 26, 26, 26, 26, 26, 26, 26, 27, 27, 27, 27, 27, 27, 27, 27, 27, 27, 28, 28, 28, 28, 28, 28, 28, 28, 28, 28, 29, 29, 29, 29, 29, 29, 29, 29, 29, 29, 29, 29, 30, 30, 30, 30, 30, 30, 30, 30, 30, 30, 30, 30, 30, 30, 31, 31, 31, 31, 31, 31, 31, 31, 31, 31, 31, 31, 31, 31, 31};
}
namespace pg8 {
#define PG8_LAS __attribute__((address_space(3)))
typedef unsigned short bf16_t;
typedef short bf16x8 __attribute__((ext_vector_type(8)));
typedef float f32x4 __attribute__((ext_vector_type(4)));
typedef float f32x2 __attribute__((ext_vector_type(2)));
typedef unsigned u32x4 __attribute__((ext_vector_type(4)));
#ifndef PG8_WGM
#define PG8_WGM 8
#endif
#ifndef PG8_GWGM
#define PG8_GWGM 8
#endif
#ifndef PG8_GROUP_XCD
#define PG8_GROUP_XCD 1
#endif
constexpr int BM = 256, BK = 64, HALF = 128, HTB = HALF * BK * 2  , STAGE_BYTES = 8 * HTB, NXCD = 8, WGM = PG8_WGM;

__host__ __device__ __forceinline__ int lds_byte(int r, int c) { const int st = (r >> 4) * 2 + (c >> 5), rr = r & 15, cc = c & 31, ob = rr * 64 + cc * 2; return st * 1024 + (ob ^ (((ob >> 9) & 1) << 5)); }
__host__ __device__ __forceinline__ void stage_rc(int b, int& R, int& C) { const int st = b / 1024, sb = b % 1024, swz = sb ^ (((sb >> 9) & 1) << 5); R = (st >> 1) * 16 + swz / 64; C = (st & 1) * 32 + (swz % 64) / 2; }
__host__ __device__ __forceinline__ int perm32(int rho) { const int n = rho >> 4, i = rho & 15; return 8 * (i >> 2) + 4 * n + (i & 3); }

struct Unit { int pm, pn; long boff; long aoff; };
struct Gemm { const bf16_t* A; const bf16_t* Bt; int M, N, K; const int* arow; int arows; int ld; };

struct StaticOrder {
    int nM, nN, nwg, G, c, gw;
    __host__ __device__ void init(int M, int N, int G_, int c_, int gw_ = WGM) { nM = M / BM; nN = N / BM; nwg = nM * nN; G = G_; c = c_; gw = gw_; }
    __host__ __device__ bool next(int i, Unit& u) const {
        const long L = (long)i * G + c; if (L >= nwg) return false;
        int wgid = (int)L; { const int q = nwg / NXCD, r = nwg % NXCD, xcd = wgid % NXCD, off = wgid / NXCD; wgid = (xcd < r ? xcd * (q + 1) : r * (q + 1) + (xcd - r) * q) + off; }
        const int nig = gw * nN, gid = wgid / nig, fm = gid * gw, gsz = (nM - fm) < gw ? (nM - fm) : gw;
        u.pm = fm + ((wgid % nig) % gsz); u.pn = (wgid % nig) / gsz; u.boff = 0; return true;
    }
};
struct GroupOrder {
    int nM, nN, nwg, G, c, gw; const int* blk_e; long wstride;
    __device__ void init(int nM_, int nN_, int G_, int c_, const int* be, long ws, int gw_) { nM = nM_; nN = nN_; nwg = nM * nN; G = G_; c = c_; blk_e = be; wstride = ws; gw = gw_; }
    __device__ bool next(int i, Unit& u) const {
        const long L = (long)i * G + c; if (L >= nwg) return false;
        int wgid = (int)L;
        if (PG8_GROUP_XCD) { const int q = nwg / NXCD, r = nwg % NXCD, xcd = wgid % NXCD, off = wgid / NXCD; wgid = (xcd < r ? xcd * (q + 1) : r * (q + 1) + (xcd - r) * q) + off; }
        const int nig = gw * nN, gid = wgid / nig, fm = gid * gw, gsz = (nM - fm) < gw ? (nM - fm) : gw;
        u.pm = fm + ((wgid % nig) % gsz); u.pn = (wgid % nig) / gsz; u.boff = (long)blk_e[u.pm] * wstride; return true;
    }
};

struct SplitOrder {
    int pm0, nN, ns, kc_len, nwg, G, c; const int* blk_e; long wstride;
    __device__ void init(int pm0_, int nx, int nN_, int ns_, int kc_len_, int G_, int c_, const int* be, long ws) { pm0 = pm0_; nN = nN_; ns = ns_; kc_len = kc_len_; nwg = nx > 0 ? nx * nN_ * ns_ : 0; G = G_; c = c_; blk_e = be; wstride = ws; }
    __device__ bool next(int i, Unit& u) const {
        const long L = (long)i * G + c; if (L >= nwg) return false;
        const int l = (int)L, kc = l % ns, r = l / ns; u.pn = r % nN; u.pm = pm0 + r / nN; u.aoff = (long)kc * kc_len; u.boff = (long)blk_e[u.pm] * wstride + u.aoff; return true;
    }
};

__device__ __forceinline__ unsigned cvt_pk_bf16(float lo, float hi) { unsigned r; asm volatile("v_cvt_pk_bf16_f32 %0, %1, %2" : "=v"(r) : "v"(lo), "v"(hi)); return r; }
__device__ __forceinline__ float silu_f(float v) { return v * __builtin_amdgcn_rcpf(1.0f + __builtin_amdgcn_exp2f(-1.4426950408889634f * v)); }

#ifndef PG8_WT
#define PG8_WT 0
#endif
template <class V> __device__ __forceinline__ void st16(void* p, const V& v) {
#if PG8_WT == 1
    asm volatile("global_store_dwordx4 %0, %1, off sc1\n\ts_nop 1" :: "v"(p), "v"(v) : "memory");
#elif PG8_WT == 2
    asm volatile("global_store_dwordx4 %0, %1, off sc0 sc1\n\ts_nop 1" :: "v"(p), "v"(v) : "memory");
#elif PG8_WT == 3
    asm volatile("global_store_dwordx4 %0, %1, off nt\n\ts_nop 1" :: "v"(p), "v"(v) : "memory");
#else
    *(V*)p = v;
#endif
}
template <bool RSC> struct EpiBf16T {
    static constexpr bool PERM = true;
    bf16_t* O; int ldc; float scale0; int nscaled;
    __device__ __forceinline__ void operator()(const f32x4 (&acc)[2][2][4][2], const Unit& u, int wr, int wc, int fr, int fq, const PG8_LAS float* rs) const {
        const int row0 = u.pm * BM + wr * 64 + fr, col0 = u.pn * BM + wc * 32 + 8 * fq;
        const float sc0 = (u.pn < nscaled) ? scale0 : 1.f;
#pragma unroll
        for (int ai = 0; ai < 2; ++ai)
#pragma unroll
            for (int m = 0; m < 4; ++m) { bf16_t* rowp = O + (size_t)(row0 + ai * HALF + m * 16) * ldc + col0;
                const float sc = RSC ? sc0 * rs[ai * HALF + wr * 64 + m * 16 + fr] : sc0;
#pragma unroll
                for (int bj = 0; bj < 2; ++bj) { const f32x4 v0 = acc[ai][bj][m][0] * sc, v1 = acc[ai][bj][m][1] * sc;
                    u32x4 w; w.x = cvt_pk_bf16(v0[0], v0[1]); w.y = cvt_pk_bf16(v0[2], v0[3]); w.z = cvt_pk_bf16(v1[0], v1[1]); w.w = cvt_pk_bf16(v1[2], v1[3]);
                    st16(rowp + bj * HALF, w); } }
    }
};
typedef EpiBf16T<false> EpiBf16;
struct EpiBf16Part {
    static constexpr bool PERM = true;
    bf16_t* O; int ldc, pm0, prow, kc_len;
    __device__ __forceinline__ void operator()(const f32x4 (&acc)[2][2][4][2], const Unit& u, int wr, int wc, int fr, int fq, const PG8_LAS float*) const {
        const int kc = (int)u.aoff / kc_len, row0 = kc * prow + (u.pm - pm0) * BM + wr * 64 + fr, col0 = u.pn * BM + wc * 32 + 8 * fq;
#pragma unroll
        for (int ai = 0; ai < 2; ++ai)
#pragma unroll
            for (int m = 0; m < 4; ++m) { bf16_t* rowp = O + (size_t)(row0 + ai * HALF + m * 16) * ldc + col0;
#pragma unroll
                for (int bj = 0; bj < 2; ++bj) { const f32x4 v0 = acc[ai][bj][m][0], v1 = acc[ai][bj][m][1];
                    u32x4 w; w.x = cvt_pk_bf16(v0[0], v0[1]); w.y = cvt_pk_bf16(v0[2], v0[3]); w.z = cvt_pk_bf16(v1[0], v1[1]); w.w = cvt_pk_bf16(v1[2], v1[3]);
                    st16(rowp + bj * HALF, w); } }
    }
};
template <bool RSC> struct EpiSwiGLUT {
    static constexpr bool PERM = true;
    bf16_t* O; int ldc;
    __device__ __forceinline__ void operator()(const f32x4 (&acc)[2][2][4][2], const Unit& u, int wr, int wc, int fr, int fq, const PG8_LAS float* rs) const {
        const int row0 = u.pm * BM + wr * 64 + fr, col0 = u.pn * HALF + wc * 32 + 8 * fq;
#pragma unroll
        for (int ai = 0; ai < 2; ++ai)
#pragma unroll
            for (int m = 0; m < 4; ++m) { bf16_t* rowp = O + (size_t)(row0 + ai * HALF + m * 16) * ldc + col0;
                const float rsc = RSC ? rs[ai * HALF + wr * 64 + m * 16 + fr] : 1.f;
                const f32x4 g0 = acc[ai][0][m][0] * rsc, g1 = acc[ai][0][m][1] * rsc, u0 = acc[ai][1][m][0] * rsc, u1 = acc[ai][1][m][1] * rsc;
                u32x4 w; w.x = cvt_pk_bf16(silu_f(g0[0]) * u0[0], silu_f(g0[1]) * u0[1]); w.y = cvt_pk_bf16(silu_f(g0[2]) * u0[2], silu_f(g0[3]) * u0[3]);
                w.z = cvt_pk_bf16(silu_f(g1[0]) * u1[0], silu_f(g1[1]) * u1[1]); w.w = cvt_pk_bf16(silu_f(g1[2]) * u1[2], silu_f(g1[3]) * u1[3]);
                st16(rowp, w); }
    }
};
typedef EpiSwiGLUT<false> EpiSwiGLU;
template <bool XB> struct EpiResidT {
    static constexpr bool PERM = true;
    float* O; int ldc; bf16_t* xb; float* ssq; const float* base;
    __device__ __forceinline__ void operator()(const f32x4 (&acc)[2][2][4][2], const Unit& u, int wr, int wc, int fr, int fq, const PG8_LAS float*) const {
        const int row0 = u.pm * BM + wr * 64 + fr, col0 = u.pn * BM + wc * 32 + 8 * fq, lane = fr + 16 * fq;
#pragma unroll
        for (int ai = 0; ai < 2; ++ai) {
            f32x4 xv[4][2][2];
#pragma unroll
            for (int m = 0; m < 4; ++m) { const float* rowp = base + (size_t)(row0 + ai * HALF + m * 16) * ldc + col0;
#pragma unroll
                for (int bj = 0; bj < 2; ++bj)
#pragma unroll
                    for (int n = 0; n < 2; ++n) xv[m][bj][n] = *(const f32x4*)(rowp + bj * HALF + n * 4); }
#pragma unroll
            for (int m = 0; m < 4; ++m) { float* rowp = O + (size_t)(row0 + ai * HALF + m * 16) * ldc + col0;
#pragma unroll
                for (int bj = 0; bj < 2; ++bj)
#pragma unroll
                    for (int n = 0; n < 2; ++n) { xv[m][bj][n] = xv[m][bj][n] + acc[ai][bj][m][n]; st16(rowp + bj * HALF + n * 4, xv[m][bj][n]); } }
            if (XB) {
#pragma unroll
                for (int m = 0; m < 4; ++m) { const size_t ro = (size_t)(row0 + ai * HALF + m * 16); float sq = 0.f;
#pragma unroll
                    for (int bj = 0; bj < 2; ++bj) { const f32x4 v0 = xv[m][bj][0], v1 = xv[m][bj][1];
                        sq += ((v0[0] * v0[0] + v0[1] * v0[1]) + (v0[2] * v0[2] + v0[3] * v0[3])) + ((v1[0] * v1[0] + v1[1] * v1[1]) + (v1[2] * v1[2] + v1[3] * v1[3]));
                        u32x4 w; w.x = cvt_pk_bf16(v0[0], v0[1]); w.y = cvt_pk_bf16(v0[2], v0[3]); w.z = cvt_pk_bf16(v1[0], v1[1]); w.w = cvt_pk_bf16(v1[2], v1[3]);
                        st16(xb + ro * ldc + col0 + bj * HALF, w); }
                    sq += __builtin_bit_cast(float, __builtin_amdgcn_ds_bpermute((lane ^ 16) << 2, __builtin_bit_cast(int, sq)));
                    sq += __builtin_bit_cast(float, __builtin_amdgcn_ds_bpermute((lane ^ 32) << 2, __builtin_bit_cast(int, sq)));
                    if (fq == 0) ssq[ro * 16 + u.pn * 4 + wc] = sq; }
            }
            asm volatile("" ::: "memory");
        }
    }
};
typedef EpiResidT<false> EpiResid;
template <bool SSQ> struct EpiResidB {
    static constexpr bool PERM = true;
    bf16_t* xb; int ldc; float* ssq;
    __device__ __forceinline__ void operator()(const f32x4 (&acc)[2][2][4][2], const Unit& u, int wr, int wc, int fr, int fq, const PG8_LAS float*) const {
        const int row0 = u.pm * BM + wr * 64 + fr, col0 = u.pn * BM + wc * 32 + 8 * fq, lane = fr + 16 * fq;
        u32x4 xv[2][4][2];
#pragma unroll
        for (int ai = 0; ai < 2; ++ai)
#pragma unroll
            for (int m = 0; m < 4; ++m)
#pragma unroll
                for (int bj = 0; bj < 2; ++bj) xv[ai][m][bj] = *(const u32x4*)(xb + (size_t)(row0 + ai * HALF + m * 16) * ldc + col0 + bj * HALF);
#pragma unroll
        for (int ai = 0; ai < 2; ++ai) {
#pragma unroll
            for (int m = 0; m < 4; ++m) { const size_t ro = (size_t)(row0 + ai * HALF + m * 16); float sq = 0.f;
#pragma unroll
                for (int bj = 0; bj < 2; ++bj) { const u32x4 r = xv[ai][m][bj]; const f32x4 a0 = acc[ai][bj][m][0], a1 = acc[ai][bj][m][1];
                    const float v0 = __builtin_bit_cast(float, r.x << 16) + a0[0], v1 = __builtin_bit_cast(float, r.x & 0xffff0000u) + a0[1];
                    const float v2 = __builtin_bit_cast(float, r.y << 16) + a0[2], v3 = __builtin_bit_cast(float, r.y & 0xffff0000u) + a0[3];
                    const float v4 = __builtin_bit_cast(float, r.z << 16) + a1[0], v5 = __builtin_bit_cast(float, r.z & 0xffff0000u) + a1[1];
                    const float v6 = __builtin_bit_cast(float, r.w << 16) + a1[2], v7 = __builtin_bit_cast(float, r.w & 0xffff0000u) + a1[3];
                    if (SSQ) sq += ((v0 * v0 + v1 * v1) + (v2 * v2 + v3 * v3)) + ((v4 * v4 + v5 * v5) + (v6 * v6 + v7 * v7));
                    u32x4 w; w.x = cvt_pk_bf16(v0, v1); w.y = cvt_pk_bf16(v2, v3); w.z = cvt_pk_bf16(v4, v5); w.w = cvt_pk_bf16(v6, v7);
                    st16(xb + ro * ldc + col0 + bj * HALF, w); }
                if (SSQ) {
                    sq += __builtin_bit_cast(float, __builtin_amdgcn_ds_bpermute((lane ^ 16) << 2, __builtin_bit_cast(int, sq)));
                    sq += __builtin_bit_cast(float, __builtin_amdgcn_ds_bpermute((lane ^ 32) << 2, __builtin_bit_cast(int, sq)));
                    if (fq == 0) ssq[ro * 16 + u.pn * 4 + wc] = sq; }
            }
        }
    }
};

template <class Epi, class Sched, bool ALIGN_EPI, bool GATHER, bool RS = false, bool SPLITK = false>
__device__ __forceinline__ void gemm_phase(PG8_LAS unsigned char* lds, const Gemm g, const Sched& S, const Epi& E, int wave_id, const float* ssq = nullptr, PG8_LAS float* rtab = nullptr, PG8_LAS int* gtab = nullptr) {
    int tid_; asm volatile("v_mbcnt_lo_u32_b32 %0, -1, 0\n\tv_mbcnt_hi_u32_b32 %0, -1, %0" : "=v"(tid_)); tid_ += wave_id * 64;
    const int tid = tid_, wid = __builtin_amdgcn_readfirstlane(tid >> 6), lane = tid & 63, wr = wid >> 2, wc = wid & 3, fr = lane & 15, fq = lane >> 4;
    const int K = g.K, nt = K / BK, LD = SPLITK ? g.ld : g.K;
    unsigned voffA[2], voffB[2]; int rA[2], cA2[2];
#pragma unroll
    for (int i = 0; i < 2; ++i) { int R, C; stage_rc(tid * 16 + i * 8192, R, C); const int Rb = Epi::PERM ? ((R & ~31) + perm32(R & 31)) : R;
        voffA[i] = (unsigned)(R * LD + C) * 2u; voffB[i] = (unsigned)(Rb * LD + C) * 2u; rA[i] = R; cA2[i] = C * 2; }
    const size_t kstep = (size_t)(BK * 2);
    const size_t hstep = (size_t)HALF * LD * 2;
    const size_t tstep = 2 * hstep;
    const unsigned ldsw = (unsigned)wid * 1024u;
    const int aoff = lds_byte(wr * 64 + fr, fq * 8), boff = lds_byte(wc * 32 + fr, fq * 8);
#define PG8_SA(b, h) (((b) * 2 + (h)) * HTB)
#define PG8_SB(b, h) ((4 + (b) * 2 + (h)) * HTB)
#define PG8_STAGE2(bufoff, gbase, v0, v1) do { \
        __builtin_amdgcn_global_load_lds((const unsigned*)((const char*)(gbase) + (v0)), (PG8_LAS unsigned*)(lds + (bufoff) + ldsw), 16, 0, 0); \
        __builtin_amdgcn_global_load_lds((const unsigned*)((const char*)(gbase) + (v1)), (PG8_LAS unsigned*)(lds + (bufoff) + ldsw + 8192), 16, 0, 0); } while (0)
#define PG8_STAGEB(bufoff, gbase) PG8_STAGE2(bufoff, gbase, voffB[0], voffB[1])
#define PG8_LDA(dst, b, h) do { _Pragma("unroll") for (int m = 0; m < 4; ++m) _Pragma("unroll") for (int k = 0; k < 2; ++k) dst[m][k] = *(const PG8_LAS bf16x8*)(lds + PG8_SA(b, h) + aoff + m * 2048 + k * 1024); } while (0)
#define PG8_LDB(dst, b, h) do { _Pragma("unroll") for (int n = 0; n < 2; ++n) _Pragma("unroll") for (int k = 0; k < 2; ++k) dst[n][k] = *(const PG8_LAS bf16x8*)(lds + PG8_SB(b, h) + boff + n * 2048 + k * 1024); } while (0)
#define PG8_MMA(ai, bj, At, Bt) do { __builtin_amdgcn_s_setprio(1); _Pragma("unroll") for (int m = 0; m < 4; ++m) _Pragma("unroll") for (int n = 0; n < 2; ++n) _Pragma("unroll") for (int k = 0; k < 2; ++k) \
        acc[ai][bj][m][n] = __builtin_amdgcn_mfma_f32_16x16x32_bf16(Bt[n][k], At[m][k], acc[ai][bj][m][n], 0, 0, 0); __builtin_amdgcn_s_setprio(0); } while (0)
#define PG8_WAIT_V(n) asm volatile("s_waitcnt vmcnt(" #n ")" ::: "memory")
#define PG8_WAIT_L(n) asm volatile("s_waitcnt lgkmcnt(" #n ")" ::: "memory")
#define PG8_BAR __builtin_amdgcn_s_barrier()
#define PG8_SCHED __builtin_amdgcn_sched_barrier(0)
    Unit cur, nxt; int ui = 0;
    if (!S.next(0, cur)) return;
    f32x4 acc[2][2][4][2];
#pragma unroll
    for (int a = 0; a < 2; ++a)
#pragma unroll
        for (int b = 0; b < 2; ++b)
#pragma unroll
            for (int m = 0; m < 4; ++m)
#pragma unroll
                for (int n = 0; n < 2; ++n) acc[a][b][m][n] = (f32x4){0.f, 0.f, 0.f, 0.f};
    bf16x8 At[4][2], B0[2][2], B1[2][2];
    unsigned c00, c01, c10, c11, n00, n01, n10, n11;
    const char* cA; const char* cB = (const char*)g.Bt + (size_t)cur.boff * 2 + (size_t)cur.pn * tstep;
    if constexpr (GATHER) {
        cA = (const char*)g.A;
        const int* ar = g.arow + cur.pm * BM;
        int t00 = ar[rA[0]], t01 = ar[rA[1]], t10 = ar[HALF + rA[0]], t11 = ar[HALF + rA[1]];
        t00 = (unsigned)t00 >= (unsigned)g.arows ? 0 : t00; t01 = (unsigned)t01 >= (unsigned)g.arows ? 0 : t01; t10 = (unsigned)t10 >= (unsigned)g.arows ? 0 : t10; t11 = (unsigned)t11 >= (unsigned)g.arows ? 0 : t11;
        c00 = (unsigned)t00 * (unsigned)(K * 2) + cA2[0]; c01 = (unsigned)t01 * (unsigned)(K * 2) + cA2[1]; c10 = (unsigned)t10 * (unsigned)(K * 2) + cA2[0]; c11 = (unsigned)t11 * (unsigned)(K * 2) + cA2[1];
    } else {
        cA = (const char*)g.A + (size_t)cur.pm * tstep + (SPLITK ? (size_t)cur.aoff * 2 : (size_t)0);
        c00 = voffA[0]; c01 = voffA[1]; c10 = voffA[0]; c11 = voffA[1];
    }
    const size_t HS = GATHER ? (size_t)0 : hstep;
    n00 = c00; n01 = c01; n10 = c10; n11 = c11;
    f32x4 rsld[4];
    if constexpr (RS) { if (wr == 0) { const f32x4* sp = (const f32x4*)(ssq + ((size_t)cur.pm * BM + tid) * 16); const f32x4 a = sp[0], b = sp[1], c = sp[2], d = sp[3];
            const f32x4 t = (a + b) + (c + d); rtab[tid] = __builtin_amdgcn_rsqf(((t[0] + t[1]) + (t[2] + t[3])) * (1.0f / 1024.0f) + 1e-6f); } }
    PG8_STAGEB(PG8_SB(0, 0), cB); PG8_STAGEB(PG8_SB(0, 1), cB + hstep); PG8_STAGE2(PG8_SA(0, 0), cA, c00, c01); PG8_STAGE2(PG8_SA(0, 1), cA + HS, c10, c11);
    if (wr == 1) PG8_BAR;
    PG8_WAIT_V(2); PG8_BAR;
    PG8_STAGEB(PG8_SB(1, 0), cB + kstep); PG8_STAGE2(PG8_SA(1, 0), cA + kstep, c00, c01); PG8_STAGEB(PG8_SB(1, 1), cB + hstep + kstep);
    PG8_WAIT_V(6); PG8_BAR;
    for (;;) {
        const bool has_next = S.next(ui + 1, nxt);
        const char* nA; const char* nB = has_next ? (const char*)g.Bt + (size_t)nxt.boff * 2 + (size_t)nxt.pn * tstep : cB;
        if constexpr (GATHER) {
            nA = cA;
            if (has_next && wid < 4)
                __builtin_amdgcn_global_load_lds((const unsigned*)(g.arow + nxt.pm * BM + tid), (PG8_LAS unsigned*)(gtab + ((ui + 1) & 1) * 256 + wid * 64), 4, 0, 0);
        } else {
            nA = has_next ? (const char*)g.A + (size_t)nxt.pm * tstep + (SPLITK ? (size_t)nxt.aoff * 2 : (size_t)0) : cA;
        }
        if constexpr (RS) { if (has_next && wr == 0) { const f32x4* sp = (const f32x4*)(ssq + ((size_t)nxt.pm * BM + tid) * 16); rsld[0] = sp[0]; rsld[1] = sp[1]; rsld[2] = sp[2]; rsld[3] = sp[3]; } }
        for (int t = 0; t < nt; t += 2) {
            const bool last = (t == nt - 2);
            const char* a1 = cA + (size_t)(t + 1) * kstep;
            const char* a2 = last ? nA : cA + (size_t)(t + 2) * kstep; const char* b2 = last ? nB : cB + (size_t)(t + 2) * kstep;
            const char* a3 = a2 + kstep; const char* b3 = b2 + kstep;
            unsigned x00 = c00, x01 = c01, x10 = c10, x11 = c11;
            if constexpr (GATHER) { if (last) {
                if (has_next) { const unsigned gb = (unsigned)(__SIZE_TYPE__)(gtab + ((ui + 1) & 1) * 256); int t00, t01, t10, t11;
                    asm volatile("ds_read_b32 %0, %4\n\tds_read_b32 %1, %5\n\tds_read_b32 %2, %4 offset:512\n\tds_read_b32 %3, %5 offset:512\n\ts_waitcnt lgkmcnt(0)"
                                 : "=&v"(t00), "=&v"(t01), "=&v"(t10), "=&v"(t11) : "v"(gb + 4u * (unsigned)rA[0]), "v"(gb + 4u * (unsigned)rA[1]) : "memory");
                    t00 = (unsigned)t00 >= (unsigned)g.arows ? 0 : t00; t01 = (unsigned)t01 >= (unsigned)g.arows ? 0 : t01; t10 = (unsigned)t10 >= (unsigned)g.arows ? 0 : t10; t11 = (unsigned)t11 >= (unsigned)g.arows ? 0 : t11;
                    n00 = (unsigned)t00 * (unsigned)(K * 2) + cA2[0]; n01 = (unsigned)t01 * (unsigned)(K * 2) + cA2[1]; n10 = (unsigned)t10 * (unsigned)(K * 2) + cA2[0]; n11 = (unsigned)t11 * (unsigned)(K * 2) + cA2[1]; }
                x00 = n00; x01 = n01; x10 = n10; x11 = n11; } }
            PG8_LDB(B0, 0, 0); PG8_LDB(B1, 0, 1); PG8_SCHED; PG8_LDA(At, 0, 0); PG8_STAGE2(PG8_SA(1, 1), a1 + HS, c10, c11);
            PG8_WAIT_V(8); PG8_WAIT_L(0); PG8_BAR; PG8_MMA(0, 0, At, B0); PG8_MMA(0, 1, At, B1); PG8_BAR; PG8_SCHED;
            PG8_LDA(At, 0, 1); PG8_STAGEB(PG8_SB(0, 0), b2); PG8_STAGEB(PG8_SB(0, 1), b2 + hstep); PG8_STAGE2(PG8_SA(0, 0), a2, x00, x01);
            PG8_WAIT_V(8); PG8_WAIT_L(0); PG8_BAR; PG8_MMA(1, 0, At, B0); PG8_MMA(1, 1, At, B1); PG8_BAR; PG8_SCHED;
            PG8_LDB(B0, 1, 0); PG8_LDB(B1, 1, 1); PG8_SCHED; PG8_LDA(At, 1, 0); PG8_STAGE2(PG8_SA(0, 1), a2 + HS, x10, x11);
            PG8_WAIT_V(8); PG8_WAIT_L(0); PG8_BAR; PG8_MMA(0, 0, At, B0); PG8_MMA(0, 1, At, B1); PG8_BAR; PG8_SCHED;
            PG8_LDA(At, 1, 1); PG8_STAGEB(PG8_SB(1, 0), b3); PG8_STAGEB(PG8_SB(1, 1), b3 + hstep); PG8_STAGE2(PG8_SA(1, 0), a3, x00, x01);
            PG8_WAIT_V(8); PG8_WAIT_L(0); PG8_BAR; PG8_MMA(1, 0, At, B0); PG8_MMA(1, 1, At, B1); PG8_BAR; PG8_SCHED;
        }
        if constexpr (ALIGN_EPI) { if (wr == 0) PG8_BAR; }
        if constexpr (RS) { if (has_next && wr == 0) { const f32x4 t = (rsld[0] + rsld[1]) + (rsld[2] + rsld[3]); rtab[((ui + 1) & 1) * 256 + tid] = __builtin_amdgcn_rsqf(((t[0] + t[1]) + (t[2] + t[3])) * (1.0f / 1024.0f) + 1e-6f); } }
        E(acc, cur, wr, wc, fr, fq, RS ? rtab + (ui & 1) * 256 : (PG8_LAS float*)nullptr);
        if (!has_next) break;
#pragma unroll
        for (int a = 0; a < 2; ++a)
#pragma unroll
            for (int b = 0; b < 2; ++b)
#pragma unroll
                for (int m = 0; m < 4; ++m)
#pragma unroll
                    for (int n = 0; n < 2; ++n) acc[a][b][m][n] = (f32x4){0.f, 0.f, 0.f, 0.f};
        cur = nxt; cA = nA; cB = nB; ++ui;
        c00 = n00; c01 = n01; c10 = n10; c11 = n11;
        if constexpr (ALIGN_EPI) { if (wr == 1) PG8_BAR; }
    }
    PG8_WAIT_V(0);
    if constexpr (!ALIGN_EPI) { if (wr == 0) PG8_BAR; }
    PG8_BAR;
#undef PG8_SA
#undef PG8_SB
#undef PG8_STAGE2
#undef PG8_STAGEB
#undef PG8_LDA
#undef PG8_LDB
#undef PG8_MMA
#undef PG8_WAIT_V
#undef PG8_WAIT_L
#undef PG8_BAR
#undef PG8_SCHED
}
}
namespace mk {
constexpr int NWAVES = 8, NTHR = 512;
constexpr int B = 8, S = 4096, D = 1024, M = B * S;
constexpr int FF = 3584, NE = 8, NBLK = 264, NSLOT = NBLK * 256;
constexpr size_t MiB = 1u << 20;
constexpr size_t F_CTL = 0, CTL_ZERO_BYTES = 1 * MiB;
constexpr size_t F_TOPE = 1 * MiB, F_TOPG = F_TOPE + 256 * 1024, F_SLOTTOK = F_TOPG + 256 * 1024, F_TOKSLOT = F_SLOTTOK + 320 * 1024, F_BLKE = F_TOKSLOT + 256 * 1024, F_NUSED = F_BLKE + 2048;
constexpr size_t F_LI = 3 * MiB, F_LF = 3 * MiB + 512 * 1024;
constexpr size_t F_W = 4 * MiB, F_WS = 172 * MiB, F_XN = 212 * MiB, F_BIG = 276 * MiB;
constexpr size_t F_P = F_BIG, F_HH = 468 * MiB, F_G = 596 * MiB, F_QKC = 660 * MiB;
constexpr size_t F_YP = F_WS + 9 * MiB;
constexpr int YP_SLOT0 = 65536, YP_ROWS = 2048, YP_NS = 7, YP_KC = 512;
constexpr size_t F_H = F_BIG;
constexpr size_t F_O = 468 * MiB, F_OT = 532 * MiB;
constexpr size_t F_Y = 738 * MiB, F_SSQ = 870 * MiB, F_GB = 872 * MiB;
static_assert(F_NUSED + 64 <= 3 * MiB && F_H + (size_t)NSLOT * FF * 2 <= F_Y && F_Y + (size_t)NSLOT * 1024 * 2 <= 872 * MiB, "ws map");
constexpr int CW_TMO = 0, CW_BAR = 4096, CW_GRP = 150016, CW_YP = 160000;
constexpr int MAX_LAUNCH = 40;
static_assert(CW_BAR + MAX_LAUNCH * 3456 <= CW_GRP && (CW_GRP + 64 * 64) * 4 <= (int)CTL_ZERO_BYTES, "ctl words");
constexpr int RING_OFF = 0, RING_BYTES = 131072, LDSCTL_OFF = RING_BYTES, MISC_OFF = LDSCTL_OFF + 320, LDS_BYTES = 147456;

#define GAS __attribute__((address_space(1)))
#define LAS __attribute__((address_space(3)))
typedef unsigned short bf16;
typedef unsigned v4u __attribute__((ext_vector_type(4)));
typedef unsigned v2u __attribute__((ext_vector_type(2)));
typedef float f32x4 __attribute__((ext_vector_type(4)));
typedef GAS unsigned gu32;
#define RLX_AGENT __ATOMIC_RELAXED, __HIP_MEMORY_SCOPE_AGENT
#define LDS_WAIT() asm volatile("s_waitcnt lgkmcnt(0)" ::: "memory")
#define VM_WAIT() asm volatile("s_waitcnt vmcnt(0)" ::: "memory")
__device__ __forceinline__ unsigned f2bf(float f) { unsigned u = __builtin_bit_cast(unsigned, f); return (u + 0x7fffu + ((u >> 16) & 1u)) >> 16; }
__device__ __forceinline__ unsigned pk2(float lo, float hi) { return f2bf(lo) | (f2bf(hi) << 16); }
__device__ __forceinline__ float bf_lo(unsigned w) { return __builtin_bit_cast(float, w << 16); }
__device__ __forceinline__ float bf_hi(unsigned w) { return __builtin_bit_cast(float, w & 0xffff0000u); }

#define XB_TMO      128
#define XB_XCNT(j)  (256  + 64 * (j))
#define XB_XSUB(j)  (1280 + 64 * (j))
#define XB_XGEN(j)  (2304 + 64 * (j))
#define XB_TOP      3328
#define XB_TOPGEN   3392
#define XCD_BAR_WORDS 3456
#define XB_SPIN_CAP (1u << 18)
__device__ __forceinline__ unsigned xb_ld(unsigned* p)              { return __hip_atomic_load(p, __ATOMIC_RELAXED, __HIP_MEMORY_SCOPE_AGENT); }
__device__ __forceinline__ unsigned xb_add(unsigned* p, unsigned v) { return __hip_atomic_fetch_add(p, v, __ATOMIC_RELAXED, __HIP_MEMORY_SCOPE_AGENT); }
__device__ __forceinline__ unsigned xb_xcc_id() { return (unsigned)__builtin_amdgcn_s_getreg((3 << 11) | 20) & 0xFu; }
#define XB_SPIN(cond, bar) do { unsigned _sp = 0; while (cond) { __builtin_amdgcn_s_sleep(1); \
    if ((++_sp & 255u) == 0u) { if (xb_ld(&(bar)[XB_TMO])) break; if (_sp > XB_SPIN_CAP) { atomicAdd(&(bar)[XB_TMO], 1u); break; } } } } while (0)
struct XcdBarrier { unsigned* bar; unsigned x; volatile LAS unsigned* st; };
__device__ __forceinline__ XcdBarrier xcd_barrier_post(unsigned* bar, volatile LAS unsigned* st, bool t0) {
    XcdBarrier b; b.bar = bar; b.x = xb_xcc_id(); b.st = st;
    if (t0) (void)xb_add(&bar[XB_XCNT(b.x)], 1u);
    return b;
}
__device__ __forceinline__ void xcd_barrier_complete(unsigned* bar, unsigned x, unsigned& nloc, unsigned& nx) {
    const unsigned G = gridDim.x * gridDim.y * gridDim.z;
    unsigned sum, cnt, mine, sp = 0u;
    for (;;) {
        sum = 0u; cnt = 0u; mine = 0u;
#pragma unroll
        for (unsigned j = 0; j < 16; ++j) { const unsigned c = xb_ld(&bar[XB_XCNT(j)]); sum += c; cnt += (c > 0u) ? 1u : 0u; mine = (j == x) ? c : mine; }
        if (sum == G) break;
        __builtin_amdgcn_s_sleep(1);
        if ((++sp & 255u) == 0u) { if (xb_ld(&bar[XB_TMO])) break; if (sp > XB_SPIN_CAP) { atomicAdd(&bar[XB_TMO], 1u); break; } }
    }
    nloc = mine > 0u ? mine : 1u; nx = cnt > 0u ? cnt : 1u;
}
__device__ __forceinline__ void xcd_barrier(const XcdBarrier& b, bool t0) {
    asm volatile("s_waitcnt vmcnt(0)" ::: "memory");
    __syncthreads();
    if (t0) {
        unsigned* bar = b.bar;
        __builtin_amdgcn_s_waitcnt(0);
        unsigned nloc = b.st[0], nx = b.st[1];
        if (nloc == 0u) { xcd_barrier_complete(bar, b.x, nloc, nx); b.st[0] = nloc; b.st[1] = nx; }
#if defined(MK_EARLY_WB)
        __builtin_amdgcn_fence(__ATOMIC_RELEASE, "agent"); asm volatile("s_waitcnt vmcnt(0)" ::: "memory");
#endif
        const unsigned old = xb_add(&bar[XB_XSUB(b.x)], 1u);
        const unsigned gen = old / nloc;
        if (old + 1u == (gen + 1u) * nloc) {
            __builtin_amdgcn_fence(__ATOMIC_RELEASE, "agent");
            asm volatile("s_waitcnt vmcnt(0)" ::: "memory");
            const unsigned og = xb_add(&bar[XB_TOP], 1u);
            const unsigned tg = og / nx;
            if (og + 1u == (tg + 1u) * nx) xb_add(&bar[XB_TOPGEN], 1u);
            else XB_SPIN(xb_ld(&bar[XB_TOPGEN]) == tg, bar);
            __builtin_amdgcn_fence(__ATOMIC_ACQUIRE, "agent");
            xb_add(&bar[XB_XGEN(b.x)], 1u);
            asm volatile("s_waitcnt vmcnt(0)" ::: "memory");
        } else {
            XB_SPIN(xb_ld(&bar[XB_XGEN(b.x)]) == gen, bar);
            __builtin_amdgcn_fence(__ATOMIC_ACQUIRE, "agent");
            asm volatile("s_waitcnt vmcnt(0)" ::: "memory");
        }
    }
    __syncthreads();
}

struct Frame {
    LAS unsigned char* lds;
    int vcu, G, wave;
};
__device__ __forceinline__ int lane_id() { int l; asm volatile("v_mbcnt_lo_u32_b32 %0, -1, 0\n\tv_mbcnt_hi_u32_b32 %0, -1, %0" : "=v"(l)); return l; }
__device__ __forceinline__ int fresh_tid(const Frame& F) { return F.wave * 64 + lane_id(); }
__device__ __forceinline__ float shfl_idx(float v, int src_lane) { return __builtin_bit_cast(float, __builtin_amdgcn_ds_bpermute(src_lane << 2, __builtin_bit_cast(int, v))); }
__device__ __forceinline__ int shfl_idx_i(int v, int src_lane) { return __builtin_amdgcn_ds_bpermute(src_lane << 2, v); }
__device__ __forceinline__ float wave_sum(float v, int lane) {
#pragma unroll
    for (int o = 1; o < 64; o <<= 1) v += shfl_idx(v, lane ^ o);
    return v;
}

__device__ __forceinline__ void cvt_item(const float* W, int ldw, int K, bf16* WT, int drow0, LAS float* scr, int k0, int n0, int lane) {
#pragma unroll 8
    for (int i = 0; i < 32; ++i) { const int kk = 2 * i + (lane >> 5); scr[kk * 33 + (lane & 31)] = W[(size_t)(k0 + kk) * ldw + n0 + (lane & 31)]; }
    LDS_WAIT(); asm volatile("" ::: "memory");
    const int c = lane & 7;
#pragma unroll
    for (int j = 0; j < 4; ++j) { const int n = (lane >> 3) + 8 * j; const LAS float* s = scr + (8 * c) * 33 + n;
        v4u o; o.x = pk2(s[0 * 33], s[1 * 33]); o.y = pk2(s[2 * 33], s[3 * 33]); o.z = pk2(s[4 * 33], s[5 * 33]); o.w = pk2(s[6 * 33], s[7 * 33]);
        *(GAS v4u*)(WT + (size_t)(drow0 + n) * K + k0 + 8 * c) = o; }
    LDS_WAIT(); asm volatile("" ::: "memory");
}
__device__ __forceinline__ void cvt_job(Frame& F, const float* W, int ldw, int K, int N, int nmat, size_t smat, bf16* WT, size_t dmat, int mode, int rot) {
    const int tid = fresh_tid(F), lane = tid & 63, wave = __builtin_amdgcn_readfirstlane(tid >> 6);
    LAS float* scr = (LAS float*)(F.lds + RING_OFF + wave * 8448);
    const int NGW = F.G * NWAVES; const int gw = (F.vcu * NWAVES + wave + rot) % NGW;
    const int nblk = N / 32, per = (K / 64) * nblk, total = per * nmat;
    for (int it = gw; it < total; it += NGW) {
        const int mat = it / per, r = it % per, kb = r / nblk, nb = r % nblk, n0 = 32 * nb;
        const int drow0 = mode == 0 ? n0 : ((n0 >> 7) * 256 + (n0 & 127) + (mode == 2 ? 128 : 0));
        cvt_item(W + (size_t)mat * smat, ldw, K, WT + (size_t)mat * dmat, drow0, scr, 64 * kb, n0, lane);
    }
}

constexpr int SLAB_OFF_ = 73728;
constexpr int SLAB_OFF = SLAB_OFF_;
struct RowJob {
    const float* xsrc;
    const bf16* xbsrc; bf16* xbdst;
    const float* nw;
    bf16* XN; float* outf;
    const bf16* Y; const int* tok_slot; const float* top_g;
    const float* slab; int slab_ld;
    int kind;
    const float* b0; const float* b1; float* LI; float* LF; int* top_e; float* top_g_out; int* wg_cnt;
};
constexpr int EREC_OFF = SLAB_OFF_ + 32768;

__device__ __forceinline__ void row_phase(Frame& F, const RowJob& J) {
    LAS float* slab = (LAS float*)(F.lds + SLAB_OFF);
    const int tid = fresh_tid(F), lane = tid & 63, wave = __builtin_amdgcn_readfirstlane(tid >> 6);
    if (J.slab) { float sv[16];
#pragma unroll
        for (int q = 0; q < 16; ++q) { const int i = tid + q * NTHR; sv[q] = J.slab[(size_t)(i >> 3) * J.slab_ld + (i & 7)]; }
#pragma unroll
        for (int q = 0; q < 16; ++q) { const int i = tid + q * NTHR, k = i >> 3, e = i & 7, kk = ((k >> 8) * 4 + (k & 3)) * 64 + ((k & 255) >> 2);
            slab[(e >> 2) * 4096 + kk * 4 + (e & 3)] = sv[q]; } }
    __syncthreads();
    LAS int* erec = (LAS int*)(F.lds + EREC_OFF);
    const int rpw = M / (F.G * NWAVES), m0 = (F.vcu * NWAVES + wave) * rpw;
    f32x4 nx[4]; v2u nxb[4], nya[4], nyb[4]; float ng0 = 0.f, ng1 = 0.f;
    {
        if (J.xsrc) { const GAS f32x4* xr = (const GAS f32x4*)(J.xsrc + (size_t)m0 * D) + lane;
#pragma unroll
            for (int j = 0; j < 4; ++j) nx[j] = xr[64 * j]; }
        else { const GAS v2u* xr = (const GAS v2u*)(J.xbsrc + (size_t)m0 * D) + lane;
#pragma unroll
            for (int j = 0; j < 4; ++j) nxb[j] = xr[64 * j]; }
        if (J.Y) { const int s0 = J.tok_slot[m0 * 2], s1 = J.tok_slot[m0 * 2 + 1]; ng0 = J.top_g[m0 * 2]; ng1 = J.top_g[m0 * 2 + 1];
            const GAS v2u* y0 = (const GAS v2u*)(J.Y + (size_t)s0 * D) + lane; const GAS v2u* y1 = (const GAS v2u*)(J.Y + (size_t)s1 * D) + lane;
#pragma unroll
            for (int j = 0; j < 4; ++j) { nya[j] = y0[64 * j]; nyb[j] = y1[64 * j]; } }
    }
    for (int m = m0; m < m0 + rpw; ++m) {
        f32x4 v[4]; v2u ya[4], yb[4]; const float g0 = ng0, g1 = ng1;
#pragma unroll
        for (int j = 0; j < 4; ++j) { ya[j] = nya[j]; yb[j] = nyb[j];
            if (J.xsrc) v[j] = nx[j];
            else { const v2u r = nxb[j]; v[j].x = bf_lo(r.x); v[j].y = bf_hi(r.x); v[j].z = bf_lo(r.y); v[j].w = bf_hi(r.y); } }
        if (m + 1 < m0 + rpw) {
            if (J.xsrc) { const GAS f32x4* xr = (const GAS f32x4*)(J.xsrc + (size_t)(m + 1) * D) + lane;
#pragma unroll
                for (int j = 0; j < 4; ++j) nx[j] = xr[64 * j]; }
            else { const GAS v2u* xr = (const GAS v2u*)(J.xbsrc + (size_t)(m + 1) * D) + lane;
#pragma unroll
                for (int j = 0; j < 4; ++j) nxb[j] = xr[64 * j]; }
            if (J.Y) { const int s0 = J.tok_slot[(m + 1) * 2], s1 = J.tok_slot[(m + 1) * 2 + 1]; ng0 = J.top_g[(m + 1) * 2]; ng1 = J.top_g[(m + 1) * 2 + 1];
                const GAS v2u* y0 = (const GAS v2u*)(J.Y + (size_t)s0 * D) + lane; const GAS v2u* y1 = (const GAS v2u*)(J.Y + (size_t)s1 * D) + lane;
#pragma unroll
                for (int j = 0; j < 4; ++j) { nya[j] = y0[64 * j]; nyb[j] = y1[64 * j]; } }
        }
        if (J.Y) {
#pragma unroll
            for (int j = 0; j < 4; ++j) { const v2u a = ya[j], b = yb[j];
                v[j].x += g0 * bf_lo(a.x) + g1 * bf_lo(b.x); v[j].y += g0 * bf_hi(a.x) + g1 * bf_hi(b.x); v[j].z += g0 * bf_lo(a.y) + g1 * bf_lo(b.y); v[j].w += g0 * bf_hi(a.y) + g1 * bf_hi(b.y); }
        }
        if (J.xbdst) { GAS v2u* xo = (GAS v2u*)(J.xbdst + (size_t)m * D) + lane;
#pragma unroll
            for (int j = 0; j < 4; ++j) { v2u w; w.x = pk2(v[j].x, v[j].y); w.y = pk2(v[j].z, v[j].w); xo[64 * j] = w; } }
        float ss = 0.f;
#pragma unroll
        for (int j = 0; j < 4; ++j) ss += (v[j].x * v[j].x + v[j].y * v[j].y) + (v[j].z * v[j].z + v[j].w * v[j].w);
#pragma unroll
        for (int j = 0; j < 4; ++j) v[j] = v[j] * ((const GAS f32x4*)J.nw)[lane + 64 * j];
        float a1 = 0.f;
        if (J.slab) {
            float acc[8];
#pragma unroll
            for (int e = 0; e < 8; ++e) acc[e] = 0.f;
#pragma unroll
            for (int j = 0; j < 4; ++j)
#pragma unroll
                for (int i = 0; i < 4; ++i) { const int kk = (4 * j + i) * 64 + lane; const float xv = v[j][i];
                    const f32x4 w0 = *(const LAS f32x4*)(slab + kk * 4), w1 = *(const LAS f32x4*)(slab + 4096 + kk * 4);
                    acc[0] += xv * w0.x; acc[1] += xv * w0.y; acc[2] += xv * w0.z; acc[3] += xv * w0.w; acc[4] += xv * w1.x; acc[5] += xv * w1.y; acc[6] += xv * w1.z; acc[7] += xv * w1.w; }
            const bool h5 = (lane & 32) != 0, h4 = (lane & 16) != 0, h3 = (lane & 8) != 0;
            float a4[4], a2[2];
#pragma unroll
            for (int i = 0; i < 4; ++i) { const float send = h5 ? acc[i] : acc[i + 4], keep = h5 ? acc[i + 4] : acc[i]; a4[i] = keep + shfl_idx(send, lane ^ 32); }
#pragma unroll
            for (int i = 0; i < 2; ++i) { const float send = h4 ? a4[i] : a4[i + 2], keep = h4 ? a4[i + 2] : a4[i]; a2[i] = keep + shfl_idx(send, lane ^ 16); }
            { const float send = h3 ? a2[0] : a2[1], keep = h3 ? a2[1] : a2[0]; a1 = keep + shfl_idx(send, lane ^ 8); }
            a1 += shfl_idx(a1, lane ^ 1); a1 += shfl_idx(a1, lane ^ 2); a1 += shfl_idx(a1, lane ^ 4);
        }
        const float sst = wave_sum(ss, lane);
        const float rstd = __builtin_amdgcn_rsqf(sst * (1.f / D) + 1e-6f);
#pragma unroll
        for (int j = 0; j < 4; ++j) v[j] = v[j] * rstd;
        if (J.outf) { GAS f32x4* o = (GAS f32x4*)(J.outf + (size_t)m * D) + lane;
#pragma unroll
            for (int j = 0; j < 4; ++j) o[64 * j] = v[j]; }
        if (J.XN) { GAS v2u* o = (GAS v2u*)(J.XN + (size_t)m * D) + lane;
#pragma unroll
            for (int j = 0; j < 4; ++j) { v2u w; w.x = pk2(v[j].x, v[j].y); w.y = pk2(v[j].z, v[j].w); o[64 * j] = w; } }
        if (J.slab) {
            a1 *= rstd;
            if (J.kind == 1) {
                if ((lane & 7) == 0) { const int e = lane >> 3;
                    if (e < 4) J.LI[m * 4 + e] = a1 + J.b0[e];
                    else { const int h = e - 4; const float z = a1 + J.b1[h]; const float ez = __expf(-fabsf(z));
                        const float l1p = ez < 0.06f ? ez * (1.f + ez * (-0.5f + ez * (0.33333333f - 0.25f * ez))) : __logf(1.f + ez);
                        J.LF[m * 4 + h] = fminf(z, 0.f) - l1p; } }
            } else if (J.kind == 2) {
                float acc[8];
#pragma unroll
                for (int e = 0; e < 8; ++e) acc[e] = __builtin_bit_cast(float, __builtin_amdgcn_readlane(__builtin_bit_cast(int, a1), 8 * e)) + J.b0[e];
                int e0 = 0; float l0 = acc[0];
#pragma unroll
                for (int e = 1; e < 8; ++e) if (acc[e] > l0) { l0 = acc[e]; e0 = e; }
                int e1 = 0; float l1 = -INFINITY;
#pragma unroll
                for (int e = 0; e < 8; ++e) if (e != e0 && acc[e] > l1) { l1 = acc[e]; e1 = e; }
                if (lane == 0) {
                    const float ex = __expf(l1 - l0);
                    J.top_e[m * 2] = e0; J.top_e[m * 2 + 1] = e1; J.top_g_out[m * 2] = 1.f / (1.f + ex); J.top_g_out[m * 2 + 1] = ex / (1.f + ex);
                    const int ml = m - F.vcu * NWAVES * rpw; erec[ml * 2] = e0; erec[ml * 2 + 1] = e1;
                }
            }
        }
    }
    if (J.kind == 2) {
        __syncthreads();
        { const int na = 2 * NWAVES * rpw;
          LAS int* wc = erec + 2 * NWAVES * 64;
          const int ev = tid < na ? erec[tid] : -1;
#pragma unroll
          for (int e = 0; e < 8; ++e) { const unsigned long long b = __builtin_amdgcn_ballot_w64(ev == e); if (lane == 0) wc[wave * 8 + e] = __builtin_popcountll(b); }
          __syncthreads();
          if (tid < 8) { int c = 0;
#pragma unroll
              for (int w = 0; w < NWAVES; ++w) c += wc[w * 8 + tid]; J.wg_cnt[F.vcu * 8 + tid] = c; } }
    }
}
}
namespace att {
using bf16x8 = __attribute__((ext_vector_type(8))) short;
using s16x4 = __attribute__((ext_vector_type(4))) short;
using f32x16 = __attribute__((ext_vector_type(16))) float;
using u32x4 = __attribute__((ext_vector_type(4))) unsigned;
typedef __attribute__((address_space(3))) const char* lds_cptr;
typedef __attribute__((address_space(3))) char* lds_ptr;
typedef short v4i16_t __attribute__((ext_vector_type(4)));
constexpr int SEQ = 4096, PITCH = 3072, QB = 256, KVBLK = 64, NQB = SEQ / QB;
constexpr int NSLOT = 3, KSLOT = 8192, VSLOT = 16384;
constexpr int LDS_K = 0, LDS_V = NSLOT * KSLOT, LDS_WS = LDS_V + NSLOT * VSLOT, LDS_BT = LDS_WS + 8 * 256, LDS_END = LDS_BT + 1024;
constexpr float LOG2E = 1.4426950408889634f;
#ifndef ATT_THR
#define ATT_THR 8.0f
#endif
#define ATT_MFMA(a, b, c) __builtin_amdgcn_mfma_f32_32x32x16_bf16(a, b, c, 0, 0, 0)
__device__ __forceinline__ int crow(int r, int hi) { return (r & 3) + 8 * (r >> 2) + 4 * hi; }
__device__ __forceinline__ void glds16(const void* gsrc, unsigned lds_dst) { unsigned keep;
    asm volatile("s_mov_b32 %0, m0\n\ts_mov_b32 m0, %2\n\ts_nop 0\n\tglobal_load_lds_dwordx4 %1, off\n\ts_mov_b32 m0, %0" : "=&s"(keep) : "v"(gsrc), "s"(lds_dst) : "memory"); }
typedef float f32x2_t __attribute__((ext_vector_type(2))); typedef __bf16 bf16x2_t __attribute__((ext_vector_type(2)));
__device__ __forceinline__ unsigned cvtpk(float lo, float hi) { f32x2_t v = {lo, hi}; bf16x2_t b = __builtin_convertvector(v, bf16x2_t); return __builtin_bit_cast(unsigned, b); }
__device__ __forceinline__ s16x4 vtr(lds_cptr p) { return __builtin_bit_cast(s16x4, __builtin_amdgcn_ds_read_tr16_b64_v4i16((__attribute__((address_space(3))) v4i16_t*)p)); }
#define ATT_MX3(a, b, c) __builtin_fmaxf(__builtin_fmaxf((a), (b)), (c))
__device__ __forceinline__ float rowmax(const f32x16& p0, const f32x16& p1) {
    float a = ATT_MX3(p0[0], p0[1], p1[0]), b = ATT_MX3(p0[2], p0[3], p1[1]); a = ATT_MX3(a, p1[2], p1[3]);
#pragma unroll
    for (int r = 4; r < 16; r += 4) { a = ATT_MX3(a, p0[r], p0[r + 1]); b = ATT_MX3(b, p0[r + 2], p0[r + 3]); a = ATT_MX3(a, p1[r], p1[r + 1]); b = ATT_MX3(b, p1[r + 2], p1[r + 3]); }
    const float m = __builtin_fmaxf(a, b); auto rr = __builtin_amdgcn_permlane32_swap(__float_as_uint(m), __float_as_uint(m), false, false);
    return __builtin_fmaxf(__uint_as_float(rr[0]), __uint_as_float(rr[1])); }
#define ATT_WAIT_BAR(N) asm volatile("s_waitcnt vmcnt(" #N ") lgkmcnt(0)\n\ts_barrier" ::: "memory")

struct Params {
    const unsigned short* QKV; unsigned short* O; float* OT;
    const float* rel; const float* subln; float lam, lam_init;
};

template <int PASS>
__device__ __forceinline__ void attn_pass(int b, int h, int qb, const Params& P, lds_ptr shm, int wid, int lane_in, unsigned (&o1p)[4][8], bool bt_ready = false) {
    int lane; asm volatile("v_mbcnt_lo_u32_b32 %0, -1, 0\n\tv_mbcnt_hi_u32_b32 %0, -1, %0" : "=v"(lane));
    (void)lane_in;
    const int r32 = lane & 31, hi = lane >> 5, m = 2 * h + PASS;
    const long rowbase = (long)b * SEQ; const int q0 = qb * QB, NT = (q0 + QB) / KVBLK;
    const unsigned short* Qw = P.QKV + (rowbase + q0 + wid * 32) * PITCH + m * 64;
    const unsigned short* Kh = P.QKV + rowbase * PITCH + 1024 + m * 64; const unsigned short* Vh = P.QKV + rowbase * PITCH + 2048 + h * 128;
    const unsigned lds0 = (unsigned)(uintptr_t)shm;
    __attribute__((address_space(3))) float* wsf = (__attribute__((address_space(3))) float*)(shm + LDS_WS) + wid * 64;
    __attribute__((address_space(3))) float* BT = (__attribute__((address_space(3))) float*)(shm + LDS_BT) + PASS * 128;
    if (!bt_ready && wid < 2) { const int rel = wid * 64 + lane; BT[rel] = P.rel[nv::BUCKET[rel] * 16 + m] * LOG2E; }
    const float c31 = bt_ready ? BT[127] : P.rel[31 * 16 + m] * LOG2E;
    const unsigned short* ksrc = Kh + (long)lane * PITCH + wid * 8;
    const unsigned short* vsrc = Vh + (long)(16 * (wid & 3) + (lane >> 2)) * PITCH + (wid >> 2) * 32 + (lane & 3) * 8;
    const unsigned kdst = lds0 + LDS_K + wid * 1024, vdst = lds0 + LDS_V + wid * 1024;
#define ATT_DMA(t, s) do { glds16(ksrc + (long)(t) * KVBLK * PITCH, (unsigned)__builtin_amdgcn_readfirstlane(kdst + (s) * KSLOT)); \
        glds16(vsrc + (long)(t) * KVBLK * PITCH, (unsigned)__builtin_amdgcn_readfirstlane(vdst + (s) * VSLOT)); \
        glds16(vsrc + (long)(t) * KVBLK * PITCH + 64, (unsigned)__builtin_amdgcn_readfirstlane(vdst + (s) * VSLOT + 8192)); } while (0)
    ATT_DMA(0, 0); ATT_DMA(1, 1);
    bf16x8 qr[4];
#pragma unroll
    for (int d0 = 0; d0 < 4; ++d0) qr[d0] = *reinterpret_cast<const bf16x8*>(&Qw[(long)r32 * PITCH + d0 * 16 + hi * 8]);
    float c31p = c31;
    asm volatile("" : "+v"(qr[0]), "+v"(qr[1]), "+v"(qr[2]), "+v"(qr[3]), "+v"(c31p));
    float mhat = 0.f, l_reg = 0.f; f32x16 o[4];
#pragma unroll
    for (int d = 0; d < 4; ++d) o[d] = f32x16{};
    const int qabs = q0 + wid * 32 + r32;
    const lds_cptr kp0 = (lds_cptr)shm + LDS_K + hi * 1024 + r32 * 16;
    const lds_cptr vp0 = (lds_cptr)shm + LDS_V + ((lane >> 4) & 1) * 32 + (lane & 3) * 8 + (4 * hi + ((lane & 15) >> 2)) * 64;
    int slot = 0;
#pragma unroll 1
    for (int t = 0; t < NT; ++t) {
        if (t + 1 < NT) { ATT_WAIT_BAR(3); } else { ATT_WAIT_BAR(0); }
        const lds_cptr kp = kp0 + slot * KSLOT; const lds_cptr vp = vp0 + slot * VSLOT;
        f32x16 p0, p1;
        bf16x8 kf[8];
#pragma unroll
        for (int d0 = 0; d0 < 4; ++d0) { kf[2 * d0] = *(const __attribute__((address_space(3))) bf16x8*)(kp + d0 * 2048); kf[2 * d0 + 1] = *(const __attribute__((address_space(3))) bf16x8*)(kp + d0 * 2048 + 512); }
        if (t + 6 < NT) {
            p0 = ATT_MFMA(kf[0], qr[0], (f32x16{})); p1 = ATT_MFMA(kf[1], qr[0], (f32x16{}));
        } else {
            const int kb = t * KVBLK + 4 * hi;
#pragma unroll
            for (int r = 0; r < 16; ++r) { const int k0 = kb + (r & 3) + 8 * (r >> 2); int rel0 = qabs - k0, rel1 = rel0 - 32;
                const float b0 = BT[rel0 < 0 ? 0 : (rel0 > 127 ? 127 : rel0)], b1 = BT[rel1 < 0 ? 0 : (rel1 > 127 ? 127 : rel1)];
                p0[r] = rel0 < 0 ? -INFINITY : b0; p1[r] = rel1 < 0 ? -INFINITY : b1; }
            p0 = ATT_MFMA(kf[0], qr[0], p0); p1 = ATT_MFMA(kf[1], qr[0], p1);
        }
#pragma unroll
        for (int d0 = 1; d0 < 4; ++d0) { p0 = ATT_MFMA(kf[2 * d0], qr[d0], p0); p1 = ATT_MFMA(kf[2 * d0 + 1], qr[d0], p1); }
        if (t + 2 < NT) { const int s2 = slot == 0 ? 2 : slot - 1; ATT_DMA(t + 2, s2); }
        s16x4 loA[4], hhA[4], loB[4], hhB[4];
#pragma unroll
        for (int ks = 0; ks < 4; ++ks) { loA[ks] = vtr(vp + ks * 1024); hhA[ks] = vtr(vp + ks * 1024 + 512); }
        __builtin_amdgcn_sched_barrier(0);
        const float base = (t + 6 < NT) ? c31p : 0.f;
        const float rm = rowmax(p0, p1) + base - mhat;
        bool resc = false;
        if (t == 0 || __any(rm > ATT_THR)) {
            const float dl = t == 0 ? rm : __builtin_fmaxf(rm, 0.f);
            mhat += dl;
            const float f = __builtin_amdgcn_exp2f(-dl); l_reg *= f; if (hi == 0) wsf[r32] = f; resc = (t != 0);
        }
        const float ref = base - mhat;
        float sacc = 0.f;
#pragma unroll
        for (int r = 0; r < 16; ++r) { p0[r] = __builtin_amdgcn_exp2f(p0[r] + ref); p1[r] = __builtin_amdgcn_exp2f(p1[r] + ref); sacc += p0[r] + p1[r]; }
        l_reg += sacc;
        u32x4 pw0 = (u32x4){cvtpk(p0[0], p0[1]), cvtpk(p0[2], p0[3]), cvtpk(p0[4], p0[5]), cvtpk(p0[6], p0[7])};
        u32x4 pw1 = (u32x4){cvtpk(p0[8], p0[9]), cvtpk(p0[10], p0[11]), cvtpk(p0[12], p0[13]), cvtpk(p0[14], p0[15])};
        u32x4 pw2 = (u32x4){cvtpk(p1[0], p1[1]), cvtpk(p1[2], p1[3]), cvtpk(p1[4], p1[5]), cvtpk(p1[6], p1[7])};
        u32x4 pw3 = (u32x4){cvtpk(p1[8], p1[9]), cvtpk(p1[10], p1[11]), cvtpk(p1[12], p1[13]), cvtpk(p1[14], p1[15])};
        __builtin_amdgcn_sched_barrier(0);
        if (resc) {
#pragma unroll
            for (int r = 0; r < 16; ++r) { const float f = wsf[crow(r, hi)];
#pragma unroll
                for (int d = 0; d < 4; ++d) o[d][r] *= f; }
        }
#define ATT_PKX(L, H, k) (bf16x8){L[k][0], L[k][1], L[k][2], L[k][3], H[k][0], H[k][1], H[k][2], H[k][3]}
#define ATT_RD(L, H, d) do { _Pragma("unroll") for (int ks = 0; ks < 4; ++ks) { L[ks] = vtr(vp + (d) * 4096 + ks * 1024); H[ks] = vtr(vp + (d) * 4096 + ks * 1024 + 512); } } while (0)
#define ATT_MM(L, H, d) do { o[d] = ATT_MFMA(__builtin_bit_cast(bf16x8, pw0), ATT_PKX(L, H, 0), o[d]); o[d] = ATT_MFMA(__builtin_bit_cast(bf16x8, pw1), ATT_PKX(L, H, 1), o[d]); \
        o[d] = ATT_MFMA(__builtin_bit_cast(bf16x8, pw2), ATT_PKX(L, H, 2), o[d]); o[d] = ATT_MFMA(__builtin_bit_cast(bf16x8, pw3), ATT_PKX(L, H, 3), o[d]); } while (0)
        ATT_RD(loB, hhB, 1); __builtin_amdgcn_sched_barrier(0); ATT_MM(loA, hhA, 0); __builtin_amdgcn_sched_barrier(0);
        ATT_RD(loA, hhA, 2); __builtin_amdgcn_sched_barrier(0); ATT_MM(loB, hhB, 1); __builtin_amdgcn_sched_barrier(0);
        ATT_RD(loB, hhB, 3); __builtin_amdgcn_sched_barrier(0); ATT_MM(loA, hhA, 2); __builtin_amdgcn_sched_barrier(0);
        ATT_MM(loB, hhB, 3); __builtin_amdgcn_sched_barrier(0);
#undef ATT_PKX
#undef ATT_RD
#undef ATT_MM
        slot = slot == 2 ? 0 : slot + 1;
    }
#undef ATT_DMA
    { auto rr = __builtin_amdgcn_permlane32_swap(__float_as_uint(l_reg), __float_as_uint(l_reg), false, false); l_reg = __uint_as_float(rr[0]) + __uint_as_float(rr[1]); }
    if (hi == 0) wsf[32 + r32] = l_reg;
    asm volatile("s_waitcnt lgkmcnt(0)" ::: "memory");
    if (PASS == 0) {
#pragma unroll
        for (int r = 0; r < 16; r += 2) { const float i0 = __builtin_amdgcn_rcpf(wsf[32 + crow(r, hi)]), i1 = __builtin_amdgcn_rcpf(wsf[32 + crow(r + 1, hi)]);
#pragma unroll
            for (int d = 0; d < 4; ++d) o1p[d][r >> 1] = cvtpk(o[d][r] * i0, o[d][r + 1] * i1); }
        asm volatile("s_waitcnt vmcnt(0) lgkmcnt(0)\n\ts_barrier" ::: "memory");
    } else {
        float sw[4];
#pragma unroll
        for (int d = 0; d < 4; ++d) sw[d] = P.subln[d * 32 + r32] * (1.f - P.lam_init);
        asm volatile("s_waitcnt vmcnt(0) lgkmcnt(0)\n\ts_barrier" ::: "memory");
        __attribute__((address_space(3))) unsigned short* stg = (__attribute__((address_space(3))) unsigned short*)(shm) + wid * 4096;
#pragma unroll
        for (int r0 = 0; r0 < 16; r0 += 4) {
            float ss[4];
#pragma unroll
            for (int q = 0; q < 4; ++q) { const int r = r0 + q; const float il = __builtin_amdgcn_rcpf(wsf[32 + crow(r, hi)]); float sq = 0.f;
#pragma unroll
                for (int d = 0; d < 4; ++d) { const unsigned w_ = o1p[d][r >> 1]; const float o1v = __builtin_bit_cast(float, (r & 1) ? (w_ & 0xffff0000u) : (w_ << 16));
                    const float a = o1v - P.lam * (o[d][r] * il); o[d][r] = a; sq += a * a; }
                ss[q] = sq; }
#pragma unroll
            for (int x = 1; x < 32; x <<= 1)
#pragma unroll
                for (int q = 0; q < 4; ++q) ss[q] += __builtin_bit_cast(float, __builtin_amdgcn_ds_bpermute((lane ^ x) << 2, __builtin_bit_cast(int, ss[q])));
#pragma unroll
            for (int q = 0; q < 4; ++q) { const int r = r0 + q; const float rs = __builtin_amdgcn_rsqf(ss[q] * (1.f / 128.f) + 1e-5f); const int orow = crow(r, hi);
#pragma unroll
                for (int d = 0; d < 4; ++d) { const float v = o[d][r] * rs * sw[d]; stg[orow * 128 + d * 32 + r32] = (unsigned short)(cvtpk(v, v) & 0xffffu); } }
            __builtin_amdgcn_sched_barrier(0);
        }
        asm volatile("s_waitcnt lgkmcnt(0)" ::: "memory");
        unsigned short* Ow = P.O + (rowbase + q0 + wid * 32) * 1024 + h * 128;
#pragma unroll
        for (int i = 0; i < 8; ++i) { const int row = i * 4 + (lane >> 4), ch = lane & 15; const u32x4 v = *(const __attribute__((address_space(3))) u32x4*)(stg + row * 128 + ch * 8); *(u32x4*)(Ow + (long)row * 1024 + ch * 8) = v; }
        asm volatile("s_waitcnt vmcnt(0) lgkmcnt(0)\n\ts_barrier" ::: "memory");
    }
}
__device__ __forceinline__ void attn_phase(const Params& P, lds_ptr shm, int vcu, int G, int wid, int lane) {
    if (G == 256) {
        const int bh = vcu >> 2, s = vcu & 3;
        { __attribute__((address_space(3))) float* BT = (__attribute__((address_space(3))) float*)(shm + LDS_BT); const int hh = bh & 7;
          int ln; asm volatile("v_mbcnt_lo_u32_b32 %0, -1, 0\n\tv_mbcnt_hi_u32_b32 %0, -1, %0" : "=v"(ln));
          if (wid < 4) { const int pass = wid >> 1, rel = (wid & 1) * 64 + ln; BT[pass * 128 + rel] = P.rel[nv::BUCKET[rel] * 16 + 2 * hh + pass] * LOG2E; } }
        asm volatile("s_waitcnt vmcnt(0) lgkmcnt(0)\n\ts_barrier" ::: "memory");
        for (int i = 0; i < 4; ++i) { const int qb = (i == 0) ? s : (i == 1) ? 7 - s : (i == 2) ? 8 + s : 15 - s;
            unsigned o1p[4][8]; attn_pass<0>(bh >> 3, bh & 7, qb, P, shm, wid, lane, o1p, true); attn_pass<1>(bh >> 3, bh & 7, qb, P, shm, wid, lane, o1p, true); }
    } else {
        for (int u = vcu; u < 64 * NQB; u += G) { const int bh = u >> 4, qb = u & 15;
            unsigned o1p[4][8]; attn_pass<0>(bh >> 3, bh & 7, qb, P, shm, wid, lane, o1p); attn_pass<1>(bh >> 3, bh & 7, qb, P, shm, wid, lane, o1p); }
    }
}
}
namespace mls {
using bf16x8 = __attribute__((ext_vector_type(8))) short;
using f32x4 = __attribute__((ext_vector_type(4))) float;
using u32x4 = __attribute__((ext_vector_type(4))) unsigned;
using u32x2 = __attribute__((ext_vector_type(2))) unsigned;
#define MLS_LAS __attribute__((address_space(3)))
typedef MLS_LAS char* lptr;
constexpr int SEQ = 4096, PITCH = 3072, L = 64, NCH = SEQ / L;
constexpr int QSTR = 136, SSTR = 72;
constexpr int QS = 0, KS = QS + 64 * QSTR * 2, KT = KS + 64 * QSTR * 2, VT = KT + 128 * SSTR * 2, VW = VT + 32 * SSTR * 2, SD = VW + 32 * SSTR * 2, CT = SD + 64 * SSTR * 2,
              NV = CT + 32 * QSTR * 2, FV = NV + 256, AV = FV + 256, IV = AV + 256, EV = IV + 256, WV = EV + 256, WB = WV + 256, DC = WB + 128, LDS_END = DC + 16;
static_assert(LDS_END <= 131072, "mLSTM LDS");
#define MLS_MFMA(a, b, c) __builtin_amdgcn_mfma_f32_16x16x32_bf16(a, b, c, 0, 0, 0)
#ifndef MK_NT_CVT
#define MK_NT_CVT 1
#endif
#if MK_NT_CVT
#define MLS_NTLOAD(p) __builtin_nontemporal_load(p)
#else
#define MLS_NTLOAD(p) (*(p))
#endif
#define MLS_BAR() asm volatile("s_waitcnt lgkmcnt(0)\n\ts_barrier" ::: "memory")
__device__ __forceinline__ unsigned pk(float lo, float hi) { typedef float f2 __attribute__((ext_vector_type(2))); typedef __bf16 b2 __attribute__((ext_vector_type(2))); f2 v = {lo, hi}; b2 b = __builtin_convertvector(v, b2); return __builtin_bit_cast(unsigned, b); }
__device__ __forceinline__ float blo(unsigned w) { return __builtin_bit_cast(float, w << 16); }
__device__ __forceinline__ float bhi(unsigned w) { return __builtin_bit_cast(float, w & 0xffff0000u); }
__device__ __forceinline__ float bperm(float v, int src) { return __builtin_bit_cast(float, __builtin_amdgcn_ds_bpermute(src << 2, __builtin_bit_cast(int, v))); }

struct Params { const unsigned short* P; const unsigned short* QKC; const float* GB; const float* GA; const float* GP; float* HH;
                const float* wg; const float* wu; const float* wd; unsigned short* wt_gu; unsigned short* wt_d; int gw;
                const float* fg; const float* fu; const float* fd; const float* ai; const float* ao; unsigned short* ws_small; const float* ks_ffn; const float* ks_att; };
constexpr int CV_MOE = 86016, CV_TOTAL = CV_MOE + 3 * 3584 + 3072 + 1024, CV_ITERS = (CV_TOTAL + 2047) / 2048;
constexpr size_t WS_FGU = (size_t)4096 * 1024, WS_FD = (size_t)11264 * 1024, WS_AI = (size_t)14848 * 1024, WS_AO = (size_t)17920 * 1024;
constexpr int CV_SCR = (LDS_END + 127) / 128 * 128;
constexpr int LDS_END2 = CV_SCR + 8 * 4224;
static_assert(LDS_END2 <= 131072, "mLSTM + cvt LDS");
struct CvItem { const float* src; unsigned short* dst; const float* ks; int ldw, K; };
__device__ __forceinline__ CvItem cv_decode(const Params& A, int it) {
    CvItem c; c.ks = nullptr;
    if (it >= CV_MOE) {
        int r = it - CV_MOE;
        if (r < 2 * 3584) { const int up = r >= 3584; r -= up * 3584; const int kb = r / 112, nb = r - kb * 112, n0 = 32 * nb, drow = (n0 >> 7) * 256 + (n0 & 127) + (up ? 128 : 0);
            c.src = (up ? A.fu : A.fg) + (size_t)(32 * kb) * 3584 + n0; c.ldw = 3584; c.K = 1024; c.dst = A.ws_small + WS_FGU + (size_t)drow * 1024 + 32 * kb; c.ks = A.ks_ffn ? A.ks_ffn + 32 * kb : nullptr; return c; }
        r -= 2 * 3584;
        if (r < 3584) { const int kb = r >> 5, nb = r & 31; c.src = A.fd + (size_t)(32 * kb) * 1024 + 32 * nb; c.ldw = 1024; c.K = 3584; c.dst = A.ws_small + WS_FD + (size_t)(32 * nb) * 3584 + 32 * kb; return c; }
        r -= 3584;
        if (r < 3072) { const int kb = r / 96, nb = r - kb * 96; c.src = A.ai + (size_t)(32 * kb) * 3072 + 32 * nb; c.ldw = 3072; c.K = 1024; c.dst = A.ws_small + WS_AI + (size_t)(32 * nb) * 1024 + 32 * kb; c.ks = A.ks_att ? A.ks_att + 32 * kb : nullptr; return c; }
        r -= 3072;
        if (r >= 1024) r = 1023;
        { const int kb = r >> 5, nb = r & 31; c.src = A.ao + (size_t)(32 * kb) * 1024 + 32 * nb; c.ldw = 1024; c.K = 1024; c.dst = A.ws_small + WS_AO + (size_t)(32 * nb) * 1024 + 32 * kb; return c; }
    }
    const int type = it / 28672, r = it - type * 28672, mat = r / 3584, r2 = r - mat * 3584;
    if (type < 2) { const int kb = r2 / 112, nb = r2 - kb * 112, n0 = 32 * nb; const int drow = (n0 >> 7) * 256 + (n0 & 127) + (type ? 128 : 0);
        c.src = (type ? A.wu : A.wg) + (size_t)mat * 1024 * 3584 + (size_t)(32 * kb) * 3584 + n0; c.ldw = 3584; c.K = 1024; c.dst = A.wt_gu + (size_t)mat * 7168 * 1024 + (size_t)drow * 1024 + 32 * kb; }
    else { const int kb = r2 >> 5, nb = r2 & 31, n0 = 32 * nb;
        c.src = A.wd + (size_t)mat * 3584 * 1024 + (size_t)(32 * kb) * 1024 + n0; c.ldw = 1024; c.K = 3584; c.dst = A.wt_d + (size_t)mat * 1024 * 3584 + (size_t)n0 * 3584 + 32 * kb; }
    return c;
}

__device__ __forceinline__ void scan_unit(int b, int h, int sl, const Params& A, lptr shm, int wid, int lane) {
    const int tid = wid * 64 + lane, lr = lane & 15, lq = lane >> 4;
    const long rowbase = (long)b * SEQ;
    const int o = tid & 31, g = tid >> 5, isk = o >> 4, ch0 = (o & 15) * 8;
    const int pcol = isk * 512 + h * 128 + ch0;
    const unsigned short* rawp = A.QKC + (rowbase + 4 * g) * 1024 + pcol;
    const int vs = tid >> 3, vj = (tid & 7) * 4;
    const unsigned short* vp = A.P + (rowbase + vs) * PITCH + 1024 + h * 256 + sl * 32 + vj;
    const int to = wid >> 1, jo = wid & 1;
    f32x4 Cst[2], nst;
    Cst[0] = (f32x4){0.f, 0.f, 0.f, 0.f}; Cst[1] = Cst[0]; nst = Cst[0];
    for (int i = tid; i < (32 * QSTR * 2 + 256) / 4; i += 512) ((MLS_LAS unsigned*)(shm + CT))[i] = 0u;
    float m_prev = 0.f;
    bf16x8 ones; { const short o1 = (short)0x3f80; ones = (bf16x8){o1, o1, o1, o1, o1, o1, o1, o1}; }
    float* hhp = A.HH + (rowbase + 16 * to + 4 * lq) * 1024 + h * 256 + sl * 32 + 16 * jo + lr;
    f32x4 cvr[4]; float cvs[4] = {1.f, 1.f, 1.f, 1.f}; unsigned short* cvdst = nullptr; int cvK = 0; bool cvhave = false;
#ifndef MK_CV_FIRST
#define MK_CV_FIRST 0
#endif
    if (A.gw >= 0) { const CvItem ci = cv_decode(A, MK_CV_FIRST + A.gw);
#pragma unroll
      for (int i = 0; i < 4; ++i) cvr[i] = MLS_NTLOAD((const f32x4*)(ci.src + (size_t)(8 * i + (lane >> 3)) * ci.ldw + (lane & 7) * 4));
      cvdst = ci.dst; cvK = ci.K; cvhave = true;
#pragma unroll
      for (int i = 0; i < 4; ++i) cvs[i] = ci.ks ? ci.ks[8 * i + (lane >> 3)] : 1.f; }
    else { cvr[0] = cvr[1] = cvr[2] = cvr[3] = (f32x4){0.f, 0.f, 0.f, 0.f}; }
    u32x4 raw[4]; u32x2 vraw; float gb = 0.f, ga = 0.f, gp = 0.f;
#pragma unroll
    for (int i = 0; i < 4; ++i) raw[i] = *(const u32x4*)(rawp + (long)i * 1024);
    vraw = *(const u32x2*)vp;
    if (wid == 7) { gb = A.GB[(rowbase + lane) * 4 + h]; ga = A.GA[(rowbase + lane) * 4 + h]; gp = A.GP[(rowbase + lane) * 4 + h]; }
    float hout[4] = {0.f, 0.f, 0.f, 0.f};
    MLS_BAR();
#pragma unroll 1
    for (int c = 0; c < NCH; ++c) {
        const int t0 = c * L;
        if (c > 0) {
#pragma unroll
            for (int r = 0; r < 4; ++r) hhp[(long)(t0 - L + r) * 1024] = hout[r];
        }
        float vv[4]; vv[0] = blo(vraw[0]); vv[1] = bhi(vraw[0]); vv[2] = blo(vraw[1]); vv[3] = bhi(vraw[1]);
        {
#pragma unroll
            for (int r = 0; r < 4; ++r) *(MLS_LAS u32x4*)(shm + (isk ? KS : QS) + ((4 * g + r) * QSTR + ch0) * 2) = raw[r];
            if (isk) {
#pragma unroll
                for (int e = 0; e < 8; ++e) { const int dw = e >> 1, sh = (e & 1) * 16;
                    const unsigned a0 = (raw[0][dw] >> sh) & 0xffffu, a1 = (raw[1][dw] >> sh) & 0xffffu, a2 = (raw[2][dw] >> sh) & 0xffffu, a3 = (raw[3][dw] >> sh) & 0xffffu;
                    *(MLS_LAS u32x2*)(shm + KT + ((ch0 + e) * SSTR + 4 * g) * 2) = (u32x2){a0 | (a1 << 16), a2 | (a3 << 16)}; }
            }
        }
#pragma unroll
        for (int e = 0; e < 4; ++e) *(MLS_LAS unsigned short*)(shm + VT + ((vj + e) * SSTR + vs) * 2) = (unsigned short)(pk(vv[e], vv[e]) & 0xffffu);
        if (wid == 7) {
            const float bs = gb, a = ga, pm = gp;
            const float gsum = __builtin_bit_cast(float, __builtin_amdgcn_readlane(__builtin_bit_cast(int, bs), 63)), amax = __builtin_bit_cast(float, __builtin_amdgcn_readlane(__builtin_bit_cast(int, pm), 63));
            const float mref = fmaxf(m_prev, pm);
            const float mt = bs + mref;
            const float mrefn = fmaxf(m_prev, amax);
            const float w = __expf(a - mrefn);
            ((MLS_LAS float*)(shm + FV))[lane] = -mref;
            ((MLS_LAS float*)(shm + AV))[lane] = a;
            ((MLS_LAS float*)(shm + IV))[lane] = __expf(m_prev - mref);
            ((MLS_LAS float*)(shm + EV))[lane] = __expf(-mt);
            ((MLS_LAS float*)(shm + WV))[lane] = w;
            ((MLS_LAS unsigned short*)(shm + WB))[lane] = (unsigned short)(pk(w, w) & 0xffffu);
            if (lane == 0) ((MLS_LAS float*)(shm + DC))[0] = __expf(m_prev - mrefn);
            m_prev = gsum + mrefn;
        }
        if (cvhave) {
            MLS_LAS float* scr = (MLS_LAS float*)(shm + CV_SCR + wid * 4224);
#pragma unroll
            for (int i = 0; i < 4; ++i)
#pragma unroll
                for (int e = 0; e < 4; ++e) scr[(8 * i + (lane >> 3)) * 33 + (lane & 7) * 4 + e] = cvr[i][e] * cvs[i];
            float tv[16];
#pragma unroll
            for (int j = 0; j < 16; ++j) tv[j] = scr[(16 * (lane & 1) + j) * 33 + (lane >> 1)];
            u32x4* dp = (u32x4*)(cvdst + (size_t)(lane >> 1) * cvK + 16 * (lane & 1));
            dp[0] = (u32x4){pk(tv[0], tv[1]), pk(tv[2], tv[3]), pk(tv[4], tv[5]), pk(tv[6], tv[7])}; dp[1] = (u32x4){pk(tv[8], tv[9]), pk(tv[10], tv[11]), pk(tv[12], tv[13]), pk(tv[14], tv[15])};
        }
        cvhave = (MK_CV_FIRST + 2048 * (c + 1) < CV_TOTAL + 2047) && (c + 1 < CV_ITERS) && (A.gw >= 0);
        if (cvhave) { const CvItem ci = cv_decode(A, MK_CV_FIRST + A.gw + 2048 * (c + 1));
#pragma unroll
            for (int i = 0; i < 4; ++i) cvs[i] = ci.ks ? ci.ks[8 * i + (lane >> 3)] : 1.f;
#pragma unroll
            for (int i = 0; i < 4; ++i) cvr[i] = MLS_NTLOAD((const f32x4*)(ci.src + (size_t)(8 * i + (lane >> 3)) * ci.ldw + (lane & 7) * 4));
            cvdst = ci.dst; cvK = ci.K; }
        if (c + 1 < NCH) {
            const long adv = (long)(t0 + L) * PITCH;
#pragma unroll
            for (int i = 0; i < 4; ++i) raw[i] = *(const u32x4*)(rawp + (long)(t0 + L) * 1024 + (long)i * 1024);
            vraw = *(const u32x2*)(vp + adv);
            if (wid == 7) { const long gi = (rowbase + t0 + L + lane) * 4 + h; gb = A.GB[gi]; ga = A.GA[gi]; gp = A.GP[gi]; }
        }
        MLS_BAR();
        { const float w = ((MLS_LAS float*)(shm + WV))[vs];
#pragma unroll
          for (int e = 0; e < 4; ++e) *(MLS_LAS unsigned short*)(shm + VW + ((vj + e) * SSTR + vs) * 2) = (unsigned short)(pk(vv[e] * w, vv[e] * w) & 0xffffu); }
        bf16x8 qa[4];
#pragma unroll
        for (int ks = 0; ks < 4; ++ks) qa[ks] = *(const MLS_LAS bf16x8*)(shm + QS + ((16 * to + lr) * QSTR + 32 * ks + 8 * lq) * 2);
        f32x4 fvr; { const f32x4 t4 = *(const MLS_LAS f32x4*)(shm + FV + (16 * to + 4 * lq) * 4); fvr = t4; }
#pragma unroll
        for (int q = 0; q < 2; ++q) {
            const int si = 2 * jo + q;
            f32x4 s4 = (f32x4){0.f, 0.f, 0.f, 0.f};
            if (si <= to) {
#pragma unroll
                for (int ks = 0; ks < 4; ++ks) { const bf16x8 kb = *(const MLS_LAS bf16x8*)(shm + KS + ((16 * si + lr) * QSTR + 32 * ks + 8 * lq) * 2); s4 = MLS_MFMA(qa[ks], kb, s4); }
                const float av = ((MLS_LAS float*)(shm + AV))[16 * si + lr];
                const int scol = 16 * si + lr, trow = 16 * to + 4 * lq;
#pragma unroll
                for (int r = 0; r < 4; ++r) s4[r] = (scol <= trow + r) ? s4[r] * __expf(fvr[r] + av) : 0.f;
            }
#pragma unroll
            for (int r = 0; r < 4; ++r) *(MLS_LAS unsigned short*)(shm + SD + ((16 * to + 4 * lq + r) * SSTR + 16 * si + lr) * 2) = (unsigned short)(pk(s4[r], s4[r]) & 0xffffu);
        }
        f32x4 qc = (f32x4){0.f, 0.f, 0.f, 0.f}, qn = qc;
#pragma unroll
        for (int ks = 0; ks < 4; ++ks) { const bf16x8 cb8 = *(const MLS_LAS bf16x8*)(shm + CT + ((16 * jo + lr) * QSTR + 32 * ks + 8 * lq) * 2); const bf16x8 nb8 = *(const MLS_LAS bf16x8*)(shm + NV + (32 * ks + 8 * lq) * 2);
            qc = MLS_MFMA(qa[ks], cb8, qc); qn = MLS_MFMA(qa[ks], nb8, qn); }
        MLS_BAR();
        {
            f32x4 sv = (f32x4){0.f, 0.f, 0.f, 0.f}, rs = sv;
#pragma unroll
            for (int ks = 0; ks < 2; ++ks) { const bf16x8 sa = *(const MLS_LAS bf16x8*)(shm + SD + ((16 * to + lr) * SSTR + 32 * ks + 8 * lq) * 2); const bf16x8 vb = *(const MLS_LAS bf16x8*)(shm + VT + ((16 * jo + lr) * SSTR + 32 * ks + 8 * lq) * 2);
                sv = MLS_MFMA(sa, vb, sv); rs = MLS_MFMA(sa, ones, rs); }
            const f32x4 iv = *(const MLS_LAS f32x4*)(shm + IV + (16 * to + 4 * lq) * 4), ev = *(const MLS_LAS f32x4*)(shm + EV + (16 * to + 4 * lq) * 4);
#pragma unroll
            for (int r = 0; r < 4; ++r) { const float num = sv[r] + iv[r] * qc[r], den = rs[r] + iv[r] * qn[r]; hout[r] = num * __builtin_amdgcn_rcpf(fmaxf(fabsf(den), ev[r])); }
        }
        {
            const float decay = ((MLS_LAS float*)(shm + DC))[0];
            Cst[0] = Cst[0] * decay; Cst[1] = Cst[1] * decay; nst = nst * decay;
#pragma unroll
            for (int ks = 0; ks < 2; ++ks) { const bf16x8 ka = *(const MLS_LAS bf16x8*)(shm + KT + ((16 * wid + lr) * SSTR + 32 * ks + 8 * lq) * 2);
                const bf16x8 v0 = *(const MLS_LAS bf16x8*)(shm + VW + ((lr) * SSTR + 32 * ks + 8 * lq) * 2), v1 = *(const MLS_LAS bf16x8*)(shm + VW + ((16 + lr) * SSTR + 32 * ks + 8 * lq) * 2);
                const bf16x8 wb8 = *(const MLS_LAS bf16x8*)(shm + WB + (32 * ks + 8 * lq) * 2);
                Cst[0] = MLS_MFMA(ka, v0, Cst[0]); Cst[1] = MLS_MFMA(ka, v1, Cst[1]); nst = MLS_MFMA(ka, wb8, nst); }
        }
        MLS_BAR();
#pragma unroll
        for (int jt = 0; jt < 2; ++jt) *(MLS_LAS u32x2*)(shm + CT + ((16 * jt + lr) * QSTR + 16 * wid + 4 * lq) * 2) = (u32x2){pk(Cst[jt][0], Cst[jt][1]), pk(Cst[jt][2], Cst[jt][3])};
        if (lr == 0) *(MLS_LAS u32x2*)(shm + NV + (16 * wid + 4 * lq) * 2) = (u32x2){pk(nst[0], nst[1]), pk(nst[2], nst[3])};
    }
#pragma unroll
    for (int r = 0; r < 4; ++r) hhp[(long)(SEQ - L + r) * 1024] = hout[r];
    asm volatile("s_waitcnt vmcnt(0) lgkmcnt(0)\n\ts_barrier" ::: "memory");
}
__device__ __forceinline__ void scan_phase(const Params& A, lptr shm, int vcu, int G, int wid) {
    for (int u = vcu; u < 256; u += G) {
        int lane; asm volatile("v_mbcnt_lo_u32_b32 %0, -1, 0\n\tv_mbcnt_hi_u32_b32 %0, -1, %0" : "=v"(lane));
        const int bh = u >> 3; scan_unit(bh >> 2, bh & 3, u & 7, A, shm, wid, lane);
    }
}
__device__ __forceinline__ void conv_phase(const unsigned short* P, const float* cw, const float* cb, unsigned short* QKC, const float* LI, const float* LF, float* GB, float* GA, float* GP, int vcu, int G, int tid) {
    const int o = tid & 127, g = tid >> 7, c0 = o * 8;
    float cwr[4][8], cbr[8];
#pragma unroll
    for (int j = 0; j < 4; ++j) { const f32x4 a = *(const f32x4*)(cw + j * 1024 + c0), c = *(const f32x4*)(cw + j * 1024 + c0 + 4);
        cwr[j][0] = a[0]; cwr[j][1] = a[1]; cwr[j][2] = a[2]; cwr[j][3] = a[3]; cwr[j][4] = c[0]; cwr[j][5] = c[1]; cwr[j][6] = c[2]; cwr[j][7] = c[3]; }
    { const f32x4 a = *(const f32x4*)(cb + c0), c = *(const f32x4*)(cb + c0 + 4); cbr[0] = a[0]; cbr[1] = a[1]; cbr[2] = a[2]; cbr[3] = a[3]; cbr[4] = c[0]; cbr[5] = c[1]; cbr[6] = c[2]; cbr[7] = c[3]; }
    const float osc = c0 >= 512 ? 0.08838834764831845f : 1.0f;
    for (int blk = vcu; blk < 8 * SEQ / 128; blk += G) {
        {
            const int w = tid >> 6, lane = tid & 63; const long gi = ((long)blk * 128 + (w >> 2) * 64 + lane) * 4 + (w & 3);
            float bs = LF[gi]; const float li = LI[gi];
#pragma unroll
            for (int x = 1; x < 64; x <<= 1) { const float v = bperm(bs, (lane - x) & 63); if (lane >= x) bs += v; }
            const float a = li - bs; float pm = a;
#pragma unroll
            for (int x = 1; x < 64; x <<= 1) { const float v = bperm(pm, (lane - x) & 63); if (lane >= x) pm = fmaxf(pm, v); }
            GB[gi] = bs; GA[gi] = a; GP[gi] = pm;
        }
        const long r0 = (long)blk * 128 + 32 * g;
        float x[3][8];
#pragma unroll
        for (int i = 0; i < 3; ++i) { const long rr = r0 - 3 + i; u32x4 w = (u32x4){0u, 0u, 0u, 0u}; if ((r0 & (SEQ - 1)) != 0) w = *(const u32x4*)(P + rr * PITCH + c0);
            x[i][0] = blo(w[0]); x[i][1] = bhi(w[0]); x[i][2] = blo(w[1]); x[i][3] = bhi(w[1]); x[i][4] = blo(w[2]); x[i][5] = bhi(w[2]); x[i][6] = blo(w[3]); x[i][7] = bhi(w[3]); }
#pragma unroll 1
        for (int rb = 0; rb < 32; rb += 16) {
            u32x4 wv[16];
#pragma unroll
            for (int r = 0; r < 16; ++r) wv[r] = *(const u32x4*)(P + (r0 + rb + r) * PITCH + c0);
#pragma unroll
            for (int r = 0; r < 16; ++r) { const u32x4 w = wv[r];
                float xn[8]; xn[0] = blo(w[0]); xn[1] = bhi(w[0]); xn[2] = blo(w[1]); xn[3] = bhi(w[1]); xn[4] = blo(w[2]); xn[5] = bhi(w[2]); xn[6] = blo(w[3]); xn[7] = bhi(w[3]);
                float y[8];
#pragma unroll
                for (int e = 0; e < 8; ++e) { const float a = cbr[e] + cwr[0][e] * x[0][e] + cwr[1][e] * x[1][e] + cwr[2][e] * x[2][e] + cwr[3][e] * xn[e];
                    y[e] = osc * a * __builtin_amdgcn_rcpf(1.0f + __builtin_amdgcn_exp2f(-1.4426950408889634f * a)); x[0][e] = x[1][e]; x[1][e] = x[2][e]; x[2][e] = xn[e]; }
                *(u32x4*)(QKC + (r0 + rb + r) * 1024 + c0) = (u32x4){pk(y[0], y[1]), pk(y[2], y[3]), pk(y[4], y[5]), pk(y[6], y[7])}; }
        }
    }
}
__device__ __forceinline__ void headnorm_phase(const float* HH, const unsigned short* P, const float* hn, unsigned short* Gout, int vcu, int G, int wid, int lane) {
    const int gw = vcu * 8 + wid, NGW = G * 8;
    f32x4 nv[4]; u32x4 no0, no1;
    { const f32x4* hp = (const f32x4*)(HH + (long)gw * 1024 + lane * 16);
#pragma unroll
      for (int i = 0; i < 4; ++i) nv[i] = hp[i];
      const u32x4* op = (const u32x4*)(P + (long)gw * PITCH + 2048 + lane * 16); no0 = op[0]; no1 = op[1]; }
    for (int m = gw; m < 8 * SEQ; m += NGW) {
        f32x4 v[4]; float ss = 0.f; const u32x4 o0 = no0, o1 = no1;
#pragma unroll
        for (int i = 0; i < 4; ++i) { v[i] = nv[i]; ss += v[i][0] * v[i][0] + v[i][1] * v[i][1] + v[i][2] * v[i][2] + v[i][3] * v[i][3]; }
        if (m + NGW < 8 * SEQ) { const f32x4* hp = (const f32x4*)(HH + (long)(m + NGW) * 1024 + lane * 16);
#pragma unroll
            for (int i = 0; i < 4; ++i) nv[i] = hp[i];
            const u32x4* op = (const u32x4*)(P + (long)(m + NGW) * PITCH + 2048 + lane * 16); no0 = op[0]; no1 = op[1]; }
#pragma unroll
        for (int x = 1; x < 16; x <<= 1) ss += bperm(ss, lane ^ x);
        const float rs = __builtin_amdgcn_rsqf(ss * (1.f / 256.f) + 1e-6f);
        const f32x4* wp = (const f32x4*)(hn + lane * 16);
        float og[16];
#pragma unroll
        for (int i = 0; i < 4; ++i) { og[2 * i] = blo(o0[i]); og[2 * i + 1] = bhi(o0[i]); og[8 + 2 * i] = blo(o1[i]); og[8 + 2 * i + 1] = bhi(o1[i]); }
        float r[16];
#pragma unroll
        for (int i = 0; i < 4; ++i) { const f32x4 w = wp[i];
#pragma unroll
            for (int e = 0; e < 4; ++e) { const float sg = __builtin_amdgcn_rcpf(1.0f + __builtin_amdgcn_exp2f(-1.4426950408889634f * og[4 * i + e])); r[4 * i + e] = sg * v[i][e] * rs * w[e]; } }
        u32x4* gp = (u32x4*)(Gout + (long)m * 1024 + lane * 16);
        gp[0] = (u32x4){pk(r[0], r[1]), pk(r[2], r[3]), pk(r[4], r[5]), pk(r[6], r[7])}; gp[1] = (u32x4){pk(r[8], r[9]), pk(r[10], r[11]), pk(r[12], r[13]), pk(r[14], r[15])};
    }
}
}
#define MK_KS_FFN (KA_IN(18) + pr * 1024)
#define MK_KS_ATT (KA_IN(10) + pr * 1024)
#define MK_QSCALE (0.125f * 1.4426950408889634f)
#define MK_ATTENTION { const int tid = fresh_tid(F), lane = tid & 63, wave = __builtin_amdgcn_readfirstlane(tid >> 6); \
    const float lam_init = 0.8f - 0.6f * __expf(-0.3f * (float)(2 * pr + 1)); \
    const float* lq1 = KA_IN(12) + pr * 64; const float* lk1 = KA_IN(13) + pr * 64; const float* lq2 = KA_IN(14) + pr * 64; const float* lk2 = KA_IN(15) + pr * 64; \
    const float lam = __expf(wave_sum(lq1[lane] * lk1[lane], lane)) - __expf(wave_sum(lq2[lane] * lk2[lane], lane)) + lam_init; \
    att::Params AP{(const unsigned short*)(ws + F_P), (unsigned short*)(ws + F_O), (float*)(ws + F_OT), KA_IN(1), KA_IN(16) + pr * 128, lam, lam_init}; \
    att::attn_phase(AP, (att::lds_ptr)(F.lds + RING_OFF), F.vcu, F.G, wave, lane); }
#define MK_MLSTM_CONV { const int tid = fresh_tid(F); mls::conv_phase((const unsigned short*)(ws + F_P), KA_IN(4) + pr * 4096, KA_IN(5) + pr * 1024, (unsigned short*)(ws + F_QKC), LI, LF, (float*)(ws + F_GB), (float*)(ws + F_GB) + M * 4, (float*)(ws + F_GB) + 2 * M * 4, F.vcu, F.G, tid); }
#define MK_MLSTM_SCAN { const int tid = fresh_tid(F); const int wave = __builtin_amdgcn_readfirstlane(tid >> 6); \
    mls::Params MP{(const unsigned short*)(ws + F_P), (const unsigned short*)(ws + F_QKC), (const float*)(ws + F_GB), (const float*)(ws + F_GB) + M * 4, (const float*)(ws + F_GB) + 2 * M * 4, (float*)(ws + F_HH), \
        KA_IN(25) + (size_t)pr * NE * 1024 * FF, KA_IN(26) + (size_t)pr * NE * 1024 * FF, KA_IN(27) + (size_t)pr * NE * FF * 1024, W0, W0 + (size_t)NE * 7168 * 1024, F.G == 256 ? F.vcu * NWAVES + wave : -1, \
        KA_IN(19) + (size_t)pr * 1024 * FF, KA_IN(20) + (size_t)pr * 1024 * FF, KA_IN(21) + (size_t)pr * FF * 1024, KA_IN(11) + (size_t)pr * 1024 * 3072, KA_IN(17) + (size_t)pr * 1024 * 1024, WS0, MK_KS_FFN, MK_KS_ATT}; \
    mls::scan_phase(MP, (mls::lptr)(F.lds + RING_OFF), F.vcu, F.G, wave); }
#define MK_MLSTM_HEADNORM { const int tid = fresh_tid(F), lane = tid & 63, wave = __builtin_amdgcn_readfirstlane(tid >> 6); \
    mls::headnorm_phase((const float*)(ws + F_HH), (const unsigned short*)(ws + F_P), KA_IN(8) + pr * 1024, (unsigned short*)(ws + F_G), F.vcu, F.G, wave, lane); }
#ifndef MK_MLSTM_SCAN
#define MK_MLSTM_SCAN
#endif
#ifndef MK_MLSTM_HEADNORM
#define MK_MLSTM_HEADNORM
#endif
#ifndef MK_ATTENTION
#define MK_ATTENTION
#endif
#ifndef MK_QSCALE
#define MK_KS_FFN (KA_IN(18) + pr * 1024)
#define MK_KS_ATT (KA_IN(10) + pr * 1024)
#define MK_QSCALE 1.0f
#endif
#ifndef MK_GW_QKV
#define MK_GW_QKV 8
#endif
#ifndef MK_GW_RES
#define MK_GW_RES 8
#endif
#ifndef MK_GW_F1
#define MK_GW_F1 8
#endif
#ifndef MK_GW_E2
#define MK_GW_E2 4
#endif
#ifndef MK_GW_E3
#define MK_GW_E3 4
#endif
#ifndef MK_ALIGN_SWI
#define MK_ALIGN_SWI true
#endif
#ifndef MK_ALIGN_RESID
#define MK_ALIGN_RESID true
#endif
namespace mk {
__device__ __forceinline__ void assign_phase(Frame& F, const int* top_e, const int* wg_cnt, int* tok_slot, int* blk_expert, int* n_used, int* slot_row) {
    LAS int* cnt = (LAS int*)(F.lds + RING_OFF);
    LAS int* base = cnt + 2048; LAS int* tot = base + 8; LAS int* wcnt = tot + 8;
    const int t = fresh_tid(F), lane = t & 63, w = __builtin_amdgcn_readfirstlane(t >> 6);
    int c4[4];
#pragma unroll
    for (int q = 0; q < 4; ++q) c4[q] = wg_cnt[t + q * NTHR];
    const int e_own = t < 256 ? top_e[F.vcu * 256 + t] : -1;
#pragma unroll
    for (int q = 0; q < 4; ++q) cnt[t + q * NTHR] = c4[q];
    unsigned long long mym = 0ull;
#pragma unroll
    for (int e = 0; e < 8; ++e) { const unsigned long long bm = __builtin_amdgcn_ballot_w64(e_own == e); mym = (e_own == e) ? bm : mym; if (w < 4 && lane == 0) wcnt[w * 8 + e] = __builtin_popcountll(bm); }
    __syncthreads();
    { int s = 0, b = 0;
#pragma unroll
      for (int q = 0; q < 4; ++q) { const int v = lane * 4 + q, c = cnt[v * 8 + w]; s += c; b += (v < F.vcu) ? c : 0; }
#pragma unroll
      for (int o = 1; o < 64; o <<= 1) { s += shfl_idx_i(s, lane ^ o); b += shfl_idx_i(b, lane ^ o); }
      if (lane == 0) { tot[w] = s; base[w] = b; } }
    __syncthreads();
    int pstv[9]; { int acc = 0;
#pragma unroll
      for (int e = 0; e < 8; ++e) { pstv[e] = acc; acc += (tot[e] + 255) / 256 * 256; }
      pstv[8] = acc; }
    if (F.vcu == 0) {
        if (t == 0) *n_used = pstv[8] / 256;
        if (t < NBLK) { int e = 0;
#pragma unroll
            for (int q = 1; q < 8; ++q) e += (t * 256 >= pstv[q]) ? 1 : 0;
            blk_expert[t] = e; }
    }
    if (t < 256) { const int e = e_own; int r = __builtin_popcountll(mym & ((1ull << lane) - 1ull)), p = 0, bs = 0;
#pragma unroll
        for (int w2 = 0; w2 < 4; ++w2) r += (w2 < w) ? wcnt[w2 * 8 + e] : 0;
#pragma unroll
        for (int q = 0; q < 8; ++q) { p = (e == q) ? pstv[q] : p; }
        bs = base[e];
        const int slot = p + bs + r; tok_slot[F.vcu * 256 + t] = slot; slot_row[slot] = (F.vcu * 256 + t) >> 1; }
    __syncthreads();
}

struct Args { const float* in[29]; float* out; unsigned char* ws; int ph_lo, ph_hi, li, flags; };
constexpr int PH_FINAL = 34, PH_COMBINE = 35;
constexpr float ATT_C2 = 0.125f * 1.4426950408889634f;

typedef const __attribute__((address_space(4))) unsigned char* kaptr_t;
__device__ __forceinline__ kaptr_t ka_fresh() { kaptr_t p = (kaptr_t)__builtin_amdgcn_kernarg_segment_ptr(); asm volatile("" : "+s"(p)); return p; }
#define KA_IN(k) (*(const float* const __attribute__((address_space(4)))*)(ka + 8 * (k)))
#define KA_OUT (*(float* const __attribute__((address_space(4)))*)(ka + 232))
#define KA_WS (*(unsigned char* const __attribute__((address_space(4)))*)(ka + 240))
#define KA_INT(off) (*(const int __attribute__((address_space(4)))*)(ka + (off)))
static_assert(sizeof(Args) == 264, "Args layout (kernarg offsets above)");
#define PHASE_PTRS kaptr_t ka = ka_fresh(); unsigned char* const ws = KA_WS; float* const xo = KA_OUT; bf16* const XN = (bf16*)xo; bf16* const XB = (bf16*)(ws + F_XN); bf16* const W0 = (bf16*)(ws + F_W); bf16* const WS0 = (bf16*)(ws + F_WS); (void)WS0; \
    int* const top_e = (int*)(ws + F_TOPE); float* const top_g = (float*)(ws + F_TOPG); int* const slot_tok = (int*)(ws + F_SLOTTOK); int* const tok_slot = (int*)(ws + F_TOKSLOT); \
    int* const blk_e = (int*)(ws + F_BLKE); int* const n_used = (int*)(ws + F_NUSED); float* const LI = (float*)(ws + F_LI); float* const LF = (float*)(ws + F_LF); bf16* const Ybuf = (bf16*)(ws + F_Y); \
    (void)xo; (void)XN; (void)XB; (void)W0; (void)top_e; (void)top_g; (void)slot_tok; (void)tok_slot; (void)blk_e; (void)n_used; (void)LI; (void)LF; (void)Ybuf; (void)ws
__global__ void __launch_bounds__(NTHR, 2) mk_fwd(Args) {
    extern __shared__ __attribute__((aligned(16))) unsigned char lds[];
    Frame F;
    F.lds = (LAS unsigned char*)lds;
    volatile LAS unsigned* MISC = (volatile LAS unsigned*)(F.lds + MISC_OFF);
    F.wave = __builtin_amdgcn_readfirstlane((int)threadIdx.x >> 6);
    F.G = gridDim.x; { const int bx = blockIdx.x; F.vcu = (F.G % 8 == 0) ? (bx % 8) * (F.G / 8) + bx / 8 : bx; }
    for (int u = threadIdx.x; u < (LDS_BYTES - LDSCTL_OFF) / 4; u += NTHR) ((LAS unsigned*)(F.lds + LDSCTL_OFF))[u] = 0u;
    __syncthreads();
    int lo, hi, flags; XcdBarrier bar;
    { kaptr_t ka = ka_fresh(); lo = KA_INT(248); hi = KA_INT(252); flags = KA_INT(260); const int li = KA_INT(256);
      bar = xcd_barrier_post((unsigned*)((gu32*)(KA_WS + F_CTL) + CW_BAR) + li * XCD_BAR_WORDS, MISC + 8, threadIdx.x == 0); }
#define IN(k) (lo <= (k) && (k) < hi)
#if defined(PROBE_PHSET)
#ifndef PROBE_PAIR
#define PROBE_PAIR pr
#endif
#define PT0(n) if (((PROBE_PHSET >> (n)) & 1) && pr == PROBE_PAIR) pt0_ = __builtin_amdgcn_s_memrealtime();
#define PT1(n) if (((PROBE_PHSET >> (n)) & 1) && pr == PROBE_PAIR) { asm volatile("s_waitcnt vmcnt(0) lgkmcnt(0)" ::: "memory"); probe_acc += (unsigned)(__builtin_amdgcn_s_memrealtime() - pt0_); }
#else
#define PT0(n)
#define PT1(n)
#endif
#if defined(PROBE_PHASE)
#define REPS(n) ((n) == PROBE_PHASE ? 1 + PROBE_REPS : 1)
#else
#define REPS(n) 1
#endif
#if defined(PROBE_BARWAIT)
#define SEAM(k) do { if (IN(k) && IN((k) + 1)) { const unsigned long long t0_ = __builtin_amdgcn_s_memrealtime(); xcd_barrier(bar, F.wave == 0 && lane_id() == 0); probe_acc += (unsigned)(__builtin_amdgcn_s_memrealtime() - t0_); } } while (0)
#else
#define SEAM(k) do { PT1((k) - pb) if (IN(k) && IN((k) + 1)) xcd_barrier(bar, F.wave == 0 && lane_id() == 0); } while (0)
#endif

    unsigned probe_acc = 0u; (void)probe_acc; unsigned long long pt0_ = 0; (void)pt0_;
    for (int pr = 0; pr < 2; ++pr) {
        const int pb = pr * 17;
        if (IN(pb + 0)) _Pragma("unroll") for (int rep_ = 0; rep_ < REPS(0); ++rep_) { PHASE_PTRS; PT0(0)
            cvt_job(F, KA_IN(3) + (size_t)pr * 1024 * 3080, 3080, 1024, 3072, 1, 0, WS0, 0, 0, 0);
            cvt_job(F, KA_IN(9) + (size_t)pr * 1024 * 1024, 1024, 1024, 1024, 1, 0, WS0 + 3072 * 1024, 0, 0, 1536);
            RowJob J{}; const bool first = (pr == 0) && !(flags & 1);
            const bool comb = (pr == 1) && !(flags & 2);
            J.xsrc = first ? KA_IN(0) : nullptr; J.xbsrc = XB; J.xbdst = (first || comb) ? XB : nullptr; J.nw = KA_IN(2) + pr * 1024; J.XN = XN;
            if (comb) { J.Y = Ybuf; J.tok_slot = tok_slot; J.top_g = top_g; }
            J.slab = KA_IN(3) + (size_t)pr * 1024 * 3080 + 3072; J.slab_ld = 3080; J.kind = 1; J.b0 = KA_IN(6) + pr * 4; J.b1 = KA_IN(7) + pr * 4; J.LI = LI; J.LF = LF;
            row_phase(F, J);
        }
        SEAM(pb + 0);
        if (IN(pb + 1)) _Pragma("unroll") for (int rep_ = 0; rep_ < REPS(1); ++rep_) { PHASE_PTRS; PT0(1)
            pg8::Gemm g{XN, WS0, M, 3072, 1024, nullptr}; pg8::StaticOrder S; S.init(M, 3072, F.G, (int)blockIdx.x, MK_GW_QKV);
            pg8::EpiBf16 E{(bf16*)(ws + F_P), 3072, 1.f, 0};
            pg8::gemm_phase<pg8::EpiBf16, pg8::StaticOrder, true, false>(F.lds + RING_OFF, g, S, E, F.wave);
        }
        SEAM(pb + 1);
        if (IN(pb + 2)) _Pragma("unroll") for (int rep_ = 0; rep_ < REPS(2); ++rep_) { PHASE_PTRS; PT0(2) MK_MLSTM_CONV }
        SEAM(pb + 2);
        if (IN(pb + 3)) _Pragma("unroll") for (int rep_ = 0; rep_ < REPS(3); ++rep_) { PHASE_PTRS; PT0(3) MK_MLSTM_SCAN }
        SEAM(pb + 3);
        if (IN(pb + 4)) _Pragma("unroll") for (int rep_ = 0; rep_ < REPS(4); ++rep_) { PHASE_PTRS; PT0(4) MK_MLSTM_HEADNORM }
        SEAM(pb + 4);
        if (IN(pb + 5)) _Pragma("unroll") for (int rep_ = 0; rep_ < REPS(5); ++rep_) { PHASE_PTRS; PT0(5)
            pg8::Gemm g{(const bf16*)(ws + F_G), WS0 + 3072 * 1024, M, 1024, 1024, nullptr}; pg8::StaticOrder S; S.init(M, 1024, F.G, (int)blockIdx.x, MK_GW_RES);
            pg8::EpiResidB<true> E{XB, 1024, (float*)(ws + F_SSQ)};
            pg8::gemm_phase<pg8::EpiResidB<true>, pg8::StaticOrder, MK_ALIGN_RESID, false>(F.lds + RING_OFF, g, S, E, F.wave);
        }
        SEAM(pb + 5);
        if (IN(pb + 7)) _Pragma("unroll") for (int rep_ = 0; rep_ < REPS(7); ++rep_) { PHASE_PTRS; PT0(7)
            pg8::Gemm g{XB, WS0 + mls::WS_FGU, M, 2 * FF, 1024, nullptr}; pg8::StaticOrder S; S.init(M, 2 * FF, F.G, (int)blockIdx.x, MK_GW_F1);
            pg8::EpiSwiGLUT<true> E{(bf16*)(ws + F_H), FF};
            pg8::gemm_phase<pg8::EpiSwiGLUT<true>, pg8::StaticOrder, MK_ALIGN_SWI, false, true>(F.lds + RING_OFF, g, S, E, F.wave, (const float*)(ws + F_SSQ), (PG8_LAS float*)(F.lds + LDSCTL_OFF + 1024));
        }
        SEAM(pb + 7);
        if (IN(pb + 8)) _Pragma("unroll") for (int rep_ = 0; rep_ < REPS(8); ++rep_) { PHASE_PTRS; PT0(8)
            pg8::Gemm g{(const bf16*)(ws + F_H), WS0 + mls::WS_FD, M, 1024, FF, nullptr}; pg8::StaticOrder S; S.init(M, 1024, F.G, (int)blockIdx.x, MK_GW_RES);
            pg8::EpiResidB<true> E{XB, 1024, (float*)(ws + F_SSQ)};
            pg8::gemm_phase<pg8::EpiResidB<true>, pg8::StaticOrder, MK_ALIGN_RESID, false>(F.lds + RING_OFF, g, S, E, F.wave);
        }
        SEAM(pb + 8);
        if (IN(pb + 10)) _Pragma("unroll") for (int rep_ = 0; rep_ < REPS(10); ++rep_) { PHASE_PTRS; PT0(10)
            pg8::Gemm g{XB, WS0 + mls::WS_AI, M, 3072, 1024, nullptr}; pg8::StaticOrder S; S.init(M, 3072, F.G, (int)blockIdx.x, MK_GW_QKV);
            pg8::EpiBf16T<true> E{(bf16*)(ws + F_P), 3072, MK_QSCALE, 4};
            pg8::gemm_phase<pg8::EpiBf16T<true>, pg8::StaticOrder, true, false, true>(F.lds + RING_OFF, g, S, E, F.wave, (const float*)(ws + F_SSQ), (PG8_LAS float*)(F.lds + LDSCTL_OFF + 1024));
        }
        SEAM(pb + 10);
        if (IN(pb + 11)) _Pragma("unroll") for (int rep_ = 0; rep_ < REPS(11); ++rep_) { PHASE_PTRS; PT0(11) MK_ATTENTION }
        SEAM(pb + 11);
        if (IN(pb + 12)) _Pragma("unroll") for (int rep_ = 0; rep_ < REPS(12); ++rep_) { PHASE_PTRS; PT0(12)
            pg8::Gemm g{(const bf16*)(ws + F_O), WS0 + mls::WS_AO, M, 1024, 1024, nullptr}; pg8::StaticOrder S; S.init(M, 1024, F.G, (int)blockIdx.x, MK_GW_RES);
            pg8::EpiResidB<false> E{XB, 1024, nullptr};
            pg8::gemm_phase<pg8::EpiResidB<false>, pg8::StaticOrder, MK_ALIGN_RESID, false>(F.lds + RING_OFF, g, S, E, F.wave);
        }
        SEAM(pb + 12);
        if (IN(pb + 13)) _Pragma("unroll") for (int rep_ = 0; rep_ < REPS(13); ++rep_) { PHASE_PTRS; PT0(13)
#ifndef MK_CV_FIRST
#define MK_CV_FIRST 0
#endif
            if (F.G != 256 || MK_CV_FIRST != 0) {
            cvt_job(F, KA_IN(25) + (size_t)pr * NE * 1024 * FF, FF, 1024, FF, NE, (size_t)1024 * FF, W0, (size_t)7168 * 1024, 1, 0);
            cvt_job(F, KA_IN(26) + (size_t)pr * NE * 1024 * FF, FF, 1024, FF, NE, (size_t)1024 * FF, W0, (size_t)7168 * 1024, 2, 0);
            cvt_job(F, KA_IN(27) + (size_t)pr * NE * FF * 1024, 1024, FF, 1024, NE, (size_t)FF * 1024, W0 + (size_t)NE * 7168 * 1024, (size_t)1024 * FF, 0, 0); }
            RowJob J{}; J.xbsrc = XB; J.nw = KA_IN(22) + pr * 1024; J.XN = XN;
            J.slab = KA_IN(23) + (size_t)pr * 8192; J.slab_ld = 8; J.kind = 2; J.b0 = KA_IN(24) + pr * 8; J.top_e = top_e; J.top_g_out = top_g; J.wg_cnt = slot_tok;
            row_phase(F, J);
        }
        SEAM(pb + 13);
        if (IN(pb + 14)) _Pragma("unroll") for (int rep_ = 0; rep_ < REPS(14); ++rep_) { PHASE_PTRS; PT0(14) assign_phase(F, top_e, slot_tok, tok_slot, blk_e, n_used, slot_tok + 4096); }
        SEAM(pb + 14);
        if (IN(pb + 15)) _Pragma("unroll") for (int rep_ = 0; rep_ < REPS(15); ++rep_) { PHASE_PTRS; PT0(15)
            const int nb = __builtin_amdgcn_readfirstlane(*(volatile int*)n_used);
            pg8::Gemm g{XN, W0, nb * 256, 2 * FF, 1024, slot_tok + 4096, M}; pg8::GroupOrder S; S.init(nb, 2 * FF / 256, F.G, (int)blockIdx.x, blk_e, (long)7168 * 1024, MK_GW_E2);
            pg8::EpiSwiGLU E{(bf16*)(ws + F_H), FF};
            pg8::gemm_phase<pg8::EpiSwiGLU, pg8::GroupOrder, MK_ALIGN_SWI, true>(F.lds + RING_OFF, g, S, E, F.wave, nullptr, nullptr, (PG8_LAS int*)(F.lds + LDSCTL_OFF + 4096));
        }
        SEAM(pb + 15);
        if (IN(pb + 16)) _Pragma("unroll") for (int rep_ = 0; rep_ < REPS(16); ++rep_) { PHASE_PTRS; PT0(16)
            const int nb = __builtin_amdgcn_readfirstlane(*(volatile int*)n_used);
            const int nmain = nb < 256 ? nb : 256;
            pg8::Gemm g{(const bf16*)(ws + F_H), W0 + (size_t)NE * 7168 * 1024, nb * 256, 1024, FF, nullptr}; pg8::GroupOrder S; S.init(nmain, 4, F.G, (int)blockIdx.x, blk_e, (long)1024 * FF, MK_GW_E3);
            pg8::EpiBf16 E{Ybuf, 1024, 1.f, 0};
            pg8::gemm_phase<pg8::EpiBf16, pg8::GroupOrder, true, false>(F.lds + RING_OFF, g, S, E, F.wave);
            __syncthreads();
            { pg8::Gemm g2{(const bf16*)(ws + F_H), W0 + (size_t)NE * 7168 * 1024, nb * 256, 1024, YP_KC, nullptr, 0, FF}; pg8::SplitOrder S2; S2.init(256, nb - 256, 4, YP_NS, YP_KC, F.G, (int)blockIdx.x, blk_e, (long)1024 * FF);
              pg8::EpiBf16Part E2{(bf16*)(ws + F_YP), 1024, 256, YP_ROWS, YP_KC};
              pg8::gemm_phase<pg8::EpiBf16Part, pg8::SplitOrder, true, false, false, true>(F.lds + RING_OFF, g2, S2, E2, F.wave);
              const int nsu = (nb - 256) * 4 * YP_NS, tid = fresh_tid(F);
              for (int L = (int)blockIdx.x; L < nsu; L += F.G) {
                  asm volatile("s_waitcnt vmcnt(0)" ::: "memory"); __syncthreads();
                  const int tile = L / YP_NS;
                  if (tid == 0) { __builtin_amdgcn_fence(__ATOMIC_RELEASE, "agent"); asm volatile("s_waitcnt vmcnt(0)" ::: "memory");
                      const unsigned old = __hip_atomic_fetch_add((unsigned*)((gu32*)(ws + F_CTL) + CW_YP + pr * 32 + tile), 1u, RLX_AGENT);
                      if (old == (unsigned)(YP_NS - 1)) { __builtin_amdgcn_fence(__ATOMIC_ACQUIRE, "agent"); asm volatile("s_waitcnt vmcnt(0)" ::: "memory"); }
                      MISC[13] = old; }
                  __syncthreads();
                  if (MISC[13] == (unsigned)(YP_NS - 1)) {
                      const int x = tile >> 2, pn = tile & 3; const bf16* pl = (const bf16*)(ws + F_YP);
                      for (int q = tid; q < 256 * 32; q += NTHR) { const int r = q >> 5, c8 = (q & 31) * 8; float t[8];
#pragma unroll
                          for (int e = 0; e < 8; ++e) t[e] = 0.f;
#pragma unroll
                          for (int kc = 0; kc < YP_NS; ++kc) { const v4u v = *(const GAS v4u*)(pl + ((size_t)kc * YP_ROWS + x * 256 + r) * 1024 + pn * 256 + c8);
                              t[0] += bf_lo(v.x); t[1] += bf_hi(v.x); t[2] += bf_lo(v.y); t[3] += bf_hi(v.y); t[4] += bf_lo(v.z); t[5] += bf_hi(v.z); t[6] += bf_lo(v.w); t[7] += bf_hi(v.w); }
                          v4u o; o.x = pk2(t[0], t[1]); o.y = pk2(t[2], t[3]); o.z = pk2(t[4], t[5]); o.w = pk2(t[6], t[7]);
                          *(GAS v4u*)(Ybuf + ((size_t)(256 + x) * 256 + r) * 1024 + pn * 256 + c8) = o; } }
                  __syncthreads();
              } }
        }
        SEAM(pb + 16);
    }
    if (IN(PH_FINAL)) { PHASE_PTRS;
        RowJob J{}; J.xbsrc = XB; J.nw = KA_IN(28); J.outf = xo; if (!(flags & 2)) { J.Y = Ybuf; J.tok_slot = tok_slot; J.top_g = top_g; }
        row_phase(F, J);
    }
#if defined(PROBE_BARWAIT) || defined(PROBE_PHSET)
#ifndef PROBE_BARWAIT
#define PROBE_BARWAIT 0
#endif
#ifndef PROBE_SCALE
#define PROBE_SCALE 0.001f
#endif
#ifndef PROBE_OFFS
#define PROBE_OFFS 0.f
#endif
    if (IN(PH_FINAL)) { PHASE_PTRS; __syncthreads(); asm volatile("s_waitcnt vmcnt(0)" ::: "memory"); if (blockIdx.x == PROBE_BARWAIT && F.wave == 0 && lane_id() == 0) xo[0] += (float)probe_acc * PROBE_SCALE - PROBE_OFFS; }
#endif
#undef IN
#undef SEAM
}
}
extern "C" void kernel_launch(void* const* d_in, const int* in_sizes, int n_in, void* d_out, int out_size, void* d_ws, size_t ws_size, hipStream_t stream) {
    static int grid = 0;
    if (grid == 0) {
        int dev = 0, cus = 0, per_cu = 0;
        (void)hipGetDevice(&dev); (void)hipDeviceGetAttribute(&cus, hipDeviceAttributeMultiprocessorCount, dev);
        (void)hipFuncSetAttribute((const void*)mk::mk_fwd, hipFuncAttributeMaxDynamicSharedMemorySize, mk::LDS_BYTES);
        (void)hipOccupancyMaxActiveBlocksPerMultiprocessor(&per_cu, (const void*)mk::mk_fwd, mk::NTHR, mk::LDS_BYTES);
        (void)hipGetLastError();
        grid = cus > 0 ? cus : 256;
    }
    mk::Args a{}; for (int i = 0; i < 29; ++i) a.in[i] = (const float*)d_in[i];
    a.out = (float*)d_out; a.ws = (unsigned char*)d_ws; a.ph_lo = 0; a.ph_hi = mk::PH_FINAL + 1; a.li = 0; a.flags = 0;
    (void)hipMemsetAsync((unsigned char*)d_ws + mk::F_CTL, 0, mk::CTL_ZERO_BYTES, stream);
    hipLaunchKernelGGL(mk::mk_fwd, dim3(grid), dim3(mk::NTHR), mk::LDS_BYTES, stream, a);
}
```

```cpp
#include <hip/hip_runtime.h>
#include <cstdio>
#include <cstdint>
#include <cmath>
namespace nv {
__device__ const int BUCKET[128] = {0, 1, 2, 3, 4, 5, 6, 7, 8, 9, 10, 11, 12, 13, 14, 15, 16, 16, 16, 17, 17, 18, 18, 18, 19, 19, 19, 20, 20, 20, 20, 21, 21, 21, 21, 22, 22, 22, 22, 22, 23, 23, 23, 23, 23, 23, 24, 24, 24, 24, 24, 24, 25, 25, 25, 25, 25, 25, 25, 26, 26, 26, 26, 26, 26, 26, 26, 27, 27, 27, 27, 27, 27, 27, 27, 27, 27, 28, 28, 28, 28, 28, 28, 28, 28, 28, 28, 29, 29, 29, 29, 29, 29, 29, 29, 29, 29, 29, 29, 30, 30, 30, 30, 30, 30, 30, 30, 30, 30, 30, 30, 30, 30, 31, 31, 31, 31, 31, 31, 31, 31, 31, 31, 31, 31, 31, 31, 31};
}
namespace pg8 {
#define PG8_LAS __attribute__((address_space(3)))
typedef unsigned short bf16_t;
typedef short bf16x8 __attribute__((ext_vector_type(8)));
typedef float f32x4 __attribute__((ext_vector_type(4)));
typedef float f32x2 __attribute__((ext_vector_type(2)));
typedef unsigned u32x4 __attribute__((ext_vector_type(4)));
#ifndef PG8_WGM
#define PG8_WGM 8
#endif
#ifndef PG8_GWGM
#define PG8_GWGM 8
#endif
#ifndef PG8_GROUP_XCD
#define PG8_GROUP_XCD 1
#endif
constexpr int BM = 256, BK = 64, HALF = 128, HTB = HALF * BK * 2  , STAGE_BYTES = 8 * HTB, NXCD = 8, WGM = PG8_WGM;

__host__ __device__ __forceinline__ int lds_byte(int r, int c) { const int st = (r >> 4) * 2 + (c >> 5), rr = r & 15, cc = c & 31, ob = rr * 64 + cc * 2; return st * 1024 + (ob ^ (((ob >> 9) & 1) << 5)); }
__host__ __device__ __forceinline__ void stage_rc(int b, int& R, int& C) { const int st = b / 1024, sb = b % 1024, swz = sb ^ (((sb >> 9) & 1) << 5); R = (st >> 1) * 16 + swz / 64; C = (st & 1) * 32 + (swz % 64) / 2; }
__host__ __device__ __forceinline__ int perm32(int rho) { const int n = rho >> 4, i = rho & 15; return 8 * (i >> 2) + 4 * n + (i & 3); }

struct Unit { int pm, pn; long boff; long aoff; };
struct Gemm { const bf16_t* A; const bf16_t* Bt; int M, N, K; const int* arow; int arows; int ld; };

struct StaticOrder {
    int nM, nN, nwg, G, c, gw;
    __host__ __device__ void init(int M, int N, int G_, int c_, int gw_ = WGM) { nM = M / BM; nN = N / BM; nwg = nM * nN; G = G_; c = c_; gw = gw_; }
    __host__ __device__ bool next(int i, Unit& u) const {
        const long L = (long)i * G + c; if (L >= nwg) return false;
        int wgid = (int)L; { const int q = nwg / NXCD, r = nwg % NXCD, xcd = wgid % NXCD, off = wgid / NXCD; wgid = (xcd < r ? xcd * (q + 1) : r * (q + 1) + (xcd - r) * q) + off; }
        const int nig = gw * nN, gid = wgid / nig, fm = gid * gw, gsz = (nM - fm) < gw ? (nM - fm) : gw;
        u.pm = fm + ((wgid % nig) % gsz); u.pn = (wgid % nig) / gsz; u.boff = 0; return true;
    }
};
struct GroupOrder {
    int nM, nN, nwg, G, c, gw; const int* blk_e; long wstride;
    __device__ void init(int nM_, int nN_, int G_, int c_, const int* be, long ws, int gw_) { nM = nM_; nN = nN_; nwg = nM * nN; G = G_; c = c_; blk_e = be; wstride = ws; gw = gw_; }
    __device__ bool next(int i, Unit& u) const {
        const long L = (long)i * G + c; if (L >= nwg) return false;
        int wgid = (int)L;
        if (PG8_GROUP_XCD) { const int q = nwg / NXCD, r = nwg % NXCD, xcd = wgid % NXCD, off = wgid / NXCD; wgid = (xcd < r ? xcd * (q + 1) : r * (q + 1) + (xcd - r) * q) + off; }
        const int nig = gw * nN, gid = wgid / nig, fm = gid * gw, gsz = (nM - fm) < gw ? (nM - fm) : gw;
        u.pm = fm + ((wgid % nig) % gsz); u.pn = (wgid % nig) / gsz; u.boff = (long)blk_e[u.pm] * wstride; return true;
    }
};

struct SplitOrder {
    int pm0, nN, ns, kc_len, nwg, G, c; const int* blk_e; long wstride;
    __device__ void init(int pm0_, int nx, int nN_, int ns_, int kc_len_, int G_, int c_, const int* be, long ws) { pm0 = pm0_; nN = nN_; ns = ns_; kc_len = kc_len_; nwg = nx > 0 ? nx * nN_ * ns_ : 0; G = G_; c = c_; blk_e = be; wstride = ws; }
    __device__ bool next(int i, Unit& u) const {
        const long L = (long)i * G + c; if (L >= nwg) return false;
        const int l = (int)L, kc = l % ns, r = l / ns; u.pn = r % nN; u.pm = pm0 + r / nN; u.aoff = (long)kc * kc_len; u.boff = (long)blk_e[u.pm] * wstride + u.aoff; return true;
    }
};

__device__ __forceinline__ unsigned cvt_pk_bf16(float lo, float hi) { unsigned r; asm volatile("v_cvt_pk_bf16_f32 %0, %1, %2" : "=v"(r) : "v"(lo), "v"(hi)); return r; }
__device__ __forceinline__ float silu_f(float v) { return v * __builtin_amdgcn_rcpf(1.0f + __builtin_amdgcn_exp2f(-1.4426950408889634f * v)); }

#ifndef PG8_WT
#define PG8_WT 0
#endif
template <class V> __device__ __forceinline__ void st16(void* p, const V& v) {
#if PG8_WT == 1
    asm volatile("global_store_dwordx4 %0, %1, off sc1\n\ts_nop 1" :: "v"(p), "v"(v) : "memory");
#elif PG8_WT == 2
    asm volatile("global_store_dwordx4 %0, %1, off sc0 sc1\n\ts_nop 1" :: "v"(p), "v"(v) : "memory");
#elif PG8_WT == 3
    asm volatile("global_store_dwordx4 %0, %1, off nt\n\ts_nop 1" :: "v"(p), "v"(v) : "memory");
#else
    *(V*)p = v;
#endif
}
template <bool RSC> struct EpiBf16T {
    static constexpr bool PERM = true;
    bf16_t* O; int ldc; float scale0; int nscaled;
    __device__ __forceinline__ void operator()(const f32x4 (&acc)[2][2][4][2], const Unit& u, int wr, int wc, int fr, int fq, const PG8_LAS float* rs) const {
        const int row0 = u.pm * BM + wr * 64 + fr, col0 = u.pn * BM + wc * 32 + 8 * fq;
        const float sc0 = (u.pn < nscaled) ? scale0 : 1.f;
#pragma unroll
        for (int ai = 0; ai < 2; ++ai)
#pragma unroll
            for (int m = 0; m < 4; ++m) { bf16_t* rowp = O + (size_t)(row0 + ai * HALF + m * 16) * ldc + col0;
                const float sc = RSC ? sc0 * rs[ai * HALF + wr * 64 + m * 16 + fr] : sc0;
#pragma unroll
                for (int bj = 0; bj < 2; ++bj) { const f32x4 v0 = acc[ai][bj][m][0] * sc, v1 = acc[ai][bj][m][1] * sc;
                    u32x4 w; w.x = cvt_pk_bf16(v0[0], v0[1]); w.y = cvt_pk_bf16(v0[2], v0[3]); w.z = cvt_pk_bf16(v1[0], v1[1]); w.w = cvt_pk_bf16(v1[2], v1[3]);
                    st16(rowp + bj * HALF, w); } }
    }
};
typedef EpiBf16T<false> EpiBf16;
struct EpiBf16Part {
    static constexpr bool PERM = true;
    bf16_t* O; int ldc, pm0, prow, kc_len;
    __device__ __forceinline__ void operator()(const f32x4 (&acc)[2][2][4][2], const Unit& u, int wr, int wc, int fr, int fq, const PG8_LAS float*) const {
        const int kc = (int)u.aoff / kc_len, row0 = kc * prow + (u.pm - pm0) * BM + wr * 64 + fr, col0 = u.pn * BM + wc * 32 + 8 * fq;
#pragma unroll
        for (int ai = 0; ai < 2; ++ai)
#pragma unroll
            for (int m = 0; m < 4; ++m) { bf16_t* rowp = O + (size_t)(row0 + ai * HALF + m * 16) * ldc + col0;
#pragma unroll
                for (int bj = 0; bj < 2; ++bj) { const f32x4 v0 = acc[ai][bj][m][0], v1 = acc[ai][bj][m][1];
                    u32x4 w; w.x = cvt_pk_bf16(v0[0], v0[1]); w.y = cvt_pk_bf16(v0[2], v0[3]); w.z = cvt_pk_bf16(v1[0], v1[1]); w.w = cvt_pk_bf16(v1[2], v1[3]);
                    st16(rowp + bj * HALF, w); } }
    }
};
template <bool RSC> struct EpiSwiGLUT {
    static constexpr bool PERM = true;
    bf16_t* O; int ldc;
    __device__ __forceinline__ void operator()(const f32x4 (&acc)[2][2][4][2], const Unit& u, int wr, int wc, int fr, int fq, const PG8_LAS float* rs) const {
        const int row0 = u.pm * BM + wr * 64 + fr, col0 = u.pn * HALF + wc * 32 + 8 * fq;
#pragma unroll
        for (int ai = 0; ai < 2; ++ai)
#pragma unroll
            for (int m = 0; m < 4; ++m) { bf16_t* rowp = O + (size_t)(row0 + ai * HALF + m * 16) * ldc + col0;
                const float rsc = RSC ? rs[ai * HALF + wr * 64 + m * 16 + fr] : 1.f;
                const f32x4 g0 = acc[ai][0][m][0] * rsc, g1 = acc[ai][0][m][1] * rsc, u0 = acc[ai][1][m][0] * rsc, u1 = acc[ai][1][m][1] * rsc;
                u32x4 w; w.x = cvt_pk_bf16(silu_f(g0[0]) * u0[0], silu_f(g0[1]) * u0[1]); w.y = cvt_pk_bf16(silu_f(g0[2]) * u0[2], silu_f(g0[3]) * u0[3]);
                w.z = cvt_pk_bf16(silu_f(g1[0]) * u1[0], silu_f(g1[1]) * u1[1]); w.w = cvt_pk_bf16(silu_f(g1[2]) * u1[2], silu_f(g1[3]) * u1[3]);
                st16(rowp, w); }
    }
};
typedef EpiSwiGLUT<false> EpiSwiGLU;
template <bool XB> struct EpiResidT {
    static constexpr bool PERM = true;
    float* O; int ldc; bf16_t* xb; float* ssq; const float* base;
    __device__ __forceinline__ void operator()(const f32x4 (&acc)[2][2][4][2], const Unit& u, int wr, int wc, int fr, int fq, const PG8_LAS float*) const {
        const int row0 = u.pm * BM + wr * 64 + fr, col0 = u.pn * BM + wc * 32 + 8 * fq, lane = fr + 16 * fq;
#pragma unroll
        for (int ai = 0; ai < 2; ++ai) {
            f32x4 xv[4][2][2];
#pragma unroll
            for (int m = 0; m < 4; ++m) { const float* rowp = base + (size_t)(row0 + ai * HALF + m * 16) * ldc + col0;
#pragma unroll
                for (int bj = 0; bj < 2; ++bj)
#pragma unroll
                    for (int n = 0; n < 2; ++n) xv[m][bj][n] = *(const f32x4*)(rowp + bj * HALF + n * 4); }
#pragma unroll
            for (int m = 0; m < 4; ++m) { float* rowp = O + (size_t)(row0 + ai * HALF + m * 16) * ldc + col0;
#pragma unroll
                for (int bj = 0; bj < 2; ++bj)
#pragma unroll
                    for (int n = 0; n < 2; ++n) { xv[m][bj][n] = xv[m][bj][n] + acc[ai][bj][m][n]; st16(rowp + bj * HALF + n * 4, xv[m][bj][n]); } }
            if (XB) {
#pragma unroll
                for (int m = 0; m < 4; ++m) { const size_t ro = (size_t)(row0 + ai * HALF + m * 16); float sq = 0.f;
#pragma unroll
                    for (int bj = 0; bj < 2; ++bj) { const f32x4 v0 = xv[m][bj][0], v1 = xv[m][bj][1];
                        sq += ((v0[0] * v0[0] + v0[1] * v0[1]) + (v0[2] * v0[2] + v0[3] * v0[3])) + ((v1[0] * v1[0] + v1[1] * v1[1]) + (v1[2] * v1[2] + v1[3] * v1[3]));
                        u32x4 w; w.x = cvt_pk_bf16(v0[0], v0[1]); w.y = cvt_pk_bf16(v0[2], v0[3]); w.z = cvt_pk_bf16(v1[0], v1[1]); w.w = cvt_pk_bf16(v1[2], v1[3]);
                        st16(xb + ro * ldc + col0 + bj * HALF, w); }
                    sq += __builtin_bit_cast(float, __builtin_amdgcn_ds_bpermute((lane ^ 16) << 2, __builtin_bit_cast(int, sq)));
                    sq += __builtin_bit_cast(float, __builtin_amdgcn_ds_bpermute((lane ^ 32) << 2, __builtin_bit_cast(int, sq)));
                    if (fq == 0) ssq[ro * 16 + u.pn * 4 + wc] = sq; }
            }
            asm volatile("" ::: "memory");
        }
    }
};
typedef EpiResidT<false> EpiResid;
template <bool SSQ> struct EpiResidB {
    static constexpr bool PERM = true;
    bf16_t* xb; int ldc; float* ssq;
    __device__ __forceinline__ void operator()(const f32x4 (&acc)[2][2][4][2], const Unit& u, int wr, int wc, int fr, int fq, const PG8_LAS float*) const {
        const int row0 = u.pm * BM + wr * 64 + fr, col0 = u.pn * BM + wc * 32 + 8 * fq, lane = fr + 16 * fq;
        u32x4 xv[2][4][2];
#pragma unroll
        for (int ai = 0; ai < 2; ++ai)
#pragma unroll
            for (int m = 0; m < 4; ++m)
#pragma unroll
                for (int bj = 0; bj < 2; ++bj) xv[ai][m][bj] = *(const u32x4*)(xb + (size_t)(row0 + ai * HALF + m * 16) * ldc + col0 + bj * HALF);
#pragma unroll
        for (int ai = 0; ai < 2; ++ai) {
#pragma unroll
            for (int m = 0; m < 4; ++m) { const size_t ro = (size_t)(row0 + ai * HALF + m * 16); float sq = 0.f;
#pragma unroll
                for (int bj = 0; bj < 2; ++bj) { const u32x4 r = xv[ai][m][bj]; const f32x4 a0 = acc[ai][bj][m][0], a1 = acc[ai][bj][m][1];
                    const float v0 = __builtin_bit_cast(float, r.x << 16) + a0[0], v1 = __builtin_bit_cast(float, r.x & 0xffff0000u) + a0[1];
                    const float v2 = __builtin_bit_cast(float, r.y << 16) + a0[2], v3 = __builtin_bit_cast(float, r.y & 0xffff0000u) + a0[3];
                    const float v4 = __builtin_bit_cast(float, r.z << 16) + a1[0], v5 = __builtin_bit_cast(float, r.z & 0xffff0000u) + a1[1];
                    const float v6 = __builtin_bit_cast(float, r.w << 16) + a1[2], v7 = __builtin_bit_cast(float, r.w & 0xffff0000u) + a1[3];
                    if (SSQ) sq += ((v0 * v0 + v1 * v1) + (v2 * v2 + v3 * v3)) + ((v4 * v4 + v5 * v5) + (v6 * v6 + v7 * v7));
                    u32x4 w; w.x = cvt_pk_bf16(v0, v1); w.y = cvt_pk_bf16(v2, v3); w.z = cvt_pk_bf16(v4, v5); w.w = cvt_pk_bf16(v6, v7);
                    st16(xb + ro * ldc + col0 + bj * HALF, w); }
                if (SSQ) {
                    sq += __builtin_bit_cast(float, __builtin_amdgcn_ds_bpermute((lane ^ 16) << 2, __builtin_bit_cast(int, sq)));
                    sq += __builtin_bit_cast(float, __builtin_amdgcn_ds_bpermute((lane ^ 32) << 2, __builtin_bit_cast(int, sq)));
                    if (fq == 0) ssq[ro * 16 + u.pn * 4 + wc] = sq; }
            }
        }
    }
};

template <class Epi, class Sched, bool ALIGN_EPI, bool GATHER, bool RS = false, bool SPLITK = false>
__device__ __forceinline__ void gemm_phase(PG8_LAS unsigned char* lds, const Gemm g, const Sched& S, const Epi& E, int wave_id, const float* ssq = nullptr, PG8_LAS float* rtab = nullptr, PG8_LAS int* gtab = nullptr) {
    int tid_; asm volatile("v_mbcnt_lo_u32_b32 %0, -1, 0\n\tv_mbcnt_hi_u32_b32 %0, -1, %0" : "=v"(tid_)); tid_ += wave_id * 64;
    const int tid = tid_, wid = __builtin_amdgcn_readfirstlane(tid >> 6), lane = tid & 63, wr = wid >> 2, wc = wid & 3, fr = lane & 15, fq = lane >> 4;
    const int K = g.K, nt = K / BK, LD = SPLITK ? g.ld : g.K;
    unsigned voffA[2], voffB[2]; int rA[2], cA2[2];
#pragma unroll
    for (int i = 0; i < 2; ++i) { int R, C; stage_rc(tid * 16 + i * 8192, R, C); const int Rb = Epi::PERM ? ((R & ~31) + perm32(R & 31)) : R;
        voffA[i] = (unsigned)(R * LD + C) * 2u; voffB[i] = (unsigned)(Rb * LD + C) * 2u; rA[i] = R; cA2[i] = C * 2; }
    const size_t kstep = (size_t)(BK * 2);
    const size_t hstep = (size_t)HALF * LD * 2;
    const size_t tstep = 2 * hstep;
    const unsigned ldsw = (unsigned)wid * 1024u;
    const int aoff = lds_byte(wr * 64 + fr, fq * 8), boff = lds_byte(wc * 32 + fr, fq * 8);
#define PG8_SA(b, h) (((b) * 2 + (h)) * HTB)
#define PG8_SB(b, h) ((4 + (b) * 2 + (h)) * HTB)
#define PG8_STAGE2(bufoff, gbase, v0, v1) do { \
        __builtin_amdgcn_global_load_lds((const unsigned*)((const char*)(gbase) + (v0)), (PG8_LAS unsigned*)(lds + (bufoff) + ldsw), 16, 0, 0); \
        __builtin_amdgcn_global_load_lds((const unsigned*)((const char*)(gbase) + (v1)), (PG8_LAS unsigned*)(lds + (bufoff) + ldsw + 8192), 16, 0, 0); } while (0)
#define PG8_STAGEB(bufoff, gbase) PG8_STAGE2(bufoff, gbase, voffB[0], voffB[1])
#define PG8_LDA(dst, b, h) do { _Pragma("unroll") for (int m = 0; m < 4; ++m) _Pragma("unroll") for (int k = 0; k < 2; ++k) dst[m][k] = *(const PG8_LAS bf16x8*)(lds + PG8_SA(b, h) + aoff + m * 2048 + k * 1024); } while (0)
#define PG8_LDB(dst, b, h) do { _Pragma("unroll") for (int n = 0; n < 2; ++n) _Pragma("unroll") for (int k = 0; k < 2; ++k) dst[n][k] = *(const PG8_LAS bf16x8*)(lds + PG8_SB(b, h) + boff + n * 2048 + k * 1024); } while (0)
#define PG8_MMA(ai, bj, At, Bt) do { __builtin_amdgcn_s_setprio(1); _Pragma("unroll") for (int m = 0; m < 4; ++m) _Pragma("unroll") for (int n = 0; n < 2; ++n) _Pragma("unroll") for (int k = 0; k < 2; ++k) \
        acc[ai][bj][m][n] = __builtin_amdgcn_mfma_f32_16x16x32_bf16(Bt[n][k], At[m][k], acc[ai][bj][m][n], 0, 0, 0); __builtin_amdgcn_s_setprio(0); } while (0)
#define PG8_WAIT_V(n) asm volatile("s_waitcnt vmcnt(" #n ")" ::: "memory")
#define PG8_WAIT_L(n) asm volatile("s_waitcnt lgkmcnt(" #n ")" ::: "memory")
#define PG8_BAR __builtin_amdgcn_s_barrier()
#define PG8_SCHED __builtin_amdgcn_sched_barrier(0)
    Unit cur, nxt; int ui = 0;
    if (!S.next(0, cur)) return;
    f32x4 acc[2][2][4][2];
#pragma unroll
    for (int a = 0; a < 2; ++a)
#pragma unroll
        for (int b = 0; b < 2; ++b)
#pragma unroll
            for (int m = 0; m < 4; ++m)
#pragma unroll
                for (int n = 0; n < 2; ++n) acc[a][b][m][n] = (f32x4){0.f, 0.f, 0.f, 0.f};
    bf16x8 At[4][2], B0[2][2], B1[2][2];
    unsigned c00, c01, c10, c11, n00, n01, n10, n11;
    const char* cA; const char* cB = (const char*)g.Bt + (size_t)cur.boff * 2 + (size_t)cur.pn * tstep;
    if constexpr (GATHER) {
        cA = (const char*)g.A;
        const int* ar = g.arow + cur.pm * BM;
        int t00 = ar[rA[0]], t01 = ar[rA[1]], t10 = ar[HALF + rA[0]], t11 = ar[HALF + rA[1]];
        t00 = (unsigned)t00 >= (unsigned)g.arows ? 0 : t00; t01 = (unsigned)t01 >= (unsigned)g.arows ? 0 : t01; t10 = (unsigned)t10 >= (unsigned)g.arows ? 0 : t10; t11 = (unsigned)t11 >= (unsigned)g.arows ? 0 : t11;
        c00 = (unsigned)t00 * (unsigned)(K * 2) + cA2[0]; c01 = (unsigned)t01 * (unsigned)(K * 2) + cA2[1]; c10 = (unsigned)t10 * (unsigned)(K * 2) + cA2[0]; c11 = (unsigned)t11 * (unsigned)(K * 2) + cA2[1];
    } else {
        cA = (const char*)g.A + (size_t)cur.pm * tstep + (SPLITK ? (size_t)cur.aoff * 2 : (size_t)0);
        c00 = voffA[0]; c01 = voffA[1]; c10 = voffA[0]; c11 = voffA[1];
    }
    const size_t HS = GATHER ? (size_t)0 : hstep;
    n00 = c00; n01 = c01; n10 = c10; n11 = c11;
    f32x4 rsld[4];
    if constexpr (RS) { if (wr == 0) { const f32x4* sp = (const f32x4*)(ssq + ((size_t)cur.pm * BM + tid) * 16); const f32x4 a = sp[0], b = sp[1], c = sp[2], d = sp[3];
            const f32x4 t = (a + b) + (c + d); rtab[tid] = __builtin_amdgcn_rsqf(((t[0] + t[1]) + (t[2] + t[3])) * (1.0f / 1024.0f) + 1e-6f); } }
    PG8_STAGEB(PG8_SB(0, 0), cB); PG8_STAGEB(PG8_SB(0, 1), cB + hstep); PG8_STAGE2(PG8_SA(0, 0), cA, c00, c01); PG8_STAGE2(PG8_SA(0, 1), cA + HS, c10, c11);
    if (wr == 1) PG8_BAR;
    PG8_WAIT_V(2); PG8_BAR;
    PG8_STAGEB(PG8_SB(1, 0), cB + kstep); PG8_STAGE2(PG8_SA(1, 0), cA + kstep, c00, c01); PG8_STAGEB(PG8_SB(1, 1), cB + hstep + kstep);
    PG8_WAIT_V(6); PG8_BAR;
    for (;;) {
        const bool has_next = S.next(ui + 1, nxt);
        const char* nA; const char* nB = has_next ? (const char*)g.Bt + (size_t)nxt.boff * 2 + (size_t)nxt.pn * tstep : cB;
        if constexpr (GATHER) {
            nA = cA;
            if (has_next && wid < 4)
                __builtin_amdgcn_global_load_lds((const unsigned*)(g.arow + nxt.pm * BM + tid), (PG8_LAS unsigned*)(gtab + ((ui + 1) & 1) * 256 + wid * 64), 4, 0, 0);
        } else {
            nA = has_next ? (const char*)g.A + (size_t)nxt.pm * tstep + (SPLITK ? (size_t)nxt.aoff * 2 : (size_t)0) : cA;
        }
        if constexpr (RS) { if (has_next && wr == 0) { const f32x4* sp = (const f32x4*)(ssq + ((size_t)nxt.pm * BM + tid) * 16); rsld[0] = sp[0]; rsld[1] = sp[1]; rsld[2] = sp[2]; rsld[3] = sp[3]; } }
        for (int t = 0; t < nt; t += 2) {
            const bool last = (t == nt - 2);
            const char* a1 = cA + (size_t)(t + 1) * kstep;
            const char* a2 = last ? nA : cA + (size_t)(t + 2) * kstep; const char* b2 = last ? nB : cB + (size_t)(t + 2) * kstep;
            const char* a3 = a2 + kstep; const char* b3 = b2 + kstep;
            unsigned x00 = c00, x01 = c01, x10 = c10, x11 = c11;
            if constexpr (GATHER) { if (last) {
                if (has_next) { const unsigned gb = (unsigned)(__SIZE_TYPE__)(gtab + ((ui + 1) & 1) * 256); int t00, t01, t10, t11;
                    asm volatile("ds_read_b32 %0, %4\n\tds_read_b32 %1, %5\n\tds_read_b32 %2, %4 offset:512\n\tds_read_b32 %3, %5 offset:512\n\ts_waitcnt lgkmcnt(0)"
                                 : "=&v"(t00), "=&v"(t01), "=&v"(t10), "=&v"(t11) : "v"(gb + 4u * (unsigned)rA[0]), "v"(gb + 4u * (unsigned)rA[1]) : "memory");
                    t00 = (unsigned)t00 >= (unsigned)g.arows ? 0 : t00; t01 = (unsigned)t01 >= (unsigned)g.arows ? 0 : t01; t10 = (unsigned)t10 >= (unsigned)g.arows ? 0 : t10; t11 = (unsigned)t11 >= (unsigned)g.arows ? 0 : t11;
                    n00 = (unsigned)t00 * (unsigned)(K * 2) + cA2[0]; n01 = (unsigned)t01 * (unsigned)(K * 2) + cA2[1]; n10 = (unsigned)t10 * (unsigned)(K * 2) + cA2[0]; n11 = (unsigned)t11 * (unsigned)(K * 2) + cA2[1]; }
                x00 = n00; x01 = n01; x10 = n10; x11 = n11; } }
            PG8_LDB(B0, 0, 0); PG8_LDB(B1, 0, 1); PG8_SCHED; PG8_LDA(At, 0, 0); PG8_STAGE2(PG8_SA(1, 1), a1 + HS, c10, c11);
            PG8_WAIT_V(8); PG8_WAIT_L(0); PG8_BAR; PG8_MMA(0, 0, At, B0); PG8_MMA(0, 1, At, B1); PG8_BAR; PG8_SCHED;
            PG8_LDA(At, 0, 1); PG8_STAGEB(PG8_SB(0, 0), b2); PG8_STAGEB(PG8_SB(0, 1), b2 + hstep); PG8_STAGE2(PG8_SA(0, 0), a2, x00, x01);
            PG8_WAIT_V(8); PG8_WAIT_L(0); PG8_BAR; PG8_MMA(1, 0, At, B0); PG8_MMA(1, 1, At, B1); PG8_BAR; PG8_SCHED;
            PG8_LDB(B0, 1, 0); PG8_LDB(B1, 1, 1); PG8_SCHED; PG8_LDA(At, 1, 0); PG8_STAGE2(PG8_SA(0, 1), a2 + HS, x10, x11);
            PG8_WAIT_V(8); PG8_WAIT_L(0); PG8_BAR; PG8_MMA(0, 0, At, B0); PG8_MMA(0, 1, At, B1); PG8_BAR; PG8_SCHED;
            PG8_LDA(At, 1, 1); PG8_STAGEB(PG8_SB(1, 0), b3); PG8_STAGEB(PG8_SB(1, 1), b3 + hstep); PG8_STAGE2(PG8_SA(1, 0), a3, x00, x01);
            PG8_WAIT_V(8); PG8_WAIT_L(0); PG8_BAR; PG8_MMA(1, 0, At, B0); PG8_MMA(1, 1, At, B1); PG8_BAR; PG8_SCHED;
        }
        if constexpr (ALIGN_EPI) { if (wr == 0) PG8_BAR; }
        if constexpr (RS) { if (has_next && wr == 0) { const f32x4 t = (rsld[0] + rsld[1]) + (rsld[2] + rsld[3]); rtab[((ui + 1) & 1) * 256 + tid] = __builtin_amdgcn_rsqf(((t[0] + t[1]) + (t[2] + t[3])) * (1.0f / 1024.0f) + 1e-6f); } }
        E(acc, cur, wr, wc, fr, fq, RS ? rtab + (ui & 1) * 256 : (PG8_LAS float*)nullptr);
        if (!has_next) break;
#pragma unroll
        for (int a = 0; a < 2; ++a)
#pragma unroll
            for (int b = 0; b < 2; ++b)
#pragma unroll
                for (int m = 0; m < 4; ++m)
#pragma unroll
                    for (int n = 0; n < 2; ++n) acc[a][b][m][n] = (f32x4){0.f, 0.f, 0.f, 0.f};
        cur = nxt; cA = nA; cB = nB; ++ui;
        c00 = n00; c01 = n01; c10 = n10; c11 = n11;
        if constexpr (ALIGN_EPI) { if (wr == 1) PG8_BAR; }
    }
    PG8_WAIT_V(0);
    if constexpr (!ALIGN_EPI) { if (wr == 0) PG8_BAR; }
    PG8_BAR;
#undef PG8_SA
#undef PG8_SB
#undef PG8_STAGE2
#undef PG8_STAGEB
#undef PG8_LDA
#undef PG8_LDB
#undef PG8_MMA
#undef PG8_WAIT_V
#undef PG8_WAIT_L
#undef PG8_BAR
#undef PG8_SCHED
}
}
namespace mk {
constexpr int NWAVES = 8, NTHR = 512;
constexpr int B = 8, S = 4096, D = 1024, M = B * S;
constexpr int FF = 3584, NE = 8, NBLK = 264, NSLOT = NBLK * 256;
constexpr size_t MiB = 1u << 20;
constexpr size_t F_CTL = 0, CTL_ZERO_BYTES = 1 * MiB;
constexpr size_t F_TOPE = 1 * MiB, F_TOPG = F_TOPE + 256 * 1024, F_SLOTTOK = F_TOPG + 256 * 1024, F_TOKSLOT = F_SLOTTOK + 320 * 1024, F_BLKE = F_TOKSLOT + 256 * 1024, F_NUSED = F_BLKE + 2048;
constexpr size_t F_LI = 3 * MiB, F_LF = 3 * MiB + 512 * 1024;
constexpr size_t F_W = 4 * MiB, F_WS = 172 * MiB, F_XN = 212 * MiB, F_BIG = 276 * MiB;
constexpr size_t F_P = F_BIG, F_HH = 468 * MiB, F_G = 596 * MiB, F_QKC = 660 * MiB;
constexpr size_t F_YP = F_WS + 9 * MiB;
constexpr int YP_SLOT0 = 65536, YP_ROWS = 2048, YP_NS = 7, YP_KC = 512;
constexpr size_t F_H = F_BIG;
constexpr size_t F_O = 468 * MiB, F_OT = 532 * MiB;
constexpr size_t F_Y = 738 * MiB, F_SSQ = 870 * MiB, F_GB = 872 * MiB;
static_assert(F_NUSED + 64 <= 3 * MiB && F_H + (size_t)NSLOT * FF * 2 <= F_Y && F_Y + (size_t)NSLOT * 1024 * 2 <= 872 * MiB, "ws map");
constexpr int CW_TMO = 0, CW_BAR = 4096, CW_GRP = 150016, CW_YP = 160000;
constexpr int MAX_LAUNCH = 40;
static_assert(CW_BAR + MAX_LAUNCH * 3456 <= CW_GRP && (CW_GRP + 64 * 64) * 4 <= (int)CTL_ZERO_BYTES, "ctl words");
constexpr int RING_OFF = 0, RING_BYTES = 131072, LDSCTL_OFF = RING_BYTES, MISC_OFF = LDSCTL_OFF + 320, LDS_BYTES = 147456;

#define GAS __attribute__((address_space(1)))
#define LAS __attribute__((address_space(3)))
typedef unsigned short bf16;
typedef unsigned v4u __attribute__((ext_vector_type(4)));
typedef unsigned v2u __attribute__((ext_vector_type(2)));
typedef float f32x4 __attribute__((ext_vector_type(4)));
typedef GAS unsigned gu32;
#define RLX_AGENT __ATOMIC_RELAXED, __HIP_MEMORY_SCOPE_AGENT
#define LDS_WAIT() asm volatile("s_waitcnt lgkmcnt(0)" ::: "memory")
#define VM_WAIT() asm volatile("s_waitcnt vmcnt(0)" ::: "memory")
__device__ __forceinline__ unsigned f2bf(float f) { unsigned u = __builtin_bit_cast(unsigned, f); return (u + 0x7fffu + ((u >> 16) & 1u)) >> 16; }
__device__ __forceinline__ unsigned pk2(float lo, float hi) { return f2bf(lo) | (f2bf(hi) << 16); }
__device__ __forceinline__ float bf_lo(unsigned w) { return __builtin_bit_cast(float, w << 16); }
__device__ __forceinline__ float bf_hi(unsigned w) { return __builtin_bit_cast(float, w & 0xffff0000u); }

#define XB_TMO      128
#define XB_XCNT(j)  (256  + 64 * (j))
#define XB_XSUB(j)  (1280 + 64 * (j))
#define XB_XGEN(j)  (2304 + 64 * (j))
#define XB_TOP      3328
#define XB_TOPGEN   3392
#define XCD_BAR_WORDS 3456
#define XB_SPIN_CAP (1u << 18)
__device__ __forceinline__ unsigned xb_ld(unsigned* p)              { return __hip_atomic_load(p, __ATOMIC_RELAXED, __HIP_MEMORY_SCOPE_AGENT); }
__device__ __forceinline__ unsigned xb_add(unsigned* p, unsigned v) { return __hip_atomic_fetch_add(p, v, __ATOMIC_RELAXED, __HIP_MEMORY_SCOPE_AGENT); }
__device__ __forceinline__ unsigned xb_xcc_id() { return (unsigned)__builtin_amdgcn_s_getreg((3 << 11) | 20) & 0xFu; }
#define XB_SPIN(cond, bar) do { unsigned _sp = 0; while (cond) { __builtin_amdgcn_s_sleep(1); \
    if ((++_sp & 255u) == 0u) { if (xb_ld(&(bar)[XB_TMO])) break; if (_sp > XB_SPIN_CAP) { atomicAdd(&(bar)[XB_TMO], 1u); break; } } } } while (0)
struct XcdBarrier { unsigned* bar; unsigned x; volatile LAS unsigned* st; };
__device__ __forceinline__ XcdBarrier xcd_barrier_post(unsigned* bar, volatile LAS unsigned* st, bool t0) {
    XcdBarrier b; b.bar = bar; b.x = xb_xcc_id(); b.st = st;
    if (t0) (void)xb_add(&bar[XB_XCNT(b.x)], 1u);
    return b;
}
__device__ __forceinline__ void xcd_barrier_complete(unsigned* bar, unsigned x, unsigned& nloc, unsigned& nx) {
    const unsigned G = gridDim.x * gridDim.y * gridDim.z;
    unsigned sum, cnt, mine, sp = 0u;
    for (;;) {
        sum = 0u; cnt = 0u; mine = 0u;
#pragma unroll
        for (unsigned j = 0; j < 16; ++j) { const unsigned c = xb_ld(&bar[XB_XCNT(j)]); sum += c; cnt += (c > 0u) ? 1u : 0u; mine = (j == x) ? c : mine; }
        if (sum == G) break;
        __builtin_amdgcn_s_sleep(1);
        if ((++sp & 255u) == 0u) { if (xb_ld(&bar[XB_TMO])) break; if (sp > XB_SPIN_CAP) { atomicAdd(&bar[XB_TMO], 1u); break; } }
    }
    nloc = mine > 0u ? mine : 1u; nx = cnt > 0u ? cnt : 1u;
}
__device__ __forceinline__ void xcd_barrier(const XcdBarrier& b, bool t0) {
    asm volatile("s_waitcnt vmcnt(0)" ::: "memory");
    __syncthreads();
    if (t0) {
        unsigned* bar = b.bar;
        __builtin_amdgcn_s_waitcnt(0);
        unsigned nloc = b.st[0], nx = b.st[1];
        if (nloc == 0u) { xcd_barrier_complete(bar, b.x, nloc, nx); b.st[0] = nloc; b.st[1] = nx; }
#if defined(MK_EARLY_WB)
        __builtin_amdgcn_fence(__ATOMIC_RELEASE, "agent"); asm volatile("s_waitcnt vmcnt(0)" ::: "memory");
#endif
        const unsigned old = xb_add(&bar[XB_XSUB(b.x)], 1u);
        const unsigned gen = old / nloc;
        if (old + 1u == (gen + 1u) * nloc) {
            __builtin_amdgcn_fence(__ATOMIC_RELEASE, "agent");
            asm volatile("s_waitcnt vmcnt(0)" ::: "memory");
            const unsigned og = xb_add(&bar[XB_TOP], 1u);
            const unsigned tg = og / nx;
            if (og + 1u == (tg + 1u) * nx) xb_add(&bar[XB_TOPGEN], 1u);
            else XB_SPIN(xb_ld(&bar[XB_TOPGEN]) == tg, bar);
            __builtin_amdgcn_fence(__ATOMIC_ACQUIRE, "agent");
            xb_add(&bar[XB_XGEN(b.x)], 1u);
            asm volatile("s_waitcnt vmcnt(0)" ::: "memory");
        } else {
            XB_SPIN(xb_ld(&bar[XB_XGEN(b.x)]) == gen, bar);
            __builtin_amdgcn_fence(__ATOMIC_ACQUIRE, "agent");
            asm volatile("s_waitcnt vmcnt(0)" ::: "memory");
        }
    }
    __syncthreads();
}

struct Frame {
    LAS unsigned char* lds;
    int vcu, G, wave;
};
__device__ __forceinline__ int lane_id() { int l; asm volatile("v_mbcnt_lo_u32_b32 %0, -1, 0\n\tv_mbcnt_hi_u32_b32 %0, -1, %0" : "=v"(l)); return l; }
__device__ __forceinline__ int fresh_tid(const Frame& F) { return F.wave * 64 + lane_id(); }
__device__ __forceinline__ float shfl_idx(float v, int src_lane) { return __builtin_bit_cast(float, __builtin_amdgcn_ds_bpermute(src_lane << 2, __builtin_bit_cast(int, v))); }
__device__ __forceinline__ int shfl_idx_i(int v, int src_lane) { return __builtin_amdgcn_ds_bpermute(src_lane << 2, v); }
__device__ __forceinline__ float wave_sum(float v, int lane) {
#pragma unroll
    for (int o = 1; o < 64; o <<= 1) v += shfl_idx(v, lane ^ o);
    return v;
}

__device__ __forceinline__ void cvt_item(const float* W, int ldw, int K, bf16* WT, int drow0, LAS float* scr, int k0, int n0, int lane, const float* ks = nullptr) {
    const float ksv = ks ? ks[k0 + lane] : 1.f;
#pragma unroll 8
    for (int i = 0; i < 32; ++i) { const int kk = 2 * i + (lane >> 5);
        const float s0 = __builtin_bit_cast(float, __builtin_amdgcn_readlane(__builtin_bit_cast(int, ksv), 2 * i)), s1 = __builtin_bit_cast(float, __builtin_amdgcn_readlane(__builtin_bit_cast(int, ksv), 2 * i + 1));
        scr[kk * 33 + (lane & 31)] = W[(size_t)(k0 + kk) * ldw + n0 + (lane & 31)] * ((lane >> 5) ? s1 : s0); }
    LDS_WAIT(); asm volatile("" ::: "memory");
    const int c = lane & 7;
#pragma unroll
    for (int j = 0; j < 4; ++j) { const int n = (lane >> 3) + 8 * j; const LAS float* s = scr + (8 * c) * 33 + n;
        v4u o; o.x = pk2(s[0 * 33], s[1 * 33]); o.y = pk2(s[2 * 33], s[3 * 33]); o.z = pk2(s[4 * 33], s[5 * 33]); o.w = pk2(s[6 * 33], s[7 * 33]);
        *(GAS v4u*)(WT + (size_t)(drow0 + n) * K + k0 + 8 * c) = o; }
    LDS_WAIT(); asm volatile("" ::: "memory");
}
__device__ __forceinline__ void cvt_job(Frame& F, const float* W, int ldw, int K, int N, int nmat, size_t smat, bf16* WT, size_t dmat, int mode, int rot, const float* ks = nullptr) {
    const int tid = fresh_tid(F), lane = tid & 63, wave = __builtin_amdgcn_readfirstlane(tid >> 6);
    LAS float* scr = (LAS float*)(F.lds + RING_OFF + wave * 8448);
    const int NGW = F.G * NWAVES; const int gw = (F.vcu * NWAVES + wave + rot) % NGW;
    const int nblk = N / 32, per = (K / 64) * nblk, total = per * nmat;
    for (int it = gw; it < total; it += NGW) {
        const int mat = it / per, r = it % per, kb = r / nblk, nb = r % nblk, n0 = 32 * nb;
        const int drow0 = mode == 0 ? n0 : ((n0 >> 7) * 256 + (n0 & 127) + (mode == 2 ? 128 : 0));
        cvt_item(W + (size_t)mat * smat, ldw, K, WT + (size_t)mat * dmat, drow0, scr, 64 * kb, n0, lane, ks);
    }
}

constexpr int SLAB_OFF_ = 73728;
constexpr int SLAB_OFF = SLAB_OFF_;
struct RowJob {
    const float* xsrc;
    const bf16* xbsrc; bf16* xbdst;
    const float* nw;
    bf16* XN; float* outf; float* ssq_out;
    const bf16* Y; const int* tok_slot; const float* top_g;
    const float* slab; int slab_ld;
    int kind;
    const float* b0; const float* b1; float* LI; float* LF; int* top_e; float* top_g_out; int* wg_cnt;
};
constexpr int EREC_OFF = SLAB_OFF_ + 32768;

__device__ __forceinline__ void row_phase(Frame& F, const RowJob& J) {
    LAS float* slab = (LAS float*)(F.lds + SLAB_OFF);
    const int tid = fresh_tid(F), lane = tid & 63, wave = __builtin_amdgcn_readfirstlane(tid >> 6);
    if (J.slab) { float sv[16];
#pragma unroll
        for (int q = 0; q < 16; ++q) { const int i = tid + q * NTHR; sv[q] = J.slab[(size_t)(i >> 3) * J.slab_ld + (i & 7)]; }
#pragma unroll
        for (int q = 0; q < 16; ++q) { const int i = tid + q * NTHR, k = i >> 3, e = i & 7, kk = ((k >> 8) * 4 + (k & 3)) * 64 + ((k & 255) >> 2);
            slab[(e >> 2) * 4096 + kk * 4 + (e & 3)] = sv[q]; } }
    __syncthreads();
    LAS int* erec = (LAS int*)(F.lds + EREC_OFF);
    const int rpw = M / (F.G * NWAVES), m0 = (F.vcu * NWAVES + wave) * rpw;
    f32x4 nx[4]; v2u nxb[4], nya[4], nyb[4]; float ng0 = 0.f, ng1 = 0.f;
    {
        if (J.xsrc) { const GAS f32x4* xr = (const GAS f32x4*)(J.xsrc + (size_t)m0 * D) + lane;
#pragma unroll
            for (int j = 0; j < 4; ++j) nx[j] = xr[64 * j]; }
        else { const GAS v2u* xr = (const GAS v2u*)(J.xbsrc + (size_t)m0 * D) + lane;
#pragma unroll
            for (int j = 0; j < 4; ++j) nxb[j] = xr[64 * j]; }
        if (J.Y) { const int s0 = J.tok_slot[m0 * 2], s1 = J.tok_slot[m0 * 2 + 1]; ng0 = J.top_g[m0 * 2]; ng1 = J.top_g[m0 * 2 + 1];
            const GAS v2u* y0 = (const GAS v2u*)(J.Y + (size_t)s0 * D) + lane; const GAS v2u* y1 = (const GAS v2u*)(J.Y + (size_t)s1 * D) + lane;
#pragma unroll
            for (int j = 0; j < 4; ++j) { nya[j] = y0[64 * j]; nyb[j] = y1[64 * j]; } }
    }
    for (int m = m0; m < m0 + rpw; ++m) {
        f32x4 v[4]; v2u ya[4], yb[4]; const float g0 = ng0, g1 = ng1;
#pragma unroll
        for (int j = 0; j < 4; ++j) { ya[j] = nya[j]; yb[j] = nyb[j];
            if (J.xsrc) v[j] = nx[j];
            else { const v2u r = nxb[j]; v[j].x = bf_lo(r.x); v[j].y = bf_hi(r.x); v[j].z = bf_lo(r.y); v[j].w = bf_hi(r.y); } }
        if (m + 1 < m0 + rpw) {
            if (J.xsrc) { const GAS f32x4* xr = (const GAS f32x4*)(J.xsrc + (size_t)(m + 1) * D) + lane;
#pragma unroll
                for (int j = 0; j < 4; ++j) nx[j] = xr[64 * j]; }
            else { const GAS v2u* xr = (const GAS v2u*)(J.xbsrc + (size_t)(m + 1) * D) + lane;
#pragma unroll
                for (int j = 0; j < 4; ++j) nxb[j] = xr[64 * j]; }
            if (J.Y) { const int s0 = J.tok_slot[(m + 1) * 2], s1 = J.tok_slot[(m + 1) * 2 + 1]; ng0 = J.top_g[(m + 1) * 2]; ng1 = J.top_g[(m + 1) * 2 + 1];
                const GAS v2u* y0 = (const GAS v2u*)(J.Y + (size_t)s0 * D) + lane; const GAS v2u* y1 = (const GAS v2u*)(J.Y + (size_t)s1 * D) + lane;
#pragma unroll
                for (int j = 0; j < 4; ++j) { nya[j] = y0[64 * j]; nyb[j] = y1[64 * j]; } }
        }
        if (J.Y) {
#pragma unroll
            for (int j = 0; j < 4; ++j) { const v2u a = ya[j], b = yb[j];
                v[j].x += g0 * bf_lo(a.x) + g1 * bf_lo(b.x); v[j].y += g0 * bf_hi(a.x) + g1 * bf_hi(b.x); v[j].z += g0 * bf_lo(a.y) + g1 * bf_lo(b.y); v[j].w += g0 * bf_hi(a.y) + g1 * bf_hi(b.y); }
        }
        if (J.xbdst) { GAS v2u* xo = (GAS v2u*)(J.xbdst + (size_t)m * D) + lane;
#pragma unroll
            for (int j = 0; j < 4; ++j) { v2u w; w.x = pk2(v[j].x, v[j].y); w.y = pk2(v[j].z, v[j].w); xo[64 * j] = w; } }
        float ss = 0.f;
#pragma unroll
        for (int j = 0; j < 4; ++j) ss += (v[j].x * v[j].x + v[j].y * v[j].y) + (v[j].z * v[j].z + v[j].w * v[j].w);
#pragma unroll
        for (int j = 0; j < 4; ++j) v[j] = v[j] * ((const GAS f32x4*)J.nw)[lane + 64 * j];
        float a1 = 0.f;
        if (J.slab) {
            float acc[8];
#pragma unroll
            for (int e = 0; e < 8; ++e) acc[e] = 0.f;
#pragma unroll
            for (int j = 0; j < 4; ++j)
#pragma unroll
                for (int i = 0; i < 4; ++i) { const int kk = (4 * j + i) * 64 + lane; const float xv = v[j][i];
                    const f32x4 w0 = *(const LAS f32x4*)(slab + kk * 4), w1 = *(const LAS f32x4*)(slab + 4096 + kk * 4);
                    acc[0] += xv * w0.x; acc[1] += xv * w0.y; acc[2] += xv * w0.z; acc[3] += xv * w0.w; acc[4] += xv * w1.x; acc[5] += xv * w1.y; acc[6] += xv * w1.z; acc[7] += xv * w1.w; }
            const bool h5 = (lane & 32) != 0, h4 = (lane & 16) != 0, h3 = (lane & 8) != 0;
            float a4[4], a2[2];
#pragma unroll
            for (int i = 0; i < 4; ++i) { const float send = h5 ? acc[i] : acc[i + 4], keep = h5 ? acc[i + 4] : acc[i]; a4[i] = keep + shfl_idx(send, lane ^ 32); }
#pragma unroll
            for (int i = 0; i < 2; ++i) { const float send = h4 ? a4[i] : a4[i + 2], keep = h4 ? a4[i + 2] : a4[i]; a2[i] = keep + shfl_idx(send, lane ^ 16); }
            { const float send = h3 ? a2[0] : a2[1], keep = h3 ? a2[1] : a2[0]; a1 = keep + shfl_idx(send, lane ^ 8); }
            a1 += shfl_idx(a1, lane ^ 1); a1 += shfl_idx(a1, lane ^ 2); a1 += shfl_idx(a1, lane ^ 4);
        }
        const float sst = wave_sum(ss, lane);
        if (J.ssq_out && lane < 4) ((GAS f32x4*)(J.ssq_out + (size_t)m * 16))[lane] = (f32x4){lane == 0 ? sst : 0.f, 0.f, 0.f, 0.f};
        const float rstd = __builtin_amdgcn_rsqf(sst * (1.f / D) + 1e-6f);
#pragma unroll
        for (int j = 0; j < 4; ++j) v[j] = v[j] * rstd;
        if (J.outf) { GAS f32x4* o = (GAS f32x4*)(J.outf + (size_t)m * D) + lane;
#pragma unroll
            for (int j = 0; j < 4; ++j) o[64 * j] = v[j]; }
        if (J.XN) { GAS v2u* o = (GAS v2u*)(J.XN + (size_t)m * D) + lane;
#pragma unroll
            for (int j = 0; j < 4; ++j) { v2u w; w.x = pk2(v[j].x, v[j].y); w.y = pk2(v[j].z, v[j].w); o[64 * j] = w; } }
        if (J.slab) {
            a1 *= rstd;
            if (J.kind == 1) {
                if ((lane & 7) == 0) { int e = lane >> 3; asm volatile("" : "+v"(e));
                    if (e < 4) J.LI[m * 4 + e] = a1 + J.b0[e];
                    else { const int h = e - 4; const float z = a1 + J.b1[h]; const float ez = __expf(-fabsf(z));
                        const float l1p = ez < 0.06f ? ez * (1.f + ez * (-0.5f + ez * (0.33333333f - 0.25f * ez))) : __logf(1.f + ez);
                        J.LF[m * 4 + h] = fminf(z, 0.f) - l1p; } }
            } else if (J.kind == 2) {
                float acc[8];
#pragma unroll
                for (int e = 0; e < 8; ++e) acc[e] = __builtin_bit_cast(float, __builtin_amdgcn_readlane(__builtin_bit_cast(int, a1), 8 * e)) + J.b0[e];
                int e0 = 0; float l0 = acc[0];
#pragma unroll
                for (int e = 1; e < 8; ++e) if (acc[e] > l0) { l0 = acc[e]; e0 = e; }
                int e1 = 0; float l1 = -INFINITY;
#pragma unroll
                for (int e = 0; e < 8; ++e) if (e != e0 && acc[e] > l1) { l1 = acc[e]; e1 = e; }
                if (lane == 0) {
                    const float ex = __expf(l1 - l0);
                    J.top_e[m * 2] = e0; J.top_e[m * 2 + 1] = e1; J.top_g_out[m * 2] = 1.f / (1.f + ex); J.top_g_out[m * 2 + 1] = ex / (1.f + ex);
                    const int ml = m - F.vcu * NWAVES * rpw; erec[ml * 2] = e0; erec[ml * 2 + 1] = e1;
                }
            }
        }
    }
    if (J.kind == 2) {
        __syncthreads();
        { const int na = 2 * NWAVES * rpw;
          LAS int* wc = erec + 2 * NWAVES * 64;
          const int ev = tid < na ? erec[tid] : -1;
#pragma unroll
          for (int e = 0; e < 8; ++e) { const unsigned long long b = __builtin_amdgcn_ballot_w64(ev == e); if (lane == 0) wc[wave * 8 + e] = __builtin_popcountll(b); }
          __syncthreads();
          if (tid < 8) { int c = 0;
#pragma unroll
              for (int w = 0; w < NWAVES; ++w) c += wc[w * 8 + tid]; J.wg_cnt[F.vcu * 8 + tid] = c; } }
    }
}
__device__ __forceinline__ void router_phase(Frame& F, const RowJob& J) {
    LAS float* slab = (LAS float*)(F.lds + SLAB_OFF);
    const int tid = fresh_tid(F), lane = tid & 63, wave = __builtin_amdgcn_readfirstlane(tid >> 6);
    { float sv[16];
#pragma unroll
      for (int q = 0; q < 16; ++q) { const int i = tid + q * NTHR; sv[q] = J.slab[(size_t)(i >> 3) * J.slab_ld + (i & 7)]; }
#pragma unroll
      for (int q = 0; q < 16; ++q) { const int i = tid + q * NTHR, k = i >> 3, e = i & 7, kk = ((k >> 8) * 4 + (k & 3)) * 64 + ((k & 255) >> 2);
          slab[(e >> 2) * 4096 + kk * 4 + (e & 3)] = sv[q]; } }
    __syncthreads();
    LAS int* erec = (LAS int*)(F.lds + EREC_OFF);
    const int rpw = M / (F.G * NWAVES), m0 = (F.vcu * NWAVES + wave) * rpw;
    v2u nxa[4], nxb[4];
    { const GAS v2u* xr = (const GAS v2u*)(J.xbsrc + (size_t)m0 * D) + lane;
#pragma unroll
      for (int j = 0; j < 4; ++j) { nxa[j] = xr[64 * j]; nxb[j] = xr[64 * j + D / 4]; } }
    for (int m = m0; m < m0 + rpw; m += 2) {
        f32x4 va[4], vb[4];
#pragma unroll
        for (int j = 0; j < 4; ++j) { const v2u ra = nxa[j], rb = nxb[j];
            va[j].x = bf_lo(ra.x); va[j].y = bf_hi(ra.x); va[j].z = bf_lo(ra.y); va[j].w = bf_hi(ra.y); vb[j].x = bf_lo(rb.x); vb[j].y = bf_hi(rb.x); vb[j].z = bf_lo(rb.y); vb[j].w = bf_hi(rb.y); }
        if (m + 2 < m0 + rpw) { const GAS v2u* xr = (const GAS v2u*)(J.xbsrc + (size_t)(m + 2) * D) + lane;
#pragma unroll
            for (int j = 0; j < 4; ++j) { nxa[j] = xr[64 * j]; nxb[j] = xr[64 * j + D / 4]; } }
        float ssa = 0.f, ssb = 0.f;
#pragma unroll
        for (int j = 0; j < 4; ++j) { ssa += (va[j].x * va[j].x + va[j].y * va[j].y) + (va[j].z * va[j].z + va[j].w * va[j].w); ssb += (vb[j].x * vb[j].x + vb[j].y * vb[j].y) + (vb[j].z * vb[j].z + vb[j].w * vb[j].w); }
#pragma unroll
        for (int j = 0; j < 4; ++j) { const f32x4 w = ((const GAS f32x4*)J.nw)[lane + 64 * j]; va[j] = va[j] * w; vb[j] = vb[j] * w; }
        float aa[8], ab[8];
#pragma unroll
        for (int e = 0; e < 8; ++e) { aa[e] = 0.f; ab[e] = 0.f; }
#pragma unroll
        for (int j = 0; j < 4; ++j)
#pragma unroll
            for (int i = 0; i < 4; ++i) { const int kk = (4 * j + i) * 64 + lane; const float xa = va[j][i], xb = vb[j][i];
                const f32x4 w0 = *(const LAS f32x4*)(slab + kk * 4), w1 = *(const LAS f32x4*)(slab + 4096 + kk * 4);
                aa[0] += xa * w0.x; aa[1] += xa * w0.y; aa[2] += xa * w0.z; aa[3] += xa * w0.w; aa[4] += xa * w1.x; aa[5] += xa * w1.y; aa[6] += xa * w1.z; aa[7] += xa * w1.w;
                ab[0] += xb * w0.x; ab[1] += xb * w0.y; ab[2] += xb * w0.z; ab[3] += xb * w0.w; ab[4] += xb * w1.x; ab[5] += xb * w1.y; ab[6] += xb * w1.z; ab[7] += xb * w1.w; }
        const bool h5 = (lane & 32) != 0, h4 = (lane & 16) != 0, h3 = (lane & 8) != 0;
        float a4[4], b4[4], a2[2], b2[2], a1, b1;
#pragma unroll
        for (int i = 0; i < 4; ++i) { const float sa = h5 ? aa[i] : aa[i + 4], ka = h5 ? aa[i + 4] : aa[i], sb = h5 ? ab[i] : ab[i + 4], kb = h5 ? ab[i + 4] : ab[i];
            const float ta = shfl_idx(sa, lane ^ 32), tb = shfl_idx(sb, lane ^ 32); a4[i] = ka + ta; b4[i] = kb + tb; }
#pragma unroll
        for (int i = 0; i < 2; ++i) { const float sa = h4 ? a4[i] : a4[i + 2], ka = h4 ? a4[i + 2] : a4[i], sb = h4 ? b4[i] : b4[i + 2], kb = h4 ? b4[i + 2] : b4[i];
            const float ta = shfl_idx(sa, lane ^ 16), tb = shfl_idx(sb, lane ^ 16); a2[i] = ka + ta; b2[i] = kb + tb; }
        { const float sa = h3 ? a2[0] : a2[1], ka = h3 ? a2[1] : a2[0], sb = h3 ? b2[0] : b2[1], kb = h3 ? b2[1] : b2[0];
          const float ta = shfl_idx(sa, lane ^ 8), tb = shfl_idx(sb, lane ^ 8); a1 = ka + ta; b1 = kb + tb; }
#pragma unroll
        for (int o = 1; o < 8; o <<= 1) { const float ta = shfl_idx(a1, lane ^ o), tb = shfl_idx(b1, lane ^ o); a1 += ta; b1 += tb; }
#pragma unroll
        for (int o = 1; o < 64; o <<= 1) { const float ta = shfl_idx(ssa, lane ^ o), tb = shfl_idx(ssb, lane ^ o); ssa += ta; ssb += tb; }
        const float rsa = __builtin_amdgcn_rsqf(ssa * (1.f / D) + 1e-6f), rsb = __builtin_amdgcn_rsqf(ssb * (1.f / D) + 1e-6f);
        { GAS v2u* oa = (GAS v2u*)(J.XN + (size_t)m * D) + lane;
#pragma unroll
          for (int j = 0; j < 4; ++j) { const f32x4 pa = va[j] * rsa, pb = vb[j] * rsb; v2u wa, wb; wa.x = pk2(pa.x, pa.y); wa.y = pk2(pa.z, pa.w); wb.x = pk2(pb.x, pb.y); wb.y = pk2(pb.z, pb.w);
              oa[64 * j] = wa; oa[64 * j + D / 4] = wb; } }
#pragma unroll
        for (int rr = 0; rr < 2; ++rr) { const int mr = m + rr; const float av = rr ? b1 * rsb : a1 * rsa;
            float acc[8];
#pragma unroll
            for (int e = 0; e < 8; ++e) acc[e] = __builtin_bit_cast(float, __builtin_amdgcn_readlane(__builtin_bit_cast(int, av), 8 * e)) + J.b0[e];
            int e0 = 0; float l0 = acc[0];
#pragma unroll
            for (int e = 1; e < 8; ++e) if (acc[e] > l0) { l0 = acc[e]; e0 = e; }
            int e1 = 0; float l1 = -INFINITY;
#pragma unroll
            for (int e = 0; e < 8; ++e) if (e != e0 && acc[e] > l1) { l1 = acc[e]; e1 = e; }
            if (lane == 0) {
                const float ex = __expf(l1 - l0);
                J.top_e[mr * 2] = e0; J.top_e[mr * 2 + 1] = e1; J.top_g_out[mr * 2] = 1.f / (1.f + ex); J.top_g_out[mr * 2 + 1] = ex / (1.f + ex);
                const int ml = mr - F.vcu * NWAVES * rpw; erec[ml * 2] = e0; erec[ml * 2 + 1] = e1;
            } }
    }
    __syncthreads();
    { const int na = 2 * NWAVES * rpw;
      LAS int* wc = erec + 2 * NWAVES * 64;
      const int ev = tid < na ? erec[tid] : -1;
#pragma unroll
      for (int e = 0; e < 8; ++e) { const unsigned long long b = __builtin_amdgcn_ballot_w64(ev == e); if (lane == 0) wc[wave * 8 + e] = __builtin_popcountll(b); }
      __syncthreads();
      if (tid < 8) { int c = 0;
#pragma unroll
          for (int w = 0; w < NWAVES; ++w) c += wc[w * 8 + tid]; J.wg_cnt[F.vcu * 8 + tid] = c; } }
}
template <bool COMB>
__device__ __forceinline__ void gate_phase(Frame& F, const RowJob& J) {
    LAS float* slab = (LAS float*)(F.lds + SLAB_OFF);
    const int tid = fresh_tid(F), lane = tid & 63, wave = __builtin_amdgcn_readfirstlane(tid >> 6);
    { float sv[16];
#pragma unroll
      for (int q = 0; q < 16; ++q) { const int i = tid + q * NTHR; sv[q] = J.slab[(size_t)(i >> 3) * J.slab_ld + (i & 7)]; }
#pragma unroll
      for (int q = 0; q < 16; ++q) { const int i = tid + q * NTHR, k = i >> 3, e = i & 7, kk = ((k >> 8) * 4 + (k & 3)) * 64 + ((k & 255) >> 2);
          slab[(e >> 2) * 4096 + kk * 4 + (e & 3)] = sv[q]; } }
    __syncthreads();
    const int rpw = M / (F.G * NWAVES), m0 = (F.vcu * NWAVES + wave) * rpw;
    f32x4 nfa[4], nfb[4]; v2u nba[4], nbb[4], ya0[4], ya1[4], yb0[4], yb1[4]; float gA0 = 0.f, gA1 = 0.f, gB0 = 0.f, gB1 = 0.f;
#define GP_REQ(mm) do { \
        if (!COMB) { const GAS f32x4* xr = (const GAS f32x4*)(J.xsrc + (size_t)(mm) * D) + lane; \
            _Pragma("unroll") for (int j = 0; j < 4; ++j) { nfa[j] = xr[64 * j]; nfb[j] = xr[64 * j + D / 4]; } } \
        else { const GAS v2u* xr = (const GAS v2u*)(J.xbsrc + (size_t)(mm) * D) + lane; \
            _Pragma("unroll") for (int j = 0; j < 4; ++j) { nba[j] = xr[64 * j]; nbb[j] = xr[64 * j + D / 4]; } \
            const int sa0 = J.tok_slot[(mm) * 2], sa1 = J.tok_slot[(mm) * 2 + 1], sb0 = J.tok_slot[(mm) * 2 + 2], sb1 = J.tok_slot[(mm) * 2 + 3]; \
            gA0 = J.top_g[(mm) * 2]; gA1 = J.top_g[(mm) * 2 + 1]; gB0 = J.top_g[(mm) * 2 + 2]; gB1 = J.top_g[(mm) * 2 + 3]; \
            const GAS v2u* p0 = (const GAS v2u*)(J.Y + (size_t)sa0 * D) + lane; const GAS v2u* p1 = (const GAS v2u*)(J.Y + (size_t)sa1 * D) + lane; \
            const GAS v2u* p2 = (const GAS v2u*)(J.Y + (size_t)sb0 * D) + lane; const GAS v2u* p3 = (const GAS v2u*)(J.Y + (size_t)sb1 * D) + lane; \
            _Pragma("unroll") for (int j = 0; j < 4; ++j) { ya0[j] = p0[64 * j]; ya1[j] = p1[64 * j]; yb0[j] = p2[64 * j]; yb1[j] = p3[64 * j]; } } } while (0)
    GP_REQ(m0);
    for (int m = m0; m < m0 + rpw; m += 2) {
        f32x4 va[4], vb[4];
        if (!COMB) {
#pragma unroll
            for (int j = 0; j < 4; ++j) { va[j] = nfa[j]; vb[j] = nfb[j]; }
        } else {
#pragma unroll
            for (int j = 0; j < 4; ++j) { const v2u ra = nba[j], rb = nbb[j], a0 = ya0[j], a1 = ya1[j], b0 = yb0[j], b1 = yb1[j];
                va[j].x = bf_lo(ra.x) + gA0 * bf_lo(a0.x) + gA1 * bf_lo(a1.x); va[j].y = bf_hi(ra.x) + gA0 * bf_hi(a0.x) + gA1 * bf_hi(a1.x);
                va[j].z = bf_lo(ra.y) + gA0 * bf_lo(a0.y) + gA1 * bf_lo(a1.y); va[j].w = bf_hi(ra.y) + gA0 * bf_hi(a0.y) + gA1 * bf_hi(a1.y);
                vb[j].x = bf_lo(rb.x) + gB0 * bf_lo(b0.x) + gB1 * bf_lo(b1.x); vb[j].y = bf_hi(rb.x) + gB0 * bf_hi(b0.x) + gB1 * bf_hi(b1.x);
                vb[j].z = bf_lo(rb.y) + gB0 * bf_lo(b0.y) + gB1 * bf_lo(b1.y); vb[j].w = bf_hi(rb.y) + gB0 * bf_hi(b0.y) + gB1 * bf_hi(b1.y); }
        }
        if (m + 2 < m0 + rpw) GP_REQ(m + 2);
        { GAS v2u* xo = (GAS v2u*)(J.xbdst + (size_t)m * D) + lane;
#pragma unroll
          for (int j = 0; j < 4; ++j) { v2u wa, wb; wa.x = pk2(va[j].x, va[j].y); wa.y = pk2(va[j].z, va[j].w); wb.x = pk2(vb[j].x, vb[j].y); wb.y = pk2(vb[j].z, vb[j].w); xo[64 * j] = wa; xo[64 * j + D / 4] = wb; } }
        float ssa = 0.f, ssb = 0.f;
#pragma unroll
        for (int j = 0; j < 4; ++j) { ssa += (va[j].x * va[j].x + va[j].y * va[j].y) + (va[j].z * va[j].z + va[j].w * va[j].w); ssb += (vb[j].x * vb[j].x + vb[j].y * vb[j].y) + (vb[j].z * vb[j].z + vb[j].w * vb[j].w); }
#pragma unroll
        for (int j = 0; j < 4; ++j) { const f32x4 w = ((const GAS f32x4*)J.nw)[lane + 64 * j]; va[j] = va[j] * w; vb[j] = vb[j] * w; }
        float aa[8], ab[8];
#pragma unroll
        for (int e = 0; e < 8; ++e) { aa[e] = 0.f; ab[e] = 0.f; }
#pragma unroll
        for (int j = 0; j < 4; ++j)
#pragma unroll
            for (int i = 0; i < 4; ++i) { const int kk = (4 * j + i) * 64 + lane; const float xa = va[j][i], xb = vb[j][i];
                const f32x4 w0 = *(const LAS f32x4*)(slab + kk * 4), w1 = *(const LAS f32x4*)(slab + 4096 + kk * 4);
                aa[0] += xa * w0.x; aa[1] += xa * w0.y; aa[2] += xa * w0.z; aa[3] += xa * w0.w; aa[4] += xa * w1.x; aa[5] += xa * w1.y; aa[6] += xa * w1.z; aa[7] += xa * w1.w;
                ab[0] += xb * w0.x; ab[1] += xb * w0.y; ab[2] += xb * w0.z; ab[3] += xb * w0.w; ab[4] += xb * w1.x; ab[5] += xb * w1.y; ab[6] += xb * w1.z; ab[7] += xb * w1.w;
                if (i == 3) __builtin_amdgcn_sched_barrier(0); }
        const bool h5 = (lane & 32) != 0, h4 = (lane & 16) != 0, h3 = (lane & 8) != 0;
        float a4[4], b4[4], a2[2], b2[2], a1, b1;
#pragma unroll
        for (int i = 0; i < 4; ++i) { const float sa = h5 ? aa[i] : aa[i + 4], ka = h5 ? aa[i + 4] : aa[i], sb = h5 ? ab[i] : ab[i + 4], kb = h5 ? ab[i + 4] : ab[i];
            const float ta = shfl_idx(sa, lane ^ 32), tb = shfl_idx(sb, lane ^ 32); a4[i] = ka + ta; b4[i] = kb + tb; }
#pragma unroll
        for (int i = 0; i < 2; ++i) { const float sa = h4 ? a4[i] : a4[i + 2], ka = h4 ? a4[i + 2] : a4[i], sb = h4 ? b4[i] : b4[i + 2], kb = h4 ? b4[i + 2] : b4[i];
            const float ta = shfl_idx(sa, lane ^ 16), tb = shfl_idx(sb, lane ^ 16); a2[i] = ka + ta; b2[i] = kb + tb; }
        { const float sa = h3 ? a2[0] : a2[1], ka = h3 ? a2[1] : a2[0], sb = h3 ? b2[0] : b2[1], kb = h3 ? b2[1] : b2[0];
          const float ta = shfl_idx(sa, lane ^ 8), tb = shfl_idx(sb, lane ^ 8); a1 = ka + ta; b1 = kb + tb; }
#pragma unroll
        for (int o = 1; o < 8; o <<= 1) { const float ta = shfl_idx(a1, lane ^ o), tb = shfl_idx(b1, lane ^ o); a1 += ta; b1 += tb; }
#pragma unroll
        for (int o = 1; o < 64; o <<= 1) { const float ta = shfl_idx(ssa, lane ^ o), tb = shfl_idx(ssb, lane ^ o); ssa += ta; ssb += tb; }
        const float rsa = __builtin_amdgcn_rsqf(ssa * (1.f / D) + 1e-6f), rsb = __builtin_amdgcn_rsqf(ssb * (1.f / D) + 1e-6f);
        if (lane < 4) { ((GAS f32x4*)(J.ssq_out + (size_t)m * 16))[lane] = (f32x4){lane == 0 ? ssa : 0.f, 0.f, 0.f, 0.f}; ((GAS f32x4*)(J.ssq_out + (size_t)(m + 1) * 16))[lane] = (f32x4){lane == 0 ? ssb : 0.f, 0.f, 0.f, 0.f}; }
        if ((lane & 7) == 0) { int e = lane >> 3; asm volatile("" : "+v"(e));
#pragma unroll
            for (int rr = 0; rr < 2; ++rr) { const int mr = m + rr; const float av = rr ? b1 * rsb : a1 * rsa;
                if (e < 4) J.LI[mr * 4 + e] = av + J.b0[e];
                else { const int h = e - 4; const float z = av + J.b1[h]; const float ez = __expf(-fabsf(z));
                    const float l1p = ez < 0.06f ? ez * (1.f + ez * (-0.5f + ez * (0.33333333f - 0.25f * ez))) : __logf(1.f + ez);
                    J.LF[mr * 4 + h] = fminf(z, 0.f) - l1p; } } }
    }
#undef GP_REQ
}
}
namespace att {
using bf16x8 = __attribute__((ext_vector_type(8))) short;
using s16x4 = __attribute__((ext_vector_type(4))) short;
using f32x16 = __attribute__((ext_vector_type(16))) float;
using u32x4 = __attribute__((ext_vector_type(4))) unsigned;
typedef __attribute__((address_space(3))) const char* lds_cptr;
typedef __attribute__((address_space(3))) char* lds_ptr;
typedef short v4i16_t __attribute__((ext_vector_type(4)));
constexpr int SEQ = 4096, PITCH = 3072, QB = 256, KVBLK = 64, NQB = SEQ / QB;
constexpr int NSLOT = 3, KSLOT = 8192, VSLOT = 16384;
constexpr int LDS_K = 0, LDS_V = NSLOT * KSLOT, LDS_WS = LDS_V + NSLOT * VSLOT, LDS_BT = LDS_WS + 8 * 256, LDS_PARK = LDS_BT + 1024, LDS_END = LDS_PARK + 8 * 4096;
constexpr float LOG2E = 1.4426950408889634f;
#ifndef ATT_THR
#define ATT_THR 8.0f
#endif
#define ATT_MFMA(a, b, c) __builtin_amdgcn_mfma_f32_32x32x16_bf16(a, b, c, 0, 0, 0)
__device__ __forceinline__ int crow(int r, int hi) { return (r & 3) + 8 * (r >> 2) + 4 * hi; }
__device__ __forceinline__ void glds16(const void* gsrc, unsigned lds_dst) { unsigned keep;
    asm volatile("s_mov_b32 %0, m0\n\ts_mov_b32 m0, %2\n\ts_nop 0\n\tglobal_load_lds_dwordx4 %1, off\n\ts_mov_b32 m0, %0" : "=&s"(keep) : "v"(gsrc), "s"(lds_dst) : "memory"); }
typedef float f32x2_t __attribute__((ext_vector_type(2))); typedef __bf16 bf16x2_t __attribute__((ext_vector_type(2)));
__device__ __forceinline__ unsigned cvtpk(float lo, float hi) { f32x2_t v = {lo, hi}; bf16x2_t b = __builtin_convertvector(v, bf16x2_t); return __builtin_bit_cast(unsigned, b); }
__device__ __forceinline__ s16x4 vtr(lds_cptr p) { return __builtin_bit_cast(s16x4, __builtin_amdgcn_ds_read_tr16_b64_v4i16((__attribute__((address_space(3))) v4i16_t*)p)); }
#define ATT_MX3(a, b, c) __builtin_fmaxf(__builtin_fmaxf((a), (b)), (c))
__device__ __forceinline__ float rowmax(const f32x16& p0, const f32x16& p1) {
    float a = ATT_MX3(p0[0], p0[1], p1[0]), b = ATT_MX3(p0[2], p0[3], p1[1]); a = ATT_MX3(a, p1[2], p1[3]);
#pragma unroll
    for (int r = 4; r < 16; r += 4) { a = ATT_MX3(a, p0[r], p0[r + 1]); b = ATT_MX3(b, p0[r + 2], p0[r + 3]); a = ATT_MX3(a, p1[r], p1[r + 1]); b = ATT_MX3(b, p1[r + 2], p1[r + 3]); }
    const float m = __builtin_fmaxf(a, b); auto rr = __builtin_amdgcn_permlane32_swap(__float_as_uint(m), __float_as_uint(m), false, false);
    return __builtin_fmaxf(__uint_as_float(rr[0]), __uint_as_float(rr[1])); }
#define ATT_WAIT_BAR(N) asm volatile("s_waitcnt vmcnt(" #N ") lgkmcnt(0)\n\ts_barrier" ::: "memory")

struct Params {
    const unsigned short* QKV; unsigned short* O; float* OT;
    const float* rel; const float* subln; float lam, lam_init;
};

template <int PASS>
__device__ __forceinline__ void attn_pass(int b, int h, int qb, const Params& P, lds_ptr shm, int wid, int lane_in, unsigned (&o1p)[4][8], bool bt_ready = false) {
    int lane; asm volatile("v_mbcnt_lo_u32_b32 %0, -1, 0\n\tv_mbcnt_hi_u32_b32 %0, -1, %0" : "=v"(lane));
    (void)lane_in;
    const int r32 = lane & 31, hi = lane >> 5, m = 2 * h + PASS;
    const long rowbase = (long)b * SEQ; const int q0 = qb * QB, NT = (q0 + QB) / KVBLK;
    const unsigned short* Qw = P.QKV + (rowbase + q0 + wid * 32) * PITCH + m * 64;
    const unsigned short* Kh = P.QKV + rowbase * PITCH + 1024 + m * 64; const unsigned short* Vh = P.QKV + rowbase * PITCH + 2048 + h * 128;
    const unsigned lds0 = (unsigned)(uintptr_t)shm;
    __attribute__((address_space(3))) float* wsf = (__attribute__((address_space(3))) float*)(shm + LDS_WS) + wid * 64;
    __attribute__((address_space(3))) float* BT = (__attribute__((address_space(3))) float*)(shm + LDS_BT) + PASS * 128;
    if (!bt_ready && wid < 2) { const int rel = wid * 64 + lane; BT[rel] = P.rel[nv::BUCKET[rel] * 16 + m] * LOG2E; }
    const float c31 = bt_ready ? BT[127] : P.rel[31 * 16 + m] * LOG2E;
    const unsigned short* ksrc = Kh + (long)lane * PITCH + wid * 8;
    const unsigned short* vsrc = Vh + (long)(16 * (wid & 3) + (lane >> 2)) * PITCH + (wid >> 2) * 32 + (lane & 3) * 8;
    const unsigned kdst = lds0 + LDS_K + wid * 1024, vdst = lds0 + LDS_V + wid * 1024;
#define ATT_DMA(t, s) do { glds16(ksrc + (long)(t) * KVBLK * PITCH, (unsigned)__builtin_amdgcn_readfirstlane(kdst + (s) * KSLOT)); \
        glds16(vsrc + (long)(t) * KVBLK * PITCH, (unsigned)__builtin_amdgcn_readfirstlane(vdst + (s) * VSLOT)); \
        glds16(vsrc + (long)(t) * KVBLK * PITCH + 64, (unsigned)__builtin_amdgcn_readfirstlane(vdst + (s) * VSLOT + 8192)); } while (0)
    ATT_DMA(0, 0); ATT_DMA(1, 1);
    bf16x8 qr[4];
#pragma unroll
    for (int d0 = 0; d0 < 4; ++d0) qr[d0] = *reinterpret_cast<const bf16x8*>(&Qw[(long)r32 * PITCH + d0 * 16 + hi * 8]);
    float c31p = c31;
    asm volatile("" : "+v"(qr[0]), "+v"(qr[1]), "+v"(qr[2]), "+v"(qr[3]), "+v"(c31p));
    float mhat = 0.f, l_reg = 0.f; f32x16 o[4];
#pragma unroll
    for (int d = 0; d < 4; ++d) o[d] = f32x16{};
    const int qabs = q0 + wid * 32 + r32;
    const lds_cptr kp0 = (lds_cptr)shm + LDS_K + hi * 1024 + r32 * 16;
    const lds_cptr vp0 = (lds_cptr)shm + LDS_V + ((lane >> 4) & 1) * 32 + (lane & 3) * 8 + (4 * hi + ((lane & 15) >> 2)) * 64;
    int slot = 0;
#pragma unroll 1
    for (int t = 0; t < NT; ++t) {
        if (t + 1 < NT) { ATT_WAIT_BAR(3); } else { ATT_WAIT_BAR(0); }
        const lds_cptr kp = kp0 + slot * KSLOT; const lds_cptr vp = vp0 + slot * VSLOT;
        f32x16 p0, p1;
        bf16x8 kf[8];
#pragma unroll
        for (int d0 = 0; d0 < 4; ++d0) { kf[2 * d0] = *(const __attribute__((address_space(3))) bf16x8*)(kp + d0 * 2048); kf[2 * d0 + 1] = *(const __attribute__((address_space(3))) bf16x8*)(kp + d0 * 2048 + 512); }
        if (t + 6 < NT) {
            p0 = ATT_MFMA(kf[0], qr[0], (f32x16{})); p1 = ATT_MFMA(kf[1], qr[0], (f32x16{}));
        } else {
            const int kb = t * KVBLK + 4 * hi;
#pragma unroll
            for (int r = 0; r < 16; ++r) { const int k0 = kb + (r & 3) + 8 * (r >> 2); int rel0 = qabs - k0, rel1 = rel0 - 32;
                const float b0 = BT[rel0 < 0 ? 0 : (rel0 > 127 ? 127 : rel0)], b1 = BT[rel1 < 0 ? 0 : (rel1 > 127 ? 127 : rel1)];
                p0[r] = rel0 < 0 ? -INFINITY : b0; p1[r] = rel1 < 0 ? -INFINITY : b1; }
            p0 = ATT_MFMA(kf[0], qr[0], p0); p1 = ATT_MFMA(kf[1], qr[0], p1);
        }
#pragma unroll
        for (int d0 = 1; d0 < 4; ++d0) { p0 = ATT_MFMA(kf[2 * d0], qr[d0], p0); p1 = ATT_MFMA(kf[2 * d0 + 1], qr[d0], p1); }
        if (t + 2 < NT) { const int s2 = slot == 0 ? 2 : slot - 1; ATT_DMA(t + 2, s2); }
        s16x4 loA[4], hhA[4], loB[4], hhB[4];
#pragma unroll
        for (int ks = 0; ks < 4; ++ks) { loA[ks] = vtr(vp + ks * 1024); hhA[ks] = vtr(vp + ks * 1024 + 512); }
        __builtin_amdgcn_sched_barrier(0);
        const float base = (t + 6 < NT) ? c31p : 0.f;
        const float rm = rowmax(p0, p1) + base - mhat;
        bool resc = false;
        if (t == 0 || __any(rm > ATT_THR)) {
            const float dl = t == 0 ? rm : __builtin_fmaxf(rm, 0.f);
            mhat += dl;
            const float f = __builtin_amdgcn_exp2f(-dl); l_reg *= f; if (hi == 0) wsf[r32] = f; resc = (t != 0);
        }
        const float ref = base - mhat;
        float sacc = 0.f;
#pragma unroll
        for (int r = 0; r < 16; ++r) { p0[r] = __builtin_amdgcn_exp2f(p0[r] + ref); p1[r] = __builtin_amdgcn_exp2f(p1[r] + ref); sacc += p0[r] + p1[r]; }
        l_reg += sacc;
        u32x4 pw0 = (u32x4){cvtpk(p0[0], p0[1]), cvtpk(p0[2], p0[3]), cvtpk(p0[4], p0[5]), cvtpk(p0[6], p0[7])};
        u32x4 pw1 = (u32x4){cvtpk(p0[8], p0[9]), cvtpk(p0[10], p0[11]), cvtpk(p0[12], p0[13]), cvtpk(p0[14], p0[15])};
        u32x4 pw2 = (u32x4){cvtpk(p1[0], p1[1]), cvtpk(p1[2], p1[3]), cvtpk(p1[4], p1[5]), cvtpk(p1[6], p1[7])};
        u32x4 pw3 = (u32x4){cvtpk(p1[8], p1[9]), cvtpk(p1[10], p1[11]), cvtpk(p1[12], p1[13]), cvtpk(p1[14], p1[15])};
        __builtin_amdgcn_sched_barrier(0);
        if (resc) {
#pragma unroll
            for (int r = 0; r < 16; ++r) { const float f = wsf[crow(r, hi)];
#pragma unroll
                for (int d = 0; d < 4; ++d) o[d][r] *= f; }
        }
#define ATT_PKX(L, H, k) (bf16x8){L[k][0], L[k][1], L[k][2], L[k][3], H[k][0], H[k][1], H[k][2], H[k][3]}
#define ATT_RD(L, H, d) do { _Pragma("unroll") for (int ks = 0; ks < 4; ++ks) { L[ks] = vtr(vp + (d) * 4096 + ks * 1024); H[ks] = vtr(vp + (d) * 4096 + ks * 1024 + 512); } } while (0)
#define ATT_MM(L, H, d) do { o[d] = ATT_MFMA(__builtin_bit_cast(bf16x8, pw0), ATT_PKX(L, H, 0), o[d]); o[d] = ATT_MFMA(__builtin_bit_cast(bf16x8, pw1), ATT_PKX(L, H, 1), o[d]); \
        o[d] = ATT_MFMA(__builtin_bit_cast(bf16x8, pw2), ATT_PKX(L, H, 2), o[d]); o[d] = ATT_MFMA(__builtin_bit_cast(bf16x8, pw3), ATT_PKX(L, H, 3), o[d]); } while (0)
        ATT_RD(loB, hhB, 1); __builtin_amdgcn_sched_barrier(0); ATT_MM(loA, hhA, 0); __builtin_amdgcn_sched_barrier(0);
        ATT_RD(loA, hhA, 2); __builtin_amdgcn_sched_barrier(0); ATT_MM(loB, hhB, 1); __builtin_amdgcn_sched_barrier(0);
        ATT_RD(loB, hhB, 3); __builtin_amdgcn_sched_barrier(0); ATT_MM(loA, hhA, 2); __builtin_amdgcn_sched_barrier(0);
        ATT_MM(loB, hhB, 3); __builtin_amdgcn_sched_barrier(0);
#undef ATT_PKX
#undef ATT_RD
#undef ATT_MM
        slot = slot == 2 ? 0 : slot + 1;
    }
#undef ATT_DMA
    { auto rr = __builtin_amdgcn_permlane32_swap(__float_as_uint(l_reg), __float_as_uint(l_reg), false, false); l_reg = __uint_as_float(rr[0]) + __uint_as_float(rr[1]); }
    if (hi == 0) wsf[32 + r32] = l_reg;
    asm volatile("s_waitcnt lgkmcnt(0)" ::: "memory");
    if (PASS == 0) {
#pragma unroll
        for (int r = 0; r < 16; r += 2) { const float i0 = __builtin_amdgcn_rcpf(wsf[32 + crow(r, hi)]), i1 = __builtin_amdgcn_rcpf(wsf[32 + crow(r + 1, hi)]);
#pragma unroll
            for (int d = 0; d < 4; ++d) o1p[d][r >> 1] = cvtpk(o[d][r] * i0, o[d][r + 1] * i1); }
        { __attribute__((address_space(3))) u32x4* pk_ = (__attribute__((address_space(3))) u32x4*)(shm + LDS_PARK + wid * 4096) + lane;
#pragma unroll
          for (int q = 0; q < 4; ++q) pk_[64 * q] = (u32x4){o1p[2 + (q >> 1)][4 * (q & 1)], o1p[2 + (q >> 1)][4 * (q & 1) + 1], o1p[2 + (q >> 1)][4 * (q & 1) + 2], o1p[2 + (q >> 1)][4 * (q & 1) + 3]}; }
        asm volatile("s_waitcnt vmcnt(0) lgkmcnt(0)\n\ts_barrier" ::: "memory");
    } else {
        float sw[4];
#pragma unroll
        for (int d = 0; d < 4; ++d) sw[d] = P.subln[d * 32 + r32] * (1.f - P.lam_init);
        asm volatile("s_waitcnt vmcnt(0) lgkmcnt(0)\n\ts_barrier" ::: "memory");
        { const __attribute__((address_space(3))) u32x4* pk_ = (const __attribute__((address_space(3))) u32x4*)(shm + LDS_PARK + wid * 4096) + lane;
#pragma unroll
          for (int q = 0; q < 4; ++q) { const u32x4 t_ = pk_[64 * q]; o1p[2 + (q >> 1)][4 * (q & 1)] = t_[0]; o1p[2 + (q >> 1)][4 * (q & 1) + 1] = t_[1]; o1p[2 + (q >> 1)][4 * (q & 1) + 2] = t_[2]; o1p[2 + (q >> 1)][4 * (q & 1) + 3] = t_[3]; } }
        __attribute__((address_space(3))) unsigned short* stg = (__attribute__((address_space(3))) unsigned short*)(shm) + wid * 4096;
#pragma unroll
        for (int r0 = 0; r0 < 16; r0 += 4) {
            float ss[4];
#pragma unroll
            for (int q = 0; q < 4; ++q) { const int r = r0 + q; const float il = __builtin_amdgcn_rcpf(wsf[32 + crow(r, hi)]); float sq = 0.f;
#pragma unroll
                for (int d = 0; d < 4; ++d) { const unsigned w_ = o1p[d][r >> 1]; const float o1v = __builtin_bit_cast(float, (r & 1) ? (w_ & 0xffff0000u) : (w_ << 16));
                    const float a = o1v - P.lam * (o[d][r] * il); o[d][r] = a; sq += a * a; }
                ss[q] = sq; }
#pragma unroll
            for (int x = 1; x < 32; x <<= 1)
#pragma unroll
                for (int q = 0; q < 4; ++q) ss[q] += __builtin_bit_cast(float, __builtin_amdgcn_ds_bpermute((lane ^ x) << 2, __builtin_bit_cast(int, ss[q])));
#pragma unroll
            for (int q = 0; q < 4; ++q) { const int r = r0 + q; const float rs = __builtin_amdgcn_rsqf(ss[q] * (1.f / 128.f) + 1e-5f); const int orow = crow(r, hi);
#pragma unroll
                for (int d = 0; d < 4; ++d) { const float v = o[d][r] * rs * sw[d]; stg[orow * 128 + d * 32 + r32] = (unsigned short)(cvtpk(v, v) & 0xffffu); } }
            __builtin_amdgcn_sched_barrier(0);
        }
        asm volatile("s_waitcnt lgkmcnt(0)" ::: "memory");
        unsigned short* Ow = P.O + (rowbase + q0 + wid * 32) * 1024 + h * 128;
#pragma unroll
        for (int i = 0; i < 8; ++i) { const int row = i * 4 + (lane >> 4), ch = lane & 15; const u32x4 v = *(const __attribute__((address_space(3))) u32x4*)(stg + row * 128 + ch * 8); *(u32x4*)(Ow + (long)row * 1024 + ch * 8) = v; }
        asm volatile("s_waitcnt vmcnt(0) lgkmcnt(0)\n\ts_barrier" ::: "memory");
    }
}
__device__ __forceinline__ void attn_phase(const Params& P, lds_ptr shm, int vcu, int G, int wid, int lane) {
    if (G == 256) {
        const int bh = vcu >> 2, s = vcu & 3;
        { __attribute__((address_space(3))) float* BT = (__attribute__((address_space(3))) float*)(shm + LDS_BT); const int hh = bh & 7;
          int ln; asm volatile("v_mbcnt_lo_u32_b32 %0, -1, 0\n\tv_mbcnt_hi_u32_b32 %0, -1, %0" : "=v"(ln));
          if (wid < 4) { const int pass = wid >> 1, rel = (wid & 1) * 64 + ln; BT[pass * 128 + rel] = P.rel[nv::BUCKET[rel] * 16 + 2 * hh + pass] * LOG2E; } }
        asm volatile("s_waitcnt vmcnt(0) lgkmcnt(0)\n\ts_barrier" ::: "memory");
        for (int i = 0; i < 4; ++i) { const int qb = (i == 0) ? s : (i == 1) ? 7 - s : (i == 2) ? 8 + s : 15 - s;
            unsigned o1p[4][8]; attn_pass<0>(bh >> 3, bh & 7, qb, P, shm, wid, lane, o1p, true); attn_pass<1>(bh >> 3, bh & 7, qb, P, shm, wid, lane, o1p, true); }
    } else {
        for (int u = vcu; u < 64 * NQB; u += G) { const int bh = u >> 4, qb = u & 15;
            unsigned o1p[4][8]; attn_pass<0>(bh >> 3, bh & 7, qb, P, shm, wid, lane, o1p); attn_pass<1>(bh >> 3, bh & 7, qb, P, shm, wid, lane, o1p); }
    }
}
}
namespace mls {
using bf16x8 = __attribute__((ext_vector_type(8))) short;
using f32x4 = __attribute__((ext_vector_type(4))) float;
using u32x4 = __attribute__((ext_vector_type(4))) unsigned;
using u32x2 = __attribute__((ext_vector_type(2))) unsigned;
#define MLS_LAS __attribute__((address_space(3)))
typedef MLS_LAS char* lptr;
constexpr int SEQ = 4096, PITCH = 3072, L = 64, NCH = SEQ / L;
constexpr int QSTR = 136, SSTR = 72;
constexpr int QS = 0, KS = QS + 64 * QSTR * 2, KT = KS + 64 * QSTR * 2, VT = KT + 128 * SSTR * 2, VW = VT + 32 * SSTR * 2, SD = VW + 32 * SSTR * 2, CT = SD + 64 * SSTR * 2,
              NV = CT + 32 * QSTR * 2, FV = NV + 256, AV = FV + 256, IV = AV + 256, EV = IV + 256, WV = EV + 256, WB = WV + 256, DC = WB + 128, LDS_END = DC + 16;
static_assert(LDS_END <= 131072, "mLSTM LDS");
#define MLS_MFMA(a, b, c) __builtin_amdgcn_mfma_f32_16x16x32_bf16(a, b, c, 0, 0, 0)
#ifndef MK_NT_CVT
#define MK_NT_CVT 1
#endif
#if MK_NT_CVT
#define MLS_NTLOAD(p) __builtin_nontemporal_load(p)
#else
#define MLS_NTLOAD(p) (*(p))
#endif
#define MLS_BAR() asm volatile("s_waitcnt lgkmcnt(0)\n\ts_barrier" ::: "memory")
__device__ __forceinline__ unsigned pk(float lo, float hi) { typedef float f2 __attribute__((ext_vector_type(2))); typedef __bf16 b2 __attribute__((ext_vector_type(2))); f2 v = {lo, hi}; b2 b = __builtin_convertvector(v, b2); return __builtin_bit_cast(unsigned, b); }
__device__ __forceinline__ float blo(unsigned w) { return __builtin_bit_cast(float, w << 16); }
__device__ __forceinline__ float bhi(unsigned w) { return __builtin_bit_cast(float, w & 0xffff0000u); }
__device__ __forceinline__ float bperm(float v, int src) { return __builtin_bit_cast(float, __builtin_amdgcn_ds_bpermute(src << 2, __builtin_bit_cast(int, v))); }

struct Params { const unsigned short* P; const unsigned short* QKC; const float* GB; const float* GA; const float* GP; float* HH;
                const float* wg; const float* wu; const float* wd; unsigned short* wt_gu; unsigned short* wt_d; int gw;
                const float* fg; const float* fu; const float* fd; const float* ai; const float* ao; unsigned short* ws_small; const float* ks_ffn; const float* ks_att; };
constexpr int CV_MOE = 86016, CV_TOTAL = CV_MOE + 3 * 3584 + 3072 + 1024, CV_ITERS = (CV_TOTAL + 2047) / 2048;
constexpr size_t WS_FGU = (size_t)4096 * 1024, WS_FD = (size_t)11264 * 1024, WS_AI = (size_t)14848 * 1024, WS_AO = (size_t)17920 * 1024;
constexpr int CV_SCR = (LDS_END + 127) / 128 * 128;
constexpr int LDS_END2 = CV_SCR + 8 * 4224;
static_assert(LDS_END2 <= 131072, "mLSTM + cvt LDS");
struct CvItem { const float* src; unsigned short* dst; const float* ks; int ldw, K; };
__device__ __forceinline__ CvItem cv_decode(const Params& A, int it) {
    CvItem c; c.ks = nullptr;
    if (it >= CV_MOE) {
        int r = it - CV_MOE;
        if (r < 2 * 3584) { const int up = r >= 3584; r -= up * 3584; const int kb = r / 112, nb = r - kb * 112, n0 = 32 * nb, drow = (n0 >> 7) * 256 + (n0 & 127) + (up ? 128 : 0);
            c.src = (up ? A.fu : A.fg) + (size_t)(32 * kb) * 3584 + n0; c.ldw = 3584; c.K = 1024; c.dst = A.ws_small + WS_FGU + (size_t)drow * 1024 + 32 * kb; c.ks = A.ks_ffn ? A.ks_ffn + 32 * kb : nullptr; return c; }
        r -= 2 * 3584;
        if (r < 3584) { const int kb = r >> 5, nb = r & 31; c.src = A.fd + (size_t)(32 * kb) * 1024 + 32 * nb; c.ldw = 1024; c.K = 3584; c.dst = A.ws_small + WS_FD + (size_t)(32 * nb) * 3584 + 32 * kb; return c; }
        r -= 3584;
        if (r < 3072) { const int kb = r / 96, nb = r - kb * 96; c.src = A.ai + (size_t)(32 * kb) * 3072 + 32 * nb; c.ldw = 3072; c.K = 1024; c.dst = A.ws_small + WS_AI + (size_t)(32 * nb) * 1024 + 32 * kb; c.ks = A.ks_att ? A.ks_att + 32 * kb : nullptr; return c; }
        r -= 3072;
        if (r >= 1024) r = 1023;
        { const int kb = r >> 5, nb = r & 31; c.src = A.ao + (size_t)(32 * kb) * 1024 + 32 * nb; c.ldw = 1024; c.K = 1024; c.dst = A.ws_small + WS_AO + (size_t)(32 * nb) * 1024 + 32 * kb; return c; }
    }
    const int type = it / 28672, r = it - type * 28672, mat = r / 3584, r2 = r - mat * 3584;
    if (type < 2) { const int kb = r2 / 112, nb = r2 - kb * 112, n0 = 32 * nb; const int drow = (n0 >> 7) * 256 + (n0 & 127) + (type ? 128 : 0);
        c.src = (type ? A.wu : A.wg) + (size_t)mat * 1024 * 3584 + (size_t)(32 * kb) * 3584 + n0; c.ldw = 3584; c.K = 1024; c.dst = A.wt_gu + (size_t)mat * 7168 * 1024 + (size_t)drow * 1024 + 32 * kb; }
    else { const int kb = r2 >> 5, nb = r2 & 31, n0 = 32 * nb;
        c.src = A.wd + (size_t)mat * 3584 * 1024 + (size_t)(32 * kb) * 1024 + n0; c.ldw = 1024; c.K = 3584; c.dst = A.wt_d + (size_t)mat * 1024 * 3584 + (size_t)n0 * 3584 + 32 * kb; }
    return c;
}

__device__ __forceinline__ void scan_unit(int b, int h, int sl, const Params& A, lptr shm, int wid, int lane) {
    const int tid = wid * 64 + lane, lr = lane & 15, lq = lane >> 4;
    const long rowbase = (long)b * SEQ;
    const int o = tid & 31, g = tid >> 5, isk = o >> 4, ch0 = (o & 15) * 8;
    const int pcol = isk * 512 + h * 128 + ch0;
    const unsigned short* rawp = A.QKC + (rowbase + 4 * g) * 1024 + pcol;
    const int vs = tid >> 3, vj = (tid & 7) * 4;
    const unsigned short* vp = A.P + (rowbase + vs) * PITCH + 1024 + h * 256 + sl * 32 + vj;
    const int to = wid >> 1, jo = wid & 1;
    f32x4 Cst[2], nst;
    Cst[0] = (f32x4){0.f, 0.f, 0.f, 0.f}; Cst[1] = Cst[0]; nst = Cst[0];
    for (int i = tid; i < (32 * QSTR * 2 + 256) / 4; i += 512) ((MLS_LAS unsigned*)(shm + CT))[i] = 0u;
    float m_prev = 0.f;
    bf16x8 ones; { const short o1 = (short)0x3f80; ones = (bf16x8){o1, o1, o1, o1, o1, o1, o1, o1}; }
    unsigned short* hhp = (unsigned short*)A.HH + (rowbase + 16 * to + lr) * 1024 + h * 256 + sl * 32 + 16 * jo + 4 * lq;
    bf16x8 selH;
#pragma unroll
    for (int e = 0; e < 8; ++e) selH[e] = (e < 4 && 4 * lq + e == lr) ? (short)0x3f80 : (short)0;
    f32x4 cvr[4]; float cvs[4] = {1.f, 1.f, 1.f, 1.f}; unsigned short* cvdst = nullptr; int cvK = 0; bool cvhave = false;
#ifndef MK_CV_FIRST
#define MK_CV_FIRST 0
#endif
    if (A.gw >= 0) { const CvItem ci = cv_decode(A, MK_CV_FIRST + A.gw);
#pragma unroll
      for (int i = 0; i < 4; ++i) cvr[i] = MLS_NTLOAD((const f32x4*)(ci.src + (size_t)(8 * i + (lane >> 3)) * ci.ldw + (lane & 7) * 4));
      cvdst = ci.dst; cvK = ci.K; cvhave = true;
#pragma unroll
      for (int i = 0; i < 4; ++i) cvs[i] = ci.ks ? ci.ks[8 * i + (lane >> 3)] : 1.f; }
    else { cvr[0] = cvr[1] = cvr[2] = cvr[3] = (f32x4){0.f, 0.f, 0.f, 0.f}; }
    u32x4 raw[4]; u32x2 vraw; float gb = 0.f, ga = 0.f, gp = 0.f;
#pragma unroll
    for (int i = 0; i < 4; ++i) raw[i] = *(const u32x4*)(rawp + (long)i * 1024);
    vraw = *(const u32x2*)vp;
    if (wid == 7) { gb = A.GB[(rowbase + lane) * 4 + h]; ga = A.GA[(rowbase + lane) * 4 + h]; gp = A.GP[(rowbase + lane) * 4 + h]; }
    u32x2 hpk; { unsigned z0; asm volatile("v_mov_b32 %0, 0" : "=v"(z0)); hpk = (u32x2){z0, z0}; }
    MLS_BAR();
#pragma unroll 1
    for (int c = 0; c < NCH; ++c) {
        const int t0 = c * L;
        if (c > 0) {
            *(u32x2*)(hhp + (long)(t0 - L) * 1024) = hpk;
        }
        float vv[4]; vv[0] = blo(vraw[0]); vv[1] = bhi(vraw[0]); vv[2] = blo(vraw[1]); vv[3] = bhi(vraw[1]);
        {
#pragma unroll
            for (int r = 0; r < 4; ++r) *(MLS_LAS u32x4*)(shm + (isk ? KS : QS) + ((4 * g + r) * QSTR + ch0) * 2) = raw[r];
            if (isk) {
#pragma unroll
                for (int e = 0; e < 8; ++e) { const int dw = e >> 1, sh = (e & 1) * 16;
                    const unsigned a0 = (raw[0][dw] >> sh) & 0xffffu, a1 = (raw[1][dw] >> sh) & 0xffffu, a2 = (raw[2][dw] >> sh) & 0xffffu, a3 = (raw[3][dw] >> sh) & 0xffffu;
                    *(MLS_LAS u32x2*)(shm + KT + ((ch0 + e) * SSTR + 4 * g) * 2) = (u32x2){a0 | (a1 << 16), a2 | (a3 << 16)}; }
            }
        }
#pragma unroll
        for (int e = 0; e < 4; ++e) *(MLS_LAS unsigned short*)(shm + VT + ((vj + e) * SSTR + vs) * 2) = (unsigned short)(pk(vv[e], vv[e]) & 0xffffu);
        if (wid == 7) {
            const float bs = gb, a = ga, pm = gp;
            const float gsum = __builtin_bit_cast(float, __builtin_amdgcn_readlane(__builtin_bit_cast(int, bs), 63)), amax = __builtin_bit_cast(float, __builtin_amdgcn_readlane(__builtin_bit_cast(int, pm), 63));
            const float mref = fmaxf(m_prev, pm);
            const float mt = bs + mref;
            const float mrefn = fmaxf(m_prev, amax);
            const float w = __expf(a - mrefn);
            ((MLS_LAS float*)(shm + FV))[lane] = -mref;
            ((MLS_LAS float*)(shm + AV))[lane] = a;
            ((MLS_LAS float*)(shm + IV))[lane] = __expf(m_prev - mref);
            ((MLS_LAS float*)(shm + EV))[lane] = __expf(-mt);
            ((MLS_LAS float*)(shm + WV))[lane] = w;
            ((MLS_LAS unsigned short*)(shm + WB))[lane] = (unsigned short)(pk(w, w) & 0xffffu);
            if (lane == 0) ((MLS_LAS float*)(shm + DC))[0] = __expf(m_prev - mrefn);
            m_prev = gsum + mrefn;
        }
        if (cvhave) {
            MLS_LAS float* scr = (MLS_LAS float*)(shm + CV_SCR + wid * 4224);
#pragma unroll
            for (int i = 0; i < 4; ++i)
#pragma unroll
                for (int e = 0; e < 4; ++e) scr[(8 * i + (lane >> 3)) * 33 + (lane & 7) * 4 + e] = cvr[i][e] * cvs[i];
            float tv[16];
#pragma unroll
            for (int j = 0; j < 16; ++j) tv[j] = scr[(16 * (lane & 1) + j) * 33 + (lane >> 1)];
            u32x4* dp = (u32x4*)(cvdst + (size_t)(lane >> 1) * cvK + 16 * (lane & 1));
            dp[0] = (u32x4){pk(tv[0], tv[1]), pk(tv[2], tv[3]), pk(tv[4], tv[5]), pk(tv[6], tv[7])}; dp[1] = (u32x4){pk(tv[8], tv[9]), pk(tv[10], tv[11]), pk(tv[12], tv[13]), pk(tv[14], tv[15])};
        }
        cvhave = (MK_CV_FIRST + 2048 * (c + 1) < CV_TOTAL + 2047) && (c + 1 < CV_ITERS) && (A.gw >= 0);
        if (cvhave) { const CvItem ci = cv_decode(A, MK_CV_FIRST + A.gw + 2048 * (c + 1));
#pragma unroll
            for (int i = 0; i < 4; ++i) cvs[i] = ci.ks ? ci.ks[8 * i + (lane >> 3)] : 1.f;
#pragma unroll
            for (int i = 0; i < 4; ++i) cvr[i] = MLS_NTLOAD((const f32x4*)(ci.src + (size_t)(8 * i + (lane >> 3)) * ci.ldw + (lane & 7) * 4));
            cvdst = ci.dst; cvK = ci.K; }
        if (c + 1 < NCH) {
            const long adv = (long)(t0 + L) * PITCH;
#pragma unroll
            for (int i = 0; i < 4; ++i) raw[i] = *(const u32x4*)(rawp + (long)(t0 + L) * 1024 + (long)i * 1024);
            vraw = *(const u32x2*)(vp + adv);
            if (wid == 7) { const long gi = (rowbase + t0 + L + lane) * 4 + h; gb = A.GB[gi]; ga = A.GA[gi]; gp = A.GP[gi]; }
        }
        MLS_BAR();
        { const float w = ((MLS_LAS float*)(shm + WV))[vs];
#pragma unroll
          for (int e = 0; e < 4; ++e) *(MLS_LAS unsigned short*)(shm + VW + ((vj + e) * SSTR + vs) * 2) = (unsigned short)(pk(vv[e] * w, vv[e] * w) & 0xffffu); }
        bf16x8 qa[4];
#pragma unroll
        for (int ks = 0; ks < 4; ++ks) qa[ks] = *(const MLS_LAS bf16x8*)(shm + QS + ((16 * to + lr) * QSTR + 32 * ks + 8 * lq) * 2);
        f32x4 fvr; { const f32x4 t4 = *(const MLS_LAS f32x4*)(shm + FV + (16 * to + 4 * lq) * 4); fvr = t4; }
#pragma unroll
        for (int q = 0; q < 2; ++q) {
            const int si = 2 * jo + q;
            f32x4 s4 = (f32x4){0.f, 0.f, 0.f, 0.f};
            if (si <= to) {
#pragma unroll
                for (int ks = 0; ks < 4; ++ks) { const bf16x8 kb = *(const MLS_LAS bf16x8*)(shm + KS + ((16 * si + lr) * QSTR + 32 * ks + 8 * lq) * 2); s4 = MLS_MFMA(qa[ks], kb, s4); }
                const float av = ((MLS_LAS float*)(shm + AV))[16 * si + lr];
                const int scol = 16 * si + lr, trow = 16 * to + 4 * lq;
#pragma unroll
                for (int r = 0; r < 4; ++r) s4[r] = (scol <= trow + r) ? s4[r] * __expf(fvr[r] + av) : 0.f;
            }
#pragma unroll
            for (int r = 0; r < 4; ++r) *(MLS_LAS unsigned short*)(shm + SD + ((16 * to + 4 * lq + r) * SSTR + 16 * si + lr) * 2) = (unsigned short)(pk(s4[r], s4[r]) & 0xffffu);
        }
        f32x4 qc = (f32x4){0.f, 0.f, 0.f, 0.f}, qn = qc;
#pragma unroll
        for (int ks = 0; ks < 4; ++ks) { const bf16x8 cb8 = *(const MLS_LAS bf16x8*)(shm + CT + ((16 * jo + lr) * QSTR + 32 * ks + 8 * lq) * 2); const bf16x8 nb8 = *(const MLS_LAS bf16x8*)(shm + NV + (32 * ks + 8 * lq) * 2);
            qc = MLS_MFMA(qa[ks], cb8, qc); qn = MLS_MFMA(qa[ks], nb8, qn); }
        MLS_BAR();
        {
            f32x4 sv = (f32x4){0.f, 0.f, 0.f, 0.f}, rs = sv;
#pragma unroll
            for (int ks = 0; ks < 2; ++ks) { const bf16x8 sa = *(const MLS_LAS bf16x8*)(shm + SD + ((16 * to + lr) * SSTR + 32 * ks + 8 * lq) * 2); const bf16x8 vb = *(const MLS_LAS bf16x8*)(shm + VT + ((16 * jo + lr) * SSTR + 32 * ks + 8 * lq) * 2);
                sv = MLS_MFMA(sa, vb, sv); rs = MLS_MFMA(sa, ones, rs); }
            const f32x4 iv = *(const MLS_LAS f32x4*)(shm + IV + (16 * to + 4 * lq) * 4), ev = *(const MLS_LAS f32x4*)(shm + EV + (16 * to + 4 * lq) * 4);
            float hout[4];
#pragma unroll
            for (int r = 0; r < 4; ++r) { const float num = sv[r] + iv[r] * qc[r], den = rs[r] + iv[r] * qn[r]; hout[r] = num * __builtin_amdgcn_rcpf(fmaxf(fabsf(den), ev[r])); }
            { unsigned z0; asm volatile("v_mov_b32 %0, 0" : "=v"(z0));
              const u32x4 hw = (u32x4){pk(hout[0], hout[1]), pk(hout[2], hout[3]), z0, z0};
              const f32x4 ht = MLS_MFMA(__builtin_bit_cast(bf16x8, hw), selH, ((f32x4){0.f, 0.f, 0.f, 0.f}));
              hpk = (u32x2){pk(ht[0], ht[1]), pk(ht[2], ht[3])}; }
        }
        {
            const float decay = ((MLS_LAS float*)(shm + DC))[0];
            Cst[0] = Cst[0] * decay; Cst[1] = Cst[1] * decay; nst = nst * decay;
#pragma unroll
            for (int ks = 0; ks < 2; ++ks) { const bf16x8 ka = *(const MLS_LAS bf16x8*)(shm + KT + ((16 * wid + lr) * SSTR + 32 * ks + 8 * lq) * 2);
                const bf16x8 v0 = *(const MLS_LAS bf16x8*)(shm + VW + ((lr) * SSTR + 32 * ks + 8 * lq) * 2), v1 = *(const MLS_LAS bf16x8*)(shm + VW + ((16 + lr) * SSTR + 32 * ks + 8 * lq) * 2);
                const bf16x8 wb8 = *(const MLS_LAS bf16x8*)(shm + WB + (32 * ks + 8 * lq) * 2);
                Cst[0] = MLS_MFMA(ka, v0, Cst[0]); Cst[1] = MLS_MFMA(ka, v1, Cst[1]); nst = MLS_MFMA(ka, wb8, nst); }
        }
        MLS_BAR();
#pragma unroll
        for (int jt = 0; jt < 2; ++jt) *(MLS_LAS u32x2*)(shm + CT + ((16 * jt + lr) * QSTR + 16 * wid + 4 * lq) * 2) = (u32x2){pk(Cst[jt][0], Cst[jt][1]), pk(Cst[jt][2], Cst[jt][3])};
        if (lr == 0) *(MLS_LAS u32x2*)(shm + NV + (16 * wid + 4 * lq) * 2) = (u32x2){pk(nst[0], nst[1]), pk(nst[2], nst[3])};
    }
    *(u32x2*)(hhp + (long)(SEQ - L) * 1024) = hpk;
    asm volatile("s_waitcnt vmcnt(0) lgkmcnt(0)\n\ts_barrier" ::: "memory");
}
__device__ __forceinline__ void scan_phase(const Params& A, lptr shm, int vcu, int G, int wid) {
    for (int u = vcu; u < 256; u += G) {
        int lane; asm volatile("v_mbcnt_lo_u32_b32 %0, -1, 0\n\tv_mbcnt_hi_u32_b32 %0, -1, %0" : "=v"(lane));
        const int bh = u >> 3; scan_unit(bh >> 2, bh & 3, u & 7, A, shm, wid, lane);
    }
}
__device__ __forceinline__ void conv_phase(const unsigned short* P, const float* cw, const float* cb, unsigned short* QKC, const float* LI, const float* LF, float* GB, float* GA, float* GP, int vcu, int G, int tid) {
    const int o = tid & 127, g = tid >> 7, c0 = o * 8;
    float cwr[4][8], cbr[8];
#pragma unroll
    for (int j = 0; j < 4; ++j) { const f32x4 a = *(const f32x4*)(cw + j * 1024 + c0), c = *(const f32x4*)(cw + j * 1024 + c0 + 4);
        cwr[j][0] = a[0]; cwr[j][1] = a[1]; cwr[j][2] = a[2]; cwr[j][3] = a[3]; cwr[j][4] = c[0]; cwr[j][5] = c[1]; cwr[j][6] = c[2]; cwr[j][7] = c[3]; }
    { const f32x4 a = *(const f32x4*)(cb + c0), c = *(const f32x4*)(cb + c0 + 4); cbr[0] = a[0]; cbr[1] = a[1]; cbr[2] = a[2]; cbr[3] = a[3]; cbr[4] = c[0]; cbr[5] = c[1]; cbr[6] = c[2]; cbr[7] = c[3]; }
    const float osc = c0 >= 512 ? 0.08838834764831845f : 1.0f;
    for (int blk = vcu; blk < 8 * SEQ / 128; blk += G) {
        {
            const int w = tid >> 6, lane = tid & 63; const long gi = ((long)blk * 128 + (w >> 2) * 64 + lane) * 4 + (w & 3);
            float bs = LF[gi]; const float li = LI[gi];
#pragma unroll
            for (int x = 1; x < 64; x <<= 1) { const float v = bperm(bs, (lane - x) & 63); if (lane >= x) bs += v; }
            const float a = li - bs; float pm = a;
#pragma unroll
            for (int x = 1; x < 64; x <<= 1) { const float v = bperm(pm, (lane - x) & 63); if (lane >= x) pm = fmaxf(pm, v); }
            GB[gi] = bs; GA[gi] = a; GP[gi] = pm;
        }
        const long r0 = (long)blk * 128 + 32 * g;
        float x[3][8];
#pragma unroll
        for (int i = 0; i < 3; ++i) { const long rr = r0 - 3 + i; u32x4 w = (u32x4){0u, 0u, 0u, 0u}; if ((r0 & (SEQ - 1)) != 0) w = *(const u32x4*)(P + rr * PITCH + c0);
            x[i][0] = blo(w[0]); x[i][1] = bhi(w[0]); x[i][2] = blo(w[1]); x[i][3] = bhi(w[1]); x[i][4] = blo(w[2]); x[i][5] = bhi(w[2]); x[i][6] = blo(w[3]); x[i][7] = bhi(w[3]); }
#pragma unroll 1
        for (int rb = 0; rb < 32; rb += 16) {
            u32x4 wv[16];
#pragma unroll
            for (int r = 0; r < 16; ++r) wv[r] = *(const u32x4*)(P + (r0 + rb + r) * PITCH + c0);
#pragma unroll
            for (int r = 0; r < 16; ++r) { const u32x4 w = wv[r];
                float xn[8]; xn[0] = blo(w[0]); xn[1] = bhi(w[0]); xn[2] = blo(w[1]); xn[3] = bhi(w[1]); xn[4] = blo(w[2]); xn[5] = bhi(w[2]); xn[6] = blo(w[3]); xn[7] = bhi(w[3]);
                float y[8];
#pragma unroll
                for (int e = 0; e < 8; ++e) { const float a = cbr[e] + cwr[0][e] * x[0][e] + cwr[1][e] * x[1][e] + cwr[2][e] * x[2][e] + cwr[3][e] * xn[e];
                    y[e] = osc * a * __builtin_amdgcn_rcpf(1.0f + __builtin_amdgcn_exp2f(-1.4426950408889634f * a)); x[0][e] = x[1][e]; x[1][e] = x[2][e]; x[2][e] = xn[e]; }
                *(u32x4*)(QKC + (r0 + rb + r) * 1024 + c0) = (u32x4){pk(y[0], y[1]), pk(y[2], y[3]), pk(y[4], y[5]), pk(y[6], y[7])}; }
        }
    }
}
__device__ __forceinline__ void headnorm_phase(const float* HH, const unsigned short* P, const float* hn, unsigned short* Gout, int vcu, int G, int wid, int lane) {
    const int gw = vcu * 8 + wid, NGW = G * 8;
    const unsigned short* HB = (const unsigned short*)HH;
    u32x4 a0, a1, ao0, ao1, b0, b1, bo0, bo1;
    f32x4 hnw[4];
#pragma unroll
    for (int i = 0; i < 4; ++i) hnw[i] = ((const f32x4*)(hn + lane * 16))[i];
#define HN_LOAD(mm, x0, x1, y0, y1) do { const u32x4* hp_ = (const u32x4*)(HB + (long)(mm) * 1024 + lane * 16); x0 = hp_[0]; x1 = hp_[1]; \
        const u32x4* op_ = (const u32x4*)(P + (long)(mm) * PITCH + 2048 + lane * 16); y0 = op_[0]; y1 = op_[1]; } while (0)
#define HN_ROW(mm, x0, x1, y0, y1) do { \
        f32x4 v[4]; float ss = 0.f; float og[16]; \
        { const u32x4 q0 = x0, q1 = x1, o0 = y0, o1 = y1; \
          _Pragma("unroll") for (int i = 0; i < 4; ++i) { const unsigned w0 = (i < 2 ? q0 : q1)[2 * (i & 1)], w1 = (i < 2 ? q0 : q1)[2 * (i & 1) + 1]; v[i] = (f32x4){blo(w0), bhi(w0), blo(w1), bhi(w1)}; \
              ss += v[i][0] * v[i][0] + v[i][1] * v[i][1] + v[i][2] * v[i][2] + v[i][3] * v[i][3]; } \
          _Pragma("unroll") for (int i = 0; i < 4; ++i) { og[2 * i] = blo(o0[i]); og[2 * i + 1] = bhi(o0[i]); og[8 + 2 * i] = blo(o1[i]); og[8 + 2 * i + 1] = bhi(o1[i]); } } \
        if ((mm) + 2 * NGW < 8 * SEQ) HN_LOAD((mm) + 2 * NGW, x0, x1, y0, y1); \
        _Pragma("unroll") for (int x = 1; x < 16; x <<= 1) ss += bperm(ss, lane ^ x); \
        const float rs = __builtin_amdgcn_rsqf(ss * (1.f / 256.f) + 1e-6f); \
        float r[16]; \
        _Pragma("unroll") for (int i = 0; i < 4; ++i) { const f32x4 w = hnw[i]; \
            _Pragma("unroll") for (int e = 0; e < 4; ++e) { const float sg = __builtin_amdgcn_rcpf(1.0f + __builtin_amdgcn_exp2f(-1.4426950408889634f * og[4 * i + e])); r[4 * i + e] = sg * v[i][e] * rs * w[e]; } } \
        u32x4* gp = (u32x4*)(Gout + (long)(mm) * 1024 + lane * 16); \
        gp[0] = (u32x4){pk(r[0], r[1]), pk(r[2], r[3]), pk(r[4], r[5]), pk(r[6], r[7])}; gp[1] = (u32x4){pk(r[8], r[9]), pk(r[10], r[11]), pk(r[12], r[13]), pk(r[14], r[15])}; } while (0)
    HN_LOAD(gw, a0, a1, ao0, ao1);
    if (gw + NGW < 8 * SEQ) HN_LOAD(gw + NGW, b0, b1, bo0, bo1); else { b0 = a0; b1 = a1; bo0 = ao0; bo1 = ao1; }
    for (int m = gw; m < 8 * SEQ; m += 2 * NGW) {
        HN_ROW(m, a0, a1, ao0, ao1);
        if (m + NGW < 8 * SEQ) HN_ROW(m + NGW, b0, b1, bo0, bo1);
    }
#undef HN_LOAD
#undef HN_ROW
}
}
#define MK_KS_FFN (KA_IN(18) + pr * 1024)
#define MK_KS_ATT (KA_IN(10) + pr * 1024)
#define MK_QSCALE (0.125f * 1.4426950408889634f)
#define MK_ATTENTION { const int tid = fresh_tid(F), lane = tid & 63, wave = __builtin_amdgcn_readfirstlane(tid >> 6); \
    const float lam_init = 0.8f - 0.6f * __expf(-0.3f * (float)(2 * pr + 1)); \
    const float* lq1 = KA_IN(12) + pr * 64; const float* lk1 = KA_IN(13) + pr * 64; const float* lq2 = KA_IN(14) + pr * 64; const float* lk2 = KA_IN(15) + pr * 64; \
    const float lam = __expf(wave_sum(lq1[lane] * lk1[lane], lane)) - __expf(wave_sum(lq2[lane] * lk2[lane], lane)) + lam_init; \
    att::Params AP{(const unsigned short*)(ws + F_P), (unsigned short*)(ws + F_O), (float*)(ws + F_OT), KA_IN(1), KA_IN(16) + pr * 128, lam, lam_init}; \
    att::attn_phase(AP, (att::lds_ptr)(F.lds + RING_OFF), F.vcu, F.G, wave, lane); }
#define MK_MLSTM_CONV { const int tid = fresh_tid(F); mls::conv_phase((const unsigned short*)(ws + F_P), KA_IN(4) + pr * 4096, KA_IN(5) + pr * 1024, (unsigned short*)(ws + F_QKC), LI, LF, (float*)(ws + F_GB), (float*)(ws + F_GB) + M * 4, (float*)(ws + F_GB) + 2 * M * 4, F.vcu, F.G, tid); }
#define MK_MLSTM_SCAN { const int tid = fresh_tid(F); const int wave = __builtin_amdgcn_readfirstlane(tid >> 6); \
    mls::Params MP{(const unsigned short*)(ws + F_P), (const unsigned short*)(ws + F_QKC), (const float*)(ws + F_GB), (const float*)(ws + F_GB) + M * 4, (const float*)(ws + F_GB) + 2 * M * 4, (float*)(ws + F_HH), \
        KA_IN(25) + (size_t)pr * NE * 1024 * FF, KA_IN(26) + (size_t)pr * NE * 1024 * FF, KA_IN(27) + (size_t)pr * NE * FF * 1024, W0, W0 + (size_t)NE * 7168 * 1024, F.G == 256 ? F.vcu * NWAVES + wave : -1, \
        KA_IN(19) + (size_t)pr * 1024 * FF, KA_IN(20) + (size_t)pr * 1024 * FF, KA_IN(21) + (size_t)pr * FF * 1024, KA_IN(11) + (size_t)pr * 1024 * 3072, KA_IN(17) + (size_t)pr * 1024 * 1024, WS0, MK_KS_FFN, MK_KS_ATT}; \
    mls::scan_phase(MP, (mls::lptr)(F.lds + RING_OFF), F.vcu, F.G, wave); }
#define MK_MLSTM_HEADNORM { const int tid = fresh_tid(F), lane = tid & 63, wave = __builtin_amdgcn_readfirstlane(tid >> 6); \
    mls::headnorm_phase((const float*)(ws + F_HH), (const unsigned short*)(ws + F_P), KA_IN(8) + pr * 1024, (unsigned short*)(ws + F_G), F.vcu, F.G, wave, lane); }
#ifndef MK_MLSTM_SCAN
#define MK_MLSTM_SCAN
#endif
#ifndef MK_MLSTM_HEADNORM
#define MK_MLSTM_HEADNORM
#endif
#ifndef MK_ATTENTION
#define MK_ATTENTION
#endif
#ifndef MK_QSCALE
#define MK_KS_FFN (KA_IN(18) + pr * 1024)
#define MK_KS_ATT (KA_IN(10) + pr * 1024)
#define MK_QSCALE 1.0f
#endif
#ifndef MK_GW_QKV
#define MK_GW_QKV 8
#endif
#ifndef MK_GW_RES
#define MK_GW_RES 8
#endif
#ifndef MK_GW_F1
#define MK_GW_F1 8
#endif
#ifndef MK_GW_E2
#define MK_GW_E2 4
#endif
#ifndef MK_GW_E3
#define MK_GW_E3 4
#endif
#ifndef MK_ALIGN_SWI
#define MK_ALIGN_SWI true
#endif
#ifndef MK_ALIGN_RESID
#define MK_ALIGN_RESID true
#endif
namespace mk {
__device__ __forceinline__ void assign_phase(Frame& F, const int* top_e, const int* wg_cnt, int* tok_slot, int* blk_expert, int* n_used, int* slot_row) {
    LAS int* cnt = (LAS int*)(F.lds + RING_OFF);
    LAS int* base = cnt + 2048; LAS int* tot = base + 8; LAS int* wcnt = tot + 8;
    const int t = fresh_tid(F), lane = t & 63, w = __builtin_amdgcn_readfirstlane(t >> 6);
    int c4[4];
#pragma unroll
    for (int q = 0; q < 4; ++q) c4[q] = wg_cnt[t + q * NTHR];
    const int e_own = t < 256 ? top_e[F.vcu * 256 + t] : -1;
#pragma unroll
    for (int q = 0; q < 4; ++q) cnt[t + q * NTHR] = c4[q];
    unsigned long long mym = 0ull;
#pragma unroll
    for (int e = 0; e < 8; ++e) { const unsigned long long bm = __builtin_amdgcn_ballot_w64(e_own == e); mym = (e_own == e) ? bm : mym; if (w < 4 && lane == 0) wcnt[w * 8 + e] = __builtin_popcountll(bm); }
    __syncthreads();
    { int s = 0, b = 0;
#pragma unroll
      for (int q = 0; q < 4; ++q) { const int v = lane * 4 + q, c = cnt[v * 8 + w]; s += c; b += (v < F.vcu) ? c : 0; }
#pragma unroll
      for (int o = 1; o < 64; o <<= 1) { s += shfl_idx_i(s, lane ^ o); b += shfl_idx_i(b, lane ^ o); }
      if (lane == 0) { tot[w] = s; base[w] = b; } }
    __syncthreads();
    int pstv[9]; { int acc = 0;
#pragma unroll
      for (int e = 0; e < 8; ++e) { pstv[e] = acc; acc += (tot[e] + 255) / 256 * 256; }
      pstv[8] = acc; }
    if (F.vcu == 0) {
        if (t == 0) *n_used = pstv[8] / 256;
        if (t < NBLK) { int e = 0;
#pragma unroll
            for (int q = 1; q < 8; ++q) e += (t * 256 >= pstv[q]) ? 1 : 0;
            blk_expert[t] = e; }
    }
    if (t < 256) { const int e = e_own; int r = __builtin_popcountll(mym & ((1ull << lane) - 1ull)), p = 0, bs = 0;
#pragma unroll
        for (int w2 = 0; w2 < 4; ++w2) r += (w2 < w) ? wcnt[w2 * 8 + e] : 0;
#pragma unroll
        for (int q = 0; q < 8; ++q) { p = (e == q) ? pstv[q] : p; }
        bs = base[e];
        const int slot = p + bs + r; tok_slot[F.vcu * 256 + t] = slot; slot_row[slot] = (F.vcu * 256 + t) >> 1; }
    __syncthreads();
}

struct Args { const float* in[29]; float* out; unsigned char* ws; int ph_lo, ph_hi, li, flags; };
constexpr int PH_FINAL = 34, PH_COMBINE = 35;
constexpr float ATT_C2 = 0.125f * 1.4426950408889634f;

typedef const __attribute__((address_space(4))) unsigned char* kaptr_t;
__device__ __forceinline__ kaptr_t ka_fresh() { kaptr_t p = (kaptr_t)__builtin_amdgcn_kernarg_segment_ptr(); asm volatile("" : "+s"(p)); return p; }
#define KA_IN(k) (*(const float* const __attribute__((address_space(4)))*)(ka + 8 * (k)))
#define KA_OUT (*(float* const __attribute__((address_space(4)))*)(ka + 232))
#define KA_WS (*(unsigned char* const __attribute__((address_space(4)))*)(ka + 240))
#define KA_INT(off) (*(const int __attribute__((address_space(4)))*)(ka + (off)))
static_assert(sizeof(Args) == 264, "Args layout (kernarg offsets above)");
#define PHASE_PTRS kaptr_t ka = ka_fresh(); unsigned char* const ws = KA_WS; float* const xo = KA_OUT; bf16* const XN = (bf16*)xo; bf16* const XB = (bf16*)(ws + F_XN); bf16* const W0 = (bf16*)(ws + F_W); bf16* const WS0 = (bf16*)(ws + F_WS); (void)WS0; \
    int* const top_e = (int*)(ws + F_TOPE); float* const top_g = (float*)(ws + F_TOPG); int* const slot_tok = (int*)(ws + F_SLOTTOK); int* const tok_slot = (int*)(ws + F_TOKSLOT); \
    int* const blk_e = (int*)(ws + F_BLKE); int* const n_used = (int*)(ws + F_NUSED); float* const LI = (float*)(ws + F_LI); float* const LF = (float*)(ws + F_LF); bf16* const Ybuf = (bf16*)(ws + F_Y); \
    (void)xo; (void)XN; (void)XB; (void)W0; (void)top_e; (void)top_g; (void)slot_tok; (void)tok_slot; (void)blk_e; (void)n_used; (void)LI; (void)LF; (void)Ybuf; (void)ws
__global__ void __launch_bounds__(NTHR, 2) mk_fwd(Args) {
    extern __shared__ __attribute__((aligned(16))) unsigned char lds[];
    Frame F;
    F.lds = (LAS unsigned char*)lds;
    volatile LAS unsigned* MISC = (volatile LAS unsigned*)(F.lds + MISC_OFF);
    F.wave = __builtin_amdgcn_readfirstlane((int)threadIdx.x >> 6);
    F.G = gridDim.x; { const int bx = blockIdx.x; F.vcu = (F.G % 8 == 0) ? (bx % 8) * (F.G / 8) + bx / 8 : bx; }
    for (int u = threadIdx.x; u < (LDS_BYTES - LDSCTL_OFF) / 4; u += NTHR) ((LAS unsigned*)(F.lds + LDSCTL_OFF))[u] = 0u;
    __syncthreads();
    int lo, hi, flags; XcdBarrier bar;
    { kaptr_t ka = ka_fresh(); lo = KA_INT(248); hi = KA_INT(252); flags = KA_INT(260); const int li = KA_INT(256);
      bar = xcd_barrier_post((unsigned*)((gu32*)(KA_WS + F_CTL) + CW_BAR) + li * XCD_BAR_WORDS, MISC + 8, threadIdx.x == 0); }
#define IN(k) (lo <= (k) && (k) < hi)
#if defined(PROBE_PHSET)
#ifndef PROBE_PAIR
#define PROBE_PAIR pr
#endif
#define PT0(n) if (((PROBE_PHSET >> (n)) & 1) && pr == PROBE_PAIR) pt0_ = __builtin_amdgcn_s_memrealtime();
#define PT1(n) if (((PROBE_PHSET >> (n)) & 1) && pr == PROBE_PAIR) { asm volatile("s_waitcnt vmcnt(0) lgkmcnt(0)" ::: "memory"); probe_acc += (unsigned)(__builtin_amdgcn_s_memrealtime() - pt0_); }
#else
#define PT0(n)
#define PT1(n)
#endif
#if defined(PROBE_PHASE)
#define REPS(n) ((n) == PROBE_PHASE ? 1 + PROBE_REPS : 1)
#else
#define REPS(n) 1
#endif
#if defined(PROBE_BARWAIT)
#define SEAM(k) do { if (IN(k) && IN((k) + 1)) { const unsigned long long t0_ = __builtin_amdgcn_s_memrealtime(); xcd_barrier(bar, F.wave == 0 && lane_id() == 0); probe_acc += (unsigned)(__builtin_amdgcn_s_memrealtime() - t0_); } } while (0)
#else
#define SEAM(k) do { PT1((k) - pb) if (IN(k) && IN((k) + 1)) xcd_barrier(bar, F.wave == 0 && lane_id() == 0); } while (0)
#endif

    unsigned probe_acc = 0u; (void)probe_acc; unsigned long long pt0_ = 0; (void)pt0_;
    for (int pr = 0; pr < 2; ++pr) {
        const int pb = pr * 17;
        if (IN(pb + 0)) _Pragma("unroll") for (int rep_ = 0; rep_ < REPS(0); ++rep_) { PHASE_PTRS; PT0(0)
            cvt_job(F, KA_IN(3) + (size_t)pr * 1024 * 3080, 3080, 1024, 3072, 1, 0, WS0, 0, 0, 0, KA_IN(2) + pr * 1024);
            cvt_job(F, KA_IN(9) + (size_t)pr * 1024 * 1024, 1024, 1024, 1024, 1, 0, WS0 + 3072 * 1024, 0, 0, 1536);
            RowJob J{}; const bool first = (pr == 0) && !(flags & 1);
            const bool comb = (pr == 1) && !(flags & 2);
            J.xsrc = first ? KA_IN(0) : nullptr; J.xbsrc = XB; J.xbdst = (first || comb) ? XB : nullptr; J.nw = KA_IN(2) + pr * 1024; J.ssq_out = (float*)(ws + F_SSQ);
            if (comb) { J.Y = Ybuf; J.tok_slot = tok_slot; J.top_g = top_g; }
            J.slab = KA_IN(3) + (size_t)pr * 1024 * 3080 + 3072; J.slab_ld = 3080; J.kind = 1; J.b0 = KA_IN(6) + pr * 4; J.b1 = KA_IN(7) + pr * 4; J.LI = LI; J.LF = LF;
            if (first) gate_phase<false>(F, J); else gate_phase<true>(F, J);
        }
        SEAM(pb + 0);
        if (IN(pb + 1)) _Pragma("unroll") for (int rep_ = 0; rep_ < REPS(1); ++rep_) { PHASE_PTRS; PT0(1)
            pg8::Gemm g{XB, WS0, M, 3072, 1024, nullptr}; pg8::StaticOrder S; S.init(M, 3072, F.G, (int)blockIdx.x, MK_GW_QKV);
            pg8::EpiBf16T<true> E{(bf16*)(ws + F_P), 3072, 1.f, 0};
            pg8::gemm_phase<pg8::EpiBf16T<true>, pg8::StaticOrder, true, false, true>(F.lds + RING_OFF, g, S, E, F.wave, (const float*)(ws + F_SSQ), (PG8_LAS float*)(F.lds + LDSCTL_OFF + 1024));
        }
        SEAM(pb + 1);
        if (IN(pb + 2)) _Pragma("unroll") for (int rep_ = 0; rep_ < REPS(2); ++rep_) { PHASE_PTRS; PT0(2) MK_MLSTM_CONV }
        SEAM(pb + 2);
        if (IN(pb + 3)) _Pragma("unroll") for (int rep_ = 0; rep_ < REPS(3); ++rep_) { PHASE_PTRS; PT0(3) MK_MLSTM_SCAN }
        SEAM(pb + 3);
        if (IN(pb + 4)) _Pragma("unroll") for (int rep_ = 0; rep_ < REPS(4); ++rep_) { PHASE_PTRS; PT0(4) MK_MLSTM_HEADNORM }
        SEAM(pb + 4);
        if (IN(pb + 5)) _Pragma("unroll") for (int rep_ = 0; rep_ < REPS(5); ++rep_) { PHASE_PTRS; PT0(5)
            pg8::Gemm g{(const bf16*)(ws + F_G), WS0 + 3072 * 1024, M, 1024, 1024, nullptr}; pg8::StaticOrder S; S.init(M, 1024, F.G, (int)blockIdx.x, MK_GW_RES);
            pg8::EpiResidB<true> E{XB, 1024, (float*)(ws + F_SSQ)};
            pg8::gemm_phase<pg8::EpiResidB<true>, pg8::StaticOrder, MK_ALIGN_RESID, false>(F.lds + RING_OFF, g, S, E, F.wave);
        }
        SEAM(pb + 5);
        if (IN(pb + 7)) _Pragma("unroll") for (int rep_ = 0; rep_ < REPS(7); ++rep_) { PHASE_PTRS; PT0(7)
            pg8::Gemm g{XB, WS0 + mls::WS_FGU, M, 2 * FF, 1024, nullptr}; pg8::StaticOrder S; S.init(M, 2 * FF, F.G, (int)blockIdx.x, MK_GW_F1);
            pg8::EpiSwiGLUT<true> E{(bf16*)(ws + F_H), FF};
            pg8::gemm_phase<pg8::EpiSwiGLUT<true>, pg8::StaticOrder, MK_ALIGN_SWI, false, true>(F.lds + RING_OFF, g, S, E, F.wave, (const float*)(ws + F_SSQ), (PG8_LAS float*)(F.lds + LDSCTL_OFF + 1024));
        }
        SEAM(pb + 7);
        if (IN(pb + 8)) _Pragma("unroll") for (int rep_ = 0; rep_ < REPS(8); ++rep_) { PHASE_PTRS; PT0(8)
            pg8::Gemm g{(const bf16*)(ws + F_H), WS0 + mls::WS_FD, M, 1024, FF, nullptr}; pg8::StaticOrder S; S.init(M, 1024, F.G, (int)blockIdx.x, MK_GW_RES);
            pg8::EpiResidB<true> E{XB, 1024, (float*)(ws + F_SSQ)};
            pg8::gemm_phase<pg8::EpiResidB<true>, pg8::StaticOrder, MK_ALIGN_RESID, false>(F.lds + RING_OFF, g, S, E, F.wave);
        }
        SEAM(pb + 8);
        if (IN(pb + 10)) _Pragma("unroll") for (int rep_ = 0; rep_ < REPS(10); ++rep_) { PHASE_PTRS; PT0(10)
            pg8::Gemm g{XB, WS0 + mls::WS_AI, M, 3072, 1024, nullptr}; pg8::StaticOrder S; S.init(M, 3072, F.G, (int)blockIdx.x, MK_GW_QKV);
            pg8::EpiBf16T<true> E{(bf16*)(ws + F_P), 3072, MK_QSCALE, 4};
            pg8::gemm_phase<pg8::EpiBf16T<true>, pg8::StaticOrder, true, false, true>(F.lds + RING_OFF, g, S, E, F.wave, (const float*)(ws + F_SSQ), (PG8_LAS float*)(F.lds + LDSCTL_OFF + 1024));
        }
        SEAM(pb + 10);
        if (IN(pb + 11)) _Pragma("unroll") for (int rep_ = 0; rep_ < REPS(11); ++rep_) { PHASE_PTRS; PT0(11) MK_ATTENTION }
        SEAM(pb + 11);
        if (IN(pb + 12)) _Pragma("unroll") for (int rep_ = 0; rep_ < REPS(12); ++rep_) { PHASE_PTRS; PT0(12)
            pg8::Gemm g{(const bf16*)(ws + F_O), WS0 + mls::WS_AO, M, 1024, 1024, nullptr}; pg8::StaticOrder S; S.init(M, 1024, F.G, (int)blockIdx.x, MK_GW_RES);
            pg8::EpiResidB<false> E{XB, 1024, nullptr};
            pg8::gemm_phase<pg8::EpiResidB<false>, pg8::StaticOrder, MK_ALIGN_RESID, false>(F.lds + RING_OFF, g, S, E, F.wave);
        }
        SEAM(pb + 12);
        if (IN(pb + 13)) _Pragma("unroll") for (int rep_ = 0; rep_ < REPS(13); ++rep_) { PHASE_PTRS; PT0(13)
#ifndef MK_CV_FIRST
#define MK_CV_FIRST 0
#endif
            if (F.G != 256 || MK_CV_FIRST != 0) {
            cvt_job(F, KA_IN(25) + (size_t)pr * NE * 1024 * FF, FF, 1024, FF, NE, (size_t)1024 * FF, W0, (size_t)7168 * 1024, 1, 0);
            cvt_job(F, KA_IN(26) + (size_t)pr * NE * 1024 * FF, FF, 1024, FF, NE, (size_t)1024 * FF, W0, (size_t)7168 * 1024, 2, 0);
            cvt_job(F, KA_IN(27) + (size_t)pr * NE * FF * 1024, 1024, FF, 1024, NE, (size_t)FF * 1024, W0 + (size_t)NE * 7168 * 1024, (size_t)1024 * FF, 0, 0); }
            RowJob J{}; J.xbsrc = XB; J.nw = KA_IN(22) + pr * 1024; J.XN = XN;
            J.slab = KA_IN(23) + (size_t)pr * 8192; J.slab_ld = 8; J.kind = 2; J.b0 = KA_IN(24) + pr * 8; J.top_e = top_e; J.top_g_out = top_g; J.wg_cnt = slot_tok;
            router_phase(F, J);
        }
        SEAM(pb + 13);
        if (IN(pb + 14)) _Pragma("unroll") for (int rep_ = 0; rep_ < REPS(14); ++rep_) { PHASE_PTRS; PT0(14) assign_phase(F, top_e, slot_tok, tok_slot, blk_e, n_used, slot_tok + 4096); }
        SEAM(pb + 14);
        if (IN(pb + 15)) _Pragma("unroll") for (int rep_ = 0; rep_ < REPS(15); ++rep_) { PHASE_PTRS; PT0(15)
            const int nb = __builtin_amdgcn_readfirstlane(*(volatile int*)n_used);
            pg8::Gemm g{XN, W0, nb * 256, 2 * FF, 1024, slot_tok + 4096, M}; pg8::GroupOrder S; S.init(nb, 2 * FF / 256, F.G, (int)blockIdx.x, blk_e, (long)7168 * 1024, MK_GW_E2);
            pg8::EpiSwiGLU E{(bf16*)(ws + F_H), FF};
            pg8::gemm_phase<pg8::EpiSwiGLU, pg8::GroupOrder, MK_ALIGN_SWI, true>(F.lds + RING_OFF, g, S, E, F.wave, nullptr, nullptr, (PG8_LAS int*)(F.lds + LDSCTL_OFF + 4096));
        }
        SEAM(pb + 15);
        if (IN(pb + 16)) _Pragma("unroll") for (int rep_ = 0; rep_ < REPS(16); ++rep_) { PHASE_PTRS; PT0(16)
            const int nb = __builtin_amdgcn_readfirstlane(*(volatile int*)n_used);
            const int nmain = nb < 256 ? nb : 256;
            pg8::Gemm g{(const bf16*)(ws + F_H), W0 + (size_t)NE * 7168 * 1024, nb * 256, 1024, FF, nullptr}; pg8::GroupOrder S; S.init(nmain, 4, F.G, (int)blockIdx.x, blk_e, (long)1024 * FF, MK_GW_E3);
            pg8::EpiBf16 E{Ybuf, 1024, 1.f, 0};
            pg8::gemm_phase<pg8::EpiBf16, pg8::GroupOrder, true, false>(F.lds + RING_OFF, g, S, E, F.wave);
            __syncthreads();
            { pg8::Gemm g2{(const bf16*)(ws + F_H), W0 + (size_t)NE * 7168 * 1024, nb * 256, 1024, YP_KC, nullptr, 0, FF}; pg8::SplitOrder S2; S2.init(256, nb - 256, 4, YP_NS, YP_KC, F.G, (int)blockIdx.x, blk_e, (long)1024 * FF);
              pg8::EpiBf16Part E2{(bf16*)(ws + F_YP), 1024, 256, YP_ROWS, YP_KC};
              pg8::gemm_phase<pg8::EpiBf16Part, pg8::SplitOrder, true, false, false, true>(F.lds + RING_OFF, g2, S2, E2, F.wave);
              const int nsu = (nb - 256) * 4 * YP_NS, tid = fresh_tid(F);
              asm volatile("s_waitcnt vmcnt(0)" ::: "memory"); __syncthreads();
              if (tid == 0 && (int)blockIdx.x < nsu) { __builtin_amdgcn_fence(__ATOMIC_RELEASE, "agent"); asm volatile("s_waitcnt vmcnt(0)" ::: "memory");
                  for (int L = (int)blockIdx.x; L < nsu; L += F.G) (void)__hip_atomic_fetch_add((unsigned*)((gu32*)(ws + F_CTL) + CW_YP + pr * 32 + L / YP_NS), 1u, RLX_AGENT); }
              for (int L = (int)blockIdx.x; L < nsu; L += F.G) {
                  const int tile = L / YP_NS, kc = L - tile * YP_NS;
                  if (tid == 0) { unsigned* cp = (unsigned*)((gu32*)(ws + F_CTL) + CW_YP + pr * 32 + tile); unsigned sp = 0u;
                      while (xb_ld(cp) < (unsigned)YP_NS) { __builtin_amdgcn_s_sleep(1); if (++sp > (1u << 20)) break; }
                      __builtin_amdgcn_fence(__ATOMIC_ACQUIRE, "agent"); asm volatile("s_waitcnt vmcnt(0)" ::: "memory"); }
                  __syncthreads();
                  const int x = tile >> 2, pn = tile & 3, nr = (256 - kc + YP_NS - 1) / YP_NS; const bf16* pl = (const bf16*)(ws + F_YP);
                  v4u pv[3][YP_NS];
#pragma unroll
                  for (int u = 0; u < 3; ++u) { const int idx = tid + u * NTHR, r = kc + YP_NS * (idx < nr * 32 ? (idx >> 5) : 0), c8 = (idx & 31) * 8;
#pragma unroll
                      for (int q = 0; q < YP_NS; ++q) pv[u][q] = *(const GAS v4u*)(pl + ((size_t)q * YP_ROWS + x * 256 + r) * 1024 + pn * 256 + c8); }
#pragma unroll
                  for (int u = 0; u < 3; ++u) { const int idx = tid + u * NTHR, r = kc + YP_NS * (idx >> 5), c8 = (idx & 31) * 8;
                      { float t[8];
#pragma unroll
                          for (int e = 0; e < 8; ++e) t[e] = 0.f;
#pragma unroll
                          for (int q = 0; q < YP_NS; ++q) { const v4u v = pv[u][q];
                              t[0] += bf_lo(v.x); t[1] += bf_hi(v.x); t[2] += bf_lo(v.y); t[3] += bf_hi(v.y); t[4] += bf_lo(v.z); t[5] += bf_hi(v.z); t[6] += bf_lo(v.w); t[7] += bf_hi(v.w); }
                          v4u o; o.x = pk2(t[0], t[1]); o.y = pk2(t[2], t[3]); o.z = pk2(t[4], t[5]); o.w = pk2(t[6], t[7]);
                          if (idx < nr * 32) *(GAS v4u*)(Ybuf + ((size_t)(256 + x) * 256 + r) * 1024 + pn * 256 + c8) = o; } }
                  __syncthreads();
              } }
        }
        SEAM(pb + 16);
    }
    if (IN(PH_FINAL)) { PHASE_PTRS;
        RowJob J{}; J.xbsrc = XB; J.nw = KA_IN(28); J.outf = xo; if (!(flags & 2)) { J.Y = Ybuf; J.tok_slot = tok_slot; J.top_g = top_g; }
        row_phase(F, J);
    }
#if defined(PROBE_BARWAIT) || defined(PROBE_PHSET)
#ifndef PROBE_BARWAIT
#define PROBE_BARWAIT 0
#endif
#ifndef PROBE_SCALE
#define PROBE_SCALE 0.001f
#endif
#ifndef PROBE_OFFS
#define PROBE_OFFS 0.f
#endif
    if (IN(PH_FINAL)) { PHASE_PTRS; __syncthreads(); asm volatile("s_waitcnt vmcnt(0)" ::: "memory"); if (blockIdx.x == PROBE_BARWAIT && F.wave == 0 && lane_id() == 0) xo[0] += (float)probe_acc * PROBE_SCALE - PROBE_OFFS; }
#endif
#undef IN
#undef SEAM
}
}
extern "C" void kernel_launch(void* const* d_in, const int* in_sizes, int n_in, void* d_out, int out_size, void* d_ws, size_t ws_size, hipStream_t stream) {
    static int grid = 0;
    if (grid == 0) {
        int dev = 0, cus = 0, per_cu = 0;
        (void)hipGetDevice(&dev); (void)hipDeviceGetAttribute(&cus, hipDeviceAttributeMultiprocessorCount, dev);
        (void)hipFuncSetAttribute((const void*)mk::mk_fwd, hipFuncAttributeMaxDynamicSharedMemorySize, mk::LDS_BYTES);
        (void)hipOccupancyMaxActiveBlocksPerMultiprocessor(&per_cu, (const void*)mk::mk_fwd, mk::NTHR, mk::LDS_BYTES);
        (void)hipGetLastError();
        grid = cus > 0 ? cus : 256;
    }
    mk::Args a{}; for (int i = 0; i < 29; ++i) a.in[i] = (const float*)d_in[i];
    a.out = (float*)d_out; a.ws = (unsigned char*)d_ws; a.ph_lo = 0; a.ph_hi = mk::PH_FINAL + 1; a.li = 0; a.flags = 0;
    (void)hipMemsetAsync((unsigned char*)d_ws + mk::F_CTL, 0, mk::CTL_ZERO_BYTES, stream);
    hipLaunchKernelGGL(mk::mk_fwd, dim3(grid), dim3(mk::NTHR), mk::LDS_BYTES, stream, a);
}
```
